# Optimizing an MI355X kernel written in HIP

```python
import math
import jax, jax.numpy as jnp
from jax import lax
import numpy as np

D_MODEL = 2048
BATCH = 8
SEQ = 2048
DEPTH = 1

HEAD_DIM = 128
NSA_HEADS = 8
NSA_KV_HEADS = 2
NSA_GROUP = NSA_HEADS // NSA_KV_HEADS
FOX_HEADS = 4
MEM_HEADS = 4
MEM_TOKENS = 256
CMP_LEN = 32
CMP_STRIDE = 16
SLC_LEN = 64
N_SELECT = 16
WINDOW = 512
Q_BLOCK = 128
NUM_BUCKETS = 32
MAX_DISTANCE = 128
N_BRANCHES = 3
N_EXPERTS = 64
TOP_K = 8
D_EXPERT = 512
ROUTED_SCALE = 2.5
EXPERT_BLOCK = 256
ATTN_SCALE = HEAD_DIM ** -0.5
NEG_INF = -1e30
FORCE_SCORE = 1e4
RMS_EPS = 1e-6

NSA_Q_W = NSA_HEADS * HEAD_DIM
NSA_KV_W = NSA_KV_HEADS * HEAD_DIM
NSA_GATE_W = 3 * NSA_HEADS
FOX_W = FOX_HEADS * HEAD_DIM
MEM_W = MEM_HEADS * HEAD_DIM
MERGE_W = N_BRANCHES * D_MODEL
IN_SPLITS = (NSA_Q_W, NSA_KV_W, NSA_KV_W, NSA_KV_W, NSA_KV_W, NSA_KV_W, NSA_KV_W, NSA_GATE_W,
             FOX_W, FOX_W, FOX_W, FOX_HEADS, MEM_W, MERGE_W)
W_IN_COLS = sum(IN_SPLITS)

kernel_name = "hybrid_nsa_fox_memory_moe_layer"


def rms_norm(x, g):
    xf = x.astype(jnp.float32)
    y = xf * lax.rsqrt(jnp.mean(xf * xf, axis=-1, keepdims=True) + RMS_EPS)
    return (y * g.astype(jnp.float32)).astype(x.dtype)


def masked_softmax(logits, mask):
    z = jnp.where(mask, logits.astype(jnp.float32), NEG_INF)
    return jnp.where(mask, jax.nn.softmax(z, axis=-1), 0.0)


def t5_bucket(rel):
    n = jnp.maximum(rel, 0)
    max_exact = NUM_BUCKETS // 2
    log_ratio = jnp.log(jnp.maximum(n, 1).astype(jnp.float32) / max_exact) / math.log(MAX_DISTANCE / max_exact)
    large = jnp.minimum(max_exact + (log_ratio * (NUM_BUCKETS - max_exact)).astype(jnp.int32), NUM_BUCKETS - 1)
    return jnp.where(n < max_exact, n, large)


def swiglu(x, wg, wu, wd):
    return (jax.nn.silu(x @ wg) * (x @ wu)) @ wd


def split_columns(y, sizes):
    outs, off = [], 0
    for s in sizes:
        outs.append(y[..., off:off + s])
        off += s
    return outs


def nsa_mixer(q, k_cmp, v_cmp, k_slc, v_slc, k_win, v_win, gate_logits,
              pe_k, w_ck, pe_v, w_cv, q_g, k_g, rel_bias):
    B, T = q.shape[:2]
    G, Hg, dk = NSA_KV_HEADS, NSA_GROUP, HEAD_DIM
    nq = T // Q_BLOCK
    tpos = jnp.arange(T)
    garange = jnp.arange(G)
    harange = jnp.arange(Hg)
    bias_gh = rel_bias.T.reshape(G, Hg, NUM_BUCKETS).astype(jnp.float32)
    qg = rms_norm(q, q_g).reshape(B, T, G, Hg, dk)

    n_cmp = (T - CMP_LEN) // CMP_STRIDE + 1
    cstart = jnp.arange(n_cmp) * CMP_STRIDE
    cidx = cstart[:, None] + jnp.arange(CMP_LEN)[None, :]
    kc = jnp.einsum('bnlgd,lde->bnge', k_cmp[:, cidx] + pe_k[:, None, :], w_ck)
    vc = jnp.einsum('bnlgd,lde->bnge', v_cmp[:, cidx] + pe_v[:, None, :], w_cv)
    kc = rms_norm(kc, k_g)
    rel_c = tpos[:, None] - (cstart + CMP_LEN - 1)[None, :]
    bias_c = bias_gh[:, :, t5_bucket(rel_c)]
    logit_c = jnp.einsum('btghd,bngd->bghtn', qg, kc).astype(jnp.float32) * ATTN_SCALE + bias_c
    p_c = masked_softmax(logit_c, rel_c >= 0)
    o_c = jnp.einsum('bghtn,bngd->btghd', p_c.astype(vc.dtype), vc)

    n_slc = T // SLC_LEN
    n_sel = min(N_SELECT, n_slc)
    sstart = jnp.arange(n_slc) * SLC_LEN
    overlap = jnp.clip(jnp.minimum(cstart[:, None] + CMP_LEN, sstart[None, :] + SLC_LEN)
                       - jnp.maximum(cstart[:, None], sstart[None, :]), 0, None)
    imp = jnp.einsum('bghtn,nj->bgtj', p_c, overlap.astype(jnp.float32) / CMP_LEN)
    blk = jnp.arange(n_slc)
    cur = tpos // SLC_LEN
    valid = sstart[None, :] <= tpos[:, None]
    forced = (blk[None, :] == 0) | (blk[None, :] == cur[:, None]) | (blk[None, :] == cur[:, None] - 1)
    score = jnp.where(valid, jnp.where(forced, FORCE_SCORE, imp), -1.0)
    _, sel = lax.top_k(score, n_sel)

    kb = rms_norm(k_slc, k_g).reshape(B, n_slc, SLC_LEN, G, dk)
    vb = v_slc.reshape(B, n_slc, SLC_LEN, G, dk)
    q_items = qg.reshape(B * nq, Q_BLOCK, G, Hg, dk)
    sel_items = sel.transpose(0, 2, 1, 3).reshape(B * nq, Q_BLOCK, G, n_sel)
    larange = jnp.arange(SLC_LEN)

    def slc_block(args):
        q_c, sel_c, c = args
        b = c // nq
        qpos = (c % nq) * Q_BLOCK + jnp.arange(Q_BLOCK)
        kb_b, vb_b = kb[b], vb[b]
        gi = (sel_c[..., None], larange[None, None, None, :], garange[None, :, None, None])
        kg, vg = kb_b[gi], vb_b[gi]
        kpos = sel_c[..., None] * SLC_LEN + larange
        rel = qpos[:, None, None, None] - kpos
        bias = bias_gh[garange[None, :, None, None, None], harange[None, None, :, None, None],
                       t5_bucket(rel)[:, :, None]]
        logits = jnp.einsum('qghd,qgnld->qghnl', q_c, kg).astype(jnp.float32) * ATTN_SCALE + bias
        mask = jnp.broadcast_to((rel >= 0)[:, :, None], logits.shape)
        p = masked_softmax(logits.reshape(Q_BLOCK, G, Hg, -1), mask.reshape(Q_BLOCK, G, Hg, -1))
        p = p.reshape(logits.shape).astype(vg.dtype)
        return jnp.einsum('qghnl,qgnld->qghd', p, vg)

    o_s = lax.map(slc_block, (q_items, sel_items, jnp.arange(B * nq))).reshape(B, T, G, Hg, dk)

    kw_pad = jnp.pad(rms_norm(k_win, k_g), ((0, 0), (WINDOW, 0), (0, 0), (0, 0)))
    vw_pad = jnp.pad(v_win, ((0, 0), (WINDOW, 0), (0, 0), (0, 0)))
    q_blocks = qg.reshape(B, nq, Q_BLOCK, G, Hg, dk).swapaxes(0, 1)

    def win_block(args):
        q_c, i = args
        kw = lax.dynamic_slice_in_dim(kw_pad, i * Q_BLOCK, WINDOW + Q_BLOCK, axis=1)
        vw = lax.dynamic_slice_in_dim(vw_pad, i * Q_BLOCK, WINDOW + Q_BLOCK, axis=1)
        qpos = i * Q_BLOCK + jnp.arange(Q_BLOCK)
        kpos = i * Q_BLOCK - WINDOW + jnp.arange(WINDOW + Q_BLOCK)
        rel = qpos[:, None] - kpos[None, :]
        mask = (kpos >= 0)[None, :] & (rel >= 0) & (rel < WINDOW)
        logits = (jnp.einsum('bqghd,bkgd->bghqk', q_c, kw).astype(jnp.float32) * ATTN_SCALE
                  + bias_gh[:, :, t5_bucket(rel)])
        p = masked_softmax(logits, mask)
        return jnp.einsum('bghqk,bkgd->bqghd', p.astype(vw.dtype), vw)

    o_w = lax.map(win_block, (q_blocks, jnp.arange(nq))).swapaxes(0, 1).reshape(B, T, G, Hg, dk)

    g = jax.nn.sigmoid(gate_logits).reshape(B, T, 3, G, Hg)[..., None]
    o = g[:, :, 0] * o_c + g[:, :, 1] * o_s + g[:, :, 2] * o_w
    return o.reshape(B, T, NSA_Q_W)


def fox_mixer(q, k, v, f_logit, b_f, q_g, k_g):
    B, T = q.shape[:2]
    nq = T // Q_BLOCK
    q = rms_norm(q, q_g)
    k = rms_norm(k, k_g)
    log_f = jax.nn.log_sigmoid(f_logit.astype(jnp.float32) + b_f.astype(jnp.float32))
    cum = jnp.cumsum(log_f, axis=1).transpose(0, 2, 1)
    q_blocks = q.reshape(B, nq, Q_BLOCK, FOX_HEADS, HEAD_DIM).swapaxes(0, 1)
    c_blocks = cum.reshape(B, FOX_HEADS, nq, Q_BLOCK).transpose(2, 0, 1, 3)
    kpos = jnp.arange(T)

    def block(args):
        q_c, c_q, i = args
        qpos = i * Q_BLOCK + jnp.arange(Q_BLOCK)
        logits = (jnp.einsum('bqhd,bkhd->bhqk', q_c, k).astype(jnp.float32) * ATTN_SCALE
                  + (c_q[..., :, None] - cum[:, :, None, :]))
        p = masked_softmax(logits, kpos[None, :] <= qpos[:, None])
        return jnp.einsum('bhqk,bkhd->bqhd', p.astype(v.dtype), v)

    o = lax.map(block, (q_blocks, c_blocks, jnp.arange(nq)))
    return o.swapaxes(0, 1).reshape(B, T, FOX_W)


def memory_attention(q, mem_n, w_kv, q_g, k_g):
    B, M = mem_n.shape[:2]
    kv = (mem_n @ w_kv).reshape(B, M, 2, MEM_HEADS, HEAD_DIM)
    k = rms_norm(kv[:, :, 0], k_g)
    v = kv[:, :, 1]
    q = rms_norm(q, q_g)
    logits = jnp.einsum('bthd,bmhd->bhtm', q, k).astype(jnp.float32) * ATTN_SCALE
    p = jax.nn.softmax(logits, axis=-1)
    return jnp.einsum('bhtm,bmhd->bthd', p.astype(v.dtype), v).reshape(B, -1, MEM_W)


def moe_ffn(h, w_router, router_bias, we_gate, we_up, we_down, ws_gate, ws_up, ws_down):
    Bt, S, D = h.shape
    T = Bt * S
    hf = h.reshape(T, D)
    scores = jax.nn.sigmoid((hf @ w_router).astype(jnp.float32))
    _, top_idx = lax.top_k(scores + router_bias.astype(jnp.float32), TOP_K)
    top_s = jnp.take_along_axis(scores, top_idx, axis=-1)
    gates = top_s / jnp.sum(top_s, axis=-1, keepdims=True) * ROUTED_SCALE
    A = T * TOP_K
    flat_e = top_idx.reshape(A)
    flat_tok = jnp.arange(A, dtype=jnp.int32) // TOP_K
    flat_g = gates.reshape(A)
    order = jnp.argsort(flat_e)
    e_sorted = flat_e[order]
    counts = jnp.bincount(flat_e, length=N_EXPERTS)
    padded = (counts + EXPERT_BLOCK - 1) // EXPERT_BLOCK * EXPERT_BLOCK
    start = jnp.cumsum(counts) - counts
    pstart = jnp.cumsum(padded) - padded
    dest = pstart[e_sorted] + jnp.arange(A) - start[e_sorted]
    nb = (A + N_EXPERTS * (EXPERT_BLOCK - 1)) // EXPERT_BLOCK
    P = nb * EXPERT_BLOCK
    slot_tok = jnp.full((P,), T, jnp.int32).at[dest].set(flat_tok[order])
    slot_g = jnp.zeros((P,), hf.dtype).at[dest].set(flat_g[order].astype(hf.dtype))
    block_end = jnp.cumsum(padded) // EXPERT_BLOCK
    block_expert = jnp.minimum(jnp.searchsorted(block_end, jnp.arange(nb), side='right'), N_EXPERTS - 1)
    h_pad = jnp.concatenate([hf, jnp.zeros((1, D), hf.dtype)], axis=0)

    def step(acc, blk):
        tok, g, e = blk
        yb = swiglu(h_pad[tok], we_gate[e], we_up[e], we_down[e]) * g[:, None]
        return acc.at[tok].add(yb), None

    acc, _ = lax.scan(step, jnp.zeros((T + 1, D), hf.dtype),
                      (slot_tok.reshape(nb, EXPERT_BLOCK), slot_g.reshape(nb, EXPERT_BLOCK), block_expert))
    out = acc[:T] + swiglu(hf, ws_gate, ws_up, ws_down)
    return out.reshape(Bt, S, D)


def setup_inputs(seed: int = 0) -> dict:
    key = jax.random.key(seed)
    ks = iter(jax.random.split(key, 40))

    def nrm(shape, scale):
        return jax.random.normal(next(ks), shape, jnp.float32) * scale

    def gain(shape):
        return 1.0 + nrm(shape, 0.02)

    L = DEPTH
    return {
        "x": nrm((BATCH, SEQ, D_MODEL), 1.0),
        "mem": nrm((BATCH, MEM_TOKENS, D_MODEL), 1.0),
        "norm_attn_g": gain((L, D_MODEL)),
        "w_in": nrm((L, D_MODEL, W_IN_COLS), D_MODEL ** -0.5),
        "nsa_pe_k": nrm((L, CMP_LEN, HEAD_DIM), 0.02),
        "nsa_w_ck": nrm((L, CMP_LEN, HEAD_DIM, HEAD_DIM), (CMP_LEN * HEAD_DIM) ** -0.5),
        "nsa_pe_v": nrm((L, CMP_LEN, HEAD_DIM), 0.02),
        "nsa_w_cv": nrm((L, CMP_LEN, HEAD_DIM, HEAD_DIM), (CMP_LEN * HEAD_DIM) ** -0.5),
        "nsa_q_g": gain((L, HEAD_DIM)),
        "nsa_k_g": gain((L, HEAD_DIM)),
        "rel_bias": nrm((NUM_BUCKETS, NSA_HEADS), 0.2),
        "fox_b_f": jnp.linspace(3.0, 6.0, FOX_HEADS)[None, :] + nrm((L, FOX_HEADS), 0.1),
        "fox_q_g": gain((L, HEAD_DIM)),
        "fox_k_g": gain((L, HEAD_DIM)),
        "norm_mem_g": gain((L, D_MODEL)),
        "w_mem_kv": nrm((L, D_MODEL, 2 * MEM_W), D_MODEL ** -0.5),
        "mem_q_g": gain((L, HEAD_DIM)),
        "mem_k_g": gain((L, HEAD_DIM)),
        "w_o_nsa": nrm((L, NSA_Q_W, D_MODEL), NSA_Q_W ** -0.5),
        "w_o_fox": nrm((L, FOX_W, D_MODEL), FOX_W ** -0.5),
        "w_o_mem": nrm((L, MEM_W, D_MODEL), MEM_W ** -0.5),
        "w_out": nrm((L, D_MODEL, D_MODEL), D_MODEL ** -0.5),
        "norm_ffn_g": gain((L, D_MODEL)),
        "w_router": nrm((L, D_MODEL, N_EXPERTS), D_MODEL ** -0.5),
        "router_bias": nrm((L, N_EXPERTS), 0.01),
        "we_gate": nrm((L, N_EXPERTS, D_MODEL, D_EXPERT), D_MODEL ** -0.5),
        "we_up": nrm((L, N_EXPERTS, D_MODEL, D_EXPERT), D_MODEL ** -0.5),
        "we_down": nrm((L, N_EXPERTS, D_EXPERT, D_MODEL), D_EXPERT ** -0.5),
        "ws_gate": nrm((L, D_MODEL, D_EXPERT), D_MODEL ** -0.5),
        "ws_up": nrm((L, D_MODEL, D_EXPERT), D_MODEL ** -0.5),
        "ws_down": nrm((L, D_EXPERT, D_MODEL), D_EXPERT ** -0.5),
    }


def reference(x, mem, norm_attn_g, w_in, nsa_pe_k, nsa_w_ck, nsa_pe_v, nsa_w_cv, nsa_q_g, nsa_k_g,
              rel_bias, fox_b_f, fox_q_g, fox_k_g, norm_mem_g, w_mem_kv, mem_q_g, mem_k_g,
              w_o_nsa, w_o_fox, w_o_mem, w_out, norm_ffn_g, w_router, router_bias,
              we_gate, we_up, we_down, ws_gate, ws_up, ws_down):
    B, T = x.shape[:2]

    def heads(y, n):
        return y.reshape(B, y.shape[1], n, HEAD_DIM)

    for l in range(DEPTH):
        h = rms_norm(x, norm_attn_g[l])
        proj = h @ w_in[l]
        (q_nsa, k_cmp, v_cmp, k_slc, v_slc, k_win, v_win, nsa_gate,
         fox_q, fox_k, fox_v, fox_f, mem_q, merge_logits) = split_columns(proj, IN_SPLITS)

        o_nsa = nsa_mixer(heads(q_nsa, NSA_HEADS), heads(k_cmp, NSA_KV_HEADS), heads(v_cmp, NSA_KV_HEADS),
                          heads(k_slc, NSA_KV_HEADS), heads(v_slc, NSA_KV_HEADS),
                          heads(k_win, NSA_KV_HEADS), heads(v_win, NSA_KV_HEADS), nsa_gate,
                          nsa_pe_k[l], nsa_w_ck[l], nsa_pe_v[l], nsa_w_cv[l], nsa_q_g[l], nsa_k_g[l], rel_bias)
        o_fox = fox_mixer(heads(fox_q, FOX_HEADS), heads(fox_k, FOX_HEADS), heads(fox_v, FOX_HEADS),
                          fox_f, fox_b_f[l], fox_q_g[l], fox_k_g[l])
        o_mem = memory_attention(heads(mem_q, MEM_HEADS), rms_norm(mem, norm_mem_g[l]), w_mem_kv[l],
                                 mem_q_g[l], mem_k_g[l])

        g = jax.nn.sigmoid(merge_logits).reshape(B, T, N_BRANCHES, D_MODEL)
        z = (g[:, :, 0] * (o_nsa @ w_o_nsa[l]) + g[:, :, 1] * (o_fox @ w_o_fox[l])
             + g[:, :, 2] * (o_mem @ w_o_mem[l]))
        x = x + z @ w_out[l]

        x = x + moe_ffn(rms_norm(x, norm_ffn_g[l]), w_router[l], router_bias[l], we_gate[l], we_up[l],
                        we_down[l], ws_gate[l], ws_up[l], ws_down[l])
    return x
```

```cpp
#include <hip/hip_runtime.h>
#include <cstdio>
#include <cstdint>

#define LAS __attribute__((address_space(3)))
#define GAS __attribute__((address_space(1)))
typedef unsigned short bf16_t;
typedef short bf16x8 __attribute__((ext_vector_type(8)));
typedef short s16x4 __attribute__((ext_vector_type(4)));
typedef float f32x2 __attribute__((ext_vector_type(2)));
typedef float f32x4 __attribute__((ext_vector_type(4)));
typedef float f32x16 __attribute__((ext_vector_type(16)));
typedef unsigned u32x2 __attribute__((ext_vector_type(2)));
typedef unsigned u32x4 __attribute__((ext_vector_type(4)));
typedef GAS unsigned gu32;

constexpr int NB = 8, T = 2048, D = 2048, M = NB * T;
constexpr int HD = 128;
constexpr int MEMT = 256, MROWS = NB * MEMT;
constexpr int NE = 64, TOPK = 8, DE = 512, NEX = NE + 1;
constexpr int W_IN_COLS = 10780;
constexpr int NPA = 4608, NPG = 6144, NPAD = 11008;
constexpr int LDG = 32;
constexpr float RMS_EPS = 1e-6f;
constexpr float LOG2E = 1.4426950408889634f;
constexpr float ATTN_SCALE = 0.08838834764831845f;
constexpr int CQ_NSA = 0, CK_CMP = 1024, CV_CMP = 1280, CK_SLC = 1536, CV_SLC = 1792, CK_WIN = 2048, CV_WIN = 2304;
constexpr int CQ_FOX = 2560, CK_FOX = 3072, CV_FOX = 3584, CQ_MEM = 4096;
constexpr int ASG_PER_TOK = 9;
constexpr int MAXSLOT = M * TOPK + NE * 256 + M;

constexpr size_t MiB = 1u << 20;
constexpr size_t WS_CTL = 0, CTL_ZERO_BYTES = 1 * MiB;
constexpr size_t WS_GL = 1 * MiB;
constexpr size_t WS_KVMEM = 3 * MiB;
constexpr size_t WS_KC = 7 * MiB, WS_VC = WS_KC + 512 * 1024;
constexpr size_t WS_CUM = 8 * MiB;
constexpr size_t WS_CBIAS = WS_CUM + 256 * 1024;
constexpr size_t WS_HIST = WS_CUM + 512 * 1024;
constexpr size_t WS_ASG = 9 * MiB;
constexpr size_t WS_ROWASG = 10 * MiB;
constexpr size_t WS_ROWG = 11 * MiB;
constexpr size_t WS_CNT = 12 * MiB;
constexpr size_t WS_WRT = 12 * MiB + 256 * 1024;
constexpr size_t WS_WCK = 13 * MiB, WS_WCV = 14 * MiB;
constexpr size_t WS_WOT = 16 * MiB;
constexpr size_t WS_WOUTT = 24 * MiB;
constexpr size_t WS_WD = 32 * MiB;
constexpr size_t WS_PG = WS_WD + (size_t)NEX * 2 * MiB;
constexpr size_t WS_Y = WS_PG + 192 * MiB;
constexpr size_t WS_WGU = WS_Y;
constexpr size_t WS_WINT = WS_WGU + (size_t)NEX * 4 * MiB;
constexpr size_t WS_PA = WS_WINT + 47 * MiB;
constexpr size_t WS_A3 = WS_PA + 144 * MiB;
constexpr size_t WS_WIN8 = WS_Y + 578 * MiB;
constexpr size_t WS_H8 = WS_WIN8 + 24 * MiB;
constexpr size_t WS_END = WS_H8 + 32 * MiB;
constexpr size_t WS_X1B = WS_PA + 64 * MiB;
static_assert(WS_A3 + (size_t)(M + MROWS) * D * 2 <= WS_Y + 576 * MiB, "ws map");
static_assert((size_t)MAXSLOT * DE * 2 <= 192 * MiB, "hid fits projG");
static_assert((size_t)MAXSLOT * 4 <= 1 * MiB, "row tables");

constexpr int CW_BAR = 4096;
constexpr int CW_QUEUE = 8192;

constexpr int RING_BYTES = 131072;
constexpr int LDSCTL_OFF = RING_BYTES;
constexpr int EPI_OFF = RING_BYTES + 1024;
constexpr int LDS_BYTES = RING_BYTES + 1024 + 8192 + 4096;

#define RLX_AGENT __ATOMIC_RELAXED, __HIP_MEMORY_SCOPE_AGENT
__device__ __forceinline__ unsigned cvtpk(float lo, float hi) { unsigned r; asm volatile("v_cvt_pk_bf16_f32 %0, %1, %2" : "=v"(r) : "v"(lo), "v"(hi)); return r; }
__device__ __forceinline__ float bf_lo(unsigned u) { return __uint_as_float(u << 16); }
__device__ __forceinline__ float bf_hi(unsigned u) { return __uint_as_float(u & 0xffff0000u); }
__device__ __forceinline__ float wave_sum(float v) {
#pragma unroll
    for (int o = 1; o < 64; o <<= 1) v += __shfl_xor(v, o);
    return v;
}
constexpr float WGU_SCALE = 32.f, WD_SCALE = 16.f, WIN_SCALE = 32.f;
__device__ __forceinline__ unsigned pk_fp8x4(float a, float b, float c, float d) { int w = 0; w = __builtin_amdgcn_cvt_pk_fp8_f32(a, b, w, false); w = __builtin_amdgcn_cvt_pk_fp8_f32(c, d, w, true); return (unsigned)w; }
__device__ __forceinline__ float fast_sigmoid(float x) { return __builtin_amdgcn_rcpf(1.f + __builtin_amdgcn_exp2f(-x * LOG2E)); }

#define XB_TMO      128
#define XB_XCNT(j)  (256  + 64 * (j))
#define XB_XSUB(j)  (1280 + 64 * (j))
#define XB_XGEN(j)  (2304 + 64 * (j))
#define XB_TOP      3328
#define XB_TOPGEN   3392
#define XCD_BAR_WORDS 3456
#define XB_SPIN_CAP (1u << 18)
__device__ __forceinline__ unsigned xb_ld(unsigned* p)              { return __hip_atomic_load(p, __ATOMIC_RELAXED, __HIP_MEMORY_SCOPE_AGENT); }
__device__ __forceinline__ unsigned xb_add(unsigned* p, unsigned v) { return __hip_atomic_fetch_add(p, v, __ATOMIC_RELAXED, __HIP_MEMORY_SCOPE_AGENT); }
__device__ __forceinline__ unsigned xb_xcc_id() { return (unsigned)__builtin_amdgcn_s_getreg((3 << 11) | 20) & 0xFu; }
#define XB_SPIN(cond, bar) do { unsigned _sp = 0; while (cond) { __builtin_amdgcn_s_sleep(1); \
    if ((++_sp & 255u) == 0u) { if (xb_ld(&(bar)[XB_TMO])) break; if (_sp > XB_SPIN_CAP) { atomicAdd(&(bar)[XB_TMO], 1u); break; } } } } while (0)
struct XcdBarrier { unsigned* bar; unsigned x; volatile LAS unsigned* st; };
__device__ __forceinline__ XcdBarrier xcd_barrier_post(unsigned* bar, volatile LAS unsigned* st) {
    XcdBarrier b; b.bar = bar; b.x = xb_xcc_id(); b.st = st;
    if (threadIdx.x == 0) (void)xb_add(&bar[XB_XCNT(b.x)], 1u);
    return b;
}
__device__ __forceinline__ void xcd_barrier_complete(unsigned* bar, unsigned x, unsigned& nloc, unsigned& nx) {
    const unsigned G = gridDim.x * gridDim.y * gridDim.z;
    unsigned sum, cnt, mine, sp = 0u;
    for (;;) {
        sum = 0u; cnt = 0u; mine = 0u;
#pragma unroll
        for (unsigned j = 0; j < 16; ++j) { const unsigned c = xb_ld(&bar[XB_XCNT(j)]); sum += c; cnt += (c > 0u) ? 1u : 0u; mine = (j == x) ? c : mine; }
        if (sum == G) break;
        __builtin_amdgcn_s_sleep(1);
        if ((++sp & 255u) == 0u) { if (xb_ld(&bar[XB_TMO])) break; if (sp > XB_SPIN_CAP) { atomicAdd(&bar[XB_TMO], 1u); break; } }
    }
    nloc = mine > 0u ? mine : 1u; nx = cnt > 0u ? cnt : 1u;
}
__device__ __forceinline__ void xcd_barrier(const XcdBarrier& b) {
    asm volatile("s_waitcnt vmcnt(0)" ::: "memory");
    __syncthreads();
    if (threadIdx.x == 0) {
        unsigned* bar = b.bar;
        __builtin_amdgcn_s_waitcnt(0);
        unsigned nloc = b.st[0], nx = b.st[1];
        if (nloc == 0u) { xcd_barrier_complete(bar, b.x, nloc, nx); b.st[0] = nloc; b.st[1] = nx; }
        const unsigned old = xb_add(&bar[XB_XSUB(b.x)], 1u);
        const unsigned gen = old / nloc;
        if (old + 1u == (gen + 1u) * nloc) {
            __builtin_amdgcn_fence(__ATOMIC_RELEASE, "agent");
            asm volatile("s_waitcnt vmcnt(0)" ::: "memory");
            const unsigned og = xb_add(&bar[XB_TOP], 1u);
            const unsigned tg = og / nx;
            if (og + 1u == (tg + 1u) * nx) xb_add(&bar[XB_TOPGEN], 1u);
            else XB_SPIN(xb_ld(&bar[XB_TOPGEN]) == tg, bar);
            __builtin_amdgcn_fence(__ATOMIC_ACQUIRE, "agent");
            xb_add(&bar[XB_XGEN(b.x)], 1u);
            asm volatile("s_waitcnt vmcnt(0)" ::: "memory");
        } else {
            XB_SPIN(xb_ld(&bar[XB_XGEN(b.x)]) == gen, bar);
            __builtin_amdgcn_fence(__ATOMIC_ACQUIRE, "agent");
            asm volatile("s_waitcnt vmcnt(0)" ::: "memory");
        }
    }
    __syncthreads();
}

namespace pg8 {
constexpr int BM = 256, BK = 64, HALF = 128, HTB = HALF * BK * 2, STAGE_BYTES = 8 * HTB, NXCD = 8, WGM = 8;
__host__ __device__ __forceinline__ int lds_byte(int r, int c) { const int st = (r >> 4) * 2 + (c >> 5), rr = r & 15, cc = c & 31, ob = rr * 64 + cc * 2; return st * 1024 + (ob ^ (((ob >> 9) & 1) << 5)); }
__host__ __device__ __forceinline__ void stage_rc(int b, int& R, int& C) { const int st = b / 1024, sb = b % 1024, swz = sb ^ (((sb >> 9) & 1) << 5); R = (st >> 1) * 16 + swz / 64; C = (st & 1) * 32 + (swz % 64) / 2; }
__host__ __device__ __forceinline__ int perm32(int rho) { const int n = rho >> 4, i = rho & 15; return 8 * (i >> 2) + 4 * n + (i & 3); }

template <bool FP8> struct FragSel { struct A4 { bf16x8 f[4][2]; }; struct B2 { bf16x8 f[2][2]; }; };
template <> struct FragSel<true> { typedef int v8i_ __attribute__((ext_vector_type(8))); struct A4 { v8i_ f[4]; }; struct B2 { v8i_ f[2]; }; };
struct Unit { const char* A; const char* B; const int* ridx; int nt, pm, pn, aux; };

template <class Epi, class Sched, bool GATHER, bool FP8 = false>
__device__ __forceinline__ void gemm_phase(LAS unsigned char* lds, const int lda, const int ldb, const Sched& S, const Epi& E) {
    const int tid = threadIdx.x, wid = __builtin_amdgcn_readfirstlane(tid >> 6), lane = tid & 63, wr = wid >> 2, wc = wid & 3, fr = lane & 15, fq = lane >> 4;
    unsigned voffA[2], voffB[2]; int RA[2], CA[2];
#pragma unroll
    for (int i = 0; i < 2; ++i) { int R, C; stage_rc(tid * 16 + i * 8192, R, C); const int Rb = (R & ~31) + perm32(R & 31);
        RA[i] = R; CA[i] = C; voffA[i] = (unsigned)(R * lda + 2 * C); voffB[i] = (unsigned)(Rb * ldb + 2 * C); }
    const size_t kstep = (size_t)(BK * 2);
    const size_t hstepA = (size_t)HALF * lda, hstepB = (size_t)HALF * ldb;
    const unsigned ldsw = (unsigned)wid * 1024u;
    const int aoff = lds_byte(wr * 64 + fr, fq * 8), boff = lds_byte(wc * 32 + fr, fq * 8);
#define PG8_SA(b, h) (((b) * 2 + (h)) * HTB)
#define PG8_SB(b, h) ((4 + (b) * 2 + (h)) * HTB)
#define PG8_STG(bufoff, gptr, v0, v1) do { \
        __builtin_amdgcn_global_load_lds((const unsigned*)((const char*)(gptr) + (v0)), (LAS unsigned*)(lds + (bufoff) + ldsw), 16, 0, 0); \
        __builtin_amdgcn_global_load_lds((const unsigned*)((const char*)(gptr) + (v1)), (LAS unsigned*)(lds + (bufoff) + ldsw + 8192), 16, 0, 0); } while (0)
#define PG8_STB(b, h, kp) PG8_STG(PG8_SB(b, h), (kp) + (h) * hstepB, voffB[0], voffB[1])
#define PG8_STA_CUR(b, h, kp) do { if constexpr (GATHER) PG8_STG(PG8_SA(b, h), (kp), vg[h][0], vg[h][1]); else PG8_STG(PG8_SA(b, h), (kp) + (h) * hstepA, voffA[0], voffA[1]); } while (0)
#define PG8_STA_SEL(b, h, kp) do { if constexpr (GATHER) { const unsigned s0_ = last ? nvg[h][0] : vg[h][0], s1_ = last ? nvg[h][1] : vg[h][1]; PG8_STG(PG8_SA(b, h), (kp), s0_, s1_); } \
        else PG8_STG(PG8_SA(b, h), (kp) + (h) * hstepA, voffA[0], voffA[1]); } while (0)
#define PG8_LD16(off) (*(const LAS u32x4*)(lds + (off)))
#define PG8_LDA(dst, b, h) do { _Pragma("unroll") for (int m = 0; m < 4; ++m) { if constexpr (FP8) { const u32x4 lo_ = PG8_LD16(PG8_SA(b, h) + aoff + m * 2048), hi_ = PG8_LD16(PG8_SA(b, h) + aoff + m * 2048 + 1024); \
            dst.f[m] = __builtin_bit_cast(v8i_, __builtin_shufflevector(lo_, hi_, 0, 1, 2, 3, 4, 5, 6, 7)); } \
        else { _Pragma("unroll") for (int k = 0; k < 2; ++k) dst.f[m][k] = *(const LAS bf16x8*)(lds + PG8_SA(b, h) + aoff + m * 2048 + k * 1024); } } } while (0)
#define PG8_LDB(dst, b, h) do { _Pragma("unroll") for (int n = 0; n < 2; ++n) { if constexpr (FP8) { const u32x4 lo_ = PG8_LD16(PG8_SB(b, h) + boff + n * 2048), hi_ = PG8_LD16(PG8_SB(b, h) + boff + n * 2048 + 1024); \
            dst.f[n] = __builtin_bit_cast(v8i_, __builtin_shufflevector(lo_, hi_, 0, 1, 2, 3, 4, 5, 6, 7)); } \
        else { _Pragma("unroll") for (int k = 0; k < 2; ++k) dst.f[n][k] = *(const LAS bf16x8*)(lds + PG8_SB(b, h) + boff + n * 2048 + k * 1024); } } } while (0)
#define PG8_MMA(ai, bj, At, Bt) do { __builtin_amdgcn_s_setprio(1); _Pragma("unroll") for (int m = 0; m < 4; ++m) _Pragma("unroll") for (int n = 0; n < 2; ++n) { \
        if constexpr (FP8) asm volatile("v_mfma_scale_f32_16x16x128_f8f6f4 %0, %1, %2, %0, %3, %3 op_sel_hi:[0,0,0]" : "+v"(acc[ai][bj][m][n]) : "v"(Bt.f[n]), "v"(At.f[m]), "v"(fp8_one)); \
        else { _Pragma("unroll") for (int k = 0; k < 2; ++k) acc[ai][bj][m][n] = __builtin_amdgcn_mfma_f32_16x16x32_bf16(Bt.f[n][k], At.f[m][k], acc[ai][bj][m][n], 0, 0, 0); } } \
        __builtin_amdgcn_s_setprio(0); } while (0)
#define PG8_WAIT_V(n) asm volatile("s_waitcnt vmcnt(" #n ")" ::: "memory")
#define PG8_WAIT_L(n) asm volatile("s_waitcnt lgkmcnt(" #n ")" ::: "memory")
#define PG8_BAR __builtin_amdgcn_s_barrier()
#define PG8_SCHED __builtin_amdgcn_sched_barrier(0)
#define PG8_LOADIDX(dst, u) do { if constexpr (GATHER) { _Pragma("unroll") for (int h = 0; h < 2; ++h) _Pragma("unroll") for (int i = 0; i < 2; ++i) \
        dst[h][i] = (unsigned)(u).ridx[h * HALF + RA[i]] * (unsigned)lda + (unsigned)(CA[i] * 2); } } while (0)
    Unit cur, nxt; int ui = 0;
    if (!S.next(0, cur)) return;
#define PG8_PIN_ACC() do { _Pragma("unroll") for (int a_ = 0; a_ < 2; ++a_) _Pragma("unroll") for (int b_ = 0; b_ < 2; ++b_) \
        asm volatile("" : "+v"(acc[a_][b_][0][0]), "+v"(acc[a_][b_][0][1]), "+v"(acc[a_][b_][1][0]), "+v"(acc[a_][b_][1][1]), "+v"(acc[a_][b_][2][0]), "+v"(acc[a_][b_][2][1]), "+v"(acc[a_][b_][3][0]), "+v"(acc[a_][b_][3][1])); } while (0)

    f32x4 acc[2][2][4][2];
    E.init(acc, cur, wr, wc, fr, fq);
    typedef int v8i_ __attribute__((ext_vector_type(8)));
    typedef typename pg8::FragSel<FP8>::A4 FragA; typedef typename pg8::FragSel<FP8>::B2 FragB;
    FragA At; FragB B0, B1;
    int fp8_one = 0x7f7f7f7f; if constexpr (FP8) asm volatile("" : "+v"(fp8_one));
    unsigned vg[2][2] = {{0u, 0u}, {0u, 0u}}, nvg[2][2] = {{0u, 0u}, {0u, 0u}};
    const char* cA = cur.A; const char* cB = cur.B;
    PG8_LOADIDX(vg, cur);
    { const bool last = false; (void)last;
      PG8_STB(0, 0, cB); PG8_STB(0, 1, cB); PG8_STA_CUR(0, 0, cA); PG8_STA_CUR(0, 1, cA);
      if (wr == 1) PG8_BAR;
      PG8_WAIT_V(2); PG8_BAR;
      PG8_STB(1, 0, cB + kstep); PG8_STA_CUR(1, 0, cA + kstep); PG8_STB(1, 1, cB + kstep);
      PG8_WAIT_V(6); PG8_BAR; }
    if constexpr (Epi::INIT_LOADS) PG8_PIN_ACC();
    for (;;) {
        const bool has_next = S.next(ui + 1, nxt);
        const char* nA = has_next ? nxt.A : cA; const char* nB = has_next ? nxt.B : cB;
        if constexpr (GATHER) { if (has_next) { PG8_LOADIDX(nvg, nxt); } else { nvg[0][0] = vg[0][0]; nvg[0][1] = vg[0][1]; nvg[1][0] = vg[1][0]; nvg[1][1] = vg[1][1]; } }
        const int nt = cur.nt;
        for (int t = 0; t < nt; t += 2) {
            const bool last = (t == nt - 2);
            const char* a1 = cA + (size_t)(t + 1) * kstep;
            const char* a2 = last ? nA : cA + (size_t)(t + 2) * kstep; const char* b2 = last ? nB : cB + (size_t)(t + 2) * kstep;
            const char* a3 = a2 + kstep; const char* b3 = b2 + kstep;
            PG8_LDB(B0, 0, 0); PG8_LDB(B1, 0, 1); PG8_SCHED; PG8_LDA(At, 0, 0); PG8_STA_CUR(1, 1, a1);
            PG8_WAIT_V(8); PG8_WAIT_L(0); PG8_BAR; PG8_MMA(0, 0, At, B0); PG8_MMA(0, 1, At, B1); PG8_BAR; PG8_SCHED;
            PG8_LDA(At, 0, 1); PG8_STB(0, 0, b2); PG8_STB(0, 1, b2); PG8_STA_SEL(0, 0, a2);
            PG8_WAIT_V(8); PG8_WAIT_L(0); PG8_BAR; PG8_MMA(1, 0, At, B0); PG8_MMA(1, 1, At, B1); PG8_BAR; PG8_SCHED;
            PG8_LDB(B0, 1, 0); PG8_LDB(B1, 1, 1); PG8_SCHED; PG8_LDA(At, 1, 0); PG8_STA_SEL(0, 1, a2);
            PG8_WAIT_V(8); PG8_WAIT_L(0); PG8_BAR; PG8_MMA(0, 0, At, B0); PG8_MMA(0, 1, At, B1); PG8_BAR; PG8_SCHED;
            PG8_LDA(At, 1, 1); PG8_STB(1, 0, b3); PG8_STB(1, 1, b3); PG8_STA_SEL(1, 0, a3);
            PG8_WAIT_V(8); PG8_WAIT_L(0); PG8_BAR; PG8_MMA(1, 0, At, B0); PG8_MMA(1, 1, At, B1); PG8_BAR; PG8_SCHED;
        }
        if (wr == 0) PG8_BAR;
        if constexpr (FP8) { asm volatile("s_nop 15\n\ts_nop 15\n\ts_nop 15" ::: "memory"); PG8_PIN_ACC(); }
        E(acc, cur, wr, wc, fr, fq);
        if (!has_next) break;
        E.init(acc, nxt, wr, wc, fr, fq);
        if constexpr (Epi::INIT_LOADS) PG8_PIN_ACC();
        cur = nxt; cA = nA; cB = nB; ++ui;
        if constexpr (GATHER) { vg[0][0] = nvg[0][0]; vg[0][1] = nvg[0][1]; vg[1][0] = nvg[1][0]; vg[1][1] = nvg[1][1]; }
        if (wr == 1) PG8_BAR;
    }
    PG8_WAIT_V(0);
    PG8_BAR;
#undef PG8_SA
#undef PG8_SB
#undef PG8_STG
#undef PG8_STB
#undef PG8_STA_CUR
#undef PG8_STA_SEL
#undef PG8_LDA
#undef PG8_LD16
#undef PG8_LDB
#undef PG8_MMA
#undef PG8_WAIT_V
#undef PG8_WAIT_L
#undef PG8_BAR
#undef PG8_SCHED
#undef PG8_LOADIDX
#undef PG8_PIN_ACC
}
}

#define EPI_ZERO_INIT static constexpr bool INIT_LOADS = false; __device__ __forceinline__ void init(f32x4 (&acc)[2][2][4][2], const pg8::Unit&, int, int, int, int) const { \
        _Pragma("unroll") for (int a = 0; a < 2; ++a) _Pragma("unroll") for (int b = 0; b < 2; ++b) _Pragma("unroll") for (int m = 0; m < 4; ++m) _Pragma("unroll") for (int n = 0; n < 2; ++n) acc[a][b][m][n] = (f32x4){0.f, 0.f, 0.f, 0.f}; }
constexpr size_t WS_ROWTOK = 15 * MiB;
struct TileOrder {
    int nM, nN, nwg;
    __device__ __forceinline__ void init(int nM_, int nN_) { nM = nM_; nN = nN_; nwg = nM_ * nN_; }
    __device__ __forceinline__ void decode(int L, int& pm, int& pn) const {
        int wgid = L; { const int q = nwg / pg8::NXCD, r = nwg % pg8::NXCD, xcd = wgid % pg8::NXCD, off = wgid / pg8::NXCD; wgid = (xcd < r ? xcd * (q + 1) : r * (q + 1) + (xcd - r) * q) + off; }
        const int nig = pg8::WGM * nN, gid = wgid / nig, fm = gid * pg8::WGM, gsz = (nM - fm) < pg8::WGM ? (nM - fm) : pg8::WGM;
        pm = fm + ((wgid % nig) % gsz); pn = (wgid % nig) / gsz;
    }
};
#ifndef P1_FP8_MASK
#define P1_FP8_MASK 0x3FFFFu
#endif
constexpr unsigned FP8M = P1_FP8_MASK & 0x3ffffu;
constexpr int NF8 = __builtin_popcount(FP8M), NB16 = 18 - NF8;
__device__ __forceinline__ int nth_set(unsigned m, int n) { for (int i = 0; i < n; ++i) m &= m - 1; return __builtin_ctz(m); }
struct Sched1 {
    TileOrder o; const char* A; const char* Bt; int G, c, fp8;
    __device__ __forceinline__ bool next(int i, pg8::Unit& u) const {
        const int L = i * G + c; int pm, pn;
        if (fp8) { constexpr int NT8 = 64 * (24 + NF8), NBU = 64 * (NB16 + 1) + 32;
            int L8 = L;
            if (NBU < G) { const int RB = NT8 / G, rem = NT8 - RB * G, nfree = G - NBU;
                if (i >= RB) { const int idx = (c - NBU) + (i - RB) * nfree; if (c < NBU || idx >= rem) return false; L8 = RB * G + idx; } }
            if (L8 >= NT8) return false; o.decode(L8, pm, pn);
            u.A = A + (size_t)pm * 256 * D; u.B = Bt + (size_t)pn * 256 * D; u.nt = D / 128; pn = pn < 24 ? pn + 18 : nth_set(FP8M, pn - 24); u.aux = 1; }
        else { if (L < 64 * (NB16 + 1)) { o.decode(L, pm, pn); pn = pn == NB16 ? 42 : nth_set(~FP8M & 0x3ffffu, pn); } else if (L < 64 * (NB16 + 1) + 32) { const int r = L - 64 * (NB16 + 1); pm = 64 + (r >> 2); pn = 43 + (r & 3); } else return false;
            u.A = A + (size_t)pm * 256 * D * 2; u.B = Bt + (size_t)pn * 256 * D * 2; u.nt = D / 64; u.aux = 0; }
        u.ridx = nullptr; u.pm = pm; u.pn = pn; return true;
    }
};
struct Epi1 {
    EPI_ZERO_INIT
    bf16_t* PA; unsigned char* PG8; float* GL; bf16_t* KVM;
    __device__ __forceinline__ void operator()(const f32x4 (&acc)[2][2][4][2], const pg8::Unit& u, int wr, int wc, int fr, int fq) const {
        const int pn = u.pn; int row0 = u.pm * 256 + wr * 64 + fr;
        if (pn == 42) {
            if (wc == 0) {
#pragma unroll
                for (int ai = 0; ai < 2; ++ai)
#pragma unroll
                    for (int m = 0; m < 4; ++m) { float* p = GL + (size_t)(row0 + ai * 128 + m * 16) * LDG + 8 * fq; *(f32x4*)p = acc[ai][0][m][0]; *(f32x4*)(p + 4) = acc[ai][0][m][1]; }
            }
            return;
        }
        if (pn >= 18 && pn < 42) {
            unsigned char* gb = PG8 + (pn - 18) * 256 + wc * 32 + 8 * fq;
#pragma unroll
            for (int ai = 0; ai < 2; ++ai)
#pragma unroll
                for (int m = 0; m < 4; ++m) { unsigned char* rowp = gb + (size_t)(row0 + ai * 128 + m * 16) * NPG;
#pragma unroll
                    for (int bj = 0; bj < 2; ++bj) { const f32x4 v0 = acc[ai][bj][m][0] * (1.f / WIN_SCALE), v1 = acc[ai][bj][m][1] * (1.f / WIN_SCALE); unsigned w0 = 0u, w1 = 0u;
                        w0 = __builtin_amdgcn_cvt_pk_u8_f32(fast_sigmoid(v0[0]) * 255.f, 0, w0); w0 = __builtin_amdgcn_cvt_pk_u8_f32(fast_sigmoid(v0[1]) * 255.f, 1, w0);
                        w0 = __builtin_amdgcn_cvt_pk_u8_f32(fast_sigmoid(v0[2]) * 255.f, 2, w0); w0 = __builtin_amdgcn_cvt_pk_u8_f32(fast_sigmoid(v0[3]) * 255.f, 3, w0);
                        w1 = __builtin_amdgcn_cvt_pk_u8_f32(fast_sigmoid(v1[0]) * 255.f, 0, w1); w1 = __builtin_amdgcn_cvt_pk_u8_f32(fast_sigmoid(v1[1]) * 255.f, 1, w1);
                        w1 = __builtin_amdgcn_cvt_pk_u8_f32(fast_sigmoid(v1[2]) * 255.f, 2, w1); w1 = __builtin_amdgcn_cvt_pk_u8_f32(fast_sigmoid(v1[3]) * 255.f, 3, w1);
                        *(u32x2*)(rowp + bj * 128) = (u32x2){w0, w1}; } }
            return;
        }
        bf16_t* base; int ld;
        if (pn < 18) { base = PA + pn * 256; ld = NPA; }
        else { base = KVM + (pn - 43) * 256; ld = 1024; row0 -= M; }
        base += wc * 32 + 8 * fq;
        const float sc = u.aux ? 1.f / WIN_SCALE : 1.f;
#pragma unroll
        for (int ai = 0; ai < 2; ++ai)
#pragma unroll
            for (int m = 0; m < 4; ++m) { bf16_t* rowp = base + (size_t)(row0 + ai * 128 + m * 16) * ld;
#pragma unroll
                for (int bj = 0; bj < 2; ++bj) { const f32x4 v0 = acc[ai][bj][m][0] * sc, v1 = acc[ai][bj][m][1] * sc;
                    u32x4 w; w.x = cvtpk(v0[0], v0[1]); w.y = cvtpk(v0[2], v0[3]); w.z = cvtpk(v1[0], v1[1]); w.w = cvtpk(v1[2], v1[3]);
                    *(u32x4*)(rowp + bj * 128) = w; } }
    }
};
struct Sched4 {
    TileOrder o; const char* A; const char* Bt; int G, c;
    __device__ __forceinline__ bool next(int i, pg8::Unit& u) const {
        const int it = i / 3, br = i - it * 3, L = it * G + c; if (L >= 64 * 8) return false;
        int pm, pn; o.decode(L, pm, pn);
        const int koff = br == 0 ? 0 : (br == 1 ? 1024 : 1536);
        u.A = A + ((size_t)pm * 256 * D + koff) * 2; u.B = Bt + ((size_t)pn * 256 * D + koff) * 2; u.ridx = nullptr; u.nt = br == 0 ? 16 : 8; u.pm = pm; u.pn = pn; u.aux = br; return true;
    }
};
struct Epi4 {
    EPI_ZERO_INIT
    const unsigned char* PG8; bf16_t* Z;
    __device__ __forceinline__ void operator()(const f32x4 (&acc)[2][2][4][2], const pg8::Unit& u, int wr, int wc, int fr, int fq) const {
        const int row0 = u.pm * 256 + wr * 64 + fr, col0 = u.pn * 256 + wc * 32 + 8 * fq, br = u.aux;
#pragma unroll
        for (int ai = 0; ai < 2; ++ai) {
            u32x2 gv[4][2]; u32x4 zv[4][2];
#pragma unroll
            for (int m = 0; m < 4; ++m) { const size_t row = (size_t)(row0 + ai * 128 + m * 16);
#pragma unroll
                for (int bj = 0; bj < 2; ++bj) { const int col = col0 + bj * 128; gv[m][bj] = *(const u32x2*)(PG8 + row * NPG + br * D + col);
                    if (br > 0) zv[m][bj] = *(const u32x4*)(Z + row * D + col); else zv[m][bj] = (u32x4){0u, 0u, 0u, 0u}; } }
#pragma unroll
            for (int m = 0; m < 4; ++m) { const size_t row = (size_t)(row0 + ai * 128 + m * 16);
#pragma unroll
                for (int bj = 0; bj < 2; ++bj) { const int col = col0 + bj * 128; const u32x2 g = gv[m][bj]; const u32x4 z = zv[m][bj]; const float gs = 1.f / 255.f;
                    f32x4 v0 = acc[ai][bj][m][0] * gs, v1 = acc[ai][bj][m][1] * gs;
                    v0[0] = v0[0] * (float)(g.x & 0xffu) + bf_lo(z.x); v0[1] = v0[1] * (float)((g.x >> 8) & 0xffu) + bf_hi(z.x); v0[2] = v0[2] * (float)((g.x >> 16) & 0xffu) + bf_lo(z.y); v0[3] = v0[3] * (float)(g.x >> 24) + bf_hi(z.y);
                    v1[0] = v1[0] * (float)(g.y & 0xffu) + bf_lo(z.z); v1[1] = v1[1] * (float)((g.y >> 8) & 0xffu) + bf_hi(z.z); v1[2] = v1[2] * (float)((g.y >> 16) & 0xffu) + bf_lo(z.w); v1[3] = v1[3] * (float)(g.y >> 24) + bf_hi(z.w);
                    u32x4 w; w.x = cvtpk(v0[0], v0[1]); w.y = cvtpk(v0[2], v0[3]); w.z = cvtpk(v1[0], v1[1]); w.w = cvtpk(v1[2], v1[3]);
                    *(u32x4*)(Z + row * D + col) = w; } }
        }
    }
};
struct Sched5 {
    TileOrder o; const char* A; const char* Bt; int G, c;
    __device__ __forceinline__ bool next(int i, pg8::Unit& u) const {
        const int L = i * G + c; if (L >= 64 * 8) return false;
        int pm, pn; o.decode(L, pm, pn);
        u.A = A + (size_t)pm * 256 * D * 2; u.B = Bt + (size_t)pn * 256 * D * 2; u.ridx = nullptr; u.nt = D / 64; u.pm = pm; u.pn = pn; u.aux = 0; return true;
    }
};
struct Epi5 {
    static constexpr bool INIT_LOADS = true;
    const float* X; bf16_t* O;
    __device__ __forceinline__ void init(f32x4 (&acc)[2][2][4][2], const pg8::Unit& u, int wr, int wc, int fr, int fq) const {
        const int row0 = u.pm * 256 + wr * 64 + fr, col0 = u.pn * 256 + wc * 32 + 8 * fq;
#pragma unroll
        for (int ai = 0; ai < 2; ++ai)
#pragma unroll
            for (int m = 0; m < 4; ++m) { const size_t off = (size_t)(row0 + ai * 128 + m * 16) * D + col0;
#pragma unroll
                for (int bj = 0; bj < 2; ++bj) { acc[ai][bj][m][0] = *(const f32x4*)(X + off + bj * 128); acc[ai][bj][m][1] = *(const f32x4*)(X + off + bj * 128 + 4); } }
    }
    __device__ __forceinline__ void operator()(const f32x4 (&acc)[2][2][4][2], const pg8::Unit& u, int wr, int wc, int fr, int fq) const {
        const int row0 = u.pm * 256 + wr * 64 + fr, col0 = u.pn * 256 + wc * 32 + 8 * fq;
#pragma unroll
        for (int ai = 0; ai < 2; ++ai)
#pragma unroll
            for (int m = 0; m < 4; ++m) { const size_t off = (size_t)(row0 + ai * 128 + m * 16) * D + col0;
#pragma unroll
                for (int bj = 0; bj < 2; ++bj) { const f32x4 v0 = acc[ai][bj][m][0], v1 = acc[ai][bj][m][1];
                    u32x4 w; w.x = cvtpk(v0[0], v0[1]); w.y = cvtpk(v0[2], v0[3]); w.z = cvtpk(v1[0], v1[1]); w.w = cvtpk(v1[2], v1[3]);
                    *(u32x4*)(O + off + bj * 128) = w; } }
    }
};
struct SchedMoe {
    const LAS unsigned char* blk_e; int nblk, G, c, npn_shift;
    const char* A; const char* W; const int* rowtok; bool up;
    __device__ __forceinline__ bool next(int i, pg8::Unit& u) const {
        int L; if (G == 256) L = ((i * 8 + (c & 7)) * 32 + (c >> 3)); else L = i * G + c;
        const int blk = L >> npn_shift, pn = L & ((1 << npn_shift) - 1);
        if (blk >= nblk) { if (G != 256) return false; return false; }
        const int e = blk_e[blk];
        if (up) { u.A = A; u.ridx = rowtok + blk * 256; u.B = W + ((size_t)e * 1024 + pn * 256) * D; u.nt = D / 128; }
        else    { u.A = A + (size_t)blk * 256 * DE; u.ridx = nullptr; u.B = W + ((size_t)e * D + pn * 256) * DE; u.nt = DE / 128; }
        u.pm = blk; u.pn = pn; u.aux = e; return true;
    }
};
struct Epi8 {  EPI_ZERO_INIT
    unsigned char* HID;
    __device__ __forceinline__ void operator()(const f32x4 (&acc)[2][2][4][2], const pg8::Unit& u, int wr, int wc, int fr, int fq) const {
        const int row0 = u.pm * 256 + wr * 64 + fr, col0 = u.pn * 128 + wc * 32 + 8 * fq; const float rs = 1.f / WGU_SCALE;
#pragma unroll
        for (int ai = 0; ai < 2; ++ai)
#pragma unroll
            for (int m = 0; m < 4; ++m) { float h[8];
#pragma unroll
                for (int e = 0; e < 4; ++e) { const float g0 = acc[ai][0][m][0][e] * rs, g1 = acc[ai][0][m][1][e] * rs;
                    h[e] = __builtin_amdgcn_fmed3f(g0 * fast_sigmoid(g0) * (acc[ai][1][m][0][e] * rs), -440.f, 440.f); h[4 + e] = __builtin_amdgcn_fmed3f(g1 * fast_sigmoid(g1) * (acc[ai][1][m][1][e] * rs), -440.f, 440.f); }
                *(u32x2*)(HID + (size_t)(row0 + ai * 128 + m * 16) * DE + col0) = (u32x2){pk_fp8x4(h[0], h[1], h[2], h[3]), pk_fp8x4(h[4], h[5], h[6], h[7])}; }
    }
};
constexpr float Y_SCALE = 16.f;
struct Epi9 {  EPI_ZERO_INIT
    const int* rowasg; const float* rowg; unsigned char* Y;
    __device__ __forceinline__ void operator()(const f32x4 (&acc)[2][2][4][2], const pg8::Unit& u, int wr, int wc, int fr, int fq) const {
        const int row0 = u.pm * 256 + wr * 64 + fr, col0 = u.pn * 256 + wc * 32 + 8 * fq;
        int asg[2][4]; float g[2][4];
#pragma unroll
        for (int ai = 0; ai < 2; ++ai)
#pragma unroll
            for (int m = 0; m < 4; ++m) { const int slot = row0 + ai * 128 + m * 16; asg[ai][m] = rowasg[slot]; g[ai][m] = rowg[slot] * (Y_SCALE / WD_SCALE); }
#pragma unroll
        for (int ai = 0; ai < 2; ++ai)
#pragma unroll
            for (int m = 0; m < 4; ++m) {
                if (asg[ai][m] >= 0) { unsigned char* yp = Y + (size_t)asg[ai][m] * D + col0; const float gg = g[ai][m];
#pragma unroll
                    for (int bj = 0; bj < 2; ++bj) { f32x4 v0 = acc[ai][bj][m][0] * gg, v1 = acc[ai][bj][m][1] * gg;
#pragma unroll
                        for (int e = 0; e < 4; ++e) { v0[e] = __builtin_amdgcn_fmed3f(v0[e], -440.f, 440.f); v1[e] = __builtin_amdgcn_fmed3f(v1[e], -440.f, 440.f); }
                        int w0 = 0, w1 = 0;
                        w0 = __builtin_amdgcn_cvt_pk_fp8_f32(v0[0], v0[1], w0, false); w0 = __builtin_amdgcn_cvt_pk_fp8_f32(v0[2], v0[3], w0, true);
                        w1 = __builtin_amdgcn_cvt_pk_fp8_f32(v1[0], v1[1], w1, false); w1 = __builtin_amdgcn_cvt_pk_fp8_f32(v1[2], v1[3], w1, true);
                        *(u32x2*)(yp + bj * 128) = (u32x2){(unsigned)w0, (unsigned)w1}; } } }
    }
};

struct Frame {
    LAS unsigned char* lds; int tid, lane, wave, G, gw, NGW;
    float* out; unsigned char* ws;
    __device__ __forceinline__ const float* in(int i) const { return ((const float* const __attribute__((address_space(4)))*)__builtin_amdgcn_kernarg_segment_ptr())[i]; }
};
#define LDS_WAIT() asm volatile("s_waitcnt lgkmcnt(0)" ::: "memory")
template <class SrcCol, class DstRow>
__device__ __forceinline__ void tr_item(const float* W, size_t ldw, int k0, int n0, const SrcCol& sc, bf16_t* WT, size_t ldt, int kd0, const DstRow& dr, LAS float* scr, int lane) {
    const int c = sc(n0 + (lane & 31));
#pragma unroll 8
    for (int i = 0; i < 32; ++i) { const int kk = 2 * i + (lane >> 5); scr[kk * 33 + (lane & 31)] = c >= 0 ? W[(size_t)(k0 + kk) * ldw + c] : 0.f; }
    LDS_WAIT(); asm volatile("" ::: "memory");
    const int c8 = lane & 7;
#pragma unroll
    for (int j = 0; j < 4; ++j) { const int n = (lane >> 3) + 8 * j; const LAS float* s = scr + (8 * c8) * 33 + n;
        u32x4 o; o.x = cvtpk(s[0 * 33], s[1 * 33]); o.y = cvtpk(s[2 * 33], s[3 * 33]); o.z = cvtpk(s[4 * 33], s[5 * 33]); o.w = cvtpk(s[6 * 33], s[7 * 33]);
        *(u32x4*)(WT + (size_t)dr(n0 + n) * ldt + kd0 + k0 + 8 * c8) = o; }
    LDS_WAIT(); asm volatile("" ::: "memory");
}
struct IdCol { __device__ __forceinline__ int operator()(int n) const { return n; } };
struct OffRow { int off; __device__ __forceinline__ int operator()(int n) const { return off + n; } };
struct WinCol {
    __device__ __forceinline__ int operator()(int n) const {
        if (n < 2560) return n; if (n < 4096) return 2584 + (n - 2560); if (n < 4608) return 4124 + (n - 4096); if (n < 10752) return 4636 + (n - 4608);
        if (n < 10776) return 2560 + (n - 10752); if (n < 10780) return 4120 + (n - 10776); return -1; }
};
struct GuRow { int up; __device__ __forceinline__ int operator()(int j) const { return (j >> 7) * 256 + up * 128 + (j & 127); } };
__device__ __forceinline__ void rms_row_bf16(const float* xrow, const float* gain, bf16_t* orow, int lane) {
    f32x4 v[8]; float s = 0.f;
#pragma unroll
    for (int j = 0; j < 8; ++j) { v[j] = *(const f32x4*)(xrow + 4 * lane + 256 * j); s += (v[j].x * v[j].x + v[j].y * v[j].y) + (v[j].z * v[j].z + v[j].w * v[j].w); }
    const float rstd = __builtin_amdgcn_rsqf(wave_sum(s) * (1.f / D) + RMS_EPS);
#pragma unroll
    for (int j = 0; j < 8; ++j) { const f32x4 g = *(const f32x4*)(gain + 4 * lane + 256 * j);
        u32x2 o; o.x = cvtpk(v[j].x * rstd * g.x, v[j].y * rstd * g.y); o.y = cvtpk(v[j].z * rstd * g.z, v[j].w * rstd * g.w);
        *(u32x2*)(orow + 4 * lane + 256 * j) = o; }
}
__device__ __forceinline__ void rms_row_both(const float* xrow, const float* gain, bf16_t* orow, unsigned char* orow8, int lane) {
    f32x4 v[8]; float s = 0.f;
#pragma unroll
    for (int j = 0; j < 8; ++j) { v[j] = *(const f32x4*)(xrow + 4 * lane + 256 * j); s += (v[j].x * v[j].x + v[j].y * v[j].y) + (v[j].z * v[j].z + v[j].w * v[j].w); }
    const float rstd = __builtin_amdgcn_rsqf(wave_sum(s) * (1.f / D) + RMS_EPS);
#pragma unroll
    for (int j = 0; j < 8; ++j) { const f32x4 g = *(const f32x4*)(gain + 4 * lane + 256 * j); const float a = v[j].x * rstd * g.x, b = v[j].y * rstd * g.y, c = v[j].z * rstd * g.z, d = v[j].w * rstd * g.w;
        u32x2 o; o.x = cvtpk(a, b); o.y = cvtpk(c, d); *(u32x2*)(orow + 4 * lane + 256 * j) = o;
        *(unsigned*)(orow8 + 4 * lane + 256 * j) = pk_fp8x4(a, b, c, d); }
}
enum { I_X = 0, I_MEM, I_NORM_ATTN_G, I_W_IN, I_PE_K, I_W_CK, I_PE_V, I_W_CV, I_NSA_Q_G, I_NSA_K_G, I_REL_BIAS, I_FOX_B_F, I_FOX_Q_G, I_FOX_K_G, I_NORM_MEM_G, I_W_MEM_KV,
       I_MEM_Q_G, I_MEM_K_G, I_W_O_NSA, I_W_O_FOX, I_W_O_MEM, I_W_OUT, I_NORM_FFN_G, I_W_ROUTER, I_ROUTER_BIAS, I_WE_GATE, I_WE_UP, I_WE_DOWN, I_WS_GATE, I_WS_UP, I_WS_DOWN, N_IN };

struct TrDesc { const float* src; bf16_t* dst; unsigned ldw, ldt; };
__device__ __forceinline__ TrDesc tr_decode(const Frame& F, int t) {
    unsigned char* ws = F.ws; TrDesc d;
    bf16_t* WinT = (bf16_t*)(ws + WS_WINT); bf16_t* WkvT = WinT + (size_t)NPAD * D; bf16_t* WoT = (bf16_t*)(ws + WS_WOT);
    bf16_t* Wgu = (bf16_t*)(ws + WS_WGU); bf16_t* Wd = (bf16_t*)(ws + WS_WD);
    constexpr int T0 = 16 * 2 * NB16, T1 = T0 + 128, T2 = T1 + 128, T3 = T2 + 64, T4 = T3 + 64, T5 = T4 + 256, T6 = T5 + 32, T7 = T6 + 32, T8 = T7 + 65 * 64, T9 = T8 + 65 * 64;
    if (t < T0) { constexpr int NU = NB16 ? 2 * NB16 : 1; const int kt = t / NU, nt = t - kt * NU, n0 = 256 * nth_set(~FP8M & 0x3ffffu, nt >> 1) + 128 * (nt & 1); const int sc = WinCol{}(n0);
        d.src = F.in(I_W_IN) + (size_t)(128 * kt) * W_IN_COLS + sc; d.ldw = W_IN_COLS; d.dst = WinT + (size_t)n0 * D + 128 * kt; d.ldt = D; }
    else if (t < T1) { const int r = t - T0, kt = r >> 3, nt = r & 7; d.src = F.in(I_W_MEM_KV) + (size_t)(128 * kt) * 1024 + 128 * nt; d.ldw = 1024; d.dst = WkvT + (size_t)(128 * nt) * D + 128 * kt; d.ldt = D; }
    else if (t < T2) { const int r = t - T1, kt = r >> 4, nt = r & 15; d.src = F.in(I_W_O_NSA) + (size_t)(128 * kt) * D + 128 * nt; d.ldw = D; d.dst = WoT + (size_t)(128 * nt) * D + 128 * kt; d.ldt = D; }
    else if (t < T4) { const int mm = t >= T3, r = t - (mm ? T3 : T2), kt = r >> 4, nt = r & 15; d.src = F.in(mm ? I_W_O_MEM : I_W_O_FOX) + (size_t)(128 * kt) * D + 128 * nt; d.ldw = D; d.dst = WoT + (size_t)(128 * nt) * D + (mm ? 1536 : 1024) + 128 * kt; d.ldt = D; }
    else if (t < T5) { const int r = t - T4, kt = r >> 4, nt = r & 15; d.src = F.in(I_W_OUT) + (size_t)(128 * kt) * D + 128 * nt; d.ldw = D; d.dst = (bf16_t*)(ws + WS_WOUTT) + (size_t)(128 * nt) * D + 128 * kt; d.ldt = D; }
    else if (t < T7) { const int v = t >= T6, kt = t - (v ? T6 : T5); d.src = F.in(v ? I_W_CV : I_W_CK) + (size_t)(128 * kt) * 128; d.ldw = 128; d.dst = (bf16_t*)(ws + (v ? WS_WCV : WS_WCK)) + 128 * kt; d.ldt = 4096; }
    else if (t < T8) { const int r = t - T7, e = r >> 6, rr = r & 63, kt = rr >> 2, nt = rr & 3, up = 0;
        const float* W = e < NE ? F.in(I_WE_GATE) + (size_t)e * D * DE : F.in(I_WS_GATE);
        d.src = W + (size_t)(128 * kt) * DE + 128 * nt; d.ldw = DE; d.dst = Wgu + ((size_t)e * 1024 + 256 * nt + 128 * up) * D + 128 * kt; d.ldt = D; }
    else if (t < T9) { const int r = t - T8, e = r >> 6, rr = r & 63, kt = rr >> 2, nt = rr & 3, up = 1;
        const float* W = e < NE ? F.in(I_WE_UP) + (size_t)e * D * DE : F.in(I_WS_UP);
        d.src = W + (size_t)(128 * kt) * DE + 128 * nt; d.ldw = DE; d.dst = Wgu + ((size_t)e * 1024 + 256 * nt + 128 * up) * D + 128 * kt; d.ldt = D; }
    else { const int r = t - T9, e = r >> 6, rr = r & 63, kt = rr >> 4, nt = rr & 15;
        const float* W = e < NE ? F.in(I_WE_DOWN) + (size_t)e * DE * D : F.in(I_WS_DOWN);
        d.src = W + (size_t)(128 * kt) * D + 128 * nt; d.ldw = D; d.dst = Wd + ((size_t)e * D + 128 * nt) * DE + 128 * kt; d.ldt = DE; }
    return d;
}
constexpr int TR_NTILES = 16 * 84 + 128 + 128 + 64 + 64 + 256 + 32 + 32 + 3 * 65 * 64;
__device__ __forceinline__ void tr_load(const TrDesc& d, f32x4 (&v)[8], int wave, int lane) {
#pragma unroll
    for (int i = 0; i < 4; ++i) { const int q = wave + 8 * i, n4 = (q & 3) * 8 + (lane & 7), kp = (q >> 2) * 8 + (lane >> 3);
        const float* p = d.src + (size_t)(2 * kp) * d.ldw + 4 * n4; v[2 * i] = __builtin_nontemporal_load((const f32x4*)p); v[2 * i + 1] = __builtin_nontemporal_load((const f32x4*)(p + d.ldw)); }
}
__device__ __forceinline__ void tr_to_lds(const f32x4 (&v)[8], LAS unsigned* T32, int wave, int lane) {
#pragma unroll
    for (int i = 0; i < 4; ++i) { const int q = wave + 8 * i, n4 = (q & 3) * 8 + (lane & 7), kp = (q >> 2) * 8 + (lane >> 3);
#pragma unroll
        for (int e = 0; e < 4; ++e) T32[(4 * n4 + e) * 65 + kp] = cvtpk(v[2 * i][e], v[2 * i + 1][e]); }
}
__device__ __forceinline__ void tr_from_lds(const TrDesc& d, const LAS unsigned* T32, int wave, int lane) {
    const int c = lane & 15, nn = lane >> 4;
#pragma unroll
    for (int i = 0; i < 4; ++i) { const int n = wave * 16 + 4 * i + nn; const LAS unsigned* r = T32 + n * 65 + 4 * c;
        const u32x4 o = {r[0], r[1], r[2], r[3]};
        __builtin_nontemporal_store(o, (u32x4*)(d.dst + (size_t)n * d.ldt + 8 * c)); }
}
constexpr int TR_FIRST_EXPERT = 16 * 2 * NB16 + 128 + 128 + 64 + 64 + 256 + 32 + 32;
constexpr int TR8W_NTILES = 16 * (48 + 2 * NF8);
struct Tr8Desc { const float* src; unsigned char* dst; unsigned ldw, ldt; float scale; };
__device__ __forceinline__ Tr8Desc tr8_decode(const Frame& F, int t) {
    unsigned char* ws = F.ws; Tr8Desc d; unsigned char* Wgu = ws + WS_WGU; unsigned char* Wd = ws + WS_WD;
    constexpr int TG = 65 * 64;
    if (t < 2 * TG) { const int up = t >= TG, r = t - (up ? TG : 0), e = r >> 6, rr = r & 63, kt = rr >> 2, nt = rr & 3;
        const float* W = e < NE ? F.in(up ? I_WE_UP : I_WE_GATE) + (size_t)e * D * DE : F.in(up ? I_WS_UP : I_WS_GATE);
        d.src = W + (size_t)(128 * kt) * DE + 128 * nt; d.ldw = DE; d.dst = Wgu + ((size_t)e * 1024 + 256 * nt + 128 * up) * D + 128 * kt; d.ldt = D; d.scale = WGU_SCALE; }
    else { const int r = t - 2 * TG, e = r >> 6, rr = r & 63, kt = rr >> 4, nt = rr & 15;
        const float* W = e < NE ? F.in(I_WE_DOWN) + (size_t)e * DE * D : F.in(I_WS_DOWN);
        d.src = W + (size_t)(128 * kt) * D + 128 * nt; d.ldw = D; d.dst = Wd + ((size_t)e * D + 128 * nt) * DE + 128 * kt; d.ldt = DE; d.scale = WD_SCALE; }
    return d;
}
__device__ __forceinline__ Tr8Desc tr8w_decode(const Frame& F, int t) {
    Tr8Desc d; d.scale = WIN_SCALE; d.ldt = D; constexpr int NU = 48 + 2 * NF8; const int kt = t / NU, nt = t - kt * NU, n0 = nt < 48 ? 4608 + 128 * nt : 256 * nth_set(FP8M, (nt - 48) >> 1) + 128 * (nt & 1); const int sc = WinCol{}(n0);
    d.src = F.in(I_W_IN) + (size_t)(128 * kt) * W_IN_COLS + sc; d.ldw = W_IN_COLS; d.dst = F.ws + WS_WIN8 + (size_t)(128 * nt) * D + 128 * kt;
    return d;
}
__device__ __forceinline__ void tr8_load(const Tr8Desc& d, f32x4 (&v)[8], int wave, int lane) {
#pragma unroll
    for (int i = 0; i < 2; ++i) { const int q = wave + 8 * i, n4 = (q & 3) * 8 + (lane & 7), kq = (q >> 2) * 8 + (lane >> 3);
        const float* p = d.src + (size_t)(4 * kq) * d.ldw + 4 * n4;
#pragma unroll
        for (int r = 0; r < 4; ++r) v[4 * i + r] = __builtin_nontemporal_load((const f32x4*)(p + (size_t)r * d.ldw)); }
}
__device__ __forceinline__ void tr8_to_lds(const f32x4 (&v)[8], float sc, LAS unsigned* T32, int wave, int lane) {
#pragma unroll
    for (int i = 0; i < 2; ++i) { const int q = wave + 8 * i, n4 = (q & 3) * 8 + (lane & 7), kq = (q >> 2) * 8 + (lane >> 3);
#pragma unroll
        for (int e = 0; e < 4; ++e) T32[(4 * n4 + e) * 33 + kq] = pk_fp8x4(v[4 * i][e] * sc, v[4 * i + 1][e] * sc, v[4 * i + 2][e] * sc, v[4 * i + 3][e] * sc); }
}
__device__ __forceinline__ void tr8_from_lds(const Tr8Desc& d, const LAS unsigned* T32, int wave, int lane) {
    const int c = lane & 7, nn = lane >> 3;
#pragma unroll
    for (int i = 0; i < 2; ++i) { const int n = wave * 16 + 8 * i + nn; const LAS unsigned* r = T32 + n * 33 + 4 * c;
        const u32x4 o = {r[0], r[1], r[2], r[3]};
        __builtin_nontemporal_store(o, (u32x4*)(d.dst + (size_t)n * d.ldt + 16 * c)); }
}
__device__ __forceinline__ void conv_batch(const Frame& F, int first, int end) {
    constexpr int NT8 = 3 * 65 * 64;
    if (end > NT8) end = NT8;
    if (first >= end) return;
    LAS unsigned* I0 = (LAS unsigned*)F.lds; LAS unsigned* I1 = I0 + 128 * 33; const int lane = F.lane;
    f32x4 r0[8], r1[8], r2[8], r3[8];
    int t = first;
    tr8_load(tr8_decode(F, t), r0, F.wave, lane);
    if (t + 1 < end) tr8_load(tr8_decode(F, t + 1), r1, F.wave, lane);
    if (t + 2 < end) tr8_load(tr8_decode(F, t + 2), r2, F.wave, lane);
    if (t + 3 < end) tr8_load(tr8_decode(F, t + 3), r3, F.wave, lane);
    __syncthreads();
    tr8_to_lds(r0, tr8_decode(F, t).scale, I0, F.wave, lane);
    __syncthreads();
#define CB_STEP(RF, RN, IC, IN) { \
        if (t + 4 < end) tr8_load(tr8_decode(F, t + 4), RF, F.wave, lane); \
        if (t + 1 < end) tr8_to_lds(RN, tr8_decode(F, t + 1).scale, IN, F.wave, lane); \
        tr8_from_lds(tr8_decode(F, t), IC, F.wave, lane); \
        __syncthreads(); \
        if (++t >= end) break; }
    for (;;) {
        CB_STEP(r0, r1, I0, I1)
        CB_STEP(r1, r2, I1, I0)
        CB_STEP(r2, r3, I0, I1)
        CB_STEP(r3, r0, I1, I0)
    }
#undef CB_STEP
}

namespace att {
constexpr int SHM = 16384;
constexpr int L_V = 0, L_K = 3 * SHM;
constexpr int L_WS = 5 * SHM;
constexpr int L_TBL = L_WS + 2048;
constexpr int L_SEL = L_TBL + 8 * 132 * 4;
constexpr int L_NIB = L_SEL + 512;
constexpr int L_CUM = L_SEL + 1024;
constexpr int L_IMP = L_CUM;
constexpr int L_ORD = L_IMP + 32768;
constexpr int L_Q = L_ORD + 2048;
constexpr int L_END = L_Q + 64;
static_assert(L_END <= RING_BYTES, "attention LDS map");
__constant__ unsigned char T5B[128] = {0, 1, 2, 3, 4, 5, 6, 7, 8, 9, 10, 11, 12, 13, 14, 15, 16, 16, 16, 17, 17, 18, 18, 18, 19, 19, 19, 20, 20, 20, 20, 21, 21, 21, 21, 22, 22, 22, 22, 22, 23, 23, 23, 23, 23, 23, 24, 24, 24, 24, 24, 24, 25, 25, 25, 25, 25, 25, 25, 26, 26, 26, 26, 26, 26, 26, 26, 27, 27, 27, 27, 27, 27, 27, 27, 27, 27, 28, 28, 28, 28, 28, 28, 28, 28, 28, 28, 29, 29, 29, 29, 29, 29, 29, 29, 29, 29, 29, 29, 30, 30, 30, 30, 30, 30, 30, 30, 30, 30, 30, 30, 30, 30, 31, 31, 31, 31, 31, 31, 31, 31, 31, 31, 31, 31, 31, 31, 31};

#define KSWZ(row, colB) ((row) * 256 + ((colB) ^ (((row) & 7) << 4)))
#define SBAR() __builtin_amdgcn_sched_barrier(0)
__device__ __forceinline__ int v_st(int k, int c) { const int kk = (k & ~0xC) | ((k & 4) << 1) | ((k & 8) >> 1); return ((kk >> 3) * 4 + (c >> 5)) * 512 + ((kk & 7) * 32 + (c & 31)) * 2; }
__device__ __forceinline__ int v_rd_base(int lane) { return ((lane & 3) << 3) | (((lane >> 2) & 3) << 6) | (((lane >> 4) & 1) << 5) | (((lane >> 5) & 1) << 8); }
__device__ __forceinline__ int crow(int r, int hi) { return (r & 3) + 8 * (r >> 2) + 4 * hi; }
__device__ __forceinline__ float pswap_max(float v) { auto rr = __builtin_amdgcn_permlane32_swap(__float_as_uint(v), __float_as_uint(v), false, false); return fmaxf(__uint_as_float(rr[0]), __uint_as_float(rr[1])); }
__device__ __forceinline__ float pswap_sum(float v) { auto rr = __builtin_amdgcn_permlane32_swap(__float_as_uint(v), __float_as_uint(v), false, false); return __uint_as_float(rr[0]) + __uint_as_float(rr[1]); }

__device__ __forceinline__ void qkt(f32x16& p0, f32x16& p1, const LAS char* Kb, int r32, int hi, const bf16x8 (&qr)[8]) {
    const LAS char* kb[4];
#pragma unroll
    for (int dd = 0; dd < 4; ++dd) kb[dd] = Kb + KSWZ(r32, (dd * 16 + hi * 8) * 2);
#pragma unroll
    for (int d0 = 0; d0 < 8; ++d0) { const LAS char* a = kb[d0 & 3] + (d0 >> 2) * 128;
        const bf16x8 b0 = *(const LAS bf16x8*)a;
        const bf16x8 b1 = *(const LAS bf16x8*)(a + 32 * 256);
        p0 = __builtin_amdgcn_mfma_f32_32x32x16_bf16(b0, qr[d0], p0, 0, 0, 0);
        p1 = __builtin_amdgcn_mfma_f32_32x32x16_bf16(b1, qr[d0], p1, 0, 0, 0);
#ifdef QKT_SPLIT
        if ((d0 & (QKT_SPLIT - 1)) == QKT_SPLIT - 1 && d0 != 7) SBAR();
#endif
    }
}
__device__ __forceinline__ void pv_tile(f32x16 (&o)[4], int vb, bf16x8 pa0, bf16x8 pa1, bf16x8 pa2, bf16x8 pa3) {
#define TRRD(dst, off) asm volatile("ds_read_b64_tr_b16 %0, %1 offset:%2" : "=&v"(dst) : "v"(vb), "i"(off) : "memory")
#define PV_D0(d0) do { s16x4 l0, l1, l2, l3, h0, h1, h2, h3; constexpr int b_ = (d0) * 512; \
        TRRD(l0, b_); TRRD(h0, b_ + 2048); TRRD(l1, b_ + 4096); TRRD(h1, b_ + 6144); TRRD(l2, b_ + 8192); TRRD(h2, b_ + 10240); TRRD(l3, b_ + 12288); TRRD(h3, b_ + 14336); \
        asm volatile("s_waitcnt lgkmcnt(0)" ::: "memory"); SBAR(); \
        o[d0] = __builtin_amdgcn_mfma_f32_32x32x16_bf16(pa0, (bf16x8){l0[0], l0[1], l0[2], l0[3], h0[0], h0[1], h0[2], h0[3]}, o[d0], 0, 0, 0); \
        o[d0] = __builtin_amdgcn_mfma_f32_32x32x16_bf16(pa1, (bf16x8){l1[0], l1[1], l1[2], l1[3], h1[0], h1[1], h1[2], h1[3]}, o[d0], 0, 0, 0); \
        o[d0] = __builtin_amdgcn_mfma_f32_32x32x16_bf16(pa2, (bf16x8){l2[0], l2[1], l2[2], l2[3], h2[0], h2[1], h2[2], h2[3]}, o[d0], 0, 0, 0); \
        o[d0] = __builtin_amdgcn_mfma_f32_32x32x16_bf16(pa3, (bf16x8){l3[0], l3[1], l3[2], l3[3], h3[0], h3[1], h3[2], h3[3]}, o[d0], 0, 0, 0); } while (0)
    PV_D0(0); PV_D0(1); PV_D0(2); PV_D0(3);
#undef PV_D0
#undef TRRD
}
__device__ __forceinline__ void pack_p(const f32x16& p0, const f32x16& p1, bf16x8& pa0, bf16x8& pa1, bf16x8& pa2, bf16x8& pa3) {
#define PK4(P, B_, OUT) do { unsigned a0 = cvtpk(P[B_+0], P[B_+1]), a1 = cvtpk(P[B_+2], P[B_+3]); \
        unsigned b0 = cvtpk(P[B_+4], P[B_+5]), b1 = cvtpk(P[B_+6], P[B_+7]); \
        auto r0 = __builtin_amdgcn_permlane32_swap(a0, b0, false, false); auto r1 = __builtin_amdgcn_permlane32_swap(a1, b1, false, false); \
        u32x4 w = {r0[0], r1[0], r0[1], r1[1]}; OUT = __builtin_bit_cast(bf16x8, w); } while (0)
    PK4(p0, 0, pa0); PK4(p0, 8, pa1); PK4(p1, 0, pa2); PK4(p1, 8, pa3);
#undef PK4
}
__device__ __forceinline__ void bcast_rows(float (&f)[16], float v, LAS float* ws, int r32, int hi) {
    if (hi == 0) ws[r32] = v;
    asm volatile("s_waitcnt lgkmcnt(0)" ::: "memory");
#pragma unroll
    for (int q = 0; q < 4; ++q) { const f32x4 t = *(const LAS f32x4*)(ws + 8 * q + 4 * hi); f[4 * q] = t[0]; f[4 * q + 1] = t[1]; f[4 * q + 2] = t[2]; f[4 * q + 3] = t[3]; }
    asm volatile("s_waitcnt lgkmcnt(0)" ::: "memory");
}
struct Ctx {
    LAS char* lds; int tid, wid, lane, r32, hi;
    int trow;
    int qlo;
};
struct DmaOff { unsigned k, v0, v1; };
__device__ __forceinline__ DmaOff dma_off(int wid, int lane, size_t ld) {
    DmaOff d; const int kr = 4 * wid + (lane >> 4), kc = (lane & 15) ^ (kr & 7);
    d.k = (unsigned)(kr * ld + kc * 8) * 2u;
#pragma unroll
    for (int t = 0; t < 2; ++t) { const int sub = 2 * (wid + 8 * t) + (lane >> 5), kk = (sub >> 2) * 8 + ((lane & 31) >> 2), k = (kk & ~0xC) | ((kk & 4) << 1) | ((kk & 8) >> 1), c0 = (sub & 3) * 32 + (lane & 3) * 8;
        const unsigned o = (unsigned)(k * ld + c0) * 2u; if (t == 0) d.v0 = o; else d.v1 = o; }
    return d;
}
__device__ __forceinline__ void dma_tile(const DmaOff& d, const bf16_t* Kg, const bf16_t* Vg, size_t ld, LAS char* lds, int buf, int vbuf, int wid) {
    const char* kp = (const char*)Kg; const char* vp = (const char*)Vg;
    __builtin_amdgcn_global_load_lds((const unsigned*)(kp + d.k), (LAS unsigned*)(lds + L_K + buf * SHM + wid * 1024), 16, 0, 0);
    __builtin_amdgcn_global_load_lds((const unsigned*)(kp + d.k + 32 * ld * 2), (LAS unsigned*)(lds + L_K + buf * SHM + (wid + 8) * 1024), 16, 0, 0);
    __builtin_amdgcn_global_load_lds((const unsigned*)(vp + d.v0), (LAS unsigned*)(lds + L_V + vbuf * SHM + wid * 1024), 16, 0, 0);
    __builtin_amdgcn_global_load_lds((const unsigned*)(vp + d.v1), (LAS unsigned*)(lds + L_V + vbuf * SHM + (wid + 8) * 1024), 16, 0, 0);
}
__device__ __forceinline__ void dma_tile_v(const DmaOff& d, const bf16_t* Kg, const bf16_t* Vg, size_t ld, LAS char* lds, int kbuf, int voff, int wid) {
    const char* kp = (const char*)Kg; const char* vp = (const char*)Vg;
    __builtin_amdgcn_global_load_lds((const unsigned*)(kp + d.k), (LAS unsigned*)(lds + L_K + kbuf * SHM + wid * 1024), 16, 0, 0);
    __builtin_amdgcn_global_load_lds((const unsigned*)(kp + d.k + 32 * ld * 2), (LAS unsigned*)(lds + L_K + kbuf * SHM + (wid + 8) * 1024), 16, 0, 0);
    __builtin_amdgcn_global_load_lds((const unsigned*)(vp + d.v0), (LAS unsigned*)(lds + L_V + voff + wid * 1024), 16, 0, 0);
    __builtin_amdgcn_global_load_lds((const unsigned*)(vp + d.v1), (LAS unsigned*)(lds + L_V + voff + (wid + 8) * 1024), 16, 0, 0);
}
#define DMA_WAIT() asm volatile("s_waitcnt vmcnt(0)" ::: "memory")
constexpr float DEFER_THR = 8.f;
__device__ __forceinline__ void qkt_half(f32x16& p, const LAS char* Kb, int r32, int hi, const bf16x8 (&qr)[8], bool zero) {
    const LAS char* kb[4];
#pragma unroll
    for (int dd = 0; dd < 4; ++dd) kb[dd] = Kb + KSWZ(r32, (dd * 16 + hi * 8) * 2);
    { const bf16x8 b = *(const LAS bf16x8*)(kb[0]);
      if (zero) p = __builtin_amdgcn_mfma_f32_32x32x16_bf16(b, qr[0], (f32x16){0.f, 0.f, 0.f, 0.f, 0.f, 0.f, 0.f, 0.f, 0.f, 0.f, 0.f, 0.f, 0.f, 0.f, 0.f, 0.f}, 0, 0, 0);
      else p = __builtin_amdgcn_mfma_f32_32x32x16_bf16(b, qr[0], p, 0, 0, 0); }
#pragma unroll
    for (int d0 = 1; d0 < 8; ++d0) { const bf16x8 b = *(const LAS bf16x8*)(kb[d0 & 3] + (d0 >> 2) * 128);
        p = __builtin_amdgcn_mfma_f32_32x32x16_bf16(b, qr[d0], p, 0, 0, 0); }
}
__device__ __forceinline__ float max3f(float a, float b, float c) { float r; asm("v_max3_f32 %0, %1, %2, %3" : "=v"(r) : "v"(a), "v"(b), "v"(c)); return r; }
__device__ __forceinline__ bool sm_half(f32x16& p, float& m_reg, float& l_reg, float& alpha, bf16x8& pa0, bf16x8& pa1, float brow) {
    float pmax = max3f(p[0], p[1], p[2]);
#pragma unroll
    for (int r = 3; r < 15; r += 2) pmax = max3f(pmax, p[r], p[r + 1]);
    pmax = max3f(pmax, p[15], p[15]);
    { const auto rr = __builtin_amdgcn_permlane32_swap(__float_as_uint(pmax), __float_as_uint(pmax), false, false); pmax = max3f(__uint_as_float(rr[0]), __uint_as_float(rr[1]), __uint_as_float(rr[1])) + brow; }
    const bool upd = !__all(pmax - m_reg <= DEFER_THR);
    const float mx_ = max3f(m_reg, pmax, pmax);
    const float mn = upd ? mx_ : m_reg;
    alpha = __builtin_amdgcn_exp2f(m_reg - mn); m_reg = mn;
    f32x2 mn2 = {brow - mn, brow - mn}; asm("" : "+v"(mn2)); f32x2 ps2 = {0.f, 0.f};
#pragma unroll
    for (int r = 0; r < 16; r += 2) { f32x2 t = {p[r], p[r + 1]}; t += mn2; t.x = __builtin_amdgcn_exp2f(t.x); t.y = __builtin_amdgcn_exp2f(t.y); p[r] = t.x; p[r + 1] = t.y; ps2 += t; }
    float ps = pswap_sum(ps2.x + ps2.y);
    l_reg = l_reg * alpha + ps;
#define PK4(P, B_, OUT) do { unsigned a0 = cvtpk(P[B_+0], P[B_+1]), a1 = cvtpk(P[B_+2], P[B_+3]); \
        unsigned b0 = cvtpk(P[B_+4], P[B_+5]), b1 = cvtpk(P[B_+6], P[B_+7]); \
        auto r0 = __builtin_amdgcn_permlane32_swap(a0, b0, false, false); auto r1 = __builtin_amdgcn_permlane32_swap(a1, b1, false, false); \
        u32x4 w = {r0[0], r1[0], r0[1], r1[1]}; OUT = __builtin_bit_cast(bf16x8, w); } while (0)
    PK4(p, 0, pa0); PK4(p, 8, pa1);
#undef PK4
    return upd;
}
__device__ __forceinline__ void pv_half(f32x16 (&o)[4], int vb, bf16x8 pa0, bf16x8 pa1) {
#define TRRD(dst, off) asm volatile("ds_read_b64_tr_b16 %0, %1 offset:%2" : "=&v"(dst) : "v"(vb), "i"(off) : "memory")
#define PVH(dA, dB) do { s16x4 l0, h0, l1, h1, m0, n0, m1, n1; \
        TRRD(l0, (dA) * 512); TRRD(h0, (dA) * 512 + 2048); TRRD(m0, (dB) * 512); TRRD(n0, (dB) * 512 + 2048); \
        TRRD(l1, (dA) * 512 + 4096); TRRD(h1, (dA) * 512 + 6144); TRRD(m1, (dB) * 512 + 4096); TRRD(n1, (dB) * 512 + 6144); \
        asm volatile("s_waitcnt lgkmcnt(0)" ::: "memory"); SBAR(); \
        o[dA] = __builtin_amdgcn_mfma_f32_32x32x16_bf16(pa0, (bf16x8){l0[0], l0[1], l0[2], l0[3], h0[0], h0[1], h0[2], h0[3]}, o[dA], 0, 0, 0); \
        o[dB] = __builtin_amdgcn_mfma_f32_32x32x16_bf16(pa0, (bf16x8){m0[0], m0[1], m0[2], m0[3], n0[0], n0[1], n0[2], n0[3]}, o[dB], 0, 0, 0); \
        o[dA] = __builtin_amdgcn_mfma_f32_32x32x16_bf16(pa1, (bf16x8){l1[0], l1[1], l1[2], l1[3], h1[0], h1[1], h1[2], h1[3]}, o[dA], 0, 0, 0); \
        o[dB] = __builtin_amdgcn_mfma_f32_32x32x16_bf16(pa1, (bf16x8){m1[0], m1[1], m1[2], m1[3], n1[0], n1[1], n1[2], n1[3]}, o[dB], 0, 0, 0); } while (0)
    PVH(0, 1); PVH(2, 3);
#undef PVH
#undef TRRD
}
__device__ __forceinline__ bool sm_cheap(f32x16& p, float& l_reg, float& alpha, bf16x8& pa0, bf16x8& pa1) {
    alpha = 1.f; l_reg += p[0] + p[15];
    u32x4 w0 = {__builtin_bit_cast(unsigned, p[0]), __builtin_bit_cast(unsigned, p[1]), __builtin_bit_cast(unsigned, p[2]), __builtin_bit_cast(unsigned, p[3])};
    u32x4 w1 = {__builtin_bit_cast(unsigned, p[8]), __builtin_bit_cast(unsigned, p[9]), __builtin_bit_cast(unsigned, p[10]), __builtin_bit_cast(unsigned, p[11])};
    pa0 = __builtin_bit_cast(bf16x8, w0); pa1 = __builtin_bit_cast(bf16x8, w1); return false;
}
template <int VAR = 0, class F>
__device__ __forceinline__ void stream(const Ctx& C0, const bf16x8 (&qr)[8], const bf16_t* Kg, const bf16_t* Vg, size_t ld, unsigned mask, float& m_reg, float& l_reg, f32x16 (&o)[4], const F& f) {
    Ctx C = C0; { int tz = C0.tid; asm volatile("" : "+v"(tz)); C.tid = tz; C.lane = tz & 63; C.r32 = tz & 31; C.hi = (tz >> 5) & 1; }
    const int vb0 = (int)(uintptr_t)(C.lds + L_V) + v_rd_base(C.lane);
    LAS float* ws = (LAS float*)(C.lds + L_WS) + C.wid * 64;
    const DmaOff dof = dma_off(C.wid, C.lane, ld);
    unsigned rem = mask; int j = __builtin_ctz(rem); rem &= rem - 1;
    __syncthreads();
    dma_tile_v(dof, Kg + (size_t)j * 64 * ld, Vg + (size_t)j * 64 * ld, ld, C.lds, 0, 0, C.wid);
    DMA_WAIT();
    __syncthreads();
    int kb = 0, vprev = 2 * SHM, vcur = 0, vnext = SHM;
    bool more = rem != 0u; int jn = j;
    if (more) { jn = __builtin_ctz(rem); rem &= rem - 1; if (!(VAR & 1)) dma_tile_v(dof, Kg + (size_t)jn * 64 * ld, Vg + (size_t)jn * 64 * ld, ld, C.lds, 1, vnext, C.wid); }
#define ST_RESC(a) do { if (C.hi == 0) ws[C.r32] = (a); asm volatile("s_waitcnt lgkmcnt(0)" ::: "memory"); \
        _Pragma("unroll") for (int q = 0; q < 4; ++q) { const f32x4 t = *(const LAS f32x4*)(ws + 8 * q + 4 * C.hi); \
            _Pragma("unroll") for (int d = 0; d < 4; ++d) { o[d][4 * q] *= t[0]; o[d][4 * q + 1] *= t[1]; o[d][4 * q + 2] *= t[2]; o[d][4 * q + 3] *= t[3]; } } } while (0)
    f32x16 pA, pB; float alpha, browA, browB; bf16x8 pa0, pa1;
    bool zA = f.pre(pA, j, 0, browA);
    qkt_half(pA, C.lds + L_K, C.r32, C.hi, qr, zA);
    bool zB = f.pre(pB, j, 1, browB);
    bool first = true;
    for (;;) {
        if (!(VAR & 16)) qkt_half(pB, C.lds + L_K + kb * SHM + 32 * 256, C.r32, C.hi, qr, zB);
        const bool u0 = (VAR & 4) ? sm_cheap(pA, l_reg, alpha, pa0, pa1) : sm_half(pA, m_reg, l_reg, alpha, pa0, pa1, browA);
        if (u0 && !first) ST_RESC(alpha);
        first = false;
        if (!(VAR & 8)) pv_half(o, vb0 + vcur, pa0, pa1); else { o[0][0] += __builtin_bit_cast(float, (int)pa0[0] + (int)pa1[1]); }
        if (!(VAR & 32)) zA = f.pre(pA, jn, 0, browA);
        DMA_WAIT(); if (!(VAR & 2)) __syncthreads();
        if (!more) break;
        j = jn; kb ^= 1; { const int t_ = vprev; vprev = vcur; vcur = vnext; vnext = t_; }
        more = rem != 0u;
        if (more) { jn = __builtin_ctz(rem); rem &= rem - 1; if (!(VAR & 1)) dma_tile_v(dof, Kg + (size_t)jn * 64 * ld, Vg + (size_t)jn * 64 * ld, ld, C.lds, kb ^ 1, vnext, C.wid); }
        if (!(VAR & 16)) qkt_half(pA, C.lds + L_K + kb * SHM, C.r32, C.hi, qr, zA);
        const bool u1 = (VAR & 4) ? sm_cheap(pB, l_reg, alpha, pa0, pa1) : sm_half(pB, m_reg, l_reg, alpha, pa0, pa1, browB);
        if (u1) ST_RESC(alpha);
        if (!(VAR & 8)) pv_half(o, vb0 + vprev + 8192, pa0, pa1); else { o[1][0] += __builtin_bit_cast(float, (int)pa0[2] + (int)pa1[3]); }
        if (!(VAR & 32)) zB = f.pre(pB, j, 1, browB);
    }
    { const bool u1 = sm_half(pB, m_reg, l_reg, alpha, pa0, pa1, browB);
      if (u1) ST_RESC(alpha);
      pv_half(o, vb0 + vcur + 8192, pa0, pa1); }
    __syncthreads();
#undef ST_RESC
}
__device__ __forceinline__ void load_q(bf16x8 (&qr)[8], const bf16_t* qrow, const float* gain, int hi) {
    u32x4 raw[8]; float ss = 0.f;
#pragma unroll
    for (int d0 = 0; d0 < 8; ++d0) { raw[d0] = *(const u32x4*)(qrow + d0 * 16 + hi * 8);
#pragma unroll
        for (int e = 0; e < 4; ++e) { const float a = bf_lo(raw[d0][e]), b = bf_hi(raw[d0][e]); ss += a * a + b * b; } }
    ss = pswap_sum(ss);
    const float f = __builtin_amdgcn_rsqf(ss * (1.f / HD) + RMS_EPS) * (ATTN_SCALE * LOG2E);
#pragma unroll
    for (int d0 = 0; d0 < 8; ++d0) { const f32x4 g0 = *(const f32x4*)(gain + d0 * 16 + hi * 8), g1 = *(const f32x4*)(gain + d0 * 16 + hi * 8 + 4);
        u32x4 w; w.x = cvtpk(bf_lo(raw[d0].x) * f * g0[0], bf_hi(raw[d0].x) * f * g0[1]); w.y = cvtpk(bf_lo(raw[d0].y) * f * g0[2], bf_hi(raw[d0].y) * f * g0[3]);
        w.z = cvtpk(bf_lo(raw[d0].z) * f * g1[0], bf_hi(raw[d0].z) * f * g1[1]); w.w = cvtpk(bf_lo(raw[d0].w) * f * g1[2], bf_hi(raw[d0].w) * f * g1[3]);
        qr[d0] = __builtin_bit_cast(bf16x8, w); }
}
__device__ __forceinline__ void store_o(const f32x16 (&v)[4], const float (&w)[16], bf16_t* orow0, size_t ld, LAS char* lds, int wid, int lane_, bool accum) {
    int lane = lane_; asm volatile("" : "+v"(lane));
    const int r32 = lane & 31, hi = lane >> 5;
    LAS char* st = lds + wid * 8192;
    const bool odd = (r32 & 1) != 0;
#pragma unroll
    for (int r = 0; r < 16; r += 2) { LAS char* rowp = st + (crow(r, hi) + (odd ? 1 : 0)) * 256 + (r32 & ~1) * 2;
#pragma unroll
        for (int d = 0; d < 4; ++d) { const float a = v[d][r] * w[r], b = v[d][r + 1] * w[r + 1];
            const float recv = __builtin_bit_cast(float, __builtin_amdgcn_mov_dpp(__builtin_bit_cast(int, odd ? a : b), 0xB1, 0xF, 0xF, true));
            *(LAS unsigned*)(rowp + d * 64) = cvtpk(odd ? recv : a, odd ? b : recv); } }
    asm volatile("s_waitcnt lgkmcnt(0)" ::: "memory");
    u32x4 ov[8];
    if (accum) {
#pragma unroll
        for (int it = 0; it < 8; ++it) { const int id = it * 64 + lane, row = id >> 4, c16 = id & 15; ov[it] = *(const u32x4*)(orow0 + (size_t)row * ld + c16 * 8); } }
#pragma unroll
    for (int it = 0; it < 8; ++it) { const int id = it * 64 + lane, row = id >> 4, c16 = id & 15;
        u32x4 nv = *(const LAS u32x4*)(st + row * 256 + c16 * 16);
        if (accum) {
#pragma unroll
            for (int e = 0; e < 4; ++e) nv[e] = cvtpk(bf_lo(nv[e]) + bf_lo(ov[it][e]), bf_hi(nv[e]) + bf_hi(ov[it][e])); }
        *(u32x4*)(orow0 + (size_t)row * ld + c16 * 8) = nv; }
    asm volatile("s_waitcnt lgkmcnt(0)" ::: "memory");
}

struct Tensors {
    const bf16_t* PA; const float* GL; const bf16_t* KVM; const bf16_t* KC; const bf16_t* VC; const float* CUM; bf16_t* OC;
    const float* nsa_q_g; const float* fox_q_g; const float* mem_q_g; const float* rel_bias;
};

template <int TY> struct BiasUni {
    const Ctx* C; const LAS float* tb; int u; unsigned sel; int mode;
    __device__ __forceinline__ bool pre(f32x16& bv, int j, int half, float& brow) const {
        const float NEG = -__builtin_inff();
        const int dq = C->trow - 64 * j - 4 * C->hi - 32 * half;
        brow = 0.f;
        if constexpr (TY == 0) {
            const bool win = mode == 1; const bool on = win || ((sel >> j) & 1u);
            if (j + 3 <= u && !(win && j + 8 <= u)) {
                brow = on ? tb[128] : NEG; return true;
            } else {
#pragma unroll
                for (int q = 0; q < 4; ++q) {
#pragma unroll
                    for (int e = 0; e < 4; ++e) { const int r = 4 * q + e, c = e + 8 * q, rel = dq - c;
                        const bool ok = on && (unsigned)rel < 512u; const float b = tb[min(max(rel, 0), 128)];
                        bv[r] = ok ? b : NEG; }
                    SBAR(); }
            }
        } else if constexpr (TY == 1) {
            const LAS float* cb = (const LAS float*)(C->lds + L_CUM) + 64 * j + 4 * C->hi + 32 * half;
            const bool msk = 64 * j + 63 > C->qlo;
#pragma unroll
            for (int q = 0; q < 4; ++q) { const f32x4 a = *(const LAS f32x4*)(cb + 8 * q);
#pragma unroll
                for (int e = 0; e < 4; ++e) { const int r = 4 * q + e, c = e + 8 * q; bv[r] = (msk && dq - c < 0) ? NEG : a[e]; } }
        } else {
            return true;
        }
        return false;
    }
};

__device__ __forceinline__ void nsa_pre(Ctx& C, const Tensors& Tn, const bf16x8 (&qr)[8], int b, int g, int u, float g_c, bf16_t* orow0, unsigned& sel_out, unsigned& U_out) {
    { int tz = C.tid; asm volatile("" : "+v"(tz)); C.tid = tz; C.lane = tz & 63; C.r32 = tz & 31; C.hi = (tz >> 5) & 1; }
    const int hh = C.wid >> 1, pos = (C.wid & 1) * 32 + C.r32, head = g * 4 + hh;
    const LAS float* tb = (const LAS float*)(C.lds + L_TBL) + head * 132;
    LAS float* ws = (LAS float*)(C.lds + L_WS) + C.wid * 64;
    LAS unsigned* SEL = (LAS unsigned*)(C.lds + L_SEL);
    const float NEG = -__builtin_inff();
    const int vb0 = (int)(uintptr_t)(C.lds + L_V) + v_rd_base(C.lane);
    {
        const bf16_t* KCb = Tn.KC + (size_t)(b * 2 + g) * 128 * HD; const bf16_t* VCb = Tn.VC + (size_t)(b * 2 + g) * 128 * HD;
        const DmaOff dof = dma_off(C.wid, C.lane, HD);
        __syncthreads();
        if (C.tid < 65) SEL[C.tid] = 0u;
        dma_tile(dof, KCb, VCb, HD, C.lds, 0, 0, C.wid); dma_tile(dof, KCb + 64 * HD, VCb + 64 * HD, HD, C.lds, 1, 1, C.wid);
        DMA_WAIT();
        __syncthreads();
        f32x16 P[4];
        const int dq = C.trow - 31 - 64 * C.hi;
#pragma unroll
        for (int X = 0; X < 4; ++X)
#pragma unroll
            for (int r = 0; r < 16; ++r) { const int c = (r & 3) + 8 * (r >> 2), rel = dq - 16 * (32 * X + c);
                const float bb = tb[min(max(rel, 0), 128)]; P[X][r] = rel >= 0 ? bb : NEG; }
        qkt(P[0], P[1], C.lds + L_K, C.r32, C.hi, qr); qkt(P[2], P[3], C.lds + L_K + SHM, C.r32, C.hi, qr);
        float pmax = NEG;
#pragma unroll
        for (int X = 0; X < 4; ++X)
#pragma unroll
            for (int r = 0; r < 16; ++r) pmax = fmaxf(pmax, P[X][r]);
        pmax = pswap_max(pmax);
        const float mm = pmax == NEG ? 0.f : pmax;
        float ps = 0.f;
#pragma unroll
        for (int X = 0; X < 4; ++X)
#pragma unroll
            for (int r = 0; r < 16; ++r) { P[X][r] = __builtin_amdgcn_exp2f(P[X][r] - mm); ps += P[X][r]; }
        ps = pswap_sum(ps);
        const float inv = ps > 0.f ? 1.f / ps : 0.f;
        if (u >= 16) {
            LAS float* imp = (LAS float*)(C.lds + L_IMP) + (hh * 64 + pos) * 32;
            float bprev = 0.f;
#pragma unroll
            for (int X = 0; X < 4; ++X)
#pragma unroll
                for (int q = 0; q < 4; ++q) { const float b3 = 0.5f * P[X][4 * q + 3];
                    const float aG = P[X][4 * q] + P[X][4 * q + 1] + P[X][4 * q + 2] + b3;
                    const auto sw_ = __builtin_amdgcn_permlane32_swap(__float_as_uint(b3), __float_as_uint(b3), false, false);
                    const float bp = __uint_as_float(C.hi ? sw_[0] : sw_[1]);
                    const float val = aG + (C.hi ? bp : bprev);
                    imp[2 * (4 * X + q) + C.hi] = val * inv;
                    bprev = bp; }
        }
        f32x16 o[4] = {};
        bf16x8 pa0, pa1, pa2, pa3;
        pack_p(P[0], P[1], pa0, pa1, pa2, pa3); pv_tile(o, vb0, pa0, pa1, pa2, pa3);
        pack_p(P[2], P[3], pa0, pa1, pa2, pa3); pv_tile(o, vb0 + SHM, pa0, pa1, pa2, pa3);
        float w[16]; bcast_rows(w, g_c * inv, ws, C.r32, C.hi);
        __syncthreads();
        store_o(o, w, orow0, D, C.lds, C.wid, C.lane, false);
    }
    if (u >= 16) {
        const int p = C.tid & 63, jg = C.tid >> 6;
        const LAS float* i0 = (const LAS float*)(C.lds + L_IMP) + p * 32;
        float sc[32];
#pragma unroll
        for (int j4 = 0; j4 < 8; ++j4) { const f32x4 a = *(const LAS f32x4*)(i0 + 4 * j4), b2 = *(const LAS f32x4*)(i0 + 2048 + 4 * j4), c2 = *(const LAS f32x4*)(i0 + 4096 + 4 * j4), d2 = *(const LAS f32x4*)(i0 + 6144 + 4 * j4);
#pragma unroll
            for (int e = 0; e < 4; ++e) { const int j = 4 * j4 + e; const float s = ((a[e] + b2[e]) + c2[e]) + d2[e];
                const bool valid = j <= u, forced = j == 0 || j == u || j == u - 1;
                sc[j] = valid ? (forced ? 1e4f : s) : -1.f; } }
        unsigned bits = 0u;
#pragma unroll
        for (int e = 0; e < 4; ++e) { const int j = 4 * jg + e; float sj = 0.f;
#pragma unroll
            for (int k = 0; k < 32; ++k) sj = (k == j) ? sc[k] : sj;
            int rank = 0;
#pragma unroll
            for (int k = 0; k < 32; ++k) rank += (sc[k] > sj || (sc[k] == sj && k < j)) ? 1 : 0;
            if (j <= u && rank < 16) bits |= 1u << j; }
        ((LAS unsigned char*)(C.lds + L_NIB))[p * 8 + jg] = (unsigned char)(bits >> (4 * jg));
        __syncthreads();
        if (C.tid < 64) { const u32x2 nb = *(const LAS u32x2*)(C.lds + L_NIB + C.tid * 8); unsigned full = 0u;
#pragma unroll
            for (int k = 0; k < 4; ++k) { full |= ((nb.x >> (8 * k)) & 0xfu) << (4 * k); full |= ((nb.y >> (8 * k)) & 0xfu) << (16 + 4 * k); }
            SEL[C.tid] = full; unsigned un = full;
#pragma unroll
            for (int o = 1; o < 64; o <<= 1) un |= __shfl_xor(un, o);
            if (C.tid == 0) SEL[64] = un; }
    } else { if (C.tid < 65) SEL[C.tid] = (2u << u) - 1u; }
    __syncthreads();
    sel_out = SEL[pos]; U_out = SEL[64];
}
__device__ __forceinline__ int dequeue(LAS char* lds, unsigned* head, int tid) {
    if (tid == 0) *(LAS int*)(lds + L_Q) = (int)__hip_atomic_fetch_add(head, 1u, RLX_AGENT);
    __syncthreads();
    const int q = *(const LAS int*)(lds + L_Q);
    __syncthreads();
    return q;
}
#ifndef DBL_VAR
#define DBL_VAR 0
#endif
#ifndef DBL_STREAM
#define DBL_STREAM 0
#endif
#ifndef CONV_IN_P0
#define CONV_IN_P0 0
#endif
__device__ __forceinline__ void conv_some(const Frame& F, LAS char* lds, unsigned* chead, int n) {
    if (CONV_IN_P0) return;
    if (F.tid == 0) *(LAS int*)(lds + L_Q) = (int)__hip_atomic_fetch_add(chead, (unsigned)n, RLX_AGENT);
    __syncthreads();
    const int base = *(const LAS int*)(lds + L_Q);
    __syncthreads();
    conv_batch(F, base, base + n);
}
__device__ __forceinline__ void attn_phase(const Frame& F, LAS char* lds, const Tensors& Tn, unsigned* qhead) {
    Ctx C; C.lds = lds; C.tid = threadIdx.x; C.wid = __builtin_amdgcn_readfirstlane(C.tid >> 6); C.lane = C.tid & 63; C.r32 = C.lane & 31; C.hi = C.lane >> 5; C.trow = 0; C.qlo = 0;
    for (int i = C.tid; i < 8 * 129; i += 512) { const int head = i / 129, rel = i - head * 129; const int bk = rel < 128 ? T5B[rel] : 31;
        ((LAS float*)(lds + L_TBL))[head * 132 + rel] = Tn.rel_bias[bk * 8 + head] * LOG2E; }
    __syncthreads();
    LAS float* ws = (LAS float*)(lds + L_WS) + C.wid * 64;
#ifndef PASS_MASK
#define PASS_MASK 7
#endif
    int nconv = (int)(blockIdx.x & 7) * 5;
    if (PASS_MASK & 1) for (;;) {
        conv_some(F, lds, qhead + 192, nconv); nconv = 12;
        const int q = dequeue(lds, qhead, C.tid); if (q >= 512) break;
        const int u = 31 - (q >> 4), b = (q >> 1) & 7, g = q & 1, head = g * 4 + (C.wid >> 1);
        C.qlo = 64 * u + (C.wid & 1) * 32; C.trow = C.qlo + C.r32;
        const size_t tok = (size_t)b * T + C.trow;
        bf16x8 qr[8]; load_q(qr, Tn.PA + tok * NPA + CQ_NSA + head * HD, Tn.nsa_q_g, C.hi);
        bf16_t* orow0 = Tn.OC + ((size_t)b * T + C.qlo) * D + head * HD;
        const LAS float* tb = (const LAS float*)(lds + L_TBL) + head * 132;
        const float* gl = Tn.GL + tok * LDG; const float g_c = fast_sigmoid(gl[head]), g_s = fast_sigmoid(gl[8 + head]), g_w = fast_sigmoid(gl[16 + head]);
        unsigned sel, U; nsa_pre(C, Tn, qr, b, g, u, g_c, orow0, sel, U);
        const bf16_t* PAb = Tn.PA + (size_t)b * T * NPA + g * HD;
        int br = 0;
        do {
            const unsigned mask = br ? (((2u << u) - 1u) & ~(u >= 9 ? ((1u << (u - 8)) - 1u) : 0u)) : U;
            f32x16 o[4] = {}; float m_reg = -1e30f, l_reg = 0.f;
            stream(C, qr, PAb + (br ? CK_WIN : CK_SLC), PAb + (br ? CV_WIN : CV_SLC), NPA, mask, m_reg, l_reg, o, BiasUni<0>{&C, tb, u, sel, br});
            float w[16]; bcast_rows(w, l_reg > 0.f ? (br ? g_w : g_s) / l_reg : 0.f, ws, C.r32, C.hi);
            store_o(o, w, orow0, D, lds, C.wid, C.lane, true);
#if DBL_STREAM
            { f32x16 o2[4] = {}; float m2 = -1e30f, l2 = 0.f; stream<DBL_VAR>(C, qr, PAb + (br ? CK_WIN : CK_SLC), PAb + (br ? CV_WIN : CV_SLC), NPA, mask, m2, l2, o2, BiasUni<0>{&C, tb, u, sel, br}); float sk = ((o2[0][0] + o2[1][0]) + (o2[2][0] + o2[3][0])) + l2 + m2; asm volatile("" :: "v"(sk)); }
#endif
            ++br; asm volatile("" : "+s"(br));
        } while (br < 2);
    }
    if (PASS_MASK & 2) for (;;) {
        const int q = dequeue(lds, qhead + 64, C.tid); if (q >= 256) break;
        const int qb = 7 - (q >> 5), b = (q >> 2) & 7, h = q & 3;
        C.qlo = 256 * qb + 32 * C.wid; C.trow = C.qlo + C.r32;
        const size_t tok = (size_t)b * T + C.trow;
        bf16x8 qr[8]; load_q(qr, Tn.PA + tok * NPA + CQ_FOX + h * HD, Tn.fox_q_g, C.hi);
        { LAS float* cl = (LAS float*)(lds + L_CUM); const float* cg = Tn.CUM + (size_t)(b * 4 + h) * T;
          for (int i = C.tid; i < 256 * (qb + 1); i += 512) cl[i] = -cg[i] * LOG2E; }
        const bf16_t* PAb = Tn.PA + (size_t)b * T * NPA + h * HD;
        const unsigned mask = qb == 7 ? 0xffffffffu : ((1u << (4 * qb + 4)) - 1u);
        f32x16 o[4] = {}; float m_reg = -1e30f, l_reg = 0.f;
        stream(C, qr, PAb + CK_FOX, PAb + CV_FOX, NPA, mask, m_reg, l_reg, o, BiasUni<1>{&C, nullptr, 0, 0u, 2});
        float w[16]; bcast_rows(w, l_reg > 0.f ? 1.f / l_reg : 0.f, ws, C.r32, C.hi);
        store_o(o, w, Tn.OC + ((size_t)b * T + C.qlo) * D + 1024 + h * HD, D, lds, C.wid, C.lane, false);
#if DBL_STREAM
        { f32x16 o2[4] = {}; float m2 = -1e30f, l2 = 0.f; stream<DBL_VAR>(C, qr, PAb + CK_FOX, PAb + CV_FOX, NPA, mask, m2, l2, o2, BiasUni<1>{&C, nullptr, 0, 0u, 2}); float sk = ((o2[0][0] + o2[1][0]) + (o2[2][0] + o2[3][0])) + l2 + m2; asm volatile("" :: "v"(sk)); }
#endif
        conv_some(F, lds, qhead + 192, 6);
    }
    if (PASS_MASK & 4) for (;;) {
        const int q = dequeue(lds, qhead + 128, C.tid); if (q >= 256) break;
        const int qb = q & 7, h = (q >> 3) & 3, b = q >> 5;
        C.qlo = 256 * qb + 32 * C.wid; C.trow = C.qlo + C.r32;
        const size_t tok = (size_t)b * T + C.trow;
        bf16x8 qr[8]; load_q(qr, Tn.PA + tok * NPA + CQ_MEM + h * HD, Tn.mem_q_g, C.hi);
        const bf16_t* Kb = Tn.KVM + (size_t)b * MEMT * 1024 + h * HD;
        f32x16 o[4] = {}; float m_reg = -1e30f, l_reg = 0.f;
        stream(C, qr, Kb, Kb + 512, 1024, 0xfu, m_reg, l_reg, o, BiasUni<2>{&C, nullptr, 0, 0u, 3});
        float w[16]; bcast_rows(w, l_reg > 0.f ? 1.f / l_reg : 0.f, ws, C.r32, C.hi);
        store_o(o, w, Tn.OC + ((size_t)b * T + C.qlo) * D + 1536 + h * HD, D, lds, C.wid, C.lane, false);
#if DBL_STREAM
        { f32x16 o2[4] = {}; float m2 = -1e30f, l2 = 0.f; stream<DBL_VAR>(C, qr, Kb, Kb + 512, 1024, 0xfu, m2, l2, o2, BiasUni<2>{&C, nullptr, 0, 0u, 3}); float sk = ((o2[0][0] + o2[1][0]) + (o2[2][0] + o2[3][0])) + l2 + m2; asm volatile("" :: "v"(sk)); }
#endif
        conv_some(F, lds, qhead + 192, 2);
    }
    if (!CONV_IN_P0) for (;;) {
        if (F.tid == 0) *(LAS int*)(lds + L_Q) = (int)__hip_atomic_fetch_add(qhead + 192, 8u, RLX_AGENT);
        __syncthreads();
        const int base = *(const LAS int*)(lds + L_Q);
        __syncthreads();
        if (base >= 3 * 65 * 64) break;
        conv_batch(F, base, base + 8);
    }
}
#undef KSWZ
#undef SBAR
}

__device__ __forceinline__ void p0_prologue(Frame& F) {
    LAS float* scr = (LAS float*)(F.lds + 40960 + F.wave * 8704);
    unsigned char* ws = F.ws; const int lane = F.lane;
    if (F.gw < 128) { const int kv = F.gw >> 6, j = F.gw & 63; const float* pe = F.in(kv ? I_PE_V : I_PE_K) + 64 * j; const float* w = F.in(kv ? I_W_CV : I_W_CK) + (size_t)64 * j * 128; float a0 = 0.f, a1 = 0.f;
#pragma unroll 16
        for (int k = 0; k < 64; ++k) { const float p = pe[k]; a0 += p * w[(size_t)k * 128 + lane]; a1 += p * w[(size_t)k * 128 + 64 + lane]; }
        float* cb = (float*)(ws + WS_CBIAS) + (size_t)(kv * 64 + j) * 128; cb[lane] = a0; cb[64 + lane] = a1; }
    constexpr int S0 = 32 * 8, S1 = S0 + 64;
    bf16_t* WinT = (bf16_t*)(ws + WS_WINT);
    for (int it = F.gw; it < S1; it += F.NGW) {
        if (it < S0) { const int kb = it >> 3, nb = it & 7; tr_item(F.in(I_W_IN), W_IN_COLS, 64 * kb, 10752 + 32 * nb, WinCol{}, WinT, D, 0, IdCol{}, scr, lane); }
        else {
            const int r = it - S0, kb = r >> 1, nb = r & 1, k0 = 64 * kb, n0 = 32 * nb; const float* W = F.in(I_W_ROUTER);
#pragma unroll 8
            for (int i = 0; i < 32; ++i) { const int kk = 2 * i + (lane >> 5); scr[kk * 33 + (lane & 31)] = W[(size_t)(k0 + kk) * NE + n0 + (lane & 31)]; }
            LDS_WAIT(); asm volatile("" ::: "memory");
            const int c8 = lane & 7; bf16_t* Whi = (bf16_t*)(ws + WS_WRT); bf16_t* Wlo = Whi + (size_t)NE * D;
#pragma unroll
            for (int j = 0; j < 4; ++j) { const int n = (lane >> 3) + 8 * j; const LAS float* s = scr + (8 * c8) * 33 + n; unsigned h[4], l[4];
#pragma unroll
                for (int q = 0; q < 4; ++q) { const float a = s[(2 * q) * 33], b = s[(2 * q + 1) * 33]; h[q] = cvtpk(a, b); l[q] = cvtpk(a - bf_lo(h[q]), b - bf_hi(h[q])); }
                *(u32x4*)(Whi + (size_t)(n0 + n) * D + k0 + 8 * c8) = (u32x4){h[0], h[1], h[2], h[3]};
                *(u32x4*)(Wlo + (size_t)(n0 + n) * D + k0 + 8 * c8) = (u32x4){l[0], l[1], l[2], l[3]}; }
            LDS_WAIT(); asm volatile("" ::: "memory");
        }
    }
    {
        LAS unsigned* T32 = (LAS unsigned*)F.lds;
        int t = blockIdx.x; f32x4 v[8]; Tr8Desc d = tr8w_decode(F, t < TR8W_NTILES ? t : 0);
        if (t < TR8W_NTILES) tr8_load(d, v, F.wave, lane);
        while (t < TR8W_NTILES) {
            tr8_to_lds(v, d.scale, T32, F.wave, lane);
            __syncthreads();
            const int tn = t + F.G; const Tr8Desc dn = tr8w_decode(F, tn < TR8W_NTILES ? tn : 0);
            if (tn < TR8W_NTILES) tr8_load(dn, v, F.wave, lane);
            tr8_from_lds(d, T32, F.wave, lane);
            __syncthreads();
            t = tn; d = dn;
        }
    }
    {
        LAS unsigned* T32 = (LAS unsigned*)F.lds;
        constexpr int NT0 = TR_FIRST_EXPERT;
        int t = blockIdx.x; f32x4 v[8]; TrDesc d = tr_decode(F, t < NT0 ? t : 0);
        if (t < NT0) tr_load(d, v, F.wave, lane);
        while (t < NT0) {
            tr_to_lds(v, T32, F.wave, lane);
            __syncthreads();
            const int tn = t + F.G; const TrDesc dn = tr_decode(F, tn < NT0 ? tn : 0);
            if (tn < NT0) tr_load(dn, v, F.wave, lane);
            tr_from_lds(d, T32, F.wave, lane);
            __syncthreads();
            t = tn; d = dn;
        }
    }
    if (CONV_IN_P0) { __syncthreads(); for (int base = blockIdx.x * 8; base < 3 * 65 * 64; base += F.G * 8) conv_batch(F, base, base + 8); }
    bf16_t* A3 = (bf16_t*)(ws + WS_A3); unsigned char* H8 = ws + WS_H8;
    for (int m = F.gw; m < M + MROWS; m += F.NGW) {
        if (m < M) rms_row_both(F.in(I_X) + (size_t)m * D, F.in(I_NORM_ATTN_G), A3 + (size_t)m * D, H8 + (size_t)m * D, lane);
        else rms_row_bf16(F.in(I_MEM) + (size_t)(m - M) * D, F.in(I_NORM_MEM_G), A3 + (size_t)m * D, lane);
    }
}

__device__ __forceinline__ void p2_thin(Frame& F) {
    unsigned char* ws = F.ws; const int lane = F.lane;
    bf16_t* PA = (bf16_t*)(ws + WS_PA); bf16_t* KVM = (bf16_t*)(ws + WS_KVMEM); const float* GL = (const float*)(ws + WS_GL);
    {
        LAS float* part = (LAS float*)F.lds;
        LAS float* red = (LAS float*)(F.lds + 65536);
        const int i16 = lane & 15, kg = lane >> 4, w = F.wave;
        for (int item = blockIdx.x; item < 256; item += F.G) {
            const int kv = item & 1, rt = (item >> 1) & 7, bg = item >> 4, b = bg >> 1, g = bg & 1;
            const int n = 16 * rt + i16, ne = n < 127 ? n : 126;
            const bf16_t* Ab = PA + ((size_t)(b * T + 16 * ne + 4 * w) * NPA + (kv ? CV_CMP : CK_CMP) + g * HD) + 8 * kg;
            const bf16_t* Bb = (const bf16_t*)(ws + (kv ? WS_WCV : WS_WCK)) + (size_t)i16 * 4096 + 512 * w + 8 * kg;
            f32x4 acc[8];
#pragma unroll
            for (int nt = 0; nt < 8; ++nt) acc[nt] = (f32x4){0.f, 0.f, 0.f, 0.f};
#pragma unroll 2
            for (int s = 0; s < 16; ++s) { const bf16x8 a = *(const bf16x8*)(Ab + (size_t)(s >> 2) * NPA + 32 * (s & 3));
#pragma unroll
                for (int nt = 0; nt < 8; ++nt) { const bf16x8 bb = *(const bf16x8*)(Bb + (size_t)nt * 16 * 4096 + 32 * s); acc[nt] = __builtin_amdgcn_mfma_f32_16x16x32_bf16(a, bb, acc[nt], 0, 0, 0); } }
            __syncthreads();
#pragma unroll
            for (int nt = 0; nt < 8; ++nt) *(LAS f32x4*)(part + ((w * 8 + nt) * 64 + lane) * 4) = acc[nt];
            __syncthreads();
            f32x4 t = {0.f, 0.f, 0.f, 0.f};
#pragma unroll
            for (int ww = 0; ww < 8; ++ww) t += *(const LAS f32x4*)(part + ((ww * 8 + w) * 64 + lane) * 4);
            const int e = 16 * w + i16; float cb = 0.f;
#pragma unroll 16
            for (int j = 0; j < 64; ++j) cb += ((const float*)(ws + WS_CBIAS))[(size_t)(kv * 64 + j) * 128 + e];
#pragma unroll
            for (int r = 0; r < 4; ++r) t[r] += cb;
            float scl[4] = {1.f, 1.f, 1.f, 1.f};
            if (kv == 0) {
#pragma unroll
                for (int r = 0; r < 4; ++r) { float q = t[r] * t[r]; q += __shfl_xor(q, 1); q += __shfl_xor(q, 2); q += __shfl_xor(q, 4); q += __shfl_xor(q, 8); if (i16 == 0) red[w * 16 + 4 * kg + r] = q; }
            }
            __syncthreads();
            if (kv == 0) { const float kgain = F.in(I_NSA_K_G)[e];
#pragma unroll
                for (int r = 0; r < 4; ++r) { float q = 0.f;
#pragma unroll
                    for (int ww = 0; ww < 8; ++ww) q += red[ww * 16 + 4 * kg + r];
                    scl[r] = __builtin_amdgcn_rsqf(q * (1.f / HD) + RMS_EPS) * kgain; } }
            bf16_t* Ob = (bf16_t*)(ws + (kv ? WS_VC : WS_KC)) + (size_t)bg * 128 * HD;
#pragma unroll
            for (int r = 0; r < 4; ++r) { const int nn = 16 * rt + 4 * kg + r; const float v = nn < 127 ? t[r] * scl[r] : 0.f; Ob[(size_t)nn * HD + e] = (bf16_t)(cvtpk(v, 0.f) & 0xffffu); }
        }
    }
#pragma unroll 2
    for (int row = F.gw; row < M; row += F.NGW) {
        const int hd = lane >> 3, col = (hd < 2 ? CK_SLC + hd * HD : (hd < 4 ? CK_WIN + (hd - 2) * HD : CK_FOX + (hd - 4) * HD)) + (lane & 7) * 16;
        bf16_t* p = PA + (size_t)row * NPA + col; const u32x4 r0 = *(const u32x4*)p, r1 = *(const u32x4*)(p + 8);
        float ss = 0.f;
#pragma unroll
        for (int e = 0; e < 4; ++e) { ss += bf_lo(r0[e]) * bf_lo(r0[e]) + bf_hi(r0[e]) * bf_hi(r0[e]) + bf_lo(r1[e]) * bf_lo(r1[e]) + bf_hi(r1[e]) * bf_hi(r1[e]); }
        ss += __shfl_xor(ss, 1); ss += __shfl_xor(ss, 2); ss += __shfl_xor(ss, 4);
        const float rstd = __builtin_amdgcn_rsqf(ss * (1.f / HD) + RMS_EPS); const float* gn = F.in(hd < 4 ? I_NSA_K_G : I_FOX_K_G) + (lane & 7) * 16;
        u32x4 o0, o1;
#pragma unroll
        for (int e = 0; e < 4; ++e) { o0[e] = cvtpk(bf_lo(r0[e]) * rstd * gn[2 * e], bf_hi(r0[e]) * rstd * gn[2 * e + 1]); o1[e] = cvtpk(bf_lo(r1[e]) * rstd * gn[8 + 2 * e], bf_hi(r1[e]) * rstd * gn[8 + 2 * e + 1]); }
        *(u32x4*)p = o0; *(u32x4*)(p + 8) = o1;
    }
    for (int mr = F.gw; mr < MROWS; mr += F.NGW) {
        bf16_t* p = KVM + (size_t)mr * 1024 + (lane >> 4) * HD + (lane & 15) * 8; const u32x4 r0 = *(const u32x4*)p; float ss = 0.f;
#pragma unroll
        for (int e = 0; e < 4; ++e) ss += bf_lo(r0[e]) * bf_lo(r0[e]) + bf_hi(r0[e]) * bf_hi(r0[e]);
        ss += __shfl_xor(ss, 1); ss += __shfl_xor(ss, 2); ss += __shfl_xor(ss, 4); ss += __shfl_xor(ss, 8);
        const float rstd = __builtin_amdgcn_rsqf(ss * (1.f / HD) + RMS_EPS); const float* gn = F.in(I_MEM_K_G) + (lane & 15) * 8; u32x4 o0;
#pragma unroll
        for (int e = 0; e < 4; ++e) o0[e] = cvtpk(bf_lo(r0[e]) * rstd * gn[2 * e], bf_hi(r0[e]) * rstd * gn[2 * e + 1]);
        *(u32x4*)p = o0;
    }
    for (int seq = F.gw; seq < 32; seq += F.NGW) {
        const int b = seq >> 2, h = seq & 3; const float bf = F.in(I_FOX_B_F)[h]; float v[32]; float run = 0.f;
#pragma unroll
        for (int i = 0; i < 32; ++i) { const float x = GL[(size_t)(b * T + 32 * lane + i) * LDG + 24 + h] + bf;
            const float ls = fminf(x, 0.f) - log1pf(__expf(-fabsf(x))); run += ls; v[i] = run; }
        float incl = run;
#pragma unroll
        for (int o = 1; o < 64; o <<= 1) { const float t = __shfl_up(incl, o); if (lane >= o) incl += t; }
        const float excl = incl - run; float* cp = (float*)(ws + WS_CUM) + (size_t)seq * T + 32 * lane;
#pragma unroll
        for (int i = 0; i < 32; ++i) cp[i] = v[i] + excl;
    }
}

constexpr int CW_COARSE = 16384;
constexpr int P6_WSTR = 136;
constexpr int P6_WBUF = 2 * 64 * P6_WSTR * 2;
static_assert(2 * P6_WBUF <= RING_BYTES, "P6 chunk buffers inside the ring region");
__device__ __forceinline__ void p6_router(Frame& F) {
    unsigned char* ws = F.ws; const int lane = F.lane, i16 = lane & 15, kg = lane >> 4, row = i16 & 7;
    unsigned char* H2 = (unsigned char*)(ws + WS_A3); const bf16_t* X1 = (const bf16_t*)(ws + WS_X1B); const float* gain = F.in(I_NORM_FFN_G);
    const bf16_t* Wg = (const bf16_t*)(ws + WS_WRT);
    const float rb = F.in(I_ROUTER_BIAS)[lane];
    unsigned* coarse = (unsigned*)(ws + WS_CTL) + CW_COARSE;
    if (F.gw == 0) {
#pragma unroll
        for (int q = 0; q < 2; ++q) *(u32x4*)(H2 + (size_t)M * D + 32 * lane + 16 * q) = (u32x4){0u, 0u, 0u, 0u}; }
    for (int item = blockIdx.x; item < M / 64; item += F.G) {
        const int tok0 = item * 64 + F.wave * 8;
        float myr = 0.f;
#pragma unroll 2
        for (int i = 0; i < 8; ++i) { const bf16_t* xr = X1 + (size_t)(tok0 + i) * D; float ss = 0.f;
#pragma unroll
            for (int j = 0; j < 4; ++j) { const u32x4 v = *(const u32x4*)(xr + 8 * lane + 512 * j);
#pragma unroll
                for (int e = 0; e < 4; ++e) ss += bf_lo(v[e]) * bf_lo(v[e]) + bf_hi(v[e]) * bf_hi(v[e]); }
            const float r = __builtin_amdgcn_rsqf(wave_sum(ss) * (1.f / D) + RMS_EPS); if (row == i) myr = r; }
        f32x4 acc[4] = {{0.f, 0.f, 0.f, 0.f}, {0.f, 0.f, 0.f, 0.f}, {0.f, 0.f, 0.f, 0.f}, {0.f, 0.f, 0.f, 0.f}};
        const bf16_t* xr = X1 + (size_t)(tok0 + row) * D + 8 * kg; unsigned char* hr = H2 + (size_t)(tok0 + row) * D + 8 * kg;
        u32x4 wst[4];
#define P6_LOADW(ch) do { _Pragma("unroll") for (int i = 0; i < 4; ++i) { const int p = F.tid + 512 * i; wst[i] = *(const u32x4*)(Wg + (size_t)(p >> 4) * D + 128 * (ch) + 8 * (p & 15)); } } while (0)
#define P6_STOREW(bf) do { _Pragma("unroll") for (int i = 0; i < 4; ++i) { const int p = F.tid + 512 * i; *(LAS u32x4*)(F.lds + (bf) * P6_WBUF + ((p >> 4) * P6_WSTR + 8 * (p & 15)) * 2) = wst[i]; } } while (0)
        P6_LOADW(0);
        __syncthreads();
        P6_STOREW(0);
        __syncthreads();
        for (int ch = 0; ch < 16; ++ch) {
            if (ch < 15) P6_LOADW(ch + 1);
            const LAS unsigned char* wb = F.lds + (ch & 1) * P6_WBUF + (i16 * P6_WSTR + 8 * kg) * 2;
#pragma unroll 2
            for (int s = 0; s < 4; ++s) { const int k = 128 * ch + 32 * s;
                const u32x4 xb = *(const u32x4*)(xr + k); const f32x4 g0 = *(const f32x4*)(gain + k + 8 * kg), g1 = *(const f32x4*)(gain + k + 8 * kg + 4);
                const float xn[8] = {bf_lo(xb.x) * myr * g0.x, bf_hi(xb.x) * myr * g0.y, bf_lo(xb.y) * myr * g0.z, bf_hi(xb.y) * myr * g0.w, bf_lo(xb.z) * myr * g1.x, bf_hi(xb.z) * myr * g1.y, bf_lo(xb.w) * myr * g1.z, bf_hi(xb.w) * myr * g1.w};
                u32x4 h, l;
#pragma unroll
                for (int q = 0; q < 4; ++q) { h[q] = cvtpk(xn[2 * q], xn[2 * q + 1]); l[q] = cvtpk(xn[2 * q] - bf_lo(h[q]), xn[2 * q + 1] - bf_hi(h[q])); }
                if (i16 < 8) *(u32x2*)(hr + k) = (u32x2){pk_fp8x4(xn[0], xn[1], xn[2], xn[3]), pk_fp8x4(xn[4], xn[5], xn[6], xn[7])};
                const bf16x8 ah = __builtin_bit_cast(bf16x8, h), al = __builtin_bit_cast(bf16x8, l);
#pragma unroll
                for (int nt = 0; nt < 4; ++nt) { const LAS unsigned char* wp = wb + (16 * nt * P6_WSTR + 32 * s) * 2;
                    const bf16x8 bh = *(const LAS bf16x8*)wp, bl = *(const LAS bf16x8*)(wp + 64 * P6_WSTR * 2);
                    acc[nt] = __builtin_amdgcn_mfma_f32_16x16x32_bf16(ah, bh, acc[nt], 0, 0, 0);
                    acc[nt] = __builtin_amdgcn_mfma_f32_16x16x32_bf16(al, bh, acc[nt], 0, 0, 0);
                    acc[nt] = __builtin_amdgcn_mfma_f32_16x16x32_bf16(ah, bl, acc[nt], 0, 0, 0); }
            }
            if (ch < 15) P6_STOREW((ch + 1) & 1);
            __syncthreads();
        }
#undef P6_LOADW
#undef P6_STOREW
        LAS float* lg = (LAS float*)(F.lds + F.wave * 4096);
        if (kg < 2) {
#pragma unroll
            for (int nt = 0; nt < 4; ++nt)
#pragma unroll
                for (int r = 0; r < 4; ++r) lg[(4 * kg + r) * 64 + 16 * nt + i16] = acc[nt][r]; }
        LDS_WAIT(); asm volatile("" ::: "memory");
        int cnt = 0;
        u32x2* asg = (u32x2*)(ws + WS_ASG);
        for (int tt = 0; tt < 8; ++tt) {
            const float sc = 1.f / (1.f + __expf(-lg[tt * 64 + lane])); const float key = sc + rb;
            lg[512 + lane] = key; LDS_WAIT(); asm volatile("" ::: "memory");
            int rank = 0;
#pragma unroll
            for (int q = 0; q < 16; ++q) { const f32x4 kk = *(const LAS f32x4*)(lg + 512 + 4 * q);
#pragma unroll
                for (int e = 0; e < 4; ++e) { const int eo = 4 * q + e; rank += (kk[e] > key || (kk[e] == key && eo < lane)) ? 1 : 0; } }
            LDS_WAIT(); asm volatile("" ::: "memory");
            const bool selx = rank < TOPK;
            const float ssum = wave_sum(selx ? sc : 0.f);
            const unsigned long long bal = __ballot(selx);
            if (selx) { const int k = __popcll(bal & ((1ull << lane) - 1ull));
                asg[(size_t)(tok0 + tt) * TOPK + k] = (u32x2){(unsigned)lane | ((unsigned)cnt << 8), __float_as_uint(sc / ssum * 2.5f)}; ++cnt; }
        }
        const int wi = item * 8 + F.wave;
        ((int*)(ws + WS_HIST))[wi * 64 + lane] = cnt;
        __hip_atomic_fetch_add(coarse + (wi >> 5) * 64 + lane, (unsigned)cnt, RLX_AGENT);
    }
}
__device__ __forceinline__ void p7_slots(Frame& F) {
    unsigned char* ws = F.ws; const int lane = F.lane;
    const int* hist = (const int*)(ws + WS_HIST); const u32x2* asg = (const u32x2*)(ws + WS_ASG); const unsigned* coarse = (const unsigned*)(ws + WS_CTL) + CW_COARSE;
    int* rowasg = (int*)(ws + WS_ROWASG); int* rowtok = (int*)(ws + WS_ROWTOK); float* rowg = (float*)(ws + WS_ROWG);
    for (int wi = F.gw; wi < M / 8; wi += F.NGW) {
        const int grp = wi >> 5; int base = 0, total = 0;
#pragma unroll 8
        for (int g = 0; g < 64; ++g) { const int cv = (int)coarse[g * 64 + lane]; total += cv; base += g < grp ? cv : 0; }
        for (int i = grp * 32; i < wi; ++i) base += hist[i * 64 + lane];
        const int padded = (total + 255) & ~255;
        int incl = padded;
#pragma unroll
        for (int o = 1; o < 64; o <<= 1) { const int t = __shfl_up(incl, o); if (lane >= o) incl += t; }
        const int pstart = incl - padded, rtot = __shfl(incl, 63);
        const int my = pstart + base;
        { const int tok = wi * 8 + (lane >> 3), k = lane & 7; const u32x2 rec = asg[(size_t)tok * TOPK + k];
          const int e = rec.x & 255, rl = rec.x >> 8; const int dest = __shfl(my, e) + rl;
          rowasg[dest] = tok * ASG_PER_TOK + k; rowtok[dest] = tok; rowg[dest] = __uint_as_float(rec.y); }
        if (lane < 8) { const int tok = wi * 8 + lane, dest = rtot + tok; rowasg[dest] = tok * ASG_PER_TOK + 8; rowtok[dest] = tok; rowg[dest] = 1.f; }
        if (wi == 0) { for (int sl = pstart + total; sl < pstart + padded; ++sl) { rowasg[sl] = -1; rowtok[sl] = M; rowg[sl] = 0.f; }
                       ((int*)(ws + WS_CNT))[lane] = total; }
    }
}
__device__ __forceinline__ int build_blocks(Frame& F, LAS unsigned char* blk_e, LAS int* tmp) {
    const int* cnt = (const int*)(F.ws + WS_CNT);
    if (F.tid < NEX) tmp[F.tid] = F.tid < NE ? (cnt[F.tid] + 255) >> 8 : M / 256;
    __syncthreads();
    if (F.tid < NEX) { int st = 0; for (int e = 0; e < F.tid; ++e) st += tmp[e]; const int nb = tmp[F.tid]; for (int i = 0; i < nb; ++i) blk_e[st + i] = (unsigned char)F.tid; if (F.tid == NEX - 1) tmp[NEX] = st + nb; }
    __syncthreads();
    return tmp[NEX];
}
__device__ __forceinline__ void p10_combine(Frame& F) {
    const unsigned char* Y = (const unsigned char*)(F.ws + WS_Y); float* O = F.out; const bf16_t* X1 = (const bf16_t*)(F.ws + WS_X1B); const int lane = F.lane;
    for (int tok = F.gw; tok < M; tok += F.NGW) {
#pragma unroll
        for (int c = 0; c < 2; ++c) { const int col = 16 * lane + 1024 * c; float* op = O + (size_t)tok * D + col;
            const u32x4 xa = *(const u32x4*)(X1 + (size_t)tok * D + col), xb = *(const u32x4*)(X1 + (size_t)tok * D + col + 8);
            const f32x4 x0 = {bf_lo(xa.x), bf_hi(xa.x), bf_lo(xa.y), bf_hi(xa.y)}, x1 = {bf_lo(xa.z), bf_hi(xa.z), bf_lo(xa.w), bf_hi(xa.w)}, x2 = {bf_lo(xb.x), bf_hi(xb.x), bf_lo(xb.y), bf_hi(xb.y)}, x3 = {bf_lo(xb.z), bf_hi(xb.z), bf_lo(xb.w), bf_hi(xb.w)};
            u32x4 y[ASG_PER_TOK];
#pragma unroll
            for (int k = 0; k < ASG_PER_TOK; ++k) y[k] = *(const u32x4*)(Y + ((size_t)tok * ASG_PER_TOK + k) * D + col);
            float a[16];
#pragma unroll
            for (int e = 0; e < 16; ++e) a[e] = 0.f;
#pragma unroll
            for (int k = 0; k < ASG_PER_TOK; ++k)
#pragma unroll
                for (int q = 0; q < 4; ++q) { const auto lo = __builtin_amdgcn_cvt_pk_f32_fp8((int)y[k][q], false); const auto hi = __builtin_amdgcn_cvt_pk_f32_fp8((int)y[k][q], true);
                    a[4 * q] += lo[0]; a[4 * q + 1] += lo[1]; a[4 * q + 2] += hi[0]; a[4 * q + 3] += hi[1]; }
            const float r = 1.f / Y_SCALE;
            *(f32x4*)op = (f32x4){x0[0] + a[0] * r, x0[1] + a[1] * r, x0[2] + a[2] * r, x0[3] + a[3] * r};
            *(f32x4*)(op + 4) = (f32x4){x1[0] + a[4] * r, x1[1] + a[5] * r, x1[2] + a[6] * r, x1[3] + a[7] * r};
            *(f32x4*)(op + 8) = (f32x4){x2[0] + a[8] * r, x2[1] + a[9] * r, x2[2] + a[10] * r, x2[3] + a[11] * r};
            *(f32x4*)(op + 12) = (f32x4){x3[0] + a[12] * r, x3[1] + a[13] * r, x3[2] + a[14] * r, x3[3] + a[15] * r}; }
    }
}

constexpr int N_PHASES = 11;
struct Args { const float* in[31]; float* out; unsigned char* ws; int ph_lo, ph_hi, use_bar, pad; };
__global__ void __launch_bounds__(512, 2) mega(Args args) {
    extern __shared__ __attribute__((aligned(16))) unsigned char lds_raw[];
    LAS unsigned char* lds = (LAS unsigned char*)lds_raw;
    Frame F; F.lds = lds; F.tid = threadIdx.x; F.lane = F.tid & 63; F.wave = __builtin_amdgcn_readfirstlane(F.tid >> 6); F.G = gridDim.x;
    F.gw = blockIdx.x * 8 + F.wave; F.NGW = F.G * 8; F.out = args.out; F.ws = args.ws;
    unsigned char* ws = args.ws;
    unsigned* ctl = (unsigned*)(ws + WS_CTL);
    for (int u = F.tid; u < 256; u += 512) ((LAS unsigned*)(lds + LDSCTL_OFF))[u] = 0u;
    __syncthreads();
    XcdBarrier bar; bar.bar = ctl + CW_BAR; bar.x = 0; bar.st = nullptr;
    if (args.use_bar) bar = xcd_barrier_post(ctl + CW_BAR, (volatile LAS unsigned*)(lds + LDSCTL_OFF));
    const int lo = args.ph_lo, hi = args.ph_hi;
#ifndef PH_MASK
#define PH_MASK 0x7ff
#endif
#define IN(k) (((PH_MASK >> (k)) & 1) && lo <= (k) && (k) < hi)
#define SEAM(k) do { if (IN(k) && IN((k) + 1)) xcd_barrier(bar); } while (0)
    const int c = (int)blockIdx.x;
#ifndef REP_PHASE
#define REP_PHASE -1
#endif
#define RUN(k, ...) do { if (IN(k)) { const int rep = 0; (void)rep; __VA_ARGS__ } if (REP_PHASE == (k) && IN(k)) { xcd_barrier(bar); const int rep = 1; (void)rep; __VA_ARGS__ } } while (0)
    RUN(0, p0_prologue(F); ); SEAM(0);
    RUN(1,
        Epi1 E{(bf16_t*)(ws + WS_PA), (unsigned char*)(ws + WS_PG), (float*)(ws + WS_GL), (bf16_t*)(ws + WS_KVMEM)};
        { Sched1 S; S.o.init(64, NB16 + 1); S.A = (const char*)(ws + WS_A3); S.Bt = (const char*)(ws + WS_WINT); S.G = F.G; S.c = c; S.fp8 = 0;
          pg8::gemm_phase<Epi1, Sched1, false, false>(lds, 2 * D, 2 * D, S, E); }
        { Sched1 S; S.o.init(64, 24 + NF8); S.A = (const char*)(ws + WS_H8); S.Bt = (const char*)(ws + WS_WIN8); S.G = F.G; S.c = c; S.fp8 = 1;
          pg8::gemm_phase<Epi1, Sched1, false, true>(lds, D, D, S, E); }
    ); SEAM(1);
    RUN(2, p2_thin(F); ); SEAM(2);
    RUN(3,
        att::Tensors Tn{(const bf16_t*)(ws + WS_PA), (const float*)(ws + WS_GL), (const bf16_t*)(ws + WS_KVMEM), (const bf16_t*)(ws + WS_KC), (const bf16_t*)(ws + WS_VC), (const float*)(ws + WS_CUM),
                        (bf16_t*)(ws + WS_A3), F.in(I_NSA_Q_G), F.in(I_FOX_Q_G), F.in(I_MEM_Q_G), F.in(I_REL_BIAS)};
        att::attn_phase(F, (LAS char*)lds, Tn, ctl + CW_QUEUE + rep * 256);
    ); SEAM(3);
    RUN(4,
        Sched4 S; S.o.init(64, 8); S.A = (const char*)(ws + WS_A3); S.Bt = (const char*)(ws + WS_WOT); S.G = F.G; S.c = c;
        Epi4 E{(const unsigned char*)(ws + WS_PG), (bf16_t*)(ws + WS_PA)};
        pg8::gemm_phase<Epi4, Sched4, false>(lds, 2 * D, 2 * D, S, E);
    ); SEAM(4);
    RUN(5,
        Sched5 S; S.o.init(64, 8); S.A = (const char*)(ws + WS_PA); S.Bt = (const char*)(ws + WS_WOUTT); S.G = F.G; S.c = c;
        Epi5 E{F.in(I_X), (bf16_t*)(ws + WS_X1B)};
        pg8::gemm_phase<Epi5, Sched5, false>(lds, 2 * D, 2 * D, S, E);
    ); SEAM(5);
    RUN(6, p6_router(F); ); SEAM(6);
    RUN(7, p7_slots(F); ); SEAM(7);
    RUN(8,
        LAS unsigned char* blk_e = lds + EPI_OFF; LAS int* tmp = (LAS int*)(lds + EPI_OFF + 1024);
        const int nblk = build_blocks(F, blk_e, tmp);
        SchedMoe S{blk_e, nblk, F.G, c, 2, (const char*)(ws + WS_A3), (const char*)(ws + WS_WGU), (const int*)(ws + WS_ROWTOK), true};
        Epi8 E{(unsigned char*)(ws + WS_PG)};
        pg8::gemm_phase<Epi8, SchedMoe, true, true>(lds, D, D, S, E);
    ); SEAM(8);
    RUN(9,
        LAS unsigned char* blk_e = lds + EPI_OFF; LAS int* tmp = (LAS int*)(lds + EPI_OFF + 1024);
        const int nblk = build_blocks(F, blk_e, tmp);
        SchedMoe S{blk_e, nblk, F.G, c, 3, (const char*)(ws + WS_PG), (const char*)(ws + WS_WD), nullptr, false};
        Epi9 E{(const int*)(ws + WS_ROWASG), (const float*)(ws + WS_ROWG), (unsigned char*)(ws + WS_Y)};
        pg8::gemm_phase<Epi9, SchedMoe, false, true>(lds, DE, DE, S, E);
    ); SEAM(9);
    RUN(10, p10_combine(F); );
#undef RUN
#undef IN
#undef SEAM
}

#ifndef MK_PER_PHASE
#define MK_PER_PHASE 0
#endif
extern "C" void kernel_launch(void* const* d_in, const int* in_sizes, int n_in, void* d_out, int out_size, void* d_ws, size_t ws_size, hipStream_t stream) {
    static int grid = 0;
    if (grid == 0) {
        if (n_in != N_IN || in_sizes[0] != M * D || out_size != M * D || ws_size < WS_END) { fprintf(stderr, "kernel_launch: unexpected shapes (n_in %d, in0 %d, out %d, ws %zu; need ws >= %zu)\n", n_in, n_in > 0 ? in_sizes[0] : -1, out_size, ws_size, (size_t)WS_END); grid = -1; return; }
        int dev = 0, cus = 0, per_cu = 0;
        if (hipGetDevice(&dev) != hipSuccess || hipDeviceGetAttribute(&cus, hipDeviceAttributeMultiprocessorCount, dev) != hipSuccess) { grid = -1; return; }
        if (hipFuncSetAttribute((const void*)mega, hipFuncAttributeMaxDynamicSharedMemorySize, LDS_BYTES) != hipSuccess) { fprintf(stderr, "kernel_launch: hipFuncSetAttribute failed\n"); grid = -1; return; }
        if (hipOccupancyMaxActiveBlocksPerMultiprocessor(&per_cu, (const void*)mega, 512, LDS_BYTES) != hipSuccess || per_cu < 1) fprintf(stderr, "kernel_launch: occupancy query says %d\n", per_cu);
        (void)hipGetLastError();
        grid = cus;
    }
    if (grid < 0) return;
    (void)hipMemsetAsync((char*)d_ws + WS_CTL, 0, CTL_ZERO_BYTES, stream);
    Args a{};
    for (int i = 0; i < 31; ++i) a.in[i] = (const float*)d_in[i];
    a.out = (float*)d_out; a.ws = (unsigned char*)d_ws; a.pad = 0;
#if MK_PER_PHASE
    for (int p = 0; p < N_PHASES; ++p) { a.ph_lo = p; a.ph_hi = p + 1; a.use_bar = 0; hipLaunchKernelGGL(mega, dim3(grid), dim3(512), LDS_BYTES, stream, a); }
#else
    a.ph_lo = 0; a.ph_hi = N_PHASES; a.use_bar = 1; hipLaunchKernelGGL(mega, dim3(grid), dim3(512), LDS_BYTES, stream, a);
#endif
}
```

```cpp
#include <hip/hip_runtime.h>
#include <cstdio>
#include <cstdint>

#define LAS __attribute__((address_space(3)))
#define GAS __attribute__((address_space(1)))
typedef unsigned short bf16_t;
typedef short bf16x8 __attribute__((ext_vector_type(8)));
typedef short s16x4 __attribute__((ext_vector_type(4)));
typedef float f32x2 __attribute__((ext_vector_type(2)));
typedef float f32x4 __attribute__((ext_vector_type(4)));
typedef float f32x16 __attribute__((ext_vector_type(16)));
typedef unsigned u32x2 __attribute__((ext_vector_type(2)));
typedef unsigned u32x4 __attribute__((ext_vector_type(4)));
typedef GAS unsigned gu32;

constexpr int NB = 8, T = 2048, D = 2048, M = NB * T;
constexpr int HD = 128;
constexpr int MEMT = 256, MROWS = NB * MEMT;
constexpr int NE = 64, TOPK = 8, DE = 512, NEX = NE + 1;
constexpr int W_IN_COLS = 10780;
constexpr int NPA = 4608, NPG = 6144, NPAD = 11008;
constexpr int LDG = 32;
constexpr float RMS_EPS = 1e-6f;
constexpr float LOG2E = 1.4426950408889634f;
constexpr float ATTN_SCALE = 0.08838834764831845f;
constexpr int CQ_NSA = 0, CK_CMP = 1024, CV_CMP = 1280, CK_SLC = 1536, CV_SLC = 1792, CK_WIN = 2048, CV_WIN = 2304;
constexpr int CQ_FOX = 2560, CK_FOX = 3072, CV_FOX = 3584, CQ_MEM = 4096;
constexpr int ASG_PER_TOK = 9;
constexpr int MAXSLOT = M * TOPK + NE * 256 + M;

constexpr size_t MiB = 1u << 20;
constexpr size_t WS_CTL = 0, CTL_ZERO_BYTES = 1 * MiB;
constexpr size_t WS_GL = 1 * MiB;
constexpr size_t WS_KVMEM = 3 * MiB;
constexpr size_t WS_KC = 7 * MiB, WS_VC = WS_KC + 512 * 1024;
constexpr size_t WS_CUM = 8 * MiB;
constexpr size_t WS_CBIAS = WS_CUM + 256 * 1024;
constexpr size_t WS_HIST = WS_CUM + 512 * 1024;
constexpr size_t WS_ASG = 9 * MiB;
constexpr size_t WS_ROWASG = 10 * MiB;
constexpr size_t WS_ROWG = 11 * MiB;
constexpr size_t WS_CNT = 12 * MiB;
constexpr size_t WS_WRT = 12 * MiB + 256 * 1024;
constexpr size_t WS_WCK = 13 * MiB, WS_WCV = 14 * MiB;
constexpr size_t WS_WOT = 16 * MiB;
constexpr size_t WS_WOUTT = 24 * MiB;
constexpr size_t WS_WD = 32 * MiB;
constexpr size_t WS_PG = WS_WD + (size_t)NEX * 2 * MiB;
constexpr size_t WS_Y = WS_PG + 192 * MiB;
constexpr size_t WS_WGU = WS_Y;
constexpr size_t WS_WINT = WS_WGU + (size_t)NEX * 4 * MiB;
constexpr size_t WS_PA = WS_WINT + 47 * MiB;
constexpr size_t WS_A3 = WS_PA + 144 * MiB;
constexpr size_t WS_WIN8 = WS_Y + 578 * MiB;
constexpr size_t WS_H8 = WS_WIN8 + 24 * MiB;
constexpr size_t WS_END = WS_H8 + 32 * MiB;
constexpr size_t WS_X1B = WS_PA + 64 * MiB;
static_assert(WS_A3 + (size_t)(M + MROWS) * D * 2 <= WS_Y + 576 * MiB, "ws map");
static_assert((size_t)MAXSLOT * DE * 2 <= 192 * MiB, "hid fits projG");
static_assert((size_t)MAXSLOT * 4 <= 1 * MiB, "row tables");

constexpr int CW_BAR = 4096;
constexpr int CW_QUEUE = 8192;

constexpr int RING_BYTES = 131072;
constexpr int LDSCTL_OFF = RING_BYTES;
constexpr int EPI_OFF = RING_BYTES + 1024;
constexpr int LDS_BYTES = RING_BYTES + 1024 + 8192 + 4096;

#define RLX_AGENT __ATOMIC_RELAXED, __HIP_MEMORY_SCOPE_AGENT
__device__ __forceinline__ unsigned cvtpk(float lo, float hi) { unsigned r; asm volatile("v_cvt_pk_bf16_f32 %0, %1, %2" : "=v"(r) : "v"(lo), "v"(hi)); return r; }
__device__ __forceinline__ float bf_lo(unsigned u) { return __uint_as_float(u << 16); }
__device__ __forceinline__ float bf_hi(unsigned u) { return __uint_as_float(u & 0xffff0000u); }
__device__ __forceinline__ float wave_sum(float v) {
#pragma unroll
    for (int o = 1; o < 64; o <<= 1) v += __shfl_xor(v, o);
    return v;
}
constexpr float WGU_SCALE = 32.f, WD_SCALE = 16.f, WIN_SCALE = 32.f;
__device__ __forceinline__ unsigned pk_fp8x4(float a, float b, float c, float d) { int w = 0; w = __builtin_amdgcn_cvt_pk_fp8_f32(a, b, w, false); w = __builtin_amdgcn_cvt_pk_fp8_f32(c, d, w, true); return (unsigned)w; }
__device__ __forceinline__ float fast_sigmoid(float x) { return __builtin_amdgcn_rcpf(1.f + __builtin_amdgcn_exp2f(-x * LOG2E)); }

#define XB_TMO      128
#define XB_XCNT(j)  (256  + 64 * (j))
#define XB_XSUB(j)  (1280 + 64 * (j))
#define XB_XGEN(j)  (2304 + 64 * (j))
#define XB_TOP      3328
#define XB_TOPGEN   3392
#define XCD_BAR_WORDS 3456
#define XB_SPIN_CAP (1u << 18)
__device__ __forceinline__ unsigned xb_ld(unsigned* p)              { return __hip_atomic_load(p, __ATOMIC_RELAXED, __HIP_MEMORY_SCOPE_AGENT); }
__device__ __forceinline__ unsigned xb_add(unsigned* p, unsigned v) { return __hip_atomic_fetch_add(p, v, __ATOMIC_RELAXED, __HIP_MEMORY_SCOPE_AGENT); }
__device__ __forceinline__ unsigned xb_xcc_id() { return (unsigned)__builtin_amdgcn_s_getreg((3 << 11) | 20) & 0xFu; }
#define XB_SPIN(cond, bar) do { unsigned _sp = 0; while (cond) { __builtin_amdgcn_s_sleep(1); \
    if ((++_sp & 255u) == 0u) { if (xb_ld(&(bar)[XB_TMO])) break; if (_sp > XB_SPIN_CAP) { atomicAdd(&(bar)[XB_TMO], 1u); break; } } } } while (0)
struct XcdBarrier { unsigned* bar; unsigned x; volatile LAS unsigned* st; };
__device__ __forceinline__ XcdBarrier xcd_barrier_post(unsigned* bar, volatile LAS unsigned* st) {
    XcdBarrier b; b.bar = bar; b.x = xb_xcc_id(); b.st = st;
    if (threadIdx.x == 0) (void)xb_add(&bar[XB_XCNT(b.x)], 1u);
    return b;
}
__device__ __forceinline__ void xcd_barrier_complete(unsigned* bar, unsigned x, unsigned& nloc, unsigned& nx) {
    const unsigned G = gridDim.x * gridDim.y * gridDim.z;
    unsigned sum, cnt, mine, sp = 0u;
    for (;;) {
        sum = 0u; cnt = 0u; mine = 0u;
#pragma unroll
        for (unsigned j = 0; j < 16; ++j) { const unsigned c = xb_ld(&bar[XB_XCNT(j)]); sum += c; cnt += (c > 0u) ? 1u : 0u; mine = (j == x) ? c : mine; }
        if (sum == G) break;
        __builtin_amdgcn_s_sleep(1);
        if ((++sp & 255u) == 0u) { if (xb_ld(&bar[XB_TMO])) break; if (sp > XB_SPIN_CAP) { atomicAdd(&bar[XB_TMO], 1u); break; } }
    }
    nloc = mine > 0u ? mine : 1u; nx = cnt > 0u ? cnt : 1u;
}
__device__ __forceinline__ void xcd_barrier(const XcdBarrier& b) {
    asm volatile("s_waitcnt vmcnt(0)" ::: "memory");
    __syncthreads();
    if (threadIdx.x == 0) {
        unsigned* bar = b.bar;
        __builtin_amdgcn_s_waitcnt(0);
        unsigned nloc = b.st[0], nx = b.st[1];
        if (nloc == 0u) { xcd_barrier_complete(bar, b.x, nloc, nx); b.st[0] = nloc; b.st[1] = nx; }
        const unsigned old = xb_add(&bar[XB_XSUB(b.x)], 1u);
        const unsigned gen = old / nloc;
        if (old + 1u == (gen + 1u) * nloc) {
            __builtin_amdgcn_fence(__ATOMIC_RELEASE, "agent");
            asm volatile("s_waitcnt vmcnt(0)" ::: "memory");
            const unsigned og = xb_add(&bar[XB_TOP], 1u);
            const unsigned tg = og / nx;
            if (og + 1u == (tg + 1u) * nx) xb_add(&bar[XB_TOPGEN], 1u);
            else XB_SPIN(xb_ld(&bar[XB_TOPGEN]) == tg, bar);
            __builtin_amdgcn_fence(__ATOMIC_ACQUIRE, "agent");
            xb_add(&bar[XB_XGEN(b.x)], 1u);
            asm volatile("s_waitcnt vmcnt(0)" ::: "memory");
        } else {
            XB_SPIN(xb_ld(&bar[XB_XGEN(b.x)]) == gen, bar);
            __builtin_amdgcn_fence(__ATOMIC_ACQUIRE, "agent");
            asm volatile("s_waitcnt vmcnt(0)" ::: "memory");
        }
    }
    __syncthreads();
}

namespace pg8 {
constexpr int BM = 256, BK = 64, HALF = 128, HTB = HALF * BK * 2, STAGE_BYTES = 8 * HTB, NXCD = 8, WGM = 8;
__host__ __device__ __forceinline__ int lds_byte(int r, int c) { const int st = (r >> 4) * 2 + (c >> 5), rr = r & 15, cc = c & 31, ob = rr * 64 + cc * 2; return st * 1024 + (ob ^ (((ob >> 9) & 1) << 5)); }
__host__ __device__ __forceinline__ void stage_rc(int b, int& R, int& C) { const int st = b / 1024, sb = b % 1024, swz = sb ^ (((sb >> 9) & 1) << 5); R = (st >> 1) * 16 + swz / 64; C = (st & 1) * 32 + (swz % 64) / 2; }
__host__ __device__ __forceinline__ int perm32(int rho) { const int n = rho >> 4, i = rho & 15; return 8 * (i >> 2) + 4 * n + (i & 3); }

template <bool FP8> struct FragSel { struct A4 { bf16x8 f[4][2]; }; struct B2 { bf16x8 f[2][2]; }; };
template <> struct FragSel<true> { typedef int v8i_ __attribute__((ext_vector_type(8))); struct A4 { v8i_ f[4]; }; struct B2 { v8i_ f[2]; }; };
struct Unit { const char* A; const char* B; const int* ridx; int nt, pm, pn, aux; };

template <class Epi, class Sched, bool GATHER, bool FP8 = false>
__device__ __forceinline__ void gemm_phase(LAS unsigned char* lds, const int lda, const int ldb, const Sched& S, const Epi& E) {
    const int tid = threadIdx.x, wid = __builtin_amdgcn_readfirstlane(tid >> 6), lane = tid & 63, wr = wid >> 2, wc = wid & 3, fr = lane & 15, fq = lane >> 4;
    unsigned voffA[2], voffB[2]; int RA[2], CA[2];
#pragma unroll
    for (int i = 0; i < 2; ++i) { int R, C; stage_rc(tid * 16 + i * 8192, R, C); const int Rb = (R & ~31) + perm32(R & 31);
        RA[i] = R; CA[i] = C; voffA[i] = (unsigned)(R * lda + 2 * C); voffB[i] = (unsigned)(Rb * ldb + 2 * C); }
    const size_t kstep = (size_t)(BK * 2);
    const size_t hstepA = (size_t)HALF * lda, hstepB = (size_t)HALF * ldb;
    const unsigned ldsw = (unsigned)wid * 1024u;
    const int aoff = lds_byte(wr * 64 + fr, fq * 8), boff = lds_byte(wc * 32 + fr, fq * 8);
#define PG8_SA(b, h) (((b) * 2 + (h)) * HTB)
#define PG8_SB(b, h) ((4 + (b) * 2 + (h)) * HTB)
#define PG8_STG(bufoff, gptr, v0, v1) do { \
        __builtin_amdgcn_global_load_lds((const unsigned*)((const char*)(gptr) + (v0)), (LAS unsigned*)(lds + (bufoff) + ldsw), 16, 0, 0); \
        __builtin_amdgcn_global_load_lds((const unsigned*)((const char*)(gptr) + (v1)), (LAS unsigned*)(lds + (bufoff) + ldsw + 8192), 16, 0, 0); } while (0)
#define PG8_STB(b, h, kp) PG8_STG(PG8_SB(b, h), (kp) + (h) * hstepB, voffB[0], voffB[1])
#define PG8_STA_CUR(b, h, kp) do { if constexpr (GATHER) PG8_STG(PG8_SA(b, h), (kp), vg[h][0], vg[h][1]); else PG8_STG(PG8_SA(b, h), (kp) + (h) * hstepA, voffA[0], voffA[1]); } while (0)
#define PG8_STA_SEL(b, h, kp) do { if constexpr (GATHER) { const unsigned s0_ = last ? nvg[h][0] : vg[h][0], s1_ = last ? nvg[h][1] : vg[h][1]; PG8_STG(PG8_SA(b, h), (kp), s0_, s1_); } \
        else PG8_STG(PG8_SA(b, h), (kp) + (h) * hstepA, voffA[0], voffA[1]); } while (0)
#define PG8_LD16(off) (*(const LAS u32x4*)(lds + (off)))
#define PG8_LDA(dst, b, h) do { _Pragma("unroll") for (int m = 0; m < 4; ++m) { if constexpr (FP8) { const u32x4 lo_ = PG8_LD16(PG8_SA(b, h) + aoff + m * 2048), hi_ = PG8_LD16(PG8_SA(b, h) + aoff + m * 2048 + 1024); \
            dst.f[m] = __builtin_bit_cast(v8i_, __builtin_shufflevector(lo_, hi_, 0, 1, 2, 3, 4, 5, 6, 7)); } \
        else { _Pragma("unroll") for (int k = 0; k < 2; ++k) dst.f[m][k] = *(const LAS bf16x8*)(lds + PG8_SA(b, h) + aoff + m * 2048 + k * 1024); } } } while (0)
#define PG8_LDB(dst, b, h) do { _Pragma("unroll") for (int n = 0; n < 2; ++n) { if constexpr (FP8) { const u32x4 lo_ = PG8_LD16(PG8_SB(b, h) + boff + n * 2048), hi_ = PG8_LD16(PG8_SB(b, h) + boff + n * 2048 + 1024); \
            dst.f[n] = __builtin_bit_cast(v8i_, __builtin_shufflevector(lo_, hi_, 0, 1, 2, 3, 4, 5, 6, 7)); } \
        else { _Pragma("unroll") for (int k = 0; k < 2; ++k) dst.f[n][k] = *(const LAS bf16x8*)(lds + PG8_SB(b, h) + boff + n * 2048 + k * 1024); } } } while (0)
#define PG8_MMA(ai, bj, At, Bt) do { __builtin_amdgcn_s_setprio(1); _Pragma("unroll") for (int m = 0; m < 4; ++m) _Pragma("unroll") for (int n = 0; n < 2; ++n) { \
        if constexpr (FP8) asm volatile("v_mfma_scale_f32_16x16x128_f8f6f4 %0, %1, %2, %0, %3, %3 op_sel_hi:[0,0,0]" : "+v"(acc[ai][bj][m][n]) : "v"(Bt.f[n]), "v"(At.f[m]), "v"(fp8_one)); \
        else { _Pragma("unroll") for (int k = 0; k < 2; ++k) acc[ai][bj][m][n] = __builtin_amdgcn_mfma_f32_16x16x32_bf16(Bt.f[n][k], At.f[m][k], acc[ai][bj][m][n], 0, 0, 0); } } \
        __builtin_amdgcn_s_setprio(0); } while (0)
#define PG8_WAIT_V(n) asm volatile("s_waitcnt vmcnt(" #n ")" ::: "memory")
#define PG8_WAIT_L(n) asm volatile("s_waitcnt lgkmcnt(" #n ")" ::: "memory")
#define PG8_BAR __builtin_amdgcn_s_barrier()
#define PG8_SCHED __builtin_amdgcn_sched_barrier(0)
#define PG8_LOADIDX(dst, u) do { if constexpr (GATHER) { _Pragma("unroll") for (int h = 0; h < 2; ++h) _Pragma("unroll") for (int i = 0; i < 2; ++i) \
        dst[h][i] = (unsigned)(u).ridx[h * HALF + RA[i]] * (unsigned)lda + (unsigned)(CA[i] * 2); } } while (0)
    Unit cur, nxt; int ui = 0;
    if (!S.next(0, cur)) return;
#define PG8_PIN_ACC() do { _Pragma("unroll") for (int a_ = 0; a_ < 2; ++a_) _Pragma("unroll") for (int b_ = 0; b_ < 2; ++b_) \
        asm volatile("" : "+v"(acc[a_][b_][0][0]), "+v"(acc[a_][b_][0][1]), "+v"(acc[a_][b_][1][0]), "+v"(acc[a_][b_][1][1]), "+v"(acc[a_][b_][2][0]), "+v"(acc[a_][b_][2][1]), "+v"(acc[a_][b_][3][0]), "+v"(acc[a_][b_][3][1])); } while (0)

    f32x4 acc[2][2][4][2];
    E.init(acc, cur, wr, wc, fr, fq);
    typedef int v8i_ __attribute__((ext_vector_type(8)));
    typedef typename pg8::FragSel<FP8>::A4 FragA; typedef typename pg8::FragSel<FP8>::B2 FragB;
    FragA At; FragB B0, B1;
    int fp8_one = 0x7f7f7f7f; if constexpr (FP8) asm volatile("" : "+v"(fp8_one));
    unsigned vg[2][2] = {{0u, 0u}, {0u, 0u}}, nvg[2][2] = {{0u, 0u}, {0u, 0u}};
    const char* cA = cur.A; const char* cB = cur.B;
    PG8_LOADIDX(vg, cur);
    { const bool last = false; (void)last;
      PG8_STB(0, 0, cB); PG8_STB(0, 1, cB); PG8_STA_CUR(0, 0, cA); PG8_STA_CUR(0, 1, cA);
      if (wr == 1) PG8_BAR;
      PG8_WAIT_V(2); PG8_BAR;
      PG8_STB(1, 0, cB + kstep); PG8_STA_CUR(1, 0, cA + kstep); PG8_STB(1, 1, cB + kstep);
      PG8_WAIT_V(6); PG8_BAR; }
    if constexpr (Epi::INIT_LOADS) PG8_PIN_ACC();
    for (;;) {
        const bool has_next = S.next(ui + 1, nxt);
        const char* nA = has_next ? nxt.A : cA; const char* nB = has_next ? nxt.B : cB;
        if constexpr (GATHER) { if (has_next) { PG8_LOADIDX(nvg, nxt); } else { nvg[0][0] = vg[0][0]; nvg[0][1] = vg[0][1]; nvg[1][0] = vg[1][0]; nvg[1][1] = vg[1][1]; } }
        const int nt = cur.nt;
        for (int t = 0; t < nt; t += 2) {
            const bool last = (t == nt - 2);
            const char* a1 = cA + (size_t)(t + 1) * kstep;
            const char* a2 = last ? nA : cA + (size_t)(t + 2) * kstep; const char* b2 = last ? nB : cB + (size_t)(t + 2) * kstep;
            const char* a3 = a2 + kstep; const char* b3 = b2 + kstep;
            PG8_LDB(B0, 0, 0); PG8_LDB(B1, 0, 1); PG8_SCHED; PG8_LDA(At, 0, 0); PG8_STA_CUR(1, 1, a1);
            PG8_WAIT_V(8); PG8_WAIT_L(0); PG8_BAR; PG8_MMA(0, 0, At, B0); PG8_MMA(0, 1, At, B1); PG8_BAR; PG8_SCHED;
            PG8_LDA(At, 0, 1); PG8_STB(0, 0, b2); PG8_STB(0, 1, b2); PG8_STA_SEL(0, 0, a2);
            PG8_WAIT_V(8); PG8_WAIT_L(0); PG8_BAR; PG8_MMA(1, 0, At, B0); PG8_MMA(1, 1, At, B1); PG8_BAR; PG8_SCHED;
            PG8_LDB(B0, 1, 0); PG8_LDB(B1, 1, 1); PG8_SCHED; PG8_LDA(At, 1, 0); PG8_STA_SEL(0, 1, a2);
            PG8_WAIT_V(8); PG8_WAIT_L(0); PG8_BAR; PG8_MMA(0, 0, At, B0); PG8_MMA(0, 1, At, B1); PG8_BAR; PG8_SCHED;
            PG8_LDA(At, 1, 1); PG8_STB(1, 0, b3); PG8_STB(1, 1, b3); PG8_STA_SEL(1, 0, a3);
            PG8_WAIT_V(8); PG8_WAIT_L(0); PG8_BAR; PG8_MMA(1, 0, At, B0); PG8_MMA(1, 1, At, B1); PG8_BAR; PG8_SCHED;
        }
        if (wr == 0) PG8_BAR;
        if constexpr (FP8) { asm volatile("s_nop 15\n\ts_nop 15\n\ts_nop 15" ::: "memory"); PG8_PIN_ACC(); }
        E(acc, cur, wr, wc, fr, fq);
        if (!has_next) break;
        E.init(acc, nxt, wr, wc, fr, fq);
        if constexpr (Epi::INIT_LOADS) PG8_PIN_ACC();
        cur = nxt; cA = nA; cB = nB; ++ui;
        if constexpr (GATHER) { vg[0][0] = nvg[0][0]; vg[0][1] = nvg[0][1]; vg[1][0] = nvg[1][0]; vg[1][1] = nvg[1][1]; }
        if (wr == 1) PG8_BAR;
    }
    PG8_WAIT_V(0);
    PG8_BAR;
#undef PG8_SA
#undef PG8_SB
#undef PG8_STG
#undef PG8_STB
#undef PG8_STA_CUR
#undef PG8_STA_SEL
#undef PG8_LDA
#undef PG8_LD16
#undef PG8_LDB
#undef PG8_MMA
#undef PG8_WAIT_V
#undef PG8_WAIT_L
#undef PG8_BAR
#undef PG8_SCHED
#undef PG8_LOADIDX
#undef PG8_PIN_ACC
}
}

#define EPI_ZERO_INIT static constexpr bool INIT_LOADS = false; __device__ __forceinline__ void init(f32x4 (&acc)[2][2][4][2], const pg8::Unit&, int, int, int, int) const { \
        _Pragma("unroll") for (int a = 0; a < 2; ++a) _Pragma("unroll") for (int b = 0; b < 2; ++b) _Pragma("unroll") for (int m = 0; m < 4; ++m) _Pragma("unroll") for (int n = 0; n < 2; ++n) acc[a][b][m][n] = (f32x4){0.f, 0.f, 0.f, 0.f}; }
constexpr size_t WS_ROWTOK = 15 * MiB;
struct TileOrder {
    int nM, nN, nwg;
    __device__ __forceinline__ void init(int nM_, int nN_) { nM = nM_; nN = nN_; nwg = nM_ * nN_; }
    __device__ __forceinline__ void decode(int L, int& pm, int& pn) const {
        int wgid = L; { const int q = nwg / pg8::NXCD, r = nwg % pg8::NXCD, xcd = wgid % pg8::NXCD, off = wgid / pg8::NXCD; wgid = (xcd < r ? xcd * (q + 1) : r * (q + 1) + (xcd - r) * q) + off; }
        const int nig = pg8::WGM * nN, gid = wgid / nig, fm = gid * pg8::WGM, gsz = (nM - fm) < pg8::WGM ? (nM - fm) : pg8::WGM;
        pm = fm + ((wgid % nig) % gsz); pn = (wgid % nig) / gsz;
    }
};
#ifndef P1_FP8_MASK
#define P1_FP8_MASK 0x3FFFFu
#endif
constexpr unsigned FP8M = P1_FP8_MASK & 0x3ffffu;
constexpr int NF8 = __builtin_popcount(FP8M), NB16 = 18 - NF8;
__device__ __forceinline__ int nth_set(unsigned m, int n) { for (int i = 0; i < n; ++i) m &= m - 1; return __builtin_ctz(m); }
struct Sched1 {
    TileOrder o; const char* A; const char* Bt; int G, c, fp8;
    __device__ __forceinline__ bool next(int i, pg8::Unit& u) const {
        const int L = i * G + c; int pm, pn;
        if (fp8) { constexpr int NT8 = 64 * (24 + NF8), NBU = 64 * (NB16 + 1) + 32;
            int L8 = L;
            if (NBU < G) { const int RB = NT8 / G, rem = NT8 - RB * G, nfree = G - NBU;
                if (i >= RB) { const int idx = (c - NBU) + (i - RB) * nfree; if (c < NBU || idx >= rem) return false; L8 = RB * G + idx; } }
            if (L8 >= NT8) return false; o.decode(L8, pm, pn);
            u.A = A + (size_t)pm * 256 * D; u.B = Bt + (size_t)pn * 256 * D; u.nt = D / 128; pn = pn < 24 ? pn + 18 : nth_set(FP8M, pn - 24); u.aux = 1; }
        else { if (L < 64 * (NB16 + 1)) { o.decode(L, pm, pn); pn = pn == NB16 ? 42 : nth_set(~FP8M & 0x3ffffu, pn); } else if (L < 64 * (NB16 + 1) + 32) { const int r = L - 64 * (NB16 + 1); pm = 64 + (r >> 2); pn = 43 + (r & 3); } else return false;
            u.A = A + (size_t)pm * 256 * D * 2; u.B = Bt + (size_t)pn * 256 * D * 2; u.nt = D / 64; u.aux = 0; }
        u.ridx = nullptr; u.pm = pm; u.pn = pn; return true;
    }
};
struct Epi1 {
    EPI_ZERO_INIT
    bf16_t* PA; unsigned char* PG8; float* GL; bf16_t* KVM;
    __device__ __forceinline__ void operator()(const f32x4 (&acc)[2][2][4][2], const pg8::Unit& u, int wr, int wc, int fr, int fq) const {
        const int pn = u.pn; int row0 = u.pm * 256 + wr * 64 + fr;
        if (pn == 42) {
            if (wc == 0) {
#pragma unroll
                for (int ai = 0; ai < 2; ++ai)
#pragma unroll
                    for (int m = 0; m < 4; ++m) { float* p = GL + (size_t)(row0 + ai * 128 + m * 16) * LDG + 8 * fq; *(f32x4*)p = acc[ai][0][m][0]; *(f32x4*)(p + 4) = acc[ai][0][m][1]; }
            }
            return;
        }
        if (pn >= 18 && pn < 42) {
            unsigned char* gb = PG8 + (pn - 18) * 256 + wc * 32 + 8 * fq;
#pragma unroll
            for (int ai = 0; ai < 2; ++ai)
#pragma unroll
                for (int m = 0; m < 4; ++m) { unsigned char* rowp = gb + (size_t)(row0 + ai * 128 + m * 16) * NPG;
#pragma unroll
                    for (int bj = 0; bj < 2; ++bj) { const f32x4 v0 = acc[ai][bj][m][0] * (1.f / WIN_SCALE), v1 = acc[ai][bj][m][1] * (1.f / WIN_SCALE); unsigned w0 = 0u, w1 = 0u;
                        w0 = __builtin_amdgcn_cvt_pk_u8_f32(fast_sigmoid(v0[0]) * 255.f, 0, w0); w0 = __builtin_amdgcn_cvt_pk_u8_f32(fast_sigmoid(v0[1]) * 255.f, 1, w0);
                        w0 = __builtin_amdgcn_cvt_pk_u8_f32(fast_sigmoid(v0[2]) * 255.f, 2, w0); w0 = __builtin_amdgcn_cvt_pk_u8_f32(fast_sigmoid(v0[3]) * 255.f, 3, w0);
                        w1 = __builtin_amdgcn_cvt_pk_u8_f32(fast_sigmoid(v1[0]) * 255.f, 0, w1); w1 = __builtin_amdgcn_cvt_pk_u8_f32(fast_sigmoid(v1[1]) * 255.f, 1, w1);
                        w1 = __builtin_amdgcn_cvt_pk_u8_f32(fast_sigmoid(v1[2]) * 255.f, 2, w1); w1 = __builtin_amdgcn_cvt_pk_u8_f32(fast_sigmoid(v1[3]) * 255.f, 3, w1);
                        *(u32x2*)(rowp + bj * 128) = (u32x2){w0, w1}; } }
            return;
        }
        bf16_t* base; int ld;
        if (pn < 18) { base = PA + pn * 256; ld = NPA; }
        else { base = KVM + (pn - 43) * 256; ld = 1024; row0 -= M; }
        base += wc * 32 + 8 * fq;
        const float sc = u.aux ? 1.f / WIN_SCALE : 1.f;
#pragma unroll
        for (int ai = 0; ai < 2; ++ai)
#pragma unroll
            for (int m = 0; m < 4; ++m) { bf16_t* rowp = base + (size_t)(row0 + ai * 128 + m * 16) * ld;
#pragma unroll
                for (int bj = 0; bj < 2; ++bj) { const f32x4 v0 = acc[ai][bj][m][0] * sc, v1 = acc[ai][bj][m][1] * sc;
                    u32x4 w; w.x = cvtpk(v0[0], v0[1]); w.y = cvtpk(v0[2], v0[3]); w.z = cvtpk(v1[0], v1[1]); w.w = cvtpk(v1[2], v1[3]);
                    *(u32x4*)(rowp + bj * 128) = w; } }
    }
};
struct Sched4 {
    TileOrder o; const char* A; const char* Bt; int G, c;
    __device__ __forceinline__ bool next(int i, pg8::Unit& u) const {
        const int it = i / 3, br = i - it * 3, L = it * G + c; if (L >= 64 * 8) return false;
        int pm, pn; o.decode(L, pm, pn);
        const int koff = br == 0 ? 0 : (br == 1 ? 1024 : 1536);
        u.A = A + ((size_t)pm * 256 * D + koff) * 2; u.B = Bt + ((size_t)pn * 256 * D + koff) * 2; u.ridx = nullptr; u.nt = br == 0 ? 16 : 8; u.pm = pm; u.pn = pn; u.aux = br; return true;
    }
};
struct Epi4 {
    EPI_ZERO_INIT
    const unsigned char* PG8; bf16_t* Z;
    __device__ __forceinline__ void operator()(const f32x4 (&acc)[2][2][4][2], const pg8::Unit& u, int wr, int wc, int fr, int fq) const {
        const int row0 = u.pm * 256 + wr * 64 + fr, col0 = u.pn * 256 + wc * 32 + 8 * fq, br = u.aux;
#pragma unroll
        for (int ai = 0; ai < 2; ++ai) {
            u32x2 gv[4][2]; u32x4 zv[4][2];
#pragma unroll
            for (int m = 0; m < 4; ++m) { const size_t row = (size_t)(row0 + ai * 128 + m * 16);
#pragma unroll
                for (int bj = 0; bj < 2; ++bj) { const int col = col0 + bj * 128; gv[m][bj] = *(const u32x2*)(PG8 + row * NPG + br * D + col);
                    if (br > 0) zv[m][bj] = *(const u32x4*)(Z + row * D + col); else zv[m][bj] = (u32x4){0u, 0u, 0u, 0u}; } }
#pragma unroll
            for (int m = 0; m < 4; ++m) { const size_t row = (size_t)(row0 + ai * 128 + m * 16);
#pragma unroll
                for (int bj = 0; bj < 2; ++bj) { const int col = col0 + bj * 128; const u32x2 g = gv[m][bj]; const u32x4 z = zv[m][bj]; const float gs = 1.f / 255.f;
                    f32x4 v0 = acc[ai][bj][m][0] * gs, v1 = acc[ai][bj][m][1] * gs;
                    v0[0] = v0[0] * (float)(g.x & 0xffu) + bf_lo(z.x); v0[1] = v0[1] * (float)((g.x >> 8) & 0xffu) + bf_hi(z.x); v0[2] = v0[2] * (float)((g.x >> 16) & 0xffu) + bf_lo(z.y); v0[3] = v0[3] * (float)(g.x >> 24) + bf_hi(z.y);
                    v1[0] = v1[0] * (float)(g.y & 0xffu) + bf_lo(z.z); v1[1] = v1[1] * (float)((g.y >> 8) & 0xffu) + bf_hi(z.z); v1[2] = v1[2] * (float)((g.y >> 16) & 0xffu) + bf_lo(z.w); v1[3] = v1[3] * (float)(g.y >> 24) + bf_hi(z.w);
                    u32x4 w; w.x = cvtpk(v0[0], v0[1]); w.y = cvtpk(v0[2], v0[3]); w.z = cvtpk(v1[0], v1[1]); w.w = cvtpk(v1[2], v1[3]);
                    *(u32x4*)(Z + row * D + col) = w; } }
        }
    }
};
struct Sched5 {
    TileOrder o; const char* A; const char* Bt; int G, c;
    __device__ __forceinline__ bool next(int i, pg8::Unit& u) const {
        const int L = i * G + c; if (L >= 64 * 8) return false;
        int pm, pn; o.decode(L, pm, pn);
        u.A = A + (size_t)pm * 256 * D * 2; u.B = Bt + (size_t)pn * 256 * D * 2; u.ridx = nullptr; u.nt = D / 64; u.pm = pm; u.pn = pn; u.aux = 0; return true;
    }
};
struct Epi5 {
    static constexpr bool INIT_LOADS = true;
    const float* X; bf16_t* O;
    __device__ __forceinline__ void init(f32x4 (&acc)[2][2][4][2], const pg8::Unit& u, int wr, int wc, int fr, int fq) const {
        const int row0 = u.pm * 256 + wr * 64 + fr, col0 = u.pn * 256 + wc * 32 + 8 * fq;
#pragma unroll
        for (int ai = 0; ai < 2; ++ai)
#pragma unroll
            for (int m = 0; m < 4; ++m) { const size_t off = (size_t)(row0 + ai * 128 + m * 16) * D + col0;
#pragma unroll
                for (int bj = 0; bj < 2; ++bj) { acc[ai][bj][m][0] = *(const f32x4*)(X + off + bj * 128); acc[ai][bj][m][1] = *(const f32x4*)(X + off + bj * 128 + 4); } }
    }
    __device__ __forceinline__ void operator()(const f32x4 (&acc)[2][2][4][2], const pg8::Unit& u, int wr, int wc, int fr, int fq) const {
        const int row0 = u.pm * 256 + wr * 64 + fr, col0 = u.pn * 256 + wc * 32 + 8 * fq;
#pragma unroll
        for (int ai = 0; ai < 2; ++ai)
#pragma unroll
            for (int m = 0; m < 4; ++m) { const size_t off = (size_t)(row0 + ai * 128 + m * 16) * D + col0;
#pragma unroll
                for (int bj = 0; bj < 2; ++bj) { const f32x4 v0 = acc[ai][bj][m][0], v1 = acc[ai][bj][m][1];
                    u32x4 w; w.x = cvtpk(v0[0], v0[1]); w.y = cvtpk(v0[2], v0[3]); w.z = cvtpk(v1[0], v1[1]); w.w = cvtpk(v1[2], v1[3]);
                    *(u32x4*)(O + off + bj * 128) = w; } }
    }
};
struct SchedMoe {
    const LAS unsigned char* blk_e; int nblk, G, c, npn_shift;
    const char* A; const char* W; const int* rowtok; bool up;
    __device__ __forceinline__ bool next(int i, pg8::Unit& u) const {
        int L; if (G == 256) L = ((i * 8 + (c & 7)) * 32 + (c >> 3)); else L = i * G + c;
        const int blk = L >> npn_shift, pn = L & ((1 << npn_shift) - 1);
        if (blk >= nblk) { if (G != 256) return false; return false; }
        const int e = blk_e[blk];
        if (up) { u.A = A; u.ridx = rowtok + blk * 256; u.B = W + ((size_t)e * 1024 + pn * 256) * D; u.nt = D / 128; }
        else    { u.A = A + (size_t)blk * 256 * DE; u.ridx = nullptr; u.B = W + ((size_t)e * D + pn * 256) * DE; u.nt = DE / 128; }
        u.pm = blk; u.pn = pn; u.aux = e; return true;
    }
};
struct Epi8 {  EPI_ZERO_INIT
    unsigned char* HID;
    __device__ __forceinline__ void operator()(const f32x4 (&acc)[2][2][4][2], const pg8::Unit& u, int wr, int wc, int fr, int fq) const {
        const int row0 = u.pm * 256 + wr * 64 + fr, col0 = u.pn * 128 + wc * 32 + 8 * fq; const float rs = 1.f / WGU_SCALE;
#pragma unroll
        for (int ai = 0; ai < 2; ++ai)
#pragma unroll
            for (int m = 0; m < 4; ++m) { float h[8];
#pragma unroll
                for (int e = 0; e < 4; ++e) { const float g0 = acc[ai][0][m][0][e] * rs, g1 = acc[ai][0][m][1][e] * rs;
                    h[e] = __builtin_amdgcn_fmed3f(g0 * fast_sigmoid(g0) * (acc[ai][1][m][0][e] * rs), -440.f, 440.f); h[4 + e] = __builtin_amdgcn_fmed3f(g1 * fast_sigmoid(g1) * (acc[ai][1][m][1][e] * rs), -440.f, 440.f); }
                *(u32x2*)(HID + (size_t)(row0 + ai * 128 + m * 16) * DE + col0) = (u32x2){pk_fp8x4(h[0], h[1], h[2], h[3]), pk_fp8x4(h[4], h[5], h[6], h[7])}; }
    }
};
constexpr float Y_SCALE = 16.f;
struct Epi9 {  EPI_ZERO_INIT
    const int* rowasg; const float* rowg; unsigned char* Y;
    __device__ __forceinline__ void operator()(const f32x4 (&acc)[2][2][4][2], const pg8::Unit& u, int wr, int wc, int fr, int fq) const {
        const int row0 = u.pm * 256 + wr * 64 + fr, col0 = u.pn * 256 + wc * 32 + 8 * fq;
        int asg[2][4]; float g[2][4];
#pragma unroll
        for (int ai = 0; ai < 2; ++ai)
#pragma unroll
            for (int m = 0; m < 4; ++m) { const int slot = row0 + ai * 128 + m * 16; asg[ai][m] = rowasg[slot]; g[ai][m] = rowg[slot] * (Y_SCALE / WD_SCALE); }
#pragma unroll
        for (int ai = 0; ai < 2; ++ai)
#pragma unroll
            for (int m = 0; m < 4; ++m) {
                if (asg[ai][m] >= 0) { unsigned char* yp = Y + (size_t)asg[ai][m] * D + col0; const float gg = g[ai][m];
#pragma unroll
                    for (int bj = 0; bj < 2; ++bj) { f32x4 v0 = acc[ai][bj][m][0] * gg, v1 = acc[ai][bj][m][1] * gg;
#pragma unroll
                        for (int e = 0; e < 4; ++e) { v0[e] = __builtin_amdgcn_fmed3f(v0[e], -440.f, 440.f); v1[e] = __builtin_amdgcn_fmed3f(v1[e], -440.f, 440.f); }
                        int w0 = 0, w1 = 0;
                        w0 = __builtin_amdgcn_cvt_pk_fp8_f32(v0[0], v0[1], w0, false); w0 = __builtin_amdgcn_cvt_pk_fp8_f32(v0[2], v0[3], w0, true);
                        w1 = __builtin_amdgcn_cvt_pk_fp8_f32(v1[0], v1[1], w1, false); w1 = __builtin_amdgcn_cvt_pk_fp8_f32(v1[2], v1[3], w1, true);
                        *(u32x2*)(yp + bj * 128) = (u32x2){(unsigned)w0, (unsigned)w1}; } } }
    }
};

struct Frame {
    LAS unsigned char* lds; int tid, lane, wave, G, gw, NGW;
    float* out; unsigned char* ws;
    __device__ __forceinline__ const float* in(int i) const { return ((const float* const __attribute__((address_space(4)))*)__builtin_amdgcn_kernarg_segment_ptr())[i]; }
};
#define LDS_WAIT() asm volatile("s_waitcnt lgkmcnt(0)" ::: "memory")
template <class SrcCol, class DstRow>
__device__ __forceinline__ void tr_item(const float* W, size_t ldw, int k0, int n0, const SrcCol& sc, bf16_t* WT, size_t ldt, int kd0, const DstRow& dr, LAS float* scr, int lane) {
    const int c = sc(n0 + (lane & 31));
#pragma unroll 8
    for (int i = 0; i < 32; ++i) { const int kk = 2 * i + (lane >> 5); scr[kk * 33 + (lane & 31)] = c >= 0 ? W[(size_t)(k0 + kk) * ldw + c] : 0.f; }
    LDS_WAIT(); asm volatile("" ::: "memory");
    const int c8 = lane & 7;
#pragma unroll
    for (int j = 0; j < 4; ++j) { const int n = (lane >> 3) + 8 * j; const LAS float* s = scr + (8 * c8) * 33 + n;
        u32x4 o; o.x = cvtpk(s[0 * 33], s[1 * 33]); o.y = cvtpk(s[2 * 33], s[3 * 33]); o.z = cvtpk(s[4 * 33], s[5 * 33]); o.w = cvtpk(s[6 * 33], s[7 * 33]);
        *(u32x4*)(WT + (size_t)dr(n0 + n) * ldt + kd0 + k0 + 8 * c8) = o; }
    LDS_WAIT(); asm volatile("" ::: "memory");
}
struct IdCol { __device__ __forceinline__ int operator()(int n) const { return n; } };
struct OffRow { int off; __device__ __forceinline__ int operator()(int n) const { return off + n; } };
struct WinCol {
    __device__ __forceinline__ int operator()(int n) const {
        if (n < 2560) return n; if (n < 4096) return 2584 + (n - 2560); if (n < 4608) return 4124 + (n - 4096); if (n < 10752) return 4636 + (n - 4608);
        if (n < 10776) return 2560 + (n - 10752); if (n < 10780) return 4120 + (n - 10776); return -1; }
};
struct GuRow { int up; __device__ __forceinline__ int operator()(int j) const { return (j >> 7) * 256 + up * 128 + (j & 127); } };
__device__ __forceinline__ void rms_row_bf16(const float* xrow, const float* gain, bf16_t* orow, int lane) {
    f32x4 v[8]; float s = 0.f;
#pragma unroll
    for (int j = 0; j < 8; ++j) { v[j] = *(const f32x4*)(xrow + 4 * lane + 256 * j); s += (v[j].x * v[j].x + v[j].y * v[j].y) + (v[j].z * v[j].z + v[j].w * v[j].w); }
    const float rstd = __builtin_amdgcn_rsqf(wave_sum(s) * (1.f / D) + RMS_EPS);
#pragma unroll
    for (int j = 0; j < 8; ++j) { const f32x4 g = *(const f32x4*)(gain + 4 * lane + 256 * j);
        u32x2 o; o.x = cvtpk(v[j].x * rstd * g.x, v[j].y * rstd * g.y); o.y = cvtpk(v[j].z * rstd * g.z, v[j].w * rstd * g.w);
        *(u32x2*)(orow + 4 * lane + 256 * j) = o; }
}
__device__ __forceinline__ void rms_row_both(const float* xrow, const float* gain, bf16_t* orow, unsigned char* orow8, int lane) {
    f32x4 v[8]; float s = 0.f;
#pragma unroll
    for (int j = 0; j < 8; ++j) { v[j] = *(const f32x4*)(xrow + 4 * lane + 256 * j); s += (v[j].x * v[j].x + v[j].y * v[j].y) + (v[j].z * v[j].z + v[j].w * v[j].w); }
    const float rstd = __builtin_amdgcn_rsqf(wave_sum(s) * (1.f / D) + RMS_EPS);
#pragma unroll
    for (int j = 0; j < 8; ++j) { const f32x4 g = *(const f32x4*)(gain + 4 * lane + 256 * j); const float a = v[j].x * rstd * g.x, b = v[j].y * rstd * g.y, c = v[j].z * rstd * g.z, d = v[j].w * rstd * g.w;
        u32x2 o; o.x = cvtpk(a, b); o.y = cvtpk(c, d); *(u32x2*)(orow + 4 * lane + 256 * j) = o;
        *(unsigned*)(orow8 + 4 * lane + 256 * j) = pk_fp8x4(a, b, c, d); }
}
enum { I_X = 0, I_MEM, I_NORM_ATTN_G, I_W_IN, I_PE_K, I_W_CK, I_PE_V, I_W_CV, I_NSA_Q_G, I_NSA_K_G, I_REL_BIAS, I_FOX_B_F, I_FOX_Q_G, I_FOX_K_G, I_NORM_MEM_G, I_W_MEM_KV,
       I_MEM_Q_G, I_MEM_K_G, I_W_O_NSA, I_W_O_FOX, I_W_O_MEM, I_W_OUT, I_NORM_FFN_G, I_W_ROUTER, I_ROUTER_BIAS, I_WE_GATE, I_WE_UP, I_WE_DOWN, I_WS_GATE, I_WS_UP, I_WS_DOWN, N_IN };

struct TrDesc { const float* src; bf16_t* dst; unsigned ldw, ldt; };
__device__ __forceinline__ TrDesc tr_decode(const Frame& F, int t) {
    unsigned char* ws = F.ws; TrDesc d;
    bf16_t* WinT = (bf16_t*)(ws + WS_WINT); bf16_t* WkvT = WinT + (size_t)NPAD * D; bf16_t* WoT = (bf16_t*)(ws + WS_WOT);
    bf16_t* Wgu = (bf16_t*)(ws + WS_WGU); bf16_t* Wd = (bf16_t*)(ws + WS_WD);
    constexpr int T0 = 16 * 2 * NB16, T1 = T0 + 128, T2 = T1 + 128, T3 = T2 + 64, T4 = T3 + 64, T5 = T4 + 256, T6 = T5 + 32, T7 = T6 + 32, T8 = T7 + 65 * 64, T9 = T8 + 65 * 64;
    if (t < T0) { constexpr int NU = NB16 ? 2 * NB16 : 1; const int kt = t / NU, nt = t - kt * NU, n0 = 256 * nth_set(~FP8M & 0x3ffffu, nt >> 1) + 128 * (nt & 1); const int sc = WinCol{}(n0);
        d.src = F.in(I_W_IN) + (size_t)(128 * kt) * W_IN_COLS + sc; d.ldw = W_IN_COLS; d.dst = WinT + (size_t)n0 * D + 128 * kt; d.ldt = D; }
    else if (t < T1) { const int r = t - T0, kt = r >> 3, nt = r & 7; d.src = F.in(I_W_MEM_KV) + (size_t)(128 * kt) * 1024 + 128 * nt; d.ldw = 1024; d.dst = WkvT + (size_t)(128 * nt) * D + 128 * kt; d.ldt = D; }
    else if (t < T2) { const int r = t - T1, kt = r >> 4, nt = r & 15; d.src = F.in(I_W_O_NSA) + (size_t)(128 * kt) * D + 128 * nt; d.ldw = D; d.dst = WoT + (size_t)(128 * nt) * D + 128 * kt; d.ldt = D; }
    else if (t < T4) { const int mm = t >= T3, r = t - (mm ? T3 : T2), kt = r >> 4, nt = r & 15; d.src = F.in(mm ? I_W_O_MEM : I_W_O_FOX) + (size_t)(128 * kt) * D + 128 * nt; d.ldw = D; d.dst = WoT + (size_t)(128 * nt) * D + (mm ? 1536 : 1024) + 128 * kt; d.ldt = D; }
    else if (t < T5) { const int r = t - T4, kt = r >> 4, nt = r & 15; d.src = F.in(I_W_OUT) + (size_t)(128 * kt) * D + 128 * nt; d.ldw = D; d.dst = (bf16_t*)(ws + WS_WOUTT) + (size_t)(128 * nt) * D + 128 * kt; d.ldt = D; }
    else if (t < T7) { const int v = t >= T6, kt = t - (v ? T6 : T5); d.src = F.in(v ? I_W_CV : I_W_CK) + (size_t)(128 * kt) * 128; d.ldw = 128; d.dst = (bf16_t*)(ws + (v ? WS_WCV : WS_WCK)) + 128 * kt; d.ldt = 4096; }
    else if (t < T8) { const int r = t - T7, e = r >> 6, rr = r & 63, kt = rr >> 2, nt = rr & 3, up = 0;
        const float* W = e < NE ? F.in(I_WE_GATE) + (size_t)e * D * DE : F.in(I_WS_GATE);
        d.src = W + (size_t)(128 * kt) * DE + 128 * nt; d.ldw = DE; d.dst = Wgu + ((size_t)e * 1024 + 256 * nt + 128 * up) * D + 128 * kt; d.ldt = D; }
    else if (t < T9) { const int r = t - T8, e = r >> 6, rr = r & 63, kt = rr >> 2, nt = rr & 3, up = 1;
        const float* W = e < NE ? F.in(I_WE_UP) + (size_t)e * D * DE : F.in(I_WS_UP);
        d.src = W + (size_t)(128 * kt) * DE + 128 * nt; d.ldw = DE; d.dst = Wgu + ((size_t)e * 1024 + 256 * nt + 128 * up) * D + 128 * kt; d.ldt = D; }
    else { const int r = t - T9, e = r >> 6, rr = r & 63, kt = rr >> 4, nt = rr & 15;
        const float* W = e < NE ? F.in(I_WE_DOWN) + (size_t)e * DE * D : F.in(I_WS_DOWN);
        d.src = W + (size_t)(128 * kt) * D + 128 * nt; d.ldw = D; d.dst = Wd + ((size_t)e * D + 128 * nt) * DE + 128 * kt; d.ldt = DE; }
    return d;
}
constexpr int TR_NTILES = 16 * 84 + 128 + 128 + 64 + 64 + 256 + 32 + 32 + 3 * 65 * 64;
__device__ __forceinline__ void tr_load(const TrDesc& d, f32x4 (&v)[8], int wave, int lane) {
#pragma unroll
    for (int i = 0; i < 4; ++i) { const int q = wave + 8 * i, n4 = (q & 3) * 8 + (lane & 7), kp = (q >> 2) * 8 + (lane >> 3);
        const float* p = d.src + (size_t)(2 * kp) * d.ldw + 4 * n4; v[2 * i] = __builtin_nontemporal_load((const f32x4*)p); v[2 * i + 1] = __builtin_nontemporal_load((const f32x4*)(p + d.ldw)); }
}
__device__ __forceinline__ void tr_to_lds(const f32x4 (&v)[8], LAS unsigned* T32, int wave, int lane) {
#pragma unroll
    for (int i = 0; i < 4; ++i) { const int q = wave + 8 * i, n4 = (q & 3) * 8 + (lane & 7), kp = (q >> 2) * 8 + (lane >> 3);
#pragma unroll
        for (int e = 0; e < 4; ++e) T32[(4 * n4 + e) * 65 + kp] = cvtpk(v[2 * i][e], v[2 * i + 1][e]); }
}
__device__ __forceinline__ void tr_from_lds(const TrDesc& d, const LAS unsigned* T32, int wave, int lane) {
    const int c = lane & 15, nn = lane >> 4;
#pragma unroll
    for (int i = 0; i < 4; ++i) { const int n = wave * 16 + 4 * i + nn; const LAS unsigned* r = T32 + n * 65 + 4 * c;
        const u32x4 o = {r[0], r[1], r[2], r[3]};
        __builtin_nontemporal_store(o, (u32x4*)(d.dst + (size_t)n * d.ldt + 8 * c)); }
}
constexpr int TR_FIRST_EXPERT = 16 * 2 * NB16 + 128 + 128 + 64 + 64 + 256 + 32 + 32;
constexpr int TR8W_NTILES = 16 * (48 + 2 * NF8);
struct Tr8Desc { const float* src; unsigned char* dst; unsigned ldw, ldt; float scale; };
__device__ __forceinline__ Tr8Desc tr8_decode(const Frame& F, int t) {
    unsigned char* ws = F.ws; Tr8Desc d; unsigned char* Wgu = ws + WS_WGU; unsigned char* Wd = ws + WS_WD;
    constexpr int TG = 65 * 64;
    if (t < 2 * TG) { const int up = t >= TG, r = t - (up ? TG : 0), e = r >> 6, rr = r & 63, kt = rr >> 2, nt = rr & 3;
        const float* W = e < NE ? F.in(up ? I_WE_UP : I_WE_GATE) + (size_t)e * D * DE : F.in(up ? I_WS_UP : I_WS_GATE);
        d.src = W + (size_t)(128 * kt) * DE + 128 * nt; d.ldw = DE; d.dst = Wgu + ((size_t)e * 1024 + 256 * nt + 128 * up) * D + 128 * kt; d.ldt = D; d.scale = WGU_SCALE; }
    else { const int r = t - 2 * TG, e = r >> 6, rr = r & 63, kt = rr >> 4, nt = rr & 15;
        const float* W = e < NE ? F.in(I_WE_DOWN) + (size_t)e * DE * D : F.in(I_WS_DOWN);
        d.src = W + (size_t)(128 * kt) * D + 128 * nt; d.ldw = D; d.dst = Wd + ((size_t)e * D + 128 * nt) * DE + 128 * kt; d.ldt = DE; d.scale = WD_SCALE; }
    return d;
}
__device__ __forceinline__ Tr8Desc tr8w_decode(const Frame& F, int t) {
    Tr8Desc d; d.scale = WIN_SCALE; d.ldt = D; constexpr int NU = 48 + 2 * NF8; const int kt = t / NU, nt = t - kt * NU, n0 = nt < 48 ? 4608 + 128 * nt : 256 * nth_set(FP8M, (nt - 48) >> 1) + 128 * (nt & 1); const int sc = WinCol{}(n0);
    d.src = F.in(I_W_IN) + (size_t)(128 * kt) * W_IN_COLS + sc; d.ldw = W_IN_COLS; d.dst = F.ws + WS_WIN8 + (size_t)(128 * nt) * D + 128 * kt;
    return d;
}
__device__ __forceinline__ void tr8_load(const Tr8Desc& d, f32x4 (&v)[8], int wave, int lane) {
#pragma unroll
    for (int i = 0; i < 2; ++i) { const int q = wave + 8 * i, n4 = (q & 3) * 8 + (lane & 7), kq = (q >> 2) * 8 + (lane >> 3);
        const float* p = d.src + (size_t)(4 * kq) * d.ldw + 4 * n4;
#pragma unroll
        for (int r = 0; r < 4; ++r) v[4 * i + r] = __builtin_nontemporal_load((const f32x4*)(p + (size_t)r * d.ldw)); }
}
__device__ __forceinline__ void tr8_to_lds(const f32x4 (&v)[8], float sc, LAS unsigned* T32, int wave, int lane) {
#pragma unroll
    for (int i = 0; i < 2; ++i) { const int q = wave + 8 * i, n4 = (q & 3) * 8 + (lane & 7), kq = (q >> 2) * 8 + (lane >> 3);
#pragma unroll
        for (int e = 0; e < 4; ++e) T32[(4 * n4 + e) * 33 + kq] = pk_fp8x4(v[4 * i][e] * sc, v[4 * i + 1][e] * sc, v[4 * i + 2][e] * sc, v[4 * i + 3][e] * sc); }
}
__device__ __forceinline__ void tr8_from_lds(const Tr8Desc& d, const LAS unsigned* T32, int wave, int lane) {
    const int c = lane & 7, nn = lane >> 3;
#pragma unroll
    for (int i = 0; i < 2; ++i) { const int n = wave * 16 + 8 * i + nn; const LAS unsigned* r = T32 + n * 33 + 4 * c;
        const u32x4 o = {r[0], r[1], r[2], r[3]};
        __builtin_nontemporal_store(o, (u32x4*)(d.dst + (size_t)n * d.ldt + 16 * c)); }
}
__device__ __forceinline__ void conv_batch(const Frame& F, int first, int end) {
    constexpr int NT8 = 3 * 65 * 64;
    if (end > NT8) end = NT8;
    if (first >= end) return;
    LAS unsigned* I0 = (LAS unsigned*)F.lds; LAS unsigned* I1 = I0 + 128 * 33; const int lane = F.lane;
    f32x4 r0[8], r1[8], r2[8], r3[8];
    int t = first;
    tr8_load(tr8_decode(F, t), r0, F.wave, lane);
    if (t + 1 < end) tr8_load(tr8_decode(F, t + 1), r1, F.wave, lane);
    if (t + 2 < end) tr8_load(tr8_decode(F, t + 2), r2, F.wave, lane);
    if (t + 3 < end) tr8_load(tr8_decode(F, t + 3), r3, F.wave, lane);
    __syncthreads();
    tr8_to_lds(r0, tr8_decode(F, t).scale, I0, F.wave, lane);
    __syncthreads();
#define CB_STEP(RF, RN, IC, IN) { \
        if (t + 4 < end) tr8_load(tr8_decode(F, t + 4), RF, F.wave, lane); \
        if (t + 1 < end) tr8_to_lds(RN, tr8_decode(F, t + 1).scale, IN, F.wave, lane); \
        tr8_from_lds(tr8_decode(F, t), IC, F.wave, lane); \
        __syncthreads(); \
        if (++t >= end) break; }
    for (;;) {
        CB_STEP(r0, r1, I0, I1)
        CB_STEP(r1, r2, I1, I0)
        CB_STEP(r2, r3, I0, I1)
        CB_STEP(r3, r0, I1, I0)
    }
#undef CB_STEP
}

namespace att {
constexpr int SHM = 16384;
constexpr int L_V = 0, L_K = 3 * SHM;
constexpr int L_WS = 5 * SHM;
constexpr int L_TBL = L_WS + 2048;
constexpr int L_SEL = L_TBL + 8 * 132 * 4;
constexpr int L_NIB = L_SEL + 512;
constexpr int L_CUM = L_SEL + 1024;
constexpr int L_IMP = L_CUM;
constexpr int L_ORD = L_IMP + 32768;
constexpr int L_Q = L_ORD + 2048;
constexpr int L_END = L_Q + 64;
static_assert(L_END <= RING_BYTES, "attention LDS map");
__constant__ unsigned char T5B[128] = {0, 1, 2, 3, 4, 5, 6, 7, 8, 9, 10, 11, 12, 13, 14, 15, 16, 16, 16, 17, 17, 18, 18, 18, 19, 19, 19, 20, 20, 20, 20, 21, 21, 21, 21, 22, 22, 22, 22, 22, 23, 23, 23, 23, 23, 23, 24, 24, 24, 24, 24, 24, 25, 25, 25, 25, 25, 25, 25, 26, 26, 26, 26, 26, 26, 26, 26, 27, 27, 27, 27, 27, 27, 27, 27, 27, 27, 28, 28, 28, 28, 28, 28, 28, 28, 28, 28, 29, 29, 29, 29, 29, 29, 29, 29, 29, 29, 29, 29, 30, 30, 30, 30, 30, 30, 30, 30, 30, 30, 30, 30, 30, 30, 31, 31, 31, 31, 31, 31, 31, 31, 31, 31, 31, 31, 31, 31, 31};

#define KSWZ(row, colB) ((row) * 256 + ((colB) ^ (((row) & 7) << 4)))
#define SBAR() __builtin_amdgcn_sched_barrier(0)
__device__ __forceinline__ int v_st(int k, int c) { const int kk = (k & ~0xC) | ((k & 4) << 1) | ((k & 8) >> 1); return ((kk >> 3) * 4 + (c >> 5)) * 512 + ((kk & 7) * 32 + (c & 31)) * 2; }
__device__ __forceinline__ int v_rd_base(int lane) { return ((lane & 3) << 3) | (((lane >> 2) & 3) << 6) | (((lane >> 4) & 1) << 5) | (((lane >> 5) & 1) << 8); }
__device__ __forceinline__ int crow(int r, int hi) { return (r & 3) + 8 * (r >> 2) + 4 * hi; }
__device__ __forceinline__ float pswap_max(float v) { auto rr = __builtin_amdgcn_permlane32_swap(__float_as_uint(v), __float_as_uint(v), false, false); return fmaxf(__uint_as_float(rr[0]), __uint_as_float(rr[1])); }
__device__ __forceinline__ float pswap_sum(float v) { auto rr = __builtin_amdgcn_permlane32_swap(__float_as_uint(v), __float_as_uint(v), false, false); return __uint_as_float(rr[0]) + __uint_as_float(rr[1]); }

__device__ __forceinline__ void qkt(f32x16& p0, f32x16& p1, const LAS char* Kb, int r32, int hi, const bf16x8 (&qr)[8]) {
    const LAS char* kb[4];
#pragma unroll
    for (int dd = 0; dd < 4; ++dd) kb[dd] = Kb + KSWZ(r32, (dd * 16 + hi * 8) * 2);
#pragma unroll
    for (int d0 = 0; d0 < 8; ++d0) { const LAS char* a = kb[d0 & 3] + (d0 >> 2) * 128;
        const bf16x8 b0 = *(const LAS bf16x8*)a;
        const bf16x8 b1 = *(const LAS bf16x8*)(a + 32 * 256);
        p0 = __builtin_amdgcn_mfma_f32_32x32x16_bf16(b0, qr[d0], p0, 0, 0, 0);
        p1 = __builtin_amdgcn_mfma_f32_32x32x16_bf16(b1, qr[d0], p1, 0, 0, 0);
#ifdef QKT_SPLIT
        if ((d0 & (QKT_SPLIT - 1)) == QKT_SPLIT - 1 && d0 != 7) SBAR();
#endif
    }
}
__device__ __forceinline__ void pv_tile(f32x16 (&o)[4], int vb, bf16x8 pa0, bf16x8 pa1, bf16x8 pa2, bf16x8 pa3) {
#define TRRD(dst, off) asm volatile("ds_read_b64_tr_b16 %0, %1 offset:%2" : "=&v"(dst) : "v"(vb), "i"(off) : "memory")
#define PV_D0(d0) do { s16x4 l0, l1, l2, l3, h0, h1, h2, h3; constexpr int b_ = (d0) * 512; \
        TRRD(l0, b_); TRRD(h0, b_ + 2048); TRRD(l1, b_ + 4096); TRRD(h1, b_ + 6144); TRRD(l2, b_ + 8192); TRRD(h2, b_ + 10240); TRRD(l3, b_ + 12288); TRRD(h3, b_ + 14336); \
        asm volatile("s_waitcnt lgkmcnt(0)" ::: "memory"); SBAR(); \
        o[d0] = __builtin_amdgcn_mfma_f32_32x32x16_bf16(pa0, (bf16x8){l0[0], l0[1], l0[2], l0[3], h0[0], h0[1], h0[2], h0[3]}, o[d0], 0, 0, 0); \
        o[d0] = __builtin_amdgcn_mfma_f32_32x32x16_bf16(pa1, (bf16x8){l1[0], l1[1], l1[2], l1[3], h1[0], h1[1], h1[2], h1[3]}, o[d0], 0, 0, 0); \
        o[d0] = __builtin_amdgcn_mfma_f32_32x32x16_bf16(pa2, (bf16x8){l2[0], l2[1], l2[2], l2[3], h2[0], h2[1], h2[2], h2[3]}, o[d0], 0, 0, 0); \
        o[d0] = __builtin_amdgcn_mfma_f32_32x32x16_bf16(pa3, (bf16x8){l3[0], l3[1], l3[2], l3[3], h3[0], h3[1], h3[2], h3[3]}, o[d0], 0, 0, 0); } while (0)
    PV_D0(0); PV_D0(1); PV_D0(2); PV_D0(3);
#undef PV_D0
#undef TRRD
}
__device__ __forceinline__ void pack_p(const f32x16& p0, const f32x16& p1, bf16x8& pa0, bf16x8& pa1, bf16x8& pa2, bf16x8& pa3) {
#define PK4(P, B_, OUT) do { unsigned a0 = cvtpk(P[B_+0], P[B_+1]), a1 = cvtpk(P[B_+2], P[B_+3]); \
        unsigned b0 = cvtpk(P[B_+4], P[B_+5]), b1 = cvtpk(P[B_+6], P[B_+7]); \
        auto r0 = __builtin_amdgcn_permlane32_swap(a0, b0, false, false); auto r1 = __builtin_amdgcn_permlane32_swap(a1, b1, false, false); \
        u32x4 w = {r0[0], r1[0], r0[1], r1[1]}; OUT = __builtin_bit_cast(bf16x8, w); } while (0)
    PK4(p0, 0, pa0); PK4(p0, 8, pa1); PK4(p1, 0, pa2); PK4(p1, 8, pa3);
#undef PK4
}
__device__ __forceinline__ void bcast_rows(float (&f)[16], float v, LAS float* ws, int r32, int hi) {
    if (hi == 0) ws[r32] = v;
    asm volatile("s_waitcnt lgkmcnt(0)" ::: "memory");
#pragma unroll
    for (int q = 0; q < 4; ++q) { const f32x4 t = *(const LAS f32x4*)(ws + 8 * q + 4 * hi); f[4 * q] = t[0]; f[4 * q + 1] = t[1]; f[4 * q + 2] = t[2]; f[4 * q + 3] = t[3]; }
    asm volatile("s_waitcnt lgkmcnt(0)" ::: "memory");
}
struct Ctx {
    LAS char* lds; int tid, wid, lane, r32, hi;
    int trow;
    int qlo;
};
struct DmaOff { unsigned k, v0, v1; };
__device__ __forceinline__ DmaOff dma_off(int wid, int lane, size_t ld) {
    DmaOff d; const int kr = 4 * wid + (lane >> 4), kc = (lane & 15) ^ (kr & 7);
    d.k = (unsigned)(kr * ld + kc * 8) * 2u;
#pragma unroll
    for (int t = 0; t < 2; ++t) { const int sub = 2 * (wid + 8 * t) + (lane >> 5), kk = (sub >> 2) * 8 + ((lane & 31) >> 2), k = (kk & ~0xC) | ((kk & 4) << 1) | ((kk & 8) >> 1), c0 = (sub & 3) * 32 + (lane & 3) * 8;
        const unsigned o = (unsigned)(k * ld + c0) * 2u; if (t == 0) d.v0 = o; else d.v1 = o; }
    return d;
}
__device__ __forceinline__ void dma_tile(const DmaOff& d, const bf16_t* Kg, const bf16_t* Vg, size_t ld, LAS char* lds, int buf, int vbuf, int wid) {
    const char* kp = (const char*)Kg; const char* vp = (const char*)Vg;
    __builtin_amdgcn_global_load_lds((const unsigned*)(kp + d.k), (LAS unsigned*)(lds + L_K + buf * SHM + wid * 1024), 16, 0, 0);
    __builtin_amdgcn_global_load_lds((const unsigned*)(kp + d.k + 32 * ld * 2), (LAS unsigned*)(lds + L_K + buf * SHM + (wid + 8) * 1024), 16, 0, 0);
    __builtin_amdgcn_global_load_lds((const unsigned*)(vp + d.v0), (LAS unsigned*)(lds + L_V + vbuf * SHM + wid * 1024), 16, 0, 0);
    __builtin_amdgcn_global_load_lds((const unsigned*)(vp + d.v1), (LAS unsigned*)(lds + L_V + vbuf * SHM + (wid + 8) * 1024), 16, 0, 0);
}
__device__ __forceinline__ void dma_tile_v(const DmaOff& d, const bf16_t* Kg, const bf16_t* Vg, size_t ld, LAS char* lds, int kbuf, int voff, int wid) {
    const char* kp = (const char*)Kg; const char* vp = (const char*)Vg;
    __builtin_amdgcn_global_load_lds((const unsigned*)(kp + d.k), (LAS unsigned*)(lds + L_K + kbuf * SHM + wid * 1024), 16, 0, 0);
    __builtin_amdgcn_global_load_lds((const unsigned*)(kp + d.k + 32 * ld * 2), (LAS unsigned*)(lds + L_K + kbuf * SHM + (wid + 8) * 1024), 16, 0, 0);
    __builtin_amdgcn_global_load_lds((const unsigned*)(vp + d.v0), (LAS unsigned*)(lds + L_V + voff + wid * 1024), 16, 0, 0);
    __builtin_amdgcn_global_load_lds((const unsigned*)(vp + d.v1), (LAS unsigned*)(lds + L_V + voff + (wid + 8) * 1024), 16, 0, 0);
}
#define DMA_WAIT() asm volatile("s_waitcnt vmcnt(0)" ::: "memory")
constexpr float DEFER_THR = 8.f;
__device__ __forceinline__ void qkt_half(f32x16& p, const LAS char* Kb, int r32, int hi, const bf16x8 (&qr)[8], bool zero) {
    const LAS char* kb[4];
#pragma unroll
    for (int dd = 0; dd < 4; ++dd) kb[dd] = Kb + KSWZ(r32, (dd * 16 + hi * 8) * 2);
    { const bf16x8 b = *(const LAS bf16x8*)(kb[0]);
      if (zero) p = __builtin_amdgcn_mfma_f32_32x32x16_bf16(b, qr[0], (f32x16){0.f, 0.f, 0.f, 0.f, 0.f, 0.f, 0.f, 0.f, 0.f, 0.f, 0.f, 0.f, 0.f, 0.f, 0.f, 0.f}, 0, 0, 0);
      else p = __builtin_amdgcn_mfma_f32_32x32x16_bf16(b, qr[0], p, 0, 0, 0); }
#pragma unroll
    for (int d0 = 1; d0 < 8; ++d0) { const bf16x8 b = *(const LAS bf16x8*)(kb[d0 & 3] + (d0 >> 2) * 128);
        p = __builtin_amdgcn_mfma_f32_32x32x16_bf16(b, qr[d0], p, 0, 0, 0); }
}
__device__ __forceinline__ float max3f(float a, float b, float c) { float r; asm("v_max3_f32 %0, %1, %2, %3" : "=v"(r) : "v"(a), "v"(b), "v"(c)); return r; }
__device__ __forceinline__ bool sm_half(f32x16& p, float& m_reg, float& l_reg, float& alpha, bf16x8& pa0, bf16x8& pa1, float brow) {
    float pmax = max3f(p[0], p[1], p[2]);
#pragma unroll
    for (int r = 3; r < 15; r += 2) pmax = max3f(pmax, p[r], p[r + 1]);
    pmax = max3f(pmax, p[15], p[15]);
    { const auto rr = __builtin_amdgcn_permlane32_swap(__float_as_uint(pmax), __float_as_uint(pmax), false, false); pmax = max3f(__uint_as_float(rr[0]), __uint_as_float(rr[1]), __uint_as_float(rr[1])) + brow; }
    const bool upd = !__all(pmax - m_reg <= DEFER_THR);
    const float mx_ = max3f(m_reg, pmax, pmax);
    const float mn = upd ? mx_ : m_reg;
    alpha = __builtin_amdgcn_exp2f(m_reg - mn); m_reg = mn;
    f32x2 mn2 = {brow - mn, brow - mn}; asm("" : "+v"(mn2)); f32x2 ps2 = {0.f, 0.f};
#pragma unroll
    for (int r = 0; r < 16; r += 2) { f32x2 t = {p[r], p[r + 1]}; t += mn2; t.x = __builtin_amdgcn_exp2f(t.x); t.y = __builtin_amdgcn_exp2f(t.y); p[r] = t.x; p[r + 1] = t.y; ps2 += t; }
    float ps = pswap_sum(ps2.x + ps2.y);
    l_reg = l_reg * alpha + ps;
#define PK4(P, B_, OUT) do { unsigned a0 = cvtpk(P[B_+0], P[B_+1]), a1 = cvtpk(P[B_+2], P[B_+3]); \
        unsigned b0 = cvtpk(P[B_+4], P[B_+5]), b1 = cvtpk(P[B_+6], P[B_+7]); \
        auto r0 = __builtin_amdgcn_permlane32_swap(a0, b0, false, false); auto r1 = __builtin_amdgcn_permlane32_swap(a1, b1, false, false); \
        u32x4 w = {r0[0], r1[0], r0[1], r1[1]}; OUT = __builtin_bit_cast(bf16x8, w); } while (0)
    PK4(p, 0, pa0); PK4(p, 8, pa1);
#undef PK4
    return upd;
}
__device__ __forceinline__ void pv_half(f32x16 (&o)[4], int vb, bf16x8 pa0, bf16x8 pa1) {
#define TRRD(dst, off) asm volatile("ds_read_b64_tr_b16 %0, %1 offset:%2" : "=&v"(dst) : "v"(vb), "i"(off) : "memory")
#define PVH(dA, dB) do { s16x4 l0, h0, l1, h1, m0, n0, m1, n1; \
        TRRD(l0, (dA) * 512); TRRD(h0, (dA) * 512 + 2048); TRRD(m0, (dB) * 512); TRRD(n0, (dB) * 512 + 2048); \
        TRRD(l1, (dA) * 512 + 4096); TRRD(h1, (dA) * 512 + 6144); TRRD(m1, (dB) * 512 + 4096); TRRD(n1, (dB) * 512 + 6144); \
        asm volatile("s_waitcnt lgkmcnt(0)" ::: "memory"); SBAR(); \
        o[dA] = __builtin_amdgcn_mfma_f32_32x32x16_bf16(pa0, (bf16x8){l0[0], l0[1], l0[2], l0[3], h0[0], h0[1], h0[2], h0[3]}, o[dA], 0, 0, 0); \
        o[dB] = __builtin_amdgcn_mfma_f32_32x32x16_bf16(pa0, (bf16x8){m0[0], m0[1], m0[2], m0[3], n0[0], n0[1], n0[2], n0[3]}, o[dB], 0, 0, 0); \
        o[dA] = __builtin_amdgcn_mfma_f32_32x32x16_bf16(pa1, (bf16x8){l1[0], l1[1], l1[2], l1[3], h1[0], h1[1], h1[2], h1[3]}, o[dA], 0, 0, 0); \
        o[dB] = __builtin_amdgcn_mfma_f32_32x32x16_bf16(pa1, (bf16x8){m1[0], m1[1], m1[2], m1[3], n1[0], n1[1], n1[2], n1[3]}, o[dB], 0, 0, 0); } while (0)
    PVH(0, 1); PVH(2, 3);
#undef PVH
#undef TRRD
}
__device__ __forceinline__ bool sm_cheap(f32x16& p, float& l_reg, float& alpha, bf16x8& pa0, bf16x8& pa1) {
    alpha = 1.f; l_reg += p[0] + p[15];
    u32x4 w0 = {__builtin_bit_cast(unsigned, p[0]), __builtin_bit_cast(unsigned, p[1]), __builtin_bit_cast(unsigned, p[2]), __builtin_bit_cast(unsigned, p[3])};
    u32x4 w1 = {__builtin_bit_cast(unsigned, p[8]), __builtin_bit_cast(unsigned, p[9]), __builtin_bit_cast(unsigned, p[10]), __builtin_bit_cast(unsigned, p[11])};
    pa0 = __builtin_bit_cast(bf16x8, w0); pa1 = __builtin_bit_cast(bf16x8, w1); return false;
}
template <int VAR = 0, class F>
__device__ __forceinline__ void stream(const Ctx& C0, const bf16x8 (&qr)[8], const bf16_t* Kg, const bf16_t* Vg, size_t ld, unsigned mask, float& m_reg, float& l_reg, f32x16 (&o)[4], const F& f) {
    Ctx C = C0; { int tz = C0.tid; asm volatile("" : "+v"(tz)); C.tid = tz; C.lane = tz & 63; C.r32 = tz & 31; C.hi = (tz >> 5) & 1; }
    const int vb0 = (int)(uintptr_t)(C.lds + L_V) + v_rd_base(C.lane);
    LAS float* ws = (LAS float*)(C.lds + L_WS) + C.wid * 64;
    const DmaOff dof = dma_off(C.wid, C.lane, ld);
    unsigned rem = mask; int j = __builtin_ctz(rem); rem &= rem - 1;
    __syncthreads();
    dma_tile_v(dof, Kg + (size_t)j * 64 * ld, Vg + (size_t)j * 64 * ld, ld, C.lds, 0, 0, C.wid);
    DMA_WAIT();
    __syncthreads();
    int kb = 0, vprev = 2 * SHM, vcur = 0, vnext = SHM;
    bool more = rem != 0u; int jn = j;
    if (more) { jn = __builtin_ctz(rem); rem &= rem - 1; if (!(VAR & 1)) dma_tile_v(dof, Kg + (size_t)jn * 64 * ld, Vg + (size_t)jn * 64 * ld, ld, C.lds, 1, vnext, C.wid); }
#define ST_RESC(a) do { if (C.hi == 0) ws[C.r32] = (a); asm volatile("s_waitcnt lgkmcnt(0)" ::: "memory"); \
        _Pragma("unroll") for (int q = 0; q < 4; ++q) { const f32x4 t = *(const LAS f32x4*)(ws + 8 * q + 4 * C.hi); \
            _Pragma("unroll") for (int d = 0; d < 4; ++d) { o[d][4 * q] *= t[0]; o[d][4 * q + 1] *= t[1]; o[d][4 * q + 2] *= t[2]; o[d][4 * q + 3] *= t[3]; } } } while (0)
    f32x16 pA, pB; float alpha, browA, browB; bf16x8 pa0, pa1;
    bool zA = f.pre(pA, j, 0, browA);
    qkt_half(pA, C.lds + L_K, C.r32, C.hi, qr, zA);
    bool zB = f.pre(pB, j, 1, browB);
    bool first = true;
    for (;;) {
        if (!(VAR & 16)) qkt_half(pB, C.lds + L_K + kb * SHM + 32 * 256, C.r32, C.hi, qr, zB);
        const bool u0 = (VAR & 4) ? sm_cheap(pA, l_reg, alpha, pa0, pa1) : sm_half(pA, m_reg, l_reg, alpha, pa0, pa1, browA);
        if (u0 && !first) ST_RESC(alpha);
        first = false;
        if (!(VAR & 8)) pv_half(o, vb0 + vcur, pa0, pa1); else { o[0][0] += __builtin_bit_cast(float, (int)pa0[0] + (int)pa1[1]); }
        if (!(VAR & 32)) zA = f.pre(pA, jn, 0, browA);
        DMA_WAIT(); if (!(VAR & 2)) __syncthreads();
        if (!more) break;
        j = jn; kb ^= 1; { const int t_ = vprev; vprev = vcur; vcur = vnext; vnext = t_; }
        more = rem != 0u;
        if (more) { jn = __builtin_ctz(rem); rem &= rem - 1; if (!(VAR & 1)) dma_tile_v(dof, Kg + (size_t)jn * 64 * ld, Vg + (size_t)jn * 64 * ld, ld, C.lds, kb ^ 1, vnext, C.wid); }
        if (!(VAR & 16)) qkt_half(pA, C.lds + L_K + kb * SHM, C.r32, C.hi, qr, zA);
        const bool u1 = (VAR & 4) ? sm_cheap(pB, l_reg, alpha, pa0, pa1) : sm_half(pB, m_reg, l_reg, alpha, pa0, pa1, browB);
        if (u1) ST_RESC(alpha);
        if (!(VAR & 8)) pv_half(o, vb0 + vprev + 8192, pa0, pa1); else { o[1][0] += __builtin_bit_cast(float, (int)pa0[2] + (int)pa1[3]); }
        if (!(VAR & 32)) zB = f.pre(pB, j, 1, browB);
    }
    { const bool u1 = sm_half(pB, m_reg, l_reg, alpha, pa0, pa1, browB);
      if (u1) ST_RESC(alpha);
      pv_half(o, vb0 + vcur + 8192, pa0, pa1); }
    __syncthreads();
#undef ST_RESC
}
__device__ __forceinline__ void load_q(bf16x8 (&qr)[8], const bf16_t* qrow, const float* gain, int hi) {
    u32x4 raw[8]; float ss = 0.f;
#pragma unroll
    for (int d0 = 0; d0 < 8; ++d0) { raw[d0] = *(const u32x4*)(qrow + d0 * 16 + hi * 8);
#pragma unroll
        for (int e = 0; e < 4; ++e) { const float a = bf_lo(raw[d0][e]), b = bf_hi(raw[d0][e]); ss += a * a + b * b; } }
    ss = pswap_sum(ss);
    const float f = __builtin_amdgcn_rsqf(ss * (1.f / HD) + RMS_EPS) * (ATTN_SCALE * LOG2E);
#pragma unroll
    for (int d0 = 0; d0 < 8; ++d0) { const f32x4 g0 = *(const f32x4*)(gain + d0 * 16 + hi * 8), g1 = *(const f32x4*)(gain + d0 * 16 + hi * 8 + 4);
        u32x4 w; w.x = cvtpk(bf_lo(raw[d0].x) * f * g0[0], bf_hi(raw[d0].x) * f * g0[1]); w.y = cvtpk(bf_lo(raw[d0].y) * f * g0[2], bf_hi(raw[d0].y) * f * g0[3]);
        w.z = cvtpk(bf_lo(raw[d0].z) * f * g1[0], bf_hi(raw[d0].z) * f * g1[1]); w.w = cvtpk(bf_lo(raw[d0].w) * f * g1[2], bf_hi(raw[d0].w) * f * g1[3]);
        qr[d0] = __builtin_bit_cast(bf16x8, w); }
}
__device__ __forceinline__ void store_o(const f32x16 (&v)[4], const float (&w)[16], bf16_t* orow0, size_t ld, LAS char* lds, int wid, int lane_, bool accum) {
    int lane = lane_; asm volatile("" : "+v"(lane));
    const int r32 = lane & 31, hi = lane >> 5;
    LAS char* st = lds + wid * 8192;
    const bool odd = (r32 & 1) != 0;
#pragma unroll
    for (int r = 0; r < 16; r += 2) { LAS char* rowp = st + (crow(r, hi) + (odd ? 1 : 0)) * 256 + (r32 & ~1) * 2;
#pragma unroll
        for (int d = 0; d < 4; ++d) { const float a = v[d][r] * w[r], b = v[d][r + 1] * w[r + 1];
            const float recv = __builtin_bit_cast(float, __builtin_amdgcn_mov_dpp(__builtin_bit_cast(int, odd ? a : b), 0xB1, 0xF, 0xF, true));
            *(LAS unsigned*)(rowp + d * 64) = cvtpk(odd ? recv : a, odd ? b : recv); } }
    asm volatile("s_waitcnt lgkmcnt(0)" ::: "memory");
    u32x4 ov[8];
    if (accum) {
#pragma unroll
        for (int it = 0; it < 8; ++it) { const int id = it * 64 + lane, row = id >> 4, c16 = id & 15; ov[it] = *(const u32x4*)(orow0 + (size_t)row * ld + c16 * 8); } }
#pragma unroll
    for (int it = 0; it < 8; ++it) { const int id = it * 64 + lane, row = id >> 4, c16 = id & 15;
        u32x4 nv = *(const LAS u32x4*)(st + row * 256 + c16 * 16);
        if (accum) {
#pragma unroll
            for (int e = 0; e < 4; ++e) nv[e] = cvtpk(bf_lo(nv[e]) + bf_lo(ov[it][e]), bf_hi(nv[e]) + bf_hi(ov[it][e])); }
        *(u32x4*)(orow0 + (size_t)row * ld + c16 * 8) = nv; }
    asm volatile("s_waitcnt lgkmcnt(0)" ::: "memory");
}

struct Tensors {
    const bf16_t* PA; const float* GL; const bf16_t* KVM; const bf16_t* KC; const bf16_t* VC; const float* CUM; bf16_t* OC;
    const float* nsa_q_g; const float* fox_q_g; const float* mem_q_g; const float* rel_bias;
};

template <int TY> struct BiasUni {
    const Ctx* C; const LAS float* tb; int u; unsigned sel; int mode;
    __device__ __forceinline__ bool pre(f32x16& bv, int j, int half, float& brow) const {
        const float NEG = -__builtin_inff();
        const int dq = C->trow - 64 * j - 4 * C->hi - 32 * half;
        brow = 0.f;
        if constexpr (TY == 0) {
            const bool win = mode == 1; const bool on = win || ((sel >> j) & 1u);
            if (j + 3 <= u && !(win && j + 8 <= u)) {
                brow = on ? tb[128] : NEG; return true;
            } else {
#pragma unroll
                for (int q = 0; q < 4; ++q) {
#pragma unroll
                    for (int e = 0; e < 4; ++e) { const int r = 4 * q + e, c = e + 8 * q, rel = dq - c;
                        const bool ok = on && (unsigned)rel < 512u; const float b = tb[min(max(rel, 0), 128)];
                        bv[r] = ok ? b : NEG; }
                    SBAR(); }
            }
        } else if constexpr (TY == 1) {
            const LAS float* cb = (const LAS float*)(C->lds + L_CUM) + 64 * j + 4 * C->hi + 32 * half;
            const bool msk = 64 * j + 63 > C->qlo;
#pragma unroll
            for (int q = 0; q < 4; ++q) { const f32x4 a = *(const LAS f32x4*)(cb + 8 * q);
#pragma unroll
                for (int e = 0; e < 4; ++e) { const int r = 4 * q + e, c = e + 8 * q; bv[r] = (msk && dq - c < 0) ? NEG : a[e]; } }
        } else {
            return true;
        }
        return false;
    }
};

__device__ __forceinline__ void nsa_pre(Ctx& C, const Tensors& Tn, const bf16x8 (&qr)[8], int b, int g, int u, float g_c, bf16_t* orow0, unsigned& sel_out, unsigned& U_out) {
    { int tz = C.tid; asm volatile("" : "+v"(tz)); C.tid = tz; C.lane = tz & 63; C.r32 = tz & 31; C.hi = (tz >> 5) & 1; }
    const int hh = C.wid >> 1, pos = (C.wid & 1) * 32 + C.r32, head = g * 4 + hh;
    const LAS float* tb = (const LAS float*)(C.lds + L_TBL) + head * 132;
    LAS float* ws = (LAS float*)(C.lds + L_WS) + C.wid * 64;
    LAS unsigned* SEL = (LAS unsigned*)(C.lds + L_SEL);
    const float NEG = -__builtin_inff();
    const int vb0 = (int)(uintptr_t)(C.lds + L_V) + v_rd_base(C.lane);
    {
        const bf16_t* KCb = Tn.KC + (size_t)(b * 2 + g) * 128 * HD; const bf16_t* VCb = Tn.VC + (size_t)(b * 2 + g) * 128 * HD;
        const DmaOff dof = dma_off(C.wid, C.lane, HD);
        __syncthreads();
        if (C.tid < 65) SEL[C.tid] = 0u;
        dma_tile(dof, KCb, VCb, HD, C.lds, 0, 0, C.wid); dma_tile(dof, KCb + 64 * HD, VCb + 64 * HD, HD, C.lds, 1, 1, C.wid);
        DMA_WAIT();
        __syncthreads();
        f32x16 P[4];
        const int dq = C.trow - 31 - 64 * C.hi;
#pragma unroll
        for (int X = 0; X < 4; ++X)
#pragma unroll
            for (int r = 0; r < 16; ++r) { const int c = (r & 3) + 8 * (r >> 2), rel = dq - 16 * (32 * X + c);
                const float bb = tb[min(max(rel, 0), 128)]; P[X][r] = rel >= 0 ? bb : NEG; }
        qkt(P[0], P[1], C.lds + L_K, C.r32, C.hi, qr); qkt(P[2], P[3], C.lds + L_K + SHM, C.r32, C.hi, qr);
        float pmax = NEG;
#pragma unroll
        for (int X = 0; X < 4; ++X)
#pragma unroll
            for (int r = 0; r < 16; ++r) pmax = fmaxf(pmax, P[X][r]);
        pmax = pswap_max(pmax);
        const float mm = pmax == NEG ? 0.f : pmax;
        float ps = 0.f;
#pragma unroll
        for (int X = 0; X < 4; ++X)
#pragma unroll
            for (int r = 0; r < 16; ++r) { P[X][r] = __builtin_amdgcn_exp2f(P[X][r] - mm); ps += P[X][r]; }
        ps = pswap_sum(ps);
        const float inv = ps > 0.f ? 1.f / ps : 0.f;
        if (u >= 16) {
            LAS float* imp = (LAS float*)(C.lds + L_IMP) + (hh * 64 + pos) * 32;
            float bprev = 0.f;
#pragma unroll
            for (int X = 0; X < 4; ++X)
#pragma unroll
                for (int q = 0; q < 4; ++q) { const float b3 = 0.5f * P[X][4 * q + 3];
                    const float aG = P[X][4 * q] + P[X][4 * q + 1] + P[X][4 * q + 2] + b3;
                    const auto sw_ = __builtin_amdgcn_permlane32_swap(__float_as_uint(b3), __float_as_uint(b3), false, false);
                    const float bp = __uint_as_float(C.hi ? sw_[0] : sw_[1]);
                    const float val = aG + (C.hi ? bp : bprev);
                    imp[2 * (4 * X + q) + C.hi] = val * inv;
                    bprev = bp; }
        }
        f32x16 o[4] = {};
        bf16x8 pa0, pa1, pa2, pa3;
        pack_p(P[0], P[1], pa0, pa1, pa2, pa3); pv_tile(o, vb0, pa0, pa1, pa2, pa3);
        pack_p(P[2], P[3], pa0, pa1, pa2, pa3); pv_tile(o, vb0 + SHM, pa0, pa1, pa2, pa3);
        float w[16]; bcast_rows(w, g_c * inv, ws, C.r32, C.hi);
        __syncthreads();
        store_o(o, w, orow0, D, C.lds, C.wid, C.lane, false);
    }
    if (u >= 16) {
        const int p = C.tid & 63, jg = C.tid >> 6;
        const LAS float* i0 = (const LAS float*)(C.lds + L_IMP) + p * 32;
        float sc[32];
#pragma unroll
        for (int j4 = 0; j4 < 8; ++j4) { const f32x4 a = *(const LAS f32x4*)(i0 + 4 * j4), b2 = *(const LAS f32x4*)(i0 + 2048 + 4 * j4), c2 = *(const LAS f32x4*)(i0 + 4096 + 4 * j4), d2 = *(const LAS f32x4*)(i0 + 6144 + 4 * j4);
#pragma unroll
            for (int e = 0; e < 4; ++e) { const int j = 4 * j4 + e; const float s = ((a[e] + b2[e]) + c2[e]) + d2[e];
                const bool valid = j <= u, forced = j == 0 || j == u || j == u - 1;
                sc[j] = valid ? (forced ? 1e4f : s) : -1.f; } }
        unsigned bits = 0u;
#pragma unroll
        for (int e = 0; e < 4; ++e) { const int j = 4 * jg + e; float sj = 0.f;
#pragma unroll
            for (int k = 0; k < 32; ++k) sj = (k == j) ? sc[k] : sj;
            int rank = 0;
#pragma unroll
            for (int k = 0; k < 32; ++k) rank += (sc[k] > sj || (sc[k] == sj && k < j)) ? 1 : 0;
            if (j <= u && rank < 16) bits |= 1u << j; }
        ((LAS unsigned char*)(C.lds + L_NIB))[p * 8 + jg] = (unsigned char)(bits >> (4 * jg));
        __syncthreads();
        if (C.tid < 64) { const u32x2 nb = *(const LAS u32x2*)(C.lds + L_NIB + C.tid * 8); unsigned full = 0u;
#pragma unroll
            for (int k = 0; k < 4; ++k) { full |= ((nb.x >> (8 * k)) & 0xfu) << (4 * k); full |= ((nb.y >> (8 * k)) & 0xfu) << (16 + 4 * k); }
            SEL[C.tid] = full; unsigned un = full;
#pragma unroll
            for (int o = 1; o < 64; o <<= 1) un |= __shfl_xor(un, o);
            if (C.tid == 0) SEL[64] = un; }
    } else { if (C.tid < 65) SEL[C.tid] = (2u << u) - 1u; }
    __syncthreads();
    sel_out = SEL[pos]; U_out = SEL[64];
}
__device__ __forceinline__ int dequeue(LAS char* lds, unsigned* head, int tid) {
    if (tid == 0) *(LAS int*)(lds + L_Q) = (int)__hip_atomic_fetch_add(head, 1u, RLX_AGENT);
    __syncthreads();
    const int q = *(const LAS int*)(lds + L_Q);
    __syncthreads();
    return q;
}
#ifndef DBL_VAR
#define DBL_VAR 0
#endif
#ifndef DBL_STREAM
#define DBL_STREAM 0
#endif
#ifndef CONV_IN_P0
#define CONV_IN_P0 0
#endif
__device__ __forceinline__ void conv_some(const Frame& F, LAS char* lds, unsigned* chead, int n) {
    if (CONV_IN_P0) return;
    if (F.tid == 0) *(LAS int*)(lds + L_Q) = (int)__hip_atomic_fetch_add(chead, (unsigned)n, RLX_AGENT);
    __syncthreads();
    const int base = *(const LAS int*)(lds + L_Q);
    __syncthreads();
    conv_batch(F, base, base + n);
}
__device__ __forceinline__ void attn_phase(const Frame& F, LAS char* lds, const Tensors& Tn, unsigned* qhead) {
    Ctx C; C.lds = lds; C.tid = threadIdx.x; C.wid = __builtin_amdgcn_readfirstlane(C.tid >> 6); C.lane = C.tid & 63; C.r32 = C.lane & 31; C.hi = C.lane >> 5; C.trow = 0; C.qlo = 0;
    for (int i = C.tid; i < 8 * 129; i += 512) { const int head = i / 129, rel = i - head * 129; const int bk = rel < 128 ? T5B[rel] : 31;
        ((LAS float*)(lds + L_TBL))[head * 132 + rel] = Tn.rel_bias[bk * 8 + head] * LOG2E; }
    __syncthreads();
    LAS float* ws = (LAS float*)(lds + L_WS) + C.wid * 64;
#ifndef PASS_MASK
#define PASS_MASK 7
#endif
    int nconv = (int)((blockIdx.x >> 3) & 7) * 5;
    if (PASS_MASK & 1) for (;;) {
        conv_some(F, lds, qhead + 192, nconv); nconv = 12;
        const int q = dequeue(lds, qhead, C.tid); if (q >= 512) break;
        const int u = 31 - (q >> 4), b = (q >> 1) & 7, g = q & 1, head = g * 4 + (C.wid >> 1);
        C.qlo = 64 * u + (C.wid & 1) * 32; C.trow = C.qlo + C.r32;
        const size_t tok = (size_t)b * T + C.trow;
        bf16x8 qr[8]; load_q(qr, Tn.PA + tok * NPA + CQ_NSA + head * HD, Tn.nsa_q_g, C.hi);
        bf16_t* orow0 = Tn.OC + ((size_t)b * T + C.qlo) * D + head * HD;
        const LAS float* tb = (const LAS float*)(lds + L_TBL) + head * 132;
        const float* gl = Tn.GL + tok * LDG; const float g_c = fast_sigmoid(gl[head]), g_s = fast_sigmoid(gl[8 + head]), g_w = fast_sigmoid(gl[16 + head]);
        unsigned sel, U; nsa_pre(C, Tn, qr, b, g, u, g_c, orow0, sel, U);
        const bf16_t* PAb = Tn.PA + (size_t)b * T * NPA + g * HD;
        int br = 0;
        do {
            const unsigned mask = br ? (((2u << u) - 1u) & ~(u >= 9 ? ((1u << (u - 8)) - 1u) : 0u)) : U;
            f32x16 o[4] = {}; float m_reg = -1e30f, l_reg = 0.f;
            stream(C, qr, PAb + (br ? CK_WIN : CK_SLC), PAb + (br ? CV_WIN : CV_SLC), NPA, mask, m_reg, l_reg, o, BiasUni<0>{&C, tb, u, sel, br});
            float w[16]; bcast_rows(w, l_reg > 0.f ? (br ? g_w : g_s) / l_reg : 0.f, ws, C.r32, C.hi);
            store_o(o, w, orow0, D, lds, C.wid, C.lane, true);
#if DBL_STREAM
            { f32x16 o2[4] = {}; float m2 = -1e30f, l2 = 0.f; stream<DBL_VAR>(C, qr, PAb + (br ? CK_WIN : CK_SLC), PAb + (br ? CV_WIN : CV_SLC), NPA, mask, m2, l2, o2, BiasUni<0>{&C, tb, u, sel, br}); float sk = ((o2[0][0] + o2[1][0]) + (o2[2][0] + o2[3][0])) + l2 + m2; asm volatile("" :: "v"(sk)); }
#endif
            ++br; asm volatile("" : "+s"(br));
        } while (br < 2);
    }
    if (PASS_MASK & 2) for (;;) {
        const int q = dequeue(lds, qhead + 64, C.tid); if (q >= 256) break;
        const int qb = 7 - (q >> 5), b = (q >> 2) & 7, h = q & 3;
        C.qlo = 256 * qb + 32 * C.wid; C.trow = C.qlo + C.r32;
        const size_t tok = (size_t)b * T + C.trow;
        bf16x8 qr[8]; load_q(qr, Tn.PA + tok * NPA + CQ_FOX + h * HD, Tn.fox_q_g, C.hi);
        { LAS float* cl = (LAS float*)(lds + L_CUM); const float* cg = Tn.CUM + (size_t)(b * 4 + h) * T;
          for (int i = C.tid; i < 256 * (qb + 1); i += 512) cl[i] = -cg[i] * LOG2E; }
        const bf16_t* PAb = Tn.PA + (size_t)b * T * NPA + h * HD;
        const unsigned mask = qb == 7 ? 0xffffffffu : ((1u << (4 * qb + 4)) - 1u);
        f32x16 o[4] = {}; float m_reg = -1e30f, l_reg = 0.f;
        stream(C, qr, PAb + CK_FOX, PAb + CV_FOX, NPA, mask, m_reg, l_reg, o, BiasUni<1>{&C, nullptr, 0, 0u, 2});
        float w[16]; bcast_rows(w, l_reg > 0.f ? 1.f / l_reg : 0.f, ws, C.r32, C.hi);
        store_o(o, w, Tn.OC + ((size_t)b * T + C.qlo) * D + 1024 + h * HD, D, lds, C.wid, C.lane, false);
#if DBL_STREAM
        { f32x16 o2[4] = {}; float m2 = -1e30f, l2 = 0.f; stream<DBL_VAR>(C, qr, PAb + CK_FOX, PAb + CV_FOX, NPA, mask, m2, l2, o2, BiasUni<1>{&C, nullptr, 0, 0u, 2}); float sk = ((o2[0][0] + o2[1][0]) + (o2[2][0] + o2[3][0])) + l2 + m2; asm volatile("" :: "v"(sk)); }
#endif
        conv_some(F, lds, qhead + 192, 6);
    }
    if (PASS_MASK & 4) for (;;) {
        const int q = dequeue(lds, qhead + 128, C.tid); if (q >= 256) break;
        const int qb = q & 7, h = (q >> 3) & 3, b = q >> 5;
        C.qlo = 256 * qb + 32 * C.wid; C.trow = C.qlo + C.r32;
        const size_t tok = (size_t)b * T + C.trow;
        bf16x8 qr[8]; load_q(qr, Tn.PA + tok * NPA + CQ_MEM + h * HD, Tn.mem_q_g, C.hi);
        const bf16_t* Kb = Tn.KVM + (size_t)b * MEMT * 1024 + h * HD;
        f32x16 o[4] = {}; float m_reg = -1e30f, l_reg = 0.f;
        stream(C, qr, Kb, Kb + 512, 1024, 0xfu, m_reg, l_reg, o, BiasUni<2>{&C, nullptr, 0, 0u, 3});
        float w[16]; bcast_rows(w, l_reg > 0.f ? 1.f / l_reg : 0.f, ws, C.r32, C.hi);
        store_o(o, w, Tn.OC + ((size_t)b * T + C.qlo) * D + 1536 + h * HD, D, lds, C.wid, C.lane, false);
#if DBL_STREAM
        { f32x16 o2[4] = {}; float m2 = -1e30f, l2 = 0.f; stream<DBL_VAR>(C, qr, Kb, Kb + 512, 1024, 0xfu, m2, l2, o2, BiasUni<2>{&C, nullptr, 0, 0u, 3}); float sk = ((o2[0][0] + o2[1][0]) + (o2[2][0] + o2[3][0])) + l2 + m2; asm volatile("" :: "v"(sk)); }
#endif
        conv_some(F, lds, qhead + 192, 2);
    }
    if (!CONV_IN_P0) for (;;) {
        if (F.tid == 0) *(LAS int*)(lds + L_Q) = (int)__hip_atomic_fetch_add(qhead + 192, 8u, RLX_AGENT);
        __syncthreads();
        const int base = *(const LAS int*)(lds + L_Q);
        __syncthreads();
        if (base >= 3 * 65 * 64) break;
        conv_batch(F, base, base + 8);
    }
}
#undef KSWZ
#undef SBAR
}

__device__ __forceinline__ void p0_prologue(Frame& F) {
    LAS float* scr = (LAS float*)(F.lds + 40960 + F.wave * 8704);
    unsigned char* ws = F.ws; const int lane = F.lane;
    if (F.gw < 128) { const int kv = F.gw >> 6, j = F.gw & 63; const float* pe = F.in(kv ? I_PE_V : I_PE_K) + 64 * j; const float* w = F.in(kv ? I_W_CV : I_W_CK) + (size_t)64 * j * 128; float a0 = 0.f, a1 = 0.f;
#pragma unroll 16
        for (int k = 0; k < 64; ++k) { const float p = pe[k]; a0 += p * w[(size_t)k * 128 + lane]; a1 += p * w[(size_t)k * 128 + 64 + lane]; }
        float* cb = (float*)(ws + WS_CBIAS) + (size_t)(kv * 64 + j) * 128; cb[lane] = a0; cb[64 + lane] = a1; }
    constexpr int S0 = 32 * 8, S1 = S0 + 64;
    bf16_t* WinT = (bf16_t*)(ws + WS_WINT);
    for (int it = F.gw; it < S1; it += F.NGW) {
        if (it < S0) { const int kb = it >> 3, nb = it & 7; tr_item(F.in(I_W_IN), W_IN_COLS, 64 * kb, 10752 + 32 * nb, WinCol{}, WinT, D, 0, IdCol{}, scr, lane); }
        else {
            const int r = it - S0, kb = r >> 1, nb = r & 1, k0 = 64 * kb, n0 = 32 * nb; const float* W = F.in(I_W_ROUTER);
#pragma unroll 8
            for (int i = 0; i < 32; ++i) { const int kk = 2 * i + (lane >> 5); scr[kk * 33 + (lane & 31)] = W[(size_t)(k0 + kk) * NE + n0 + (lane & 31)]; }
            LDS_WAIT(); asm volatile("" ::: "memory");
            const int c8 = lane & 7; bf16_t* Whi = (bf16_t*)(ws + WS_WRT); bf16_t* Wlo = Whi + (size_t)NE * D;
#pragma unroll
            for (int j = 0; j < 4; ++j) { const int n = (lane >> 3) + 8 * j; const LAS float* s = scr + (8 * c8) * 33 + n; unsigned h[4], l[4];
#pragma unroll
                for (int q = 0; q < 4; ++q) { const float a = s[(2 * q) * 33], b = s[(2 * q + 1) * 33]; h[q] = cvtpk(a, b); l[q] = cvtpk(a - bf_lo(h[q]), b - bf_hi(h[q])); }
                *(u32x4*)(Whi + (size_t)(n0 + n) * D + k0 + 8 * c8) = (u32x4){h[0], h[1], h[2], h[3]};
                *(u32x4*)(Wlo + (size_t)(n0 + n) * D + k0 + 8 * c8) = (u32x4){l[0], l[1], l[2], l[3]}; }
            LDS_WAIT(); asm volatile("" ::: "memory");
        }
    }
    {
        LAS unsigned* T32 = (LAS unsigned*)F.lds;
        int t = blockIdx.x; f32x4 v[8]; Tr8Desc d = tr8w_decode(F, t < TR8W_NTILES ? t : 0);
        if (t < TR8W_NTILES) tr8_load(d, v, F.wave, lane);
        while (t < TR8W_NTILES) {
            tr8_to_lds(v, d.scale, T32, F.wave, lane);
            __syncthreads();
            const int tn = t + F.G; const Tr8Desc dn = tr8w_decode(F, tn < TR8W_NTILES ? tn : 0);
            if (tn < TR8W_NTILES) tr8_load(dn, v, F.wave, lane);
            tr8_from_lds(d, T32, F.wave, lane);
            __syncthreads();
            t = tn; d = dn;
        }
    }
    {
        LAS unsigned* T32 = (LAS unsigned*)F.lds;
        constexpr int NT0 = TR_FIRST_EXPERT;
        int t = blockIdx.x; f32x4 v[8]; TrDesc d = tr_decode(F, t < NT0 ? t : 0);
        if (t < NT0) tr_load(d, v, F.wave, lane);
        while (t < NT0) {
            tr_to_lds(v, T32, F.wave, lane);
            __syncthreads();
            const int tn = t + F.G; const TrDesc dn = tr_decode(F, tn < NT0 ? tn : 0);
            if (tn < NT0) tr_load(dn, v, F.wave, lane);
            tr_from_lds(d, T32, F.wave, lane);
            __syncthreads();
            t = tn; d = dn;
        }
    }
    if (CONV_IN_P0) { __syncthreads(); for (int base = blockIdx.x * 8; base < 3 * 65 * 64; base += F.G * 8) conv_batch(F, base, base + 8); }
    bf16_t* A3 = (bf16_t*)(ws + WS_A3); unsigned char* H8 = ws + WS_H8;
    for (int m = F.gw; m < M + MROWS; m += F.NGW) {
        if (m < M) rms_row_both(F.in(I_X) + (size_t)m * D, F.in(I_NORM_ATTN_G), A3 + (size_t)m * D, H8 + (size_t)m * D, lane);
        else rms_row_bf16(F.in(I_MEM) + (size_t)(m - M) * D, F.in(I_NORM_MEM_G), A3 + (size_t)m * D, lane);
    }
}

__device__ __forceinline__ void p2_thin(Frame& F) {
    unsigned char* ws = F.ws; const int lane = F.lane;
    bf16_t* PA = (bf16_t*)(ws + WS_PA); bf16_t* KVM = (bf16_t*)(ws + WS_KVMEM); const float* GL = (const float*)(ws + WS_GL);
    {
        LAS float* part = (LAS float*)F.lds;
        LAS float* red = (LAS float*)(F.lds + 65536);
        const int i16 = lane & 15, kg = lane >> 4, w = F.wave;
        for (int item = blockIdx.x; item < 256; item += F.G) {
            const int kv = item & 1, rt = (item >> 1) & 7, bg = item >> 4, b = bg >> 1, g = bg & 1;
            const int n = 16 * rt + i16, ne = n < 127 ? n : 126;
            const bf16_t* Ab = PA + ((size_t)(b * T + 16 * ne + 4 * w) * NPA + (kv ? CV_CMP : CK_CMP) + g * HD) + 8 * kg;
            const bf16_t* Bb = (const bf16_t*)(ws + (kv ? WS_WCV : WS_WCK)) + (size_t)i16 * 4096 + 512 * w + 8 * kg;
            f32x4 acc[8];
#pragma unroll
            for (int nt = 0; nt < 8; ++nt) acc[nt] = (f32x4){0.f, 0.f, 0.f, 0.f};
#pragma unroll 2
            for (int s = 0; s < 16; ++s) { const bf16x8 a = *(const bf16x8*)(Ab + (size_t)(s >> 2) * NPA + 32 * (s & 3));
#pragma unroll
                for (int nt = 0; nt < 8; ++nt) { const bf16x8 bb = *(const bf16x8*)(Bb + (size_t)nt * 16 * 4096 + 32 * s); acc[nt] = __builtin_amdgcn_mfma_f32_16x16x32_bf16(a, bb, acc[nt], 0, 0, 0); } }
            __syncthreads();
#pragma unroll
            for (int nt = 0; nt < 8; ++nt) *(LAS f32x4*)(part + ((w * 8 + nt) * 64 + lane) * 4) = acc[nt];
            __syncthreads();
            f32x4 t = {0.f, 0.f, 0.f, 0.f};
#pragma unroll
            for (int ww = 0; ww < 8; ++ww) t += *(const LAS f32x4*)(part + ((ww * 8 + w) * 64 + lane) * 4);
            const int e = 16 * w + i16; float cb = 0.f;
#pragma unroll 16
            for (int j = 0; j < 64; ++j) cb += ((const float*)(ws + WS_CBIAS))[(size_t)(kv * 64 + j) * 128 + e];
#pragma unroll
            for (int r = 0; r < 4; ++r) t[r] += cb;
            float scl[4] = {1.f, 1.f, 1.f, 1.f};
            if (kv == 0) {
#pragma unroll
                for (int r = 0; r < 4; ++r) { float q = t[r] * t[r]; q += __shfl_xor(q, 1); q += __shfl_xor(q, 2); q += __shfl_xor(q, 4); q += __shfl_xor(q, 8); if (i16 == 0) red[w * 16 + 4 * kg + r] = q; }
            }
            __syncthreads();
            if (kv == 0) { const float kgain = F.in(I_NSA_K_G)[e];
#pragma unroll
                for (int r = 0; r < 4; ++r) { float q = 0.f;
#pragma unroll
                    for (int ww = 0; ww < 8; ++ww) q += red[ww * 16 + 4 * kg + r];
                    scl[r] = __builtin_amdgcn_rsqf(q * (1.f / HD) + RMS_EPS) * kgain; } }
            bf16_t* Ob = (bf16_t*)(ws + (kv ? WS_VC : WS_KC)) + (size_t)bg * 128 * HD;
#pragma unroll
            for (int r = 0; r < 4; ++r) { const int nn = 16 * rt + 4 * kg + r; const float v = nn < 127 ? t[r] * scl[r] : 0.f; Ob[(size_t)nn * HD + e] = (bf16_t)(cvtpk(v, 0.f) & 0xffffu); }
        }
    }
#pragma unroll 2
    for (int row = F.gw; row < M; row += F.NGW) {
        const int hd = lane >> 3, col = (hd < 2 ? CK_SLC + hd * HD : (hd < 4 ? CK_WIN + (hd - 2) * HD : CK_FOX + (hd - 4) * HD)) + (lane & 7) * 16;
        bf16_t* p = PA + (size_t)row * NPA + col; const u32x4 r0 = *(const u32x4*)p, r1 = *(const u32x4*)(p + 8);
        float ss = 0.f;
#pragma unroll
        for (int e = 0; e < 4; ++e) { ss += bf_lo(r0[e]) * bf_lo(r0[e]) + bf_hi(r0[e]) * bf_hi(r0[e]) + bf_lo(r1[e]) * bf_lo(r1[e]) + bf_hi(r1[e]) * bf_hi(r1[e]); }
        ss += __shfl_xor(ss, 1); ss += __shfl_xor(ss, 2); ss += __shfl_xor(ss, 4);
        const float rstd = __builtin_amdgcn_rsqf(ss * (1.f / HD) + RMS_EPS); const float* gn = F.in(hd < 4 ? I_NSA_K_G : I_FOX_K_G) + (lane & 7) * 16;
        u32x4 o0, o1;
#pragma unroll
        for (int e = 0; e < 4; ++e) { o0[e] = cvtpk(bf_lo(r0[e]) * rstd * gn[2 * e], bf_hi(r0[e]) * rstd * gn[2 * e + 1]); o1[e] = cvtpk(bf_lo(r1[e]) * rstd * gn[8 + 2 * e], bf_hi(r1[e]) * rstd * gn[8 + 2 * e + 1]); }
        *(u32x4*)p = o0; *(u32x4*)(p + 8) = o1;
    }
    for (int mr = F.gw; mr < MROWS; mr += F.NGW) {
        bf16_t* p = KVM + (size_t)mr * 1024 + (lane >> 4) * HD + (lane & 15) * 8; const u32x4 r0 = *(const u32x4*)p; float ss = 0.f;
#pragma unroll
        for (int e = 0; e < 4; ++e) ss += bf_lo(r0[e]) * bf_lo(r0[e]) + bf_hi(r0[e]) * bf_hi(r0[e]);
        ss += __shfl_xor(ss, 1); ss += __shfl_xor(ss, 2); ss += __shfl_xor(ss, 4); ss += __shfl_xor(ss, 8);
        const float rstd = __builtin_amdgcn_rsqf(ss * (1.f / HD) + RMS_EPS); const float* gn = F.in(I_MEM_K_G) + (lane & 15) * 8; u32x4 o0;
#pragma unroll
        for (int e = 0; e < 4; ++e) o0[e] = cvtpk(bf_lo(r0[e]) * rstd * gn[2 * e], bf_hi(r0[e]) * rstd * gn[2 * e + 1]);
        *(u32x4*)p = o0;
    }
    for (int seq = F.gw; seq < 32; seq += F.NGW) {
        const int b = seq >> 2, h = seq & 3; const float bf = F.in(I_FOX_B_F)[h]; float v[32]; float run = 0.f;
#pragma unroll
        for (int i = 0; i < 32; ++i) { const float x = GL[(size_t)(b * T + 32 * lane + i) * LDG + 24 + h] + bf;
            const float ls = fminf(x, 0.f) - log1pf(__expf(-fabsf(x))); run += ls; v[i] = run; }
        float incl = run;
#pragma unroll
        for (int o = 1; o < 64; o <<= 1) { const float t = __shfl_up(incl, o); if (lane >= o) incl += t; }
        const float excl = incl - run; float* cp = (float*)(ws + WS_CUM) + (size_t)seq * T + 32 * lane;
#pragma unroll
        for (int i = 0; i < 32; ++i) cp[i] = v[i] + excl;
    }
}

constexpr int CW_COARSE = 16384;
constexpr int P6_WSTR = 136;
constexpr int P6_WBUF = 2 * 64 * P6_WSTR * 2;
static_assert(2 * P6_WBUF <= RING_BYTES, "P6 chunk buffers inside the ring region");
__device__ __forceinline__ void p6_router(Frame& F) {
    unsigned char* ws = F.ws; const int lane = F.lane, i16 = lane & 15, kg = lane >> 4, row = i16 & 7;
    unsigned char* H2 = (unsigned char*)(ws + WS_A3); const bf16_t* X1 = (const bf16_t*)(ws + WS_X1B); const float* gain = F.in(I_NORM_FFN_G);
    const bf16_t* Wg = (const bf16_t*)(ws + WS_WRT);
    const float rb = F.in(I_ROUTER_BIAS)[lane];
    unsigned* coarse = (unsigned*)(ws + WS_CTL) + CW_COARSE;
    if (F.gw == 0) {
#pragma unroll
        for (int q = 0; q < 2; ++q) *(u32x4*)(H2 + (size_t)M * D + 32 * lane + 16 * q) = (u32x4){0u, 0u, 0u, 0u}; }
    for (int item = blockIdx.x; item < M / 64; item += F.G) {
        const int tok0 = item * 64 + F.wave * 8;
        float myr = 0.f;
#pragma unroll 2
        for (int i = 0; i < 8; ++i) { const bf16_t* xr = X1 + (size_t)(tok0 + i) * D; float ss = 0.f;
#pragma unroll
            for (int j = 0; j < 4; ++j) { const u32x4 v = *(const u32x4*)(xr + 8 * lane + 512 * j);
#pragma unroll
                for (int e = 0; e < 4; ++e) ss += bf_lo(v[e]) * bf_lo(v[e]) + bf_hi(v[e]) * bf_hi(v[e]); }
            const float r = __builtin_amdgcn_rsqf(wave_sum(ss) * (1.f / D) + RMS_EPS); if (row == i) myr = r; }
        f32x4 acc[4] = {{0.f, 0.f, 0.f, 0.f}, {0.f, 0.f, 0.f, 0.f}, {0.f, 0.f, 0.f, 0.f}, {0.f, 0.f, 0.f, 0.f}};
        const bf16_t* xr = X1 + (size_t)(tok0 + row) * D + 8 * kg; unsigned char* hr = H2 + (size_t)(tok0 + row) * D + 8 * kg;
        u32x4 wst[4];
#define P6_LOADW(ch) do { _Pragma("unroll") for (int i = 0; i < 4; ++i) { const int p = F.tid + 512 * i; wst[i] = *(const u32x4*)(Wg + (size_t)(p >> 4) * D + 128 * (ch) + 8 * (p & 15)); } } while (0)
#define P6_STOREW(bf) do { _Pragma("unroll") for (int i = 0; i < 4; ++i) { const int p = F.tid + 512 * i; *(LAS u32x4*)(F.lds + (bf) * P6_WBUF + ((p >> 4) * P6_WSTR + 8 * (p & 15)) * 2) = wst[i]; } } while (0)
        P6_LOADW(0);
        __syncthreads();
        P6_STOREW(0);
        __syncthreads();
        for (int ch = 0; ch < 16; ++ch) {
            if (ch < 15) P6_LOADW(ch + 1);
            const LAS unsigned char* wb = F.lds + (ch & 1) * P6_WBUF + (i16 * P6_WSTR + 8 * kg) * 2;
#pragma unroll 2
            for (int s = 0; s < 4; ++s) { const int k = 128 * ch + 32 * s;
                const u32x4 xb = *(const u32x4*)(xr + k); const f32x4 g0 = *(const f32x4*)(gain + k + 8 * kg), g1 = *(const f32x4*)(gain + k + 8 * kg + 4);
                const float xn[8] = {bf_lo(xb.x) * myr * g0.x, bf_hi(xb.x) * myr * g0.y, bf_lo(xb.y) * myr * g0.z, bf_hi(xb.y) * myr * g0.w, bf_lo(xb.z) * myr * g1.x, bf_hi(xb.z) * myr * g1.y, bf_lo(xb.w) * myr * g1.z, bf_hi(xb.w) * myr * g1.w};
                u32x4 h, l;
#pragma unroll
                for (int q = 0; q < 4; ++q) { h[q] = cvtpk(xn[2 * q], xn[2 * q + 1]); l[q] = cvtpk(xn[2 * q] - bf_lo(h[q]), xn[2 * q + 1] - bf_hi(h[q])); }
                if (i16 < 8) *(u32x2*)(hr + k) = (u32x2){pk_fp8x4(xn[0], xn[1], xn[2], xn[3]), pk_fp8x4(xn[4], xn[5], xn[6], xn[7])};
                const bf16x8 ah = __builtin_bit_cast(bf16x8, h), al = __builtin_bit_cast(bf16x8, l);
#pragma unroll
                for (int nt = 0; nt < 4; ++nt) { const LAS unsigned char* wp = wb + (16 * nt * P6_WSTR + 32 * s) * 2;
                    const bf16x8 bh = *(const LAS bf16x8*)wp, bl = *(const LAS bf16x8*)(wp + 64 * P6_WSTR * 2);
                    acc[nt] = __builtin_amdgcn_mfma_f32_16x16x32_bf16(ah, bh, acc[nt], 0, 0, 0);
                    acc[nt] = __builtin_amdgcn_mfma_f32_16x16x32_bf16(al, bh, acc[nt], 0, 0, 0);
                    acc[nt] = __builtin_amdgcn_mfma_f32_16x16x32_bf16(ah, bl, acc[nt], 0, 0, 0); }
            }
            if (ch < 15) P6_STOREW((ch + 1) & 1);
            __syncthreads();
        }
#undef P6_LOADW
#undef P6_STOREW
        LAS float* lg = (LAS float*)(F.lds + F.wave * 4096);
        if (kg < 2) {
#pragma unroll
            for (int nt = 0; nt < 4; ++nt)
#pragma unroll
                for (int r = 0; r < 4; ++r) lg[(4 * kg + r) * 64 + 16 * nt + i16] = acc[nt][r]; }
        LDS_WAIT(); asm volatile("" ::: "memory");
        int cnt = 0;
        u32x2* asg = (u32x2*)(ws + WS_ASG);
        for (int tt = 0; tt < 8; ++tt) {
            const float sc = 1.f / (1.f + __expf(-lg[tt * 64 + lane])); const float key = sc + rb;
            lg[512 + lane] = key; LDS_WAIT(); asm volatile("" ::: "memory");
            int rank = 0;
#pragma unroll
            for (int q = 0; q < 16; ++q) { const f32x4 kk = *(const LAS f32x4*)(lg + 512 + 4 * q);
#pragma unroll
                for (int e = 0; e < 4; ++e) { const int eo = 4 * q + e; rank += (kk[e] > key || (kk[e] == key && eo < lane)) ? 1 : 0; } }
            LDS_WAIT(); asm volatile("" ::: "memory");
            const bool selx = rank < TOPK;
            const float ssum = wave_sum(selx ? sc : 0.f);
            const unsigned long long bal = __ballot(selx);
            if (selx) { const int k = __popcll(bal & ((1ull << lane) - 1ull));
                asg[(size_t)(tok0 + tt) * TOPK + k] = (u32x2){(unsigned)lane | ((unsigned)cnt << 8), __float_as_uint(sc / ssum * 2.5f)}; ++cnt; }
        }
        const int wi = item * 8 + F.wave;
        ((int*)(ws + WS_HIST))[wi * 64 + lane] = cnt;
        __hip_atomic_fetch_add(coarse + (wi >> 5) * 64 + lane, (unsigned)cnt, RLX_AGENT);
    }
}
__device__ __forceinline__ void p7_slots(Frame& F) {
    unsigned char* ws = F.ws; const int lane = F.lane;
    const int* hist = (const int*)(ws + WS_HIST); const u32x2* asg = (const u32x2*)(ws + WS_ASG); const unsigned* coarse = (const unsigned*)(ws + WS_CTL) + CW_COARSE;
    int* rowasg = (int*)(ws + WS_ROWASG); int* rowtok = (int*)(ws + WS_ROWTOK); float* rowg = (float*)(ws + WS_ROWG);
    for (int wi = F.gw; wi < M / 8; wi += F.NGW) {
        const int grp = wi >> 5; int base = 0, total = 0;
#pragma unroll 8
        for (int g = 0; g < 64; ++g) { const int cv = (int)coarse[g * 64 + lane]; total += cv; base += g < grp ? cv : 0; }
        for (int i = grp * 32; i < wi; ++i) base += hist[i * 64 + lane];
        const int padded = (total + 255) & ~255;
        int incl = padded;
#pragma unroll
        for (int o = 1; o < 64; o <<= 1) { const int t = __shfl_up(incl, o); if (lane >= o) incl += t; }
        const int pstart = incl - padded, rtot = __shfl(incl, 63);
        const int my = pstart + base;
        { const int tok = wi * 8 + (lane >> 3), k = lane & 7; const u32x2 rec = asg[(size_t)tok * TOPK + k];
          const int e = rec.x & 255, rl = rec.x >> 8; const int dest = __shfl(my, e) + rl;
          rowasg[dest] = tok * ASG_PER_TOK + k; rowtok[dest] = tok; rowg[dest] = __uint_as_float(rec.y); }
        if (lane < 8) { const int tok = wi * 8 + lane, dest = rtot + tok; rowasg[dest] = tok * ASG_PER_TOK + 8; rowtok[dest] = tok; rowg[dest] = 1.f; }
        if (wi == 0) { for (int sl = pstart + total; sl < pstart + padded; ++sl) { rowasg[sl] = -1; rowtok[sl] = M; rowg[sl] = 0.f; }
                       ((int*)(ws + WS_CNT))[lane] = total; }
    }
}
__device__ __forceinline__ int build_blocks(Frame& F, LAS unsigned char* blk_e, LAS int* tmp) {
    const int* cnt = (const int*)(F.ws + WS_CNT);
    if (F.tid < NEX) tmp[F.tid] = F.tid < NE ? (cnt[F.tid] + 255) >> 8 : M / 256;
    __syncthreads();
    if (F.tid < NEX) { int st = 0; for (int e = 0; e < F.tid; ++e) st += tmp[e]; const int nb = tmp[F.tid]; for (int i = 0; i < nb; ++i) blk_e[st + i] = (unsigned char)F.tid; if (F.tid == NEX - 1) tmp[NEX] = st + nb; }
    __syncthreads();
    return tmp[NEX];
}
__device__ __forceinline__ void p10_combine(Frame& F) {
    const unsigned char* Y = (const unsigned char*)(F.ws + WS_Y); float* O = F.out; const bf16_t* X1 = (const bf16_t*)(F.ws + WS_X1B); const int lane = F.lane;
    for (int tok = F.gw; tok < M; tok += F.NGW) {
#pragma unroll
        for (int c = 0; c < 2; ++c) { const int col = 16 * lane + 1024 * c; float* op = O + (size_t)tok * D + col;
            const u32x4 xa = *(const u32x4*)(X1 + (size_t)tok * D + col), xb = *(const u32x4*)(X1 + (size_t)tok * D + col + 8);
            const f32x4 x0 = {bf_lo(xa.x), bf_hi(xa.x), bf_lo(xa.y), bf_hi(xa.y)}, x1 = {bf_lo(xa.z), bf_hi(xa.z), bf_lo(xa.w), bf_hi(xa.w)}, x2 = {bf_lo(xb.x), bf_hi(xb.x), bf_lo(xb.y), bf_hi(xb.y)}, x3 = {bf_lo(xb.z), bf_hi(xb.z), bf_lo(xb.w), bf_hi(xb.w)};
            u32x4 y[ASG_PER_TOK];
#pragma unroll
            for (int k = 0; k < ASG_PER_TOK; ++k) y[k] = *(const u32x4*)(Y + ((size_t)tok * ASG_PER_TOK + k) * D + col);
            float a[16];
#pragma unroll
            for (int e = 0; e < 16; ++e) a[e] = 0.f;
#pragma unroll
            for (int k = 0; k < ASG_PER_TOK; ++k)
#pragma unroll
                for (int q = 0; q < 4; ++q) { const auto lo = __builtin_amdgcn_cvt_pk_f32_fp8((int)y[k][q], false); const auto hi = __builtin_amdgcn_cvt_pk_f32_fp8((int)y[k][q], true);
                    a[4 * q] += lo[0]; a[4 * q + 1] += lo[1]; a[4 * q + 2] += hi[0]; a[4 * q + 3] += hi[1]; }
            const float r = 1.f / Y_SCALE;
            *(f32x4*)op = (f32x4){x0[0] + a[0] * r, x0[1] + a[1] * r, x0[2] + a[2] * r, x0[3] + a[3] * r};
            *(f32x4*)(op + 4) = (f32x4){x1[0] + a[4] * r, x1[1] + a[5] * r, x1[2] + a[6] * r, x1[3] + a[7] * r};
            *(f32x4*)(op + 8) = (f32x4){x2[0] + a[8] * r, x2[1] + a[9] * r, x2[2] + a[10] * r, x2[3] + a[11] * r};
            *(f32x4*)(op + 12) = (f32x4){x3[0] + a[12] * r, x3[1] + a[13] * r, x3[2] + a[14] * r, x3[3] + a[15] * r}; }
    }
}

constexpr int N_PHASES = 11;
struct Args { const float* in[31]; float* out; unsigned char* ws; int ph_lo, ph_hi, use_bar, pad; };
__global__ void __launch_bounds__(512, 2) mega(Args args) {
    extern __shared__ __attribute__((aligned(16))) unsigned char lds_raw[];
    LAS unsigned char* lds = (LAS unsigned char*)lds_raw;
    Frame F; F.lds = lds; F.tid = threadIdx.x; F.lane = F.tid & 63; F.wave = __builtin_amdgcn_readfirstlane(F.tid >> 6); F.G = gridDim.x;
    F.gw = blockIdx.x * 8 + F.wave; F.NGW = F.G * 8; F.out = args.out; F.ws = args.ws;
    unsigned char* ws = args.ws;
    unsigned* ctl = (unsigned*)(ws + WS_CTL);
    for (int u = F.tid; u < 256; u += 512) ((LAS unsigned*)(lds + LDSCTL_OFF))[u] = 0u;
    __syncthreads();
    XcdBarrier bar; bar.bar = ctl + CW_BAR; bar.x = 0; bar.st = nullptr;
    if (args.use_bar) bar = xcd_barrier_post(ctl + CW_BAR, (volatile LAS unsigned*)(lds + LDSCTL_OFF));
    const int lo = args.ph_lo, hi = args.ph_hi;
#ifndef PH_MASK
#define PH_MASK 0x7ff
#endif
#define IN(k) (((PH_MASK >> (k)) & 1) && lo <= (k) && (k) < hi)
#define SEAM(k) do { if (IN(k) && IN((k) + 1)) xcd_barrier(bar); } while (0)
    const int c = (int)blockIdx.x;
#ifndef REP_PHASE
#define REP_PHASE -1
#endif
#define RUN(k, ...) do { if (IN(k)) { const int rep = 0; (void)rep; __VA_ARGS__ } if (REP_PHASE == (k) && IN(k)) { xcd_barrier(bar); const int rep = 1; (void)rep; __VA_ARGS__ } } while (0)
    RUN(0, p0_prologue(F); ); SEAM(0);
    RUN(1,
        Epi1 E{(bf16_t*)(ws + WS_PA), (unsigned char*)(ws + WS_PG), (float*)(ws + WS_GL), (bf16_t*)(ws + WS_KVMEM)};
        { Sched1 S; S.o.init(64, NB16 + 1); S.A = (const char*)(ws + WS_A3); S.Bt = (const char*)(ws + WS_WINT); S.G = F.G; S.c = c; S.fp8 = 0;
          pg8::gemm_phase<Epi1, Sched1, false, false>(lds, 2 * D, 2 * D, S, E); }
        { Sched1 S; S.o.init(64, 24 + NF8); S.A = (const char*)(ws + WS_H8); S.Bt = (const char*)(ws + WS_WIN8); S.G = F.G; S.c = c; S.fp8 = 1;
          pg8::gemm_phase<Epi1, Sched1, false, true>(lds, D, D, S, E); }
    ); SEAM(1);
    RUN(2, p2_thin(F); ); SEAM(2);
    RUN(3,
        att::Tensors Tn{(const bf16_t*)(ws + WS_PA), (const float*)(ws + WS_GL), (const bf16_t*)(ws + WS_KVMEM), (const bf16_t*)(ws + WS_KC), (const bf16_t*)(ws + WS_VC), (const float*)(ws + WS_CUM),
                        (bf16_t*)(ws + WS_A3), F.in(I_NSA_Q_G), F.in(I_FOX_Q_G), F.in(I_MEM_Q_G), F.in(I_REL_BIAS)};
        att::attn_phase(F, (LAS char*)lds, Tn, ctl + CW_QUEUE + rep * 256);
    ); SEAM(3);
    RUN(4,
        Sched4 S; S.o.init(64, 8); S.A = (const char*)(ws + WS_A3); S.Bt = (const char*)(ws + WS_WOT); S.G = F.G; S.c = c;
        Epi4 E{(const unsigned char*)(ws + WS_PG), (bf16_t*)(ws + WS_PA)};
        pg8::gemm_phase<Epi4, Sched4, false>(lds, 2 * D, 2 * D, S, E);
    ); SEAM(4);
    RUN(5,
        Sched5 S; S.o.init(64, 8); S.A = (const char*)(ws + WS_PA); S.Bt = (const char*)(ws + WS_WOUTT); S.G = F.G; S.c = c;
        Epi5 E{F.in(I_X), (bf16_t*)(ws + WS_X1B)};
        pg8::gemm_phase<Epi5, Sched5, false>(lds, 2 * D, 2 * D, S, E);
    ); SEAM(5);
    RUN(6, p6_router(F); ); SEAM(6);
    RUN(7, p7_slots(F); ); SEAM(7);
    RUN(8,
        LAS unsigned char* blk_e = lds + EPI_OFF; LAS int* tmp = (LAS int*)(lds + EPI_OFF + 1024);
        const int nblk = build_blocks(F, blk_e, tmp);
        SchedMoe S{blk_e, nblk, F.G, c, 2, (const char*)(ws + WS_A3), (const char*)(ws + WS_WGU), (const int*)(ws + WS_ROWTOK), true};
        Epi8 E{(unsigned char*)(ws + WS_PG)};
        pg8::gemm_phase<Epi8, SchedMoe, true, true>(lds, D, D, S, E);
    ); SEAM(8);
    RUN(9,
        LAS unsigned char* blk_e = lds + EPI_OFF; LAS int* tmp = (LAS int*)(lds + EPI_OFF + 1024);
        const int nblk = build_blocks(F, blk_e, tmp);
        SchedMoe S{blk_e, nblk, F.G, c, 3, (const char*)(ws + WS_PG), (const char*)(ws + WS_WD), nullptr, false};
        Epi9 E{(const int*)(ws + WS_ROWASG), (const float*)(ws + WS_ROWG), (unsigned char*)(ws + WS_Y)};
        pg8::gemm_phase<Epi9, SchedMoe, false, true>(lds, DE, DE, S, E);
    ); SEAM(9);
    RUN(10, p10_combine(F); );
#undef RUN
#undef IN
#undef SEAM
}

#ifndef MK_PER_PHASE
#define MK_PER_PHASE 0
#endif
extern "C" void kernel_launch(void* const* d_in, const int* in_sizes, int n_in, void* d_out, int out_size, void* d_ws, size_t ws_size, hipStream_t stream) {
    static int grid = 0;
    if (grid == 0) {
        if (n_in != N_IN || in_sizes[0] != M * D || out_size != M * D || ws_size < WS_END) { fprintf(stderr, "kernel_launch: unexpected shapes (n_in %d, in0 %d, out %d, ws %zu; need ws >= %zu)\n", n_in, n_in > 0 ? in_sizes[0] : -1, out_size, ws_size, (size_t)WS_END); grid = -1; return; }
        int dev = 0, cus = 0, per_cu = 0;
        if (hipGetDevice(&dev) != hipSuccess || hipDeviceGetAttribute(&cus, hipDeviceAttributeMultiprocessorCount, dev) != hipSuccess) { grid = -1; return; }
        if (hipFuncSetAttribute((const void*)mega, hipFuncAttributeMaxDynamicSharedMemorySize, LDS_BYTES) != hipSuccess) { fprintf(stderr, "kernel_launch: hipFuncSetAttribute failed\n"); grid = -1; return; }
        if (hipOccupancyMaxActiveBlocksPerMultiprocessor(&per_cu, (const void*)mega, 512, LDS_BYTES) != hipSuccess || per_cu < 1) fprintf(stderr, "kernel_launch: occupancy query says %d\n", per_cu);
        (void)hipGetLastError();
        grid = cus;
    }
    if (grid < 0) return;
    (void)hipMemsetAsync((char*)d_ws + WS_CTL, 0, CTL_ZERO_BYTES, stream);
    Args a{};
    for (int i = 0; i < 31; ++i) a.in[i] = (const float*)d_in[i];
    a.out = (float*)d_out; a.ws = (unsigned char*)d_ws; a.pad = 0;
#if MK_PER_PHASE
    for (int p = 0; p < N_PHASES; ++p) { a.ph_lo = p; a.ph_hi = p + 1; a.use_bar = 0; hipLaunchKernelGGL(mega, dim3(grid), dim3(512), LDS_BYTES, stream, a); }
#else
    a.ph_lo = 0; a.ph_hi = N_PHASES; a.use_bar = 1; hipLaunchKernelGGL(mega, dim3(grid), dim3(512), LDS_BYTES, stream, a);
#endif
}
```

```cpp
#include <hip/hip_runtime.h>
#include <cstdio>
#include <cstdint>

#define LAS __attribute__((address_space(3)))
#define GAS __attribute__((address_space(1)))
typedef unsigned short bf16_t;
typedef short bf16x8 __attribute__((ext_vector_type(8)));
typedef short s16x4 __attribute__((ext_vector_type(4)));
typedef float f32x2 __attribute__((ext_vector_type(2)));
typedef float f32x4 __attribute__((ext_vector_type(4)));
typedef float f32x16 __attribute__((ext_vector_type(16)));
typedef unsigned u32x2 __attribute__((ext_vector_type(2)));
typedef unsigned u32x4 __attribute__((ext_vector_type(4)));
typedef GAS unsigned gu32;

constexpr int NB = 8, T = 2048, D = 2048, M = NB * T;
constexpr int HD = 128;
constexpr int MEMT = 256, MROWS = NB * MEMT;
constexpr int NE = 64, TOPK = 8, DE = 512, NEX = NE + 1;
constexpr int W_IN_COLS = 10780;
constexpr int NPA = 4608, NPG = 6144, NPAD = 11008;
constexpr int LDG = 32;
constexpr float RMS_EPS = 1e-6f;
constexpr float LOG2E = 1.4426950408889634f;
constexpr float ATTN_SCALE = 0.08838834764831845f;
constexpr int CQ_NSA = 0, CK_CMP = 1024, CV_CMP = 1280, CK_SLC = 1536, CV_SLC = 1792, CK_WIN = 2048, CV_WIN = 2304;
constexpr int CQ_FOX = 2560, CK_FOX = 3072, CV_FOX = 3584, CQ_MEM = 4096;
constexpr int ASG_PER_TOK = 9;
constexpr int MAXSLOT = M * TOPK + NE * 256 + M;

constexpr size_t MiB = 1u << 20;
constexpr size_t WS_CTL = 0, CTL_ZERO_BYTES = 1 * MiB;
constexpr size_t WS_GL = 1 * MiB;
constexpr size_t WS_KVMEM = 3 * MiB;
constexpr size_t WS_KC = 7 * MiB, WS_VC = WS_KC + 512 * 1024;
constexpr size_t WS_CUM = 8 * MiB;
constexpr size_t WS_CBIAS = WS_CUM + 256 * 1024;
constexpr size_t WS_HIST = WS_CUM + 512 * 1024;
constexpr size_t WS_ASG = 9 * MiB;
constexpr size_t WS_ROWASG = 10 * MiB;
constexpr size_t WS_ROWG = 11 * MiB;
constexpr size_t WS_CNT = 12 * MiB;
constexpr size_t WS_WRT = 12 * MiB + 256 * 1024;
constexpr size_t WS_WCK = 13 * MiB, WS_WCV = 14 * MiB;
constexpr size_t WS_WOT = 16 * MiB;
constexpr size_t WS_WOUTT = 24 * MiB;
constexpr size_t WS_WD = 32 * MiB;
constexpr size_t WS_PG = WS_WD + (size_t)NEX * 2 * MiB;
constexpr size_t WS_Y = WS_PG + 192 * MiB;
constexpr size_t WS_WGU = WS_Y;
constexpr size_t WS_WINT = WS_WGU + (size_t)NEX * 4 * MiB;
constexpr size_t WS_PA = WS_WINT + 47 * MiB;
constexpr size_t WS_A3 = WS_PA + 144 * MiB;
constexpr size_t WS_WIN8 = WS_Y + 578 * MiB;
constexpr size_t WS_H8 = WS_WIN8 + 24 * MiB;
constexpr size_t WS_END = WS_H8 + 32 * MiB;
constexpr size_t WS_X1B = WS_PA + 64 * MiB;
static_assert(WS_A3 + (size_t)(M + MROWS) * D * 2 <= WS_Y + 576 * MiB, "ws map");
static_assert((size_t)MAXSLOT * DE * 2 <= 192 * MiB, "hid fits projG");
static_assert((size_t)MAXSLOT * 4 <= 1 * MiB, "row tables");

constexpr int CW_BAR = 4096;
constexpr int CW_QUEUE = 8192;

constexpr int RING_BYTES = 131072;
constexpr int LDSCTL_OFF = RING_BYTES;
constexpr int EPI_OFF = RING_BYTES + 1024;
constexpr int LDS_BYTES = RING_BYTES + 1024 + 8192 + 4096;

#define RLX_AGENT __ATOMIC_RELAXED, __HIP_MEMORY_SCOPE_AGENT
__device__ __forceinline__ unsigned cvtpk(float lo, float hi) { unsigned r; asm volatile("v_cvt_pk_bf16_f32 %0, %1, %2" : "=v"(r) : "v"(lo), "v"(hi)); return r; }
__device__ __forceinline__ float bf_lo(unsigned u) { return __uint_as_float(u << 16); }
__device__ __forceinline__ float bf_hi(unsigned u) { return __uint_as_float(u & 0xffff0000u); }
__device__ __forceinline__ float wave_sum(float v) {
#pragma unroll
    for (int o = 1; o < 64; o <<= 1) v += __shfl_xor(v, o);
    return v;
}
constexpr float WGU_SCALE = 32.f, WD_SCALE = 16.f, WIN_SCALE = 32.f;
__device__ __forceinline__ unsigned pk_fp8x4(float a, float b, float c, float d) { int w = 0; w = __builtin_amdgcn_cvt_pk_fp8_f32(a, b, w, false); w = __builtin_amdgcn_cvt_pk_fp8_f32(c, d, w, true); return (unsigned)w; }
__device__ __forceinline__ float fast_sigmoid(float x) { return __builtin_amdgcn_rcpf(1.f + __builtin_amdgcn_exp2f(-x * LOG2E)); }

#define XB_TMO      128
#define XB_XCNT(j)  (256  + 64 * (j))
#define XB_XSUB(j)  (1280 + 64 * (j))
#define XB_XGEN(j)  (2304 + 64 * (j))
#define XB_TOP      3328
#define XB_TOPGEN   3392
#define XCD_BAR_WORDS 3456
#define XB_SPIN_CAP (1u << 18)
__device__ __forceinline__ unsigned xb_ld(unsigned* p)              { return __hip_atomic_load(p, __ATOMIC_RELAXED, __HIP_MEMORY_SCOPE_AGENT); }
__device__ __forceinline__ unsigned xb_add(unsigned* p, unsigned v) { return __hip_atomic_fetch_add(p, v, __ATOMIC_RELAXED, __HIP_MEMORY_SCOPE_AGENT); }
__device__ __forceinline__ unsigned xb_xcc_id() { return (unsigned)__builtin_amdgcn_s_getreg((3 << 11) | 20) & 0xFu; }
#define XB_SPIN(cond, bar) do { unsigned _sp = 0; while (cond) { __builtin_amdgcn_s_sleep(1); \
    if ((++_sp & 255u) == 0u) { if (xb_ld(&(bar)[XB_TMO])) break; if (_sp > XB_SPIN_CAP) { atomicAdd(&(bar)[XB_TMO], 1u); break; } } } } while (0)
struct XcdBarrier { unsigned* bar; unsigned x; volatile LAS unsigned* st; };
__device__ __forceinline__ XcdBarrier xcd_barrier_post(unsigned* bar, volatile LAS unsigned* st) {
    XcdBarrier b; b.bar = bar; b.x = xb_xcc_id(); b.st = st;
    if (threadIdx.x == 0) (void)xb_add(&bar[XB_XCNT(b.x)], 1u);
    return b;
}
__device__ __forceinline__ void xcd_barrier_complete(unsigned* bar, unsigned x, unsigned& nloc, unsigned& nx) {
    const unsigned G = gridDim.x * gridDim.y * gridDim.z;
    unsigned sum, cnt, mine, sp = 0u;
    for (;;) {
        sum = 0u; cnt = 0u; mine = 0u;
#pragma unroll
        for (unsigned j = 0; j < 16; ++j) { const unsigned c = xb_ld(&bar[XB_XCNT(j)]); sum += c; cnt += (c > 0u) ? 1u : 0u; mine = (j == x) ? c : mine; }
        if (sum == G) break;
        __builtin_amdgcn_s_sleep(1);
        if ((++sp & 255u) == 0u) { if (xb_ld(&bar[XB_TMO])) break; if (sp > XB_SPIN_CAP) { atomicAdd(&bar[XB_TMO], 1u); break; } }
    }
    nloc = mine > 0u ? mine : 1u; nx = cnt > 0u ? cnt : 1u;
}
__device__ __forceinline__ void xcd_barrier(const XcdBarrier& b) {
    asm volatile("s_waitcnt vmcnt(0)" ::: "memory");
    __syncthreads();
    if (threadIdx.x == 0) {
        unsigned* bar = b.bar;
        __builtin_amdgcn_s_waitcnt(0);
        unsigned nloc = b.st[0], nx = b.st[1];
        if (nloc == 0u) { xcd_barrier_complete(bar, b.x, nloc, nx); b.st[0] = nloc; b.st[1] = nx; }
        const unsigned old = xb_add(&bar[XB_XSUB(b.x)], 1u);
        const unsigned gen = old / nloc;
        if (old + 1u == (gen + 1u) * nloc) {
            __builtin_amdgcn_fence(__ATOMIC_RELEASE, "agent");
            asm volatile("s_waitcnt vmcnt(0)" ::: "memory");
            const unsigned og = xb_add(&bar[XB_TOP], 1u);
            const unsigned tg = og / nx;
            if (og + 1u == (tg + 1u) * nx) xb_add(&bar[XB_TOPGEN], 1u);
            else XB_SPIN(xb_ld(&bar[XB_TOPGEN]) == tg, bar);
            __builtin_amdgcn_fence(__ATOMIC_ACQUIRE, "agent");
            xb_add(&bar[XB_XGEN(b.x)], 1u);
            asm volatile("s_waitcnt vmcnt(0)" ::: "memory");
        } else {
            XB_SPIN(xb_ld(&bar[XB_XGEN(b.x)]) == gen, bar);
            __builtin_amdgcn_fence(__ATOMIC_ACQUIRE, "agent");
            asm volatile("s_waitcnt vmcnt(0)" ::: "memory");
        }
    }
    __syncthreads();
}

namespace pg8 {
constexpr int BM = 256, BK = 64, HALF = 128, HTB = HALF * BK * 2, STAGE_BYTES = 8 * HTB, NXCD = 8, WGM = 8;
__host__ __device__ __forceinline__ int lds_byte(int r, int c) { const int st = (r >> 4) * 2 + (c >> 5), rr = r & 15, cc = c & 31, ob = rr * 64 + cc * 2; return st * 1024 + (ob ^ (((ob >> 9) & 1) << 5)); }
__host__ __device__ __forceinline__ void stage_rc(int b, int& R, int& C) { const int st = b / 1024, sb = b % 1024, swz = sb ^ (((sb >> 9) & 1) << 5); R = (st >> 1) * 16 + swz / 64; C = (st & 1) * 32 + (swz % 64) / 2; }
__host__ __device__ __forceinline__ int perm32(int rho) { const int n = rho >> 4, i = rho & 15; return 8 * (i >> 2) + 4 * n + (i & 3); }

template <bool FP8> struct FragSel { struct A4 { bf16x8 f[4][2]; }; struct B2 { bf16x8 f[2][2]; }; };
template <> struct FragSel<true> { typedef int v8i_ __attribute__((ext_vector_type(8))); struct A4 { v8i_ f[4]; }; struct B2 { v8i_ f[2]; }; };
struct Unit { const char* A; const char* B; const int* ridx; int nt, pm, pn, aux; };

template <class Epi, class Sched, bool GATHER, bool FP8 = false>
__device__ __forceinline__ void gemm_phase(LAS unsigned char* lds, const int lda, const int ldb, const Sched& S, const Epi& E) {
    const int tid = threadIdx.x, wid = __builtin_amdgcn_readfirstlane(tid >> 6), lane = tid & 63, wr = wid >> 2, wc = wid & 3, fr = lane & 15, fq = lane >> 4;
    unsigned voffA[2], voffB[2]; int RA[2], CA[2];
#pragma unroll
    for (int i = 0; i < 2; ++i) { int R, C; stage_rc(tid * 16 + i * 8192, R, C); const int Rb = (R & ~31) + perm32(R & 31);
        RA[i] = R; CA[i] = C; voffA[i] = (unsigned)(R * lda + 2 * C); voffB[i] = (unsigned)(Rb * ldb + 2 * C); }
    const size_t kstep = (size_t)(BK * 2);
    const size_t hstepA = (size_t)HALF * lda, hstepB = (size_t)HALF * ldb;
    const unsigned ldsw = (unsigned)wid * 1024u;
    const int aoff = lds_byte(wr * 64 + fr, fq * 8), boff = lds_byte(wc * 32 + fr, fq * 8);
#define PG8_SA(b, h) (((b) * 2 + (h)) * HTB)
#define PG8_SB(b, h) ((4 + (b) * 2 + (h)) * HTB)
#define PG8_STG(bufoff, gptr, v0, v1) do { \
        __builtin_amdgcn_global_load_lds((const unsigned*)((const char*)(gptr) + (v0)), (LAS unsigned*)(lds + (bufoff) + ldsw), 16, 0, 0); \
        __builtin_amdgcn_global_load_lds((const unsigned*)((const char*)(gptr) + (v1)), (LAS unsigned*)(lds + (bufoff) + ldsw + 8192), 16, 0, 0); } while (0)
#define PG8_STB(b, h, kp) PG8_STG(PG8_SB(b, h), (kp) + (h) * hstepB, voffB[0], voffB[1])
#define PG8_STA_CUR(b, h, kp) do { if constexpr (GATHER) PG8_STG(PG8_SA(b, h), (kp), vg[h][0], vg[h][1]); else PG8_STG(PG8_SA(b, h), (kp) + (h) * hstepA, voffA[0], voffA[1]); } while (0)
#define PG8_STA_SEL(b, h, kp) do { if constexpr (GATHER) { const unsigned s0_ = last ? nvg[h][0] : vg[h][0], s1_ = last ? nvg[h][1] : vg[h][1]; PG8_STG(PG8_SA(b, h), (kp), s0_, s1_); } \
        else PG8_STG(PG8_SA(b, h), (kp) + (h) * hstepA, voffA[0], voffA[1]); } while (0)
#define PG8_LD16(off) (*(const LAS u32x4*)(lds + (off)))
#define PG8_LDA(dst, b, h) do { _Pragma("unroll") for (int m = 0; m < 4; ++m) { if constexpr (FP8) { const u32x4 lo_ = PG8_LD16(PG8_SA(b, h) + aoff + m * 2048), hi_ = PG8_LD16(PG8_SA(b, h) + aoff + m * 2048 + 1024); \
            dst.f[m] = __builtin_bit_cast(v8i_, __builtin_shufflevector(lo_, hi_, 0, 1, 2, 3, 4, 5, 6, 7)); } \
        else { _Pragma("unroll") for (int k = 0; k < 2; ++k) dst.f[m][k] = *(const LAS bf16x8*)(lds + PG8_SA(b, h) + aoff + m * 2048 + k * 1024); } } } while (0)
#define PG8_LDB(dst, b, h) do { _Pragma("unroll") for (int n = 0; n < 2; ++n) { if constexpr (FP8) { const u32x4 lo_ = PG8_LD16(PG8_SB(b, h) + boff + n * 2048), hi_ = PG8_LD16(PG8_SB(b, h) + boff + n * 2048 + 1024); \
            dst.f[n] = __builtin_bit_cast(v8i_, __builtin_shufflevector(lo_, hi_, 0, 1, 2, 3, 4, 5, 6, 7)); } \
        else { _Pragma("unroll") for (int k = 0; k < 2; ++k) dst.f[n][k] = *(const LAS bf16x8*)(lds + PG8_SB(b, h) + boff + n * 2048 + k * 1024); } } } while (0)
#define PG8_MMA(ai, bj, At, Bt) do { __builtin_amdgcn_s_setprio(1); _Pragma("unroll") for (int m = 0; m < 4; ++m) _Pragma("unroll") for (int n = 0; n < 2; ++n) { \
        if constexpr (FP8) asm volatile("v_mfma_scale_f32_16x16x128_f8f6f4 %0, %1, %2, %0, %3, %3 op_sel_hi:[0,0,0]" : "+v"(acc[ai][bj][m][n]) : "v"(Bt.f[n]), "v"(At.f[m]), "v"(fp8_one)); \
        else { _Pragma("unroll") for (int k = 0; k < 2; ++k) acc[ai][bj][m][n] = __builtin_amdgcn_mfma_f32_16x16x32_bf16(Bt.f[n][k], At.f[m][k], acc[ai][bj][m][n], 0, 0, 0); } } \
        __builtin_amdgcn_s_setprio(0); } while (0)
#define PG8_WAIT_V(n) asm volatile("s_waitcnt vmcnt(" #n ")" ::: "memory")
#define PG8_WAIT_L(n) asm volatile("s_waitcnt lgkmcnt(" #n ")" ::: "memory")
#define PG8_BAR __builtin_amdgcn_s_barrier()
#define PG8_SCHED __builtin_amdgcn_sched_barrier(0)
#define PG8_LOADIDX(dst, u) do { if constexpr (GATHER) { _Pragma("unroll") for (int h = 0; h < 2; ++h) _Pragma("unroll") for (int i = 0; i < 2; ++i) \
        dst[h][i] = (unsigned)(u).ridx[h * HALF + RA[i]] * (unsigned)lda + (unsigned)(CA[i] * 2); } } while (0)
    Unit cur, nxt; int ui = 0;
    if (!S.next(0, cur)) return;
#define PG8_PIN_ACC() do { _Pragma("unroll") for (int a_ = 0; a_ < 2; ++a_) _Pragma("unroll") for (int b_ = 0; b_ < 2; ++b_) \
        asm volatile("" : "+v"(acc[a_][b_][0][0]), "+v"(acc[a_][b_][0][1]), "+v"(acc[a_][b_][1][0]), "+v"(acc[a_][b_][1][1]), "+v"(acc[a_][b_][2][0]), "+v"(acc[a_][b_][2][1]), "+v"(acc[a_][b_][3][0]), "+v"(acc[a_][b_][3][1])); } while (0)

    f32x4 acc[2][2][4][2];
    E.init(acc, cur, wr, wc, fr, fq);
    typedef int v8i_ __attribute__((ext_vector_type(8)));
    typedef typename pg8::FragSel<FP8>::A4 FragA; typedef typename pg8::FragSel<FP8>::B2 FragB;
    FragA At; FragB B0, B1;
    int fp8_one = 0x7f7f7f7f; if constexpr (FP8) asm volatile("" : "+v"(fp8_one));
    unsigned vg[2][2] = {{0u, 0u}, {0u, 0u}}, nvg[2][2] = {{0u, 0u}, {0u, 0u}};
    const char* cA = cur.A; const char* cB = cur.B;
    PG8_LOADIDX(vg, cur);
    { const bool last = false; (void)last;
      PG8_STB(0, 0, cB); PG8_STB(0, 1, cB); PG8_STA_CUR(0, 0, cA); PG8_STA_CUR(0, 1, cA);
      if (wr == 1) PG8_BAR;
      PG8_WAIT_V(2); PG8_BAR;
      PG8_STB(1, 0, cB + kstep); PG8_STA_CUR(1, 0, cA + kstep); PG8_STB(1, 1, cB + kstep);
      PG8_WAIT_V(6); PG8_BAR; }
    if constexpr (Epi::INIT_LOADS) PG8_PIN_ACC();
    for (;;) {
        const bool has_next = S.next(ui + 1, nxt);
        const char* nA = has_next ? nxt.A : cA; const char* nB = has_next ? nxt.B : cB;
        if constexpr (GATHER) { if (has_next) { PG8_LOADIDX(nvg, nxt); } else { nvg[0][0] = vg[0][0]; nvg[0][1] = vg[0][1]; nvg[1][0] = vg[1][0]; nvg[1][1] = vg[1][1]; } }
        const int nt = cur.nt;
        for (int t = 0; t < nt; t += 2) {
            const bool last = (t == nt - 2);
            const char* a1 = cA + (size_t)(t + 1) * kstep;
            const char* a2 = last ? nA : cA + (size_t)(t + 2) * kstep; const char* b2 = last ? nB : cB + (size_t)(t + 2) * kstep;
            const char* a3 = a2 + kstep; const char* b3 = b2 + kstep;
            PG8_LDB(B0, 0, 0); PG8_LDB(B1, 0, 1); PG8_SCHED; PG8_LDA(At, 0, 0); PG8_STA_CUR(1, 1, a1);
            PG8_WAIT_V(8); PG8_WAIT_L(0); PG8_BAR; PG8_MMA(0, 0, At, B0); PG8_MMA(0, 1, At, B1); PG8_BAR; PG8_SCHED;
            PG8_LDA(At, 0, 1); PG8_STB(0, 0, b2); PG8_STB(0, 1, b2); PG8_STA_SEL(0, 0, a2);
            PG8_WAIT_V(8); PG8_WAIT_L(0); PG8_BAR; PG8_MMA(1, 0, At, B0); PG8_MMA(1, 1, At, B1); PG8_BAR; PG8_SCHED;
            PG8_LDB(B0, 1, 0); PG8_LDB(B1, 1, 1); PG8_SCHED; PG8_LDA(At, 1, 0); PG8_STA_SEL(0, 1, a2);
            PG8_WAIT_V(8); PG8_WAIT_L(0); PG8_BAR; PG8_MMA(0, 0, At, B0); PG8_MMA(0, 1, At, B1); PG8_BAR; PG8_SCHED;
            PG8_LDA(At, 1, 1); PG8_STB(1, 0, b3); PG8_STB(1, 1, b3); PG8_STA_SEL(1, 0, a3);
            PG8_WAIT_V(8); PG8_WAIT_L(0); PG8_BAR; PG8_MMA(1, 0, At, B0); PG8_MMA(1, 1, At, B1); PG8_BAR; PG8_SCHED;
        }
        if (wr == 0) PG8_BAR;
        if constexpr (FP8) { asm volatile("s_nop 15\n\ts_nop 15\n\ts_nop 15" ::: "memory"); PG8_PIN_ACC(); }
        E(acc, cur, wr, wc, fr, fq);
        if (!has_next) break;
        E.init(acc, nxt, wr, wc, fr, fq);
        if constexpr (Epi::INIT_LOADS) PG8_PIN_ACC();
        cur = nxt; cA = nA; cB = nB; ++ui;
        if constexpr (GATHER) { vg[0][0] = nvg[0][0]; vg[0][1] = nvg[0][1]; vg[1][0] = nvg[1][0]; vg[1][1] = nvg[1][1]; }
        if (wr == 1) PG8_BAR;
    }
    PG8_WAIT_V(0);
    PG8_BAR;
#undef PG8_SA
#undef PG8_SB
#undef PG8_STG
#undef PG8_STB
#undef PG8_STA_CUR
#undef PG8_STA_SEL
#undef PG8_LDA
#undef PG8_LD16
#undef PG8_LDB
#undef PG8_MMA
#undef PG8_WAIT_V
#undef PG8_WAIT_L
#undef PG8_BAR
#undef PG8_SCHED
#undef PG8_LOADIDX
#undef PG8_PIN_ACC
}
}

#define EPI_ZERO_INIT static constexpr bool INIT_LOADS = false; __device__ __forceinline__ void init(f32x4 (&acc)[2][2][4][2], const pg8::Unit&, int, int, int, int) const { \
        _Pragma("unroll") for (int a = 0; a < 2; ++a) _Pragma("unroll") for (int b = 0; b < 2; ++b) _Pragma("unroll") for (int m = 0; m < 4; ++m) _Pragma("unroll") for (int n = 0; n < 2; ++n) acc[a][b][m][n] = (f32x4){0.f, 0.f, 0.f, 0.f}; }
constexpr size_t WS_ROWTOK = 15 * MiB;
struct TileOrder {
    int nM, nN, nwg;
    __device__ __forceinline__ void init(int nM_, int nN_) { nM = nM_; nN = nN_; nwg = nM_ * nN_; }
    __device__ __forceinline__ void decode(int L, int& pm, int& pn) const {
        int wgid = L; { const int q = nwg / pg8::NXCD, r = nwg % pg8::NXCD, xcd = wgid % pg8::NXCD, off = wgid / pg8::NXCD; wgid = (xcd < r ? xcd * (q + 1) : r * (q + 1) + (xcd - r) * q) + off; }
        const int nig = pg8::WGM * nN, gid = wgid / nig, fm = gid * pg8::WGM, gsz = (nM - fm) < pg8::WGM ? (nM - fm) : pg8::WGM;
        pm = fm + ((wgid % nig) % gsz); pn = (wgid % nig) / gsz;
    }
};
#ifndef P1_FP8_MASK
#define P1_FP8_MASK 0x3FFFFu
#endif
constexpr unsigned FP8M = P1_FP8_MASK & 0x3ffffu;
constexpr int NF8 = __builtin_popcount(FP8M), NB16 = 18 - NF8;
__device__ __forceinline__ int nth_set(unsigned m, int n) { for (int i = 0; i < n; ++i) m &= m - 1; return __builtin_ctz(m); }
struct Sched1 {
    TileOrder o; const char* A; const char* Bt; int G, c, fp8;
    __device__ __forceinline__ bool next(int i, pg8::Unit& u) const {
        const int L = i * G + c; int pm, pn;
        if (fp8) { constexpr int NT8 = 64 * (24 + NF8), NBU = 64 * (NB16 + 1) + 32;
            int L8 = L;
            if (NBU < G) { const int RB = NT8 / G, rem = NT8 - RB * G, nfree = G - NBU;
                if (i >= RB) { const int idx = (c - NBU) + (i - RB) * nfree; if (c < NBU || idx >= rem) return false; L8 = RB * G + idx; } }
            if (L8 >= NT8) return false; o.decode(L8, pm, pn);
            u.A = A + (size_t)pm * 256 * D; u.B = Bt + (size_t)pn * 256 * D; u.nt = D / 128; pn = pn < 24 ? pn + 18 : nth_set(FP8M, pn - 24); u.aux = 1; }
        else { if (L < 64 * (NB16 + 1)) { o.decode(L, pm, pn); pn = pn == NB16 ? 42 : nth_set(~FP8M & 0x3ffffu, pn); } else if (L < 64 * (NB16 + 1) + 32) { const int r = L - 64 * (NB16 + 1); pm = 64 + (r >> 2); pn = 43 + (r & 3); } else return false;
            u.A = A + (size_t)pm * 256 * D * 2; u.B = Bt + (size_t)pn * 256 * D * 2; u.nt = D / 64; u.aux = 0; }
        u.ridx = nullptr; u.pm = pm; u.pn = pn; return true;
    }
};
struct Epi1 {
    EPI_ZERO_INIT
    bf16_t* PA; unsigned char* PG8; float* GL; bf16_t* KVM;
    __device__ __forceinline__ void operator()(const f32x4 (&acc)[2][2][4][2], const pg8::Unit& u, int wr, int wc, int fr, int fq) const {
        const int pn = u.pn; int row0 = u.pm * 256 + wr * 64 + fr;
        if (pn == 42) {
            if (wc == 0) {
#pragma unroll
                for (int ai = 0; ai < 2; ++ai)
#pragma unroll
                    for (int m = 0; m < 4; ++m) { float* p = GL + (size_t)(row0 + ai * 128 + m * 16) * LDG + 8 * fq; *(f32x4*)p = acc[ai][0][m][0]; *(f32x4*)(p + 4) = acc[ai][0][m][1]; }
            }
            return;
        }
        if (pn >= 18 && pn < 42) {
            unsigned char* gb = PG8 + (pn - 18) * 256 + wc * 32 + 8 * fq;
#pragma unroll
            for (int ai = 0; ai < 2; ++ai)
#pragma unroll
                for (int m = 0; m < 4; ++m) { unsigned char* rowp = gb + (size_t)(row0 + ai * 128 + m * 16) * NPG;
#pragma unroll
                    for (int bj = 0; bj < 2; ++bj) { const f32x4 v0 = acc[ai][bj][m][0] * (1.f / WIN_SCALE), v1 = acc[ai][bj][m][1] * (1.f / WIN_SCALE); unsigned w0 = 0u, w1 = 0u;
                        w0 = __builtin_amdgcn_cvt_pk_u8_f32(fast_sigmoid(v0[0]) * 255.f, 0, w0); w0 = __builtin_amdgcn_cvt_pk_u8_f32(fast_sigmoid(v0[1]) * 255.f, 1, w0);
                        w0 = __builtin_amdgcn_cvt_pk_u8_f32(fast_sigmoid(v0[2]) * 255.f, 2, w0); w0 = __builtin_amdgcn_cvt_pk_u8_f32(fast_sigmoid(v0[3]) * 255.f, 3, w0);
                        w1 = __builtin_amdgcn_cvt_pk_u8_f32(fast_sigmoid(v1[0]) * 255.f, 0, w1); w1 = __builtin_amdgcn_cvt_pk_u8_f32(fast_sigmoid(v1[1]) * 255.f, 1, w1);
                        w1 = __builtin_amdgcn_cvt_pk_u8_f32(fast_sigmoid(v1[2]) * 255.f, 2, w1); w1 = __builtin_amdgcn_cvt_pk_u8_f32(fast_sigmoid(v1[3]) * 255.f, 3, w1);
                        *(u32x2*)(rowp + bj * 128) = (u32x2){w0, w1}; } }
            return;
        }
        bf16_t* base; int ld;
        if (pn < 18) { base = PA + pn * 256; ld = NPA; }
        else { base = KVM + (pn - 43) * 256; ld = 1024; row0 -= M; }
        base += wc * 32 + 8 * fq;
        const float sc = u.aux ? 1.f / WIN_SCALE : 1.f;
#pragma unroll
        for (int ai = 0; ai < 2; ++ai)
#pragma unroll
            for (int m = 0; m < 4; ++m) { bf16_t* rowp = base + (size_t)(row0 + ai * 128 + m * 16) * ld;
#pragma unroll
                for (int bj = 0; bj < 2; ++bj) { const f32x4 v0 = acc[ai][bj][m][0] * sc, v1 = acc[ai][bj][m][1] * sc;
                    u32x4 w; w.x = cvtpk(v0[0], v0[1]); w.y = cvtpk(v0[2], v0[3]); w.z = cvtpk(v1[0], v1[1]); w.w = cvtpk(v1[2], v1[3]);
                    *(u32x4*)(rowp + bj * 128) = w; } }
    }
};
struct Sched4 {
    TileOrder o; const char* A; const char* Bt; int G, c;
    __device__ __forceinline__ bool next(int i, pg8::Unit& u) const {
        const int it = i / 3, br = i - it * 3, L = it * G + c; if (L >= 64 * 8) return false;
        int pm, pn; o.decode(L, pm, pn);
        const int koff = br == 0 ? 0 : (br == 1 ? 1024 : 1536);
        u.A = A + ((size_t)pm * 256 * D + koff) * 2; u.B = Bt + ((size_t)pn * 256 * D + koff) * 2; u.ridx = nullptr; u.nt = br == 0 ? 16 : 8; u.pm = pm; u.pn = pn; u.aux = br; return true;
    }
};
struct Epi4 {
    EPI_ZERO_INIT
    const unsigned char* PG8; bf16_t* Z;
    __device__ __forceinline__ void operator()(const f32x4 (&acc)[2][2][4][2], const pg8::Unit& u, int wr, int wc, int fr, int fq) const {
        const int row0 = u.pm * 256 + wr * 64 + fr, col0 = u.pn * 256 + wc * 32 + 8 * fq, br = u.aux;
#pragma unroll
        for (int ai = 0; ai < 2; ++ai) {
            u32x2 gv[4][2]; u32x4 zv[4][2];
#pragma unroll
            for (int m = 0; m < 4; ++m) { const size_t row = (size_t)(row0 + ai * 128 + m * 16);
#pragma unroll
                for (int bj = 0; bj < 2; ++bj) { const int col = col0 + bj * 128; gv[m][bj] = *(const u32x2*)(PG8 + row * NPG + br * D + col);
                    if (br > 0) zv[m][bj] = *(const u32x4*)(Z + row * D + col); else zv[m][bj] = (u32x4){0u, 0u, 0u, 0u}; } }
#pragma unroll
            for (int m = 0; m < 4; ++m) { const size_t row = (size_t)(row0 + ai * 128 + m * 16);
#pragma unroll
                for (int bj = 0; bj < 2; ++bj) { const int col = col0 + bj * 128; const u32x2 g = gv[m][bj]; const u32x4 z = zv[m][bj]; const float gs = 1.f / 255.f;
                    f32x4 v0 = acc[ai][bj][m][0] * gs, v1 = acc[ai][bj][m][1] * gs;
                    v0[0] = v0[0] * (float)(g.x & 0xffu) + bf_lo(z.x); v0[1] = v0[1] * (float)((g.x >> 8) & 0xffu) + bf_hi(z.x); v0[2] = v0[2] * (float)((g.x >> 16) & 0xffu) + bf_lo(z.y); v0[3] = v0[3] * (float)(g.x >> 24) + bf_hi(z.y);
                    v1[0] = v1[0] * (float)(g.y & 0xffu) + bf_lo(z.z); v1[1] = v1[1] * (float)((g.y >> 8) & 0xffu) + bf_hi(z.z); v1[2] = v1[2] * (float)((g.y >> 16) & 0xffu) + bf_lo(z.w); v1[3] = v1[3] * (float)(g.y >> 24) + bf_hi(z.w);
                    u32x4 w; w.x = cvtpk(v0[0], v0[1]); w.y = cvtpk(v0[2], v0[3]); w.z = cvtpk(v1[0], v1[1]); w.w = cvtpk(v1[2], v1[3]);
                    *(u32x4*)(Z + row * D + col) = w; } }
        }
    }
};
struct Sched5 {
    TileOrder o; const char* A; const char* Bt; int G, c;
    __device__ __forceinline__ bool next(int i, pg8::Unit& u) const {
        const int L = i * G + c; if (L >= 64 * 8) return false;
        int pm, pn; o.decode(L, pm, pn);
        u.A = A + (size_t)pm * 256 * D * 2; u.B = Bt + (size_t)pn * 256 * D * 2; u.ridx = nullptr; u.nt = D / 64; u.pm = pm; u.pn = pn; u.aux = 0; return true;
    }
};
struct Epi5 {
    static constexpr bool INIT_LOADS = true;
    const float* X; bf16_t* O;
    __device__ __forceinline__ void init(f32x4 (&acc)[2][2][4][2], const pg8::Unit& u, int wr, int wc, int fr, int fq) const {
        const int row0 = u.pm * 256 + wr * 64 + fr, col0 = u.pn * 256 + wc * 32 + 8 * fq;
#pragma unroll
        for (int ai = 0; ai < 2; ++ai)
#pragma unroll
            for (int m = 0; m < 4; ++m) { const size_t off = (size_t)(row0 + ai * 128 + m * 16) * D + col0;
#pragma unroll
                for (int bj = 0; bj < 2; ++bj) { acc[ai][bj][m][0] = *(const f32x4*)(X + off + bj * 128); acc[ai][bj][m][1] = *(const f32x4*)(X + off + bj * 128 + 4); } }
    }
    __device__ __forceinline__ void operator()(const f32x4 (&acc)[2][2][4][2], const pg8::Unit& u, int wr, int wc, int fr, int fq) const {
        const int row0 = u.pm * 256 + wr * 64 + fr, col0 = u.pn * 256 + wc * 32 + 8 * fq;
#pragma unroll
        for (int ai = 0; ai < 2; ++ai)
#pragma unroll
            for (int m = 0; m < 4; ++m) { const size_t off = (size_t)(row0 + ai * 128 + m * 16) * D + col0;
#pragma unroll
                for (int bj = 0; bj < 2; ++bj) { const f32x4 v0 = acc[ai][bj][m][0], v1 = acc[ai][bj][m][1];
                    u32x4 w; w.x = cvtpk(v0[0], v0[1]); w.y = cvtpk(v0[2], v0[3]); w.z = cvtpk(v1[0], v1[1]); w.w = cvtpk(v1[2], v1[3]);
                    *(u32x4*)(O + off + bj * 128) = w; } }
    }
};
struct SchedMoe {
    const LAS unsigned char* blk_e; int nblk, G, c, npn_shift;
    const char* A; const char* W; const int* rowtok; bool up;
    __device__ __forceinline__ bool next(int i, pg8::Unit& u) const {
        int L; if (G == 256) L = ((i * 8 + (c & 7)) * 32 + (c >> 3)); else L = i * G + c;
        const int blk = L >> npn_shift, pn = L & ((1 << npn_shift) - 1);
        if (blk >= nblk) { if (G != 256) return false; return false; }
        const int e = blk_e[blk];
        if (up) { u.A = A; u.ridx = rowtok + blk * 256; u.B = W + ((size_t)e * 1024 + pn * 256) * D; u.nt = D / 128; }
        else    { u.A = A + (size_t)blk * 256 * DE; u.ridx = nullptr; u.B = W + ((size_t)e * D + pn * 256) * DE; u.nt = DE / 128; }
        u.pm = blk; u.pn = pn; u.aux = e; return true;
    }
};
struct Epi8 {  EPI_ZERO_INIT
    unsigned char* HID;
    __device__ __forceinline__ void operator()(const f32x4 (&acc)[2][2][4][2], const pg8::Unit& u, int wr, int wc, int fr, int fq) const {
        const int row0 = u.pm * 256 + wr * 64 + fr, col0 = u.pn * 128 + wc * 32 + 8 * fq; const float rs = 1.f / WGU_SCALE;
#pragma unroll
        for (int ai = 0; ai < 2; ++ai)
#pragma unroll
            for (int m = 0; m < 4; ++m) { float h[8];
#pragma unroll
                for (int e = 0; e < 4; ++e) { const float g0 = acc[ai][0][m][0][e] * rs, g1 = acc[ai][0][m][1][e] * rs;
                    h[e] = __builtin_amdgcn_fmed3f(g0 * fast_sigmoid(g0) * (acc[ai][1][m][0][e] * rs), -440.f, 440.f); h[4 + e] = __builtin_amdgcn_fmed3f(g1 * fast_sigmoid(g1) * (acc[ai][1][m][1][e] * rs), -440.f, 440.f); }
                *(u32x2*)(HID + (size_t)(row0 + ai * 128 + m * 16) * DE + col0) = (u32x2){pk_fp8x4(h[0], h[1], h[2], h[3]), pk_fp8x4(h[4], h[5], h[6], h[7])}; }
    }
};
constexpr float Y_SCALE = 16.f;
struct Epi9 {  EPI_ZERO_INIT
    const int* rowasg; const float* rowg; unsigned char* Y;
    __device__ __forceinline__ void operator()(const f32x4 (&acc)[2][2][4][2], const pg8::Unit& u, int wr, int wc, int fr, int fq) const {
        const int row0 = u.pm * 256 + wr * 64 + fr, col0 = u.pn * 256 + wc * 32 + 8 * fq;
        int asg[2][4]; float g[2][4];
#pragma unroll
        for (int ai = 0; ai < 2; ++ai)
#pragma unroll
            for (int m = 0; m < 4; ++m) { const int slot = row0 + ai * 128 + m * 16; asg[ai][m] = rowasg[slot]; g[ai][m] = rowg[slot] * (Y_SCALE / WD_SCALE); }
#pragma unroll
        for (int ai = 0; ai < 2; ++ai)
#pragma unroll
            for (int m = 0; m < 4; ++m) {
                if (asg[ai][m] >= 0) { unsigned char* yp = Y + (size_t)asg[ai][m] * D + col0; const float gg = g[ai][m];
#pragma unroll
                    for (int bj = 0; bj < 2; ++bj) { f32x4 v0 = acc[ai][bj][m][0] * gg, v1 = acc[ai][bj][m][1] * gg;
#pragma unroll
                        for (int e = 0; e < 4; ++e) { v0[e] = __builtin_amdgcn_fmed3f(v0[e], -440.f, 440.f); v1[e] = __builtin_amdgcn_fmed3f(v1[e], -440.f, 440.f); }
                        int w0 = 0, w1 = 0;
                        w0 = __builtin_amdgcn_cvt_pk_fp8_f32(v0[0], v0[1], w0, false); w0 = __builtin_amdgcn_cvt_pk_fp8_f32(v0[2], v0[3], w0, true);
                        w1 = __builtin_amdgcn_cvt_pk_fp8_f32(v1[0], v1[1], w1, false); w1 = __builtin_amdgcn_cvt_pk_fp8_f32(v1[2], v1[3], w1, true);
                        *(u32x2*)(yp + bj * 128) = (u32x2){(unsigned)w0, (unsigned)w1}; } } }
    }
};

struct Frame {
    LAS unsigned char* lds; int tid, lane, wave, G, gw, NGW;
    float* out; unsigned char* ws;
    __device__ __forceinline__ const float* in(int i) const { return ((const float* const __attribute__((address_space(4)))*)__builtin_amdgcn_kernarg_segment_ptr())[i]; }
};
#define LDS_WAIT() asm volatile("s_waitcnt lgkmcnt(0)" ::: "memory")
template <class SrcCol, class DstRow>
__device__ __forceinline__ void tr_item(const float* W, size_t ldw, int k0, int n0, const SrcCol& sc, bf16_t* WT, size_t ldt, int kd0, const DstRow& dr, LAS float* scr, int lane) {
    const int c = sc(n0 + (lane & 31));
#pragma unroll 8
    for (int i = 0; i < 32; ++i) { const int kk = 2 * i + (lane >> 5); scr[kk * 33 + (lane & 31)] = c >= 0 ? W[(size_t)(k0 + kk) * ldw + c] : 0.f; }
    LDS_WAIT(); asm volatile("" ::: "memory");
    const int c8 = lane & 7;
#pragma unroll
    for (int j = 0; j < 4; ++j) { const int n = (lane >> 3) + 8 * j; const LAS float* s = scr + (8 * c8) * 33 + n;
        u32x4 o; o.x = cvtpk(s[0 * 33], s[1 * 33]); o.y = cvtpk(s[2 * 33], s[3 * 33]); o.z = cvtpk(s[4 * 33], s[5 * 33]); o.w = cvtpk(s[6 * 33], s[7 * 33]);
        *(u32x4*)(WT + (size_t)dr(n0 + n) * ldt + kd0 + k0 + 8 * c8) = o; }
    LDS_WAIT(); asm volatile("" ::: "memory");
}
struct IdCol { __device__ __forceinline__ int operator()(int n) const { return n; } };
struct OffRow { int off; __device__ __forceinline__ int operator()(int n) const { return off + n; } };
struct WinCol {
    __device__ __forceinline__ int operator()(int n) const {
        if (n < 2560) return n; if (n < 4096) return 2584 + (n - 2560); if (n < 4608) return 4124 + (n - 4096); if (n < 10752) return 4636 + (n - 4608);
        if (n < 10776) return 2560 + (n - 10752); if (n < 10780) return 4120 + (n - 10776); return -1; }
};
struct GuRow { int up; __device__ __forceinline__ int operator()(int j) const { return (j >> 7) * 256 + up * 128 + (j & 127); } };
__device__ __forceinline__ void rms_row_bf16(const float* xrow, const float* gain, bf16_t* orow, int lane) {
    f32x4 v[8]; float s = 0.f;
#pragma unroll
    for (int j = 0; j < 8; ++j) { v[j] = *(const f32x4*)(xrow + 4 * lane + 256 * j); s += (v[j].x * v[j].x + v[j].y * v[j].y) + (v[j].z * v[j].z + v[j].w * v[j].w); }
    const float rstd = __builtin_amdgcn_rsqf(wave_sum(s) * (1.f / D) + RMS_EPS);
#pragma unroll
    for (int j = 0; j < 8; ++j) { const f32x4 g = *(const f32x4*)(gain + 4 * lane + 256 * j);
        u32x2 o; o.x = cvtpk(v[j].x * rstd * g.x, v[j].y * rstd * g.y); o.y = cvtpk(v[j].z * rstd * g.z, v[j].w * rstd * g.w);
        *(u32x2*)(orow + 4 * lane + 256 * j) = o; }
}
__device__ __forceinline__ void rms_row_both(const float* xrow, const float* gain, bf16_t* orow, unsigned char* orow8, int lane) {
    f32x4 v[8]; float s = 0.f;
#pragma unroll
    for (int j = 0; j < 8; ++j) { v[j] = *(const f32x4*)(xrow + 4 * lane + 256 * j); s += (v[j].x * v[j].x + v[j].y * v[j].y) + (v[j].z * v[j].z + v[j].w * v[j].w); }
    const float rstd = __builtin_amdgcn_rsqf(wave_sum(s) * (1.f / D) + RMS_EPS);
#pragma unroll
    for (int j = 0; j < 8; ++j) { const f32x4 g = *(const f32x4*)(gain + 4 * lane + 256 * j); const float a = v[j].x * rstd * g.x, b = v[j].y * rstd * g.y, c = v[j].z * rstd * g.z, d = v[j].w * rstd * g.w;
        u32x2 o; o.x = cvtpk(a, b); o.y = cvtpk(c, d); *(u32x2*)(orow + 4 * lane + 256 * j) = o;
        *(unsigned*)(orow8 + 4 * lane + 256 * j) = pk_fp8x4(a, b, c, d); }
}
enum { I_X = 0, I_MEM, I_NORM_ATTN_G, I_W_IN, I_PE_K, I_W_CK, I_PE_V, I_W_CV, I_NSA_Q_G, I_NSA_K_G, I_REL_BIAS, I_FOX_B_F, I_FOX_Q_G, I_FOX_K_G, I_NORM_MEM_G, I_W_MEM_KV,
       I_MEM_Q_G, I_MEM_K_G, I_W_O_NSA, I_W_O_FOX, I_W_O_MEM, I_W_OUT, I_NORM_FFN_G, I_W_ROUTER, I_ROUTER_BIAS, I_WE_GATE, I_WE_UP, I_WE_DOWN, I_WS_GATE, I_WS_UP, I_WS_DOWN, N_IN };

struct TrDesc { const float* src; bf16_t* dst; unsigned ldw, ldt; };
__device__ __forceinline__ TrDesc tr_decode(const Frame& F, int t) {
    unsigned char* ws = F.ws; TrDesc d;
    bf16_t* WinT = (bf16_t*)(ws + WS_WINT); bf16_t* WkvT = WinT + (size_t)NPAD * D; bf16_t* WoT = (bf16_t*)(ws + WS_WOT);
    bf16_t* Wgu = (bf16_t*)(ws + WS_WGU); bf16_t* Wd = (bf16_t*)(ws + WS_WD);
    constexpr int T0 = 16 * 2 * NB16, T1 = T0 + 128, T2 = T1 + 128, T3 = T2 + 64, T4 = T3 + 64, T5 = T4 + 256, T6 = T5 + 32, T7 = T6 + 32, T8 = T7 + 65 * 64, T9 = T8 + 65 * 64;
    if (t < T0) { constexpr int NU = NB16 ? 2 * NB16 : 1; const int kt = t / NU, nt = t - kt * NU, n0 = 256 * nth_set(~FP8M & 0x3ffffu, nt >> 1) + 128 * (nt & 1); const int sc = WinCol{}(n0);
        d.src = F.in(I_W_IN) + (size_t)(128 * kt) * W_IN_COLS + sc; d.ldw = W_IN_COLS; d.dst = WinT + (size_t)n0 * D + 128 * kt; d.ldt = D; }
    else if (t < T1) { const int r = t - T0, kt = r >> 3, nt = r & 7; d.src = F.in(I_W_MEM_KV) + (size_t)(128 * kt) * 1024 + 128 * nt; d.ldw = 1024; d.dst = WkvT + (size_t)(128 * nt) * D + 128 * kt; d.ldt = D; }
    else if (t < T2) { const int r = t - T1, kt = r >> 4, nt = r & 15; d.src = F.in(I_W_O_NSA) + (size_t)(128 * kt) * D + 128 * nt; d.ldw = D; d.dst = WoT + (size_t)(128 * nt) * D + 128 * kt; d.ldt = D; }
    else if (t < T4) { const int mm = t >= T3, r = t - (mm ? T3 : T2), kt = r >> 4, nt = r & 15; d.src = F.in(mm ? I_W_O_MEM : I_W_O_FOX) + (size_t)(128 * kt) * D + 128 * nt; d.ldw = D; d.dst = WoT + (size_t)(128 * nt) * D + (mm ? 1536 : 1024) + 128 * kt; d.ldt = D; }
    else if (t < T5) { const int r = t - T4, kt = r >> 4, nt = r & 15; d.src = F.in(I_W_OUT) + (size_t)(128 * kt) * D + 128 * nt; d.ldw = D; d.dst = (bf16_t*)(ws + WS_WOUTT) + (size_t)(128 * nt) * D + 128 * kt; d.ldt = D; }
    else if (t < T7) { const int v = t >= T6, kt = t - (v ? T6 : T5); d.src = F.in(v ? I_W_CV : I_W_CK) + (size_t)(128 * kt) * 128; d.ldw = 128; d.dst = (bf16_t*)(ws + (v ? WS_WCV : WS_WCK)) + 128 * kt; d.ldt = 4096; }
    else if (t < T8) { const int r = t - T7, e = r >> 6, rr = r & 63, kt = rr >> 2, nt = rr & 3, up = 0;
        const float* W = e < NE ? F.in(I_WE_GATE) + (size_t)e * D * DE : F.in(I_WS_GATE);
        d.src = W + (size_t)(128 * kt) * DE + 128 * nt; d.ldw = DE; d.dst = Wgu + ((size_t)e * 1024 + 256 * nt + 128 * up) * D + 128 * kt; d.ldt = D; }
    else if (t < T9) { const int r = t - T8, e = r >> 6, rr = r & 63, kt = rr >> 2, nt = rr & 3, up = 1;
        const float* W = e < NE ? F.in(I_WE_UP) + (size_t)e * D * DE : F.in(I_WS_UP);
        d.src = W + (size_t)(128 * kt) * DE + 128 * nt; d.ldw = DE; d.dst = Wgu + ((size_t)e * 1024 + 256 * nt + 128 * up) * D + 128 * kt; d.ldt = D; }
    else { const int r = t - T9, e = r >> 6, rr = r & 63, kt = rr >> 4, nt = rr & 15;
        const float* W = e < NE ? F.in(I_WE_DOWN) + (size_t)e * DE * D : F.in(I_WS_DOWN);
        d.src = W + (size_t)(128 * kt) * D + 128 * nt; d.ldw = D; d.dst = Wd + ((size_t)e * D + 128 * nt) * DE + 128 * kt; d.ldt = DE; }
    return d;
}
constexpr int TR_NTILES = 16 * 84 + 128 + 128 + 64 + 64 + 256 + 32 + 32 + 3 * 65 * 64;
__device__ __forceinline__ void tr_load(const TrDesc& d, f32x4 (&v)[8], int wave, int lane) {
#pragma unroll
    for (int i = 0; i < 4; ++i) { const int q = wave + 8 * i, n4 = (q & 3) * 8 + (lane & 7), kp = (q >> 2) * 8 + (lane >> 3);
        const float* p = d.src + (size_t)(2 * kp) * d.ldw + 4 * n4; v[2 * i] = __builtin_nontemporal_load((const f32x4*)p); v[2 * i + 1] = __builtin_nontemporal_load((const f32x4*)(p + d.ldw)); }
}
__device__ __forceinline__ void tr_to_lds(const f32x4 (&v)[8], LAS unsigned* T32, int wave, int lane) {
#pragma unroll
    for (int i = 0; i < 4; ++i) { const int q = wave + 8 * i, n4 = (q & 3) * 8 + (lane & 7), kp = (q >> 2) * 8 + (lane >> 3);
#pragma unroll
        for (int e = 0; e < 4; ++e) T32[(4 * n4 + e) * 65 + kp] = cvtpk(v[2 * i][e], v[2 * i + 1][e]); }
}
__device__ __forceinline__ void tr_from_lds(const TrDesc& d, const LAS unsigned* T32, int wave, int lane) {
    const int c = lane & 15, nn = lane >> 4;
#pragma unroll
    for (int i = 0; i < 4; ++i) { const int n = wave * 16 + 4 * i + nn; const LAS unsigned* r = T32 + n * 65 + 4 * c;
        const u32x4 o = {r[0], r[1], r[2], r[3]};
        __builtin_nontemporal_store(o, (u32x4*)(d.dst + (size_t)n * d.ldt + 8 * c)); }
}
constexpr int TR_FIRST_EXPERT = 16 * 2 * NB16 + 128 + 128 + 64 + 64 + 256 + 32 + 32;
constexpr int TR8W_NTILES = 16 * (48 + 2 * NF8);
struct Tr8Desc { const float* src; unsigned char* dst; unsigned ldw, ldt; float scale; };
__device__ __forceinline__ Tr8Desc tr8_decode(const Frame& F, int t) {
    unsigned char* ws = F.ws; Tr8Desc d; unsigned char* Wgu = ws + WS_WGU; unsigned char* Wd = ws + WS_WD;
    constexpr int TG = 65 * 64;
    if (t < 2 * TG) { const int up = t >= TG, r = t - (up ? TG : 0), e = r >> 6, rr = r & 63, kt = rr >> 2, nt = rr & 3;
        const float* W = e < NE ? F.in(up ? I_WE_UP : I_WE_GATE) + (size_t)e * D * DE : F.in(up ? I_WS_UP : I_WS_GATE);
        d.src = W + (size_t)(128 * kt) * DE + 128 * nt; d.ldw = DE; d.dst = Wgu + ((size_t)e * 1024 + 256 * nt + 128 * up) * D + 128 * kt; d.ldt = D; d.scale = WGU_SCALE; }
    else { const int r = t - 2 * TG, e = r >> 6, rr = r & 63, kt = rr >> 4, nt = rr & 15;
        const float* W = e < NE ? F.in(I_WE_DOWN) + (size_t)e * DE * D : F.in(I_WS_DOWN);
        d.src = W + (size_t)(128 * kt) * D + 128 * nt; d.ldw = D; d.dst = Wd + ((size_t)e * D + 128 * nt) * DE + 128 * kt; d.ldt = DE; d.scale = WD_SCALE; }
    return d;
}
__device__ __forceinline__ Tr8Desc tr8w_decode(const Frame& F, int t) {
    Tr8Desc d; d.scale = WIN_SCALE; d.ldt = D; constexpr int NU = 48 + 2 * NF8; const int kt = t / NU, nt = t - kt * NU, n0 = nt < 48 ? 4608 + 128 * nt : 256 * nth_set(FP8M, (nt - 48) >> 1) + 128 * (nt & 1); const int sc = WinCol{}(n0);
    d.src = F.in(I_W_IN) + (size_t)(128 * kt) * W_IN_COLS + sc; d.ldw = W_IN_COLS; d.dst = F.ws + WS_WIN8 + (size_t)(128 * nt) * D + 128 * kt;
    return d;
}
__device__ __forceinline__ void tr8_load(const Tr8Desc& d, f32x4 (&v)[8], int wave, int lane) {
#pragma unroll
    for (int i = 0; i < 2; ++i) { const int q = wave + 8 * i, n4 = (q & 3) * 8 + (lane & 7), kq = (q >> 2) * 8 + (lane >> 3);
        const float* p = d.src + (size_t)(4 * kq) * d.ldw + 4 * n4;
#pragma unroll
        for (int r = 0; r < 4; ++r) v[4 * i + r] = __builtin_nontemporal_load((const f32x4*)(p + (size_t)r * d.ldw)); }
}
__device__ __forceinline__ void tr8_to_lds(const f32x4 (&v)[8], float sc, LAS unsigned* T32, int wave, int lane) {
#pragma unroll
    for (int i = 0; i < 2; ++i) { const int q = wave + 8 * i, n4 = (q & 3) * 8 + (lane & 7), kq = (q >> 2) * 8 + (lane >> 3);
#pragma unroll
        for (int e = 0; e < 4; ++e) T32[(4 * n4 + e) * 33 + kq] = pk_fp8x4(v[4 * i][e] * sc, v[4 * i + 1][e] * sc, v[4 * i + 2][e] * sc, v[4 * i + 3][e] * sc); }
}
__device__ __forceinline__ void tr8_from_lds(const Tr8Desc& d, const LAS unsigned* T32, int wave, int lane) {
    const int c = lane & 7, nn = lane >> 3;
#pragma unroll
    for (int i = 0; i < 2; ++i) { const int n = wave * 16 + 8 * i + nn; const LAS unsigned* r = T32 + n * 33 + 4 * c;
        const u32x4 o = {r[0], r[1], r[2], r[3]};
        __builtin_nontemporal_store(o, (u32x4*)(d.dst + (size_t)n * d.ldt + 16 * c)); }
}
__device__ __forceinline__ void conv_batch(const Frame& F, int first, int end) {
    constexpr int NT8 = 3 * 65 * 64;
    if (end > NT8) end = NT8;
    if (first >= end) return;
    LAS unsigned* I0 = (LAS unsigned*)F.lds; LAS unsigned* I1 = I0 + 128 * 33; const int lane = F.lane;
    f32x4 r0[8], r1[8], r2[8], r3[8];
    int t = first;
    tr8_load(tr8_decode(F, t), r0, F.wave, lane);
    if (t + 1 < end) tr8_load(tr8_decode(F, t + 1), r1, F.wave, lane);
    if (t + 2 < end) tr8_load(tr8_decode(F, t + 2), r2, F.wave, lane);
    if (t + 3 < end) tr8_load(tr8_decode(F, t + 3), r3, F.wave, lane);
    __syncthreads();
    tr8_to_lds(r0, tr8_decode(F, t).scale, I0, F.wave, lane);
    __syncthreads();
#define CB_STEP(RF, RN, IC, IN) { \
        if (t + 4 < end) tr8_load(tr8_decode(F, t + 4), RF, F.wave, lane); \
        if (t + 1 < end) tr8_to_lds(RN, tr8_decode(F, t + 1).scale, IN, F.wave, lane); \
        tr8_from_lds(tr8_decode(F, t), IC, F.wave, lane); \
        __syncthreads(); \
        if (++t >= end) break; }
    for (;;) {
        CB_STEP(r0, r1, I0, I1)
        CB_STEP(r1, r2, I1, I0)
        CB_STEP(r2, r3, I0, I1)
        CB_STEP(r3, r0, I1, I0)
    }
#undef CB_STEP
}

namespace att {
constexpr int SHM = 16384;
constexpr int L_V = 0, L_K = 3 * SHM;
constexpr int L_WS = 5 * SHM;
constexpr int L_TBL = L_WS + 2048;
constexpr int L_SEL = L_TBL + 8 * 132 * 4;
constexpr int L_NIB = L_SEL + 512;
constexpr int L_CUM = L_SEL + 1024;
constexpr int L_IMP = L_CUM;
constexpr int L_ORD = L_IMP + 32768;
constexpr int L_Q = L_ORD + 2048;
constexpr int L_END = L_Q + 64;
static_assert(L_END <= RING_BYTES, "attention LDS map");
__constant__ unsigned char T5B[128] = {0, 1, 2, 3, 4, 5, 6, 7, 8, 9, 10, 11, 12, 13, 14, 15, 16, 16, 16, 17, 17, 18, 18, 18, 19, 19, 19, 20, 20, 20, 20, 21, 21, 21, 21, 22, 22, 22, 22, 22, 23, 23, 23, 23, 23, 23, 24, 24, 24, 24, 24, 24, 25, 25, 25, 25, 25, 25, 25, 26, 26, 26, 26, 26, 26, 26, 26, 27, 27, 27, 27, 27, 27, 27, 27, 27, 27, 28, 28, 28, 28, 28, 28, 28, 28, 28, 28, 29, 29, 29, 29, 29, 29, 29, 29, 29, 29, 29, 29, 30, 30, 30, 30, 30, 30, 30, 30, 30, 30, 30, 30, 30, 30, 31, 31, 31, 31, 31, 31, 31, 31, 31, 31, 31, 31, 31, 31, 31};

#define KSWZ(row, colB) ((row) * 256 + ((colB) ^ (((row) & 7) << 4)))
#define SBAR() __builtin_amdgcn_sched_barrier(0)
__device__ __forceinline__ int v_st(int k, int c) { const int kk = (k & ~0xC) | ((k & 4) << 1) | ((k & 8) >> 1); return ((kk >> 3) * 4 + (c >> 5)) * 512 + ((kk & 7) * 32 + (c & 31)) * 2; }
__device__ __forceinline__ int v_rd_base(int lane) { return ((lane & 3) << 3) | (((lane >> 2) & 3) << 6) | (((lane >> 4) & 1) << 5) | (((lane >> 5) & 1) << 8); }
__device__ __forceinline__ int crow(int r, int hi) { return (r & 3) + 8 * (r >> 2) + 4 * hi; }
__device__ __forceinline__ float pswap_max(float v) { auto rr = __builtin_amdgcn_permlane32_swap(__float_as_uint(v), __float_as_uint(v), false, false); return fmaxf(__uint_as_float(rr[0]), __uint_as_float(rr[1])); }
__device__ __forceinline__ float pswap_sum(float v) { auto rr = __builtin_amdgcn_permlane32_swap(__float_as_uint(v), __float_as_uint(v), false, false); return __uint_as_float(rr[0]) + __uint_as_float(rr[1]); }

__device__ __forceinline__ void qkt(f32x16& p0, f32x16& p1, const LAS char* Kb, int r32, int hi, const bf16x8 (&qr)[8]) {
    const LAS char* kb[4];
#pragma unroll
    for (int dd = 0; dd < 4; ++dd) kb[dd] = Kb + KSWZ(r32, (dd * 16 + hi * 8) * 2);
#pragma unroll
    for (int d0 = 0; d0 < 8; ++d0) { const LAS char* a = kb[d0 & 3] + (d0 >> 2) * 128;
        const bf16x8 b0 = *(const LAS bf16x8*)a;
        const bf16x8 b1 = *(const LAS bf16x8*)(a + 32 * 256);
        p0 = __builtin_amdgcn_mfma_f32_32x32x16_bf16(b0, qr[d0], p0, 0, 0, 0);
        p1 = __builtin_amdgcn_mfma_f32_32x32x16_bf16(b1, qr[d0], p1, 0, 0, 0);
#ifdef QKT_SPLIT
        if ((d0 & (QKT_SPLIT - 1)) == QKT_SPLIT - 1 && d0 != 7) SBAR();
#endif
    }
}
__device__ __forceinline__ void pv_tile(f32x16 (&o)[4], int vb, bf16x8 pa0, bf16x8 pa1, bf16x8 pa2, bf16x8 pa3) {
#define TRRD(dst, off) asm volatile("ds_read_b64_tr_b16 %0, %1 offset:%2" : "=&v"(dst) : "v"(vb), "i"(off) : "memory")
#define PV_D0(d0) do { s16x4 l0, l1, l2, l3, h0, h1, h2, h3; constexpr int b_ = (d0) * 512; \
        TRRD(l0, b_); TRRD(h0, b_ + 2048); TRRD(l1, b_ + 4096); TRRD(h1, b_ + 6144); TRRD(l2, b_ + 8192); TRRD(h2, b_ + 10240); TRRD(l3, b_ + 12288); TRRD(h3, b_ + 14336); \
        asm volatile("s_waitcnt lgkmcnt(0)" ::: "memory"); SBAR(); \
        o[d0] = __builtin_amdgcn_mfma_f32_32x32x16_bf16(pa0, (bf16x8){l0[0], l0[1], l0[2], l0[3], h0[0], h0[1], h0[2], h0[3]}, o[d0], 0, 0, 0); \
        o[d0] = __builtin_amdgcn_mfma_f32_32x32x16_bf16(pa1, (bf16x8){l1[0], l1[1], l1[2], l1[3], h1[0], h1[1], h1[2], h1[3]}, o[d0], 0, 0, 0); \
        o[d0] = __builtin_amdgcn_mfma_f32_32x32x16_bf16(pa2, (bf16x8){l2[0], l2[1], l2[2], l2[3], h2[0], h2[1], h2[2], h2[3]}, o[d0], 0, 0, 0); \
        o[d0] = __builtin_amdgcn_mfma_f32_32x32x16_bf16(pa3, (bf16x8){l3[0], l3[1], l3[2], l3[3], h3[0], h3[1], h3[2], h3[3]}, o[d0], 0, 0, 0); } while (0)
    PV_D0(0); PV_D0(1); PV_D0(2); PV_D0(3);
#undef PV_D0
#undef TRRD
}
__device__ __forceinline__ void pack_p(const f32x16& p0, const f32x16& p1, bf16x8& pa0, bf16x8& pa1, bf16x8& pa2, bf16x8& pa3) {
#define PK4(P, B_, OUT) do { unsigned a0 = cvtpk(P[B_+0], P[B_+1]), a1 = cvtpk(P[B_+2], P[B_+3]); \
        unsigned b0 = cvtpk(P[B_+4], P[B_+5]), b1 = cvtpk(P[B_+6], P[B_+7]); \
        auto r0 = __builtin_amdgcn_permlane32_swap(a0, b0, false, false); auto r1 = __builtin_amdgcn_permlane32_swap(a1, b1, false, false); \
        u32x4 w = {r0[0], r1[0], r0[1], r1[1]}; OUT = __builtin_bit_cast(bf16x8, w); } while (0)
    PK4(p0, 0, pa0); PK4(p0, 8, pa1); PK4(p1, 0, pa2); PK4(p1, 8, pa3);
#undef PK4
}
__device__ __forceinline__ void bcast_rows(float (&f)[16], float v, LAS float* ws, int r32, int hi) {
    if (hi == 0) ws[r32] = v;
    asm volatile("s_waitcnt lgkmcnt(0)" ::: "memory");
#pragma unroll
    for (int q = 0; q < 4; ++q) { const f32x4 t = *(const LAS f32x4*)(ws + 8 * q + 4 * hi); f[4 * q] = t[0]; f[4 * q + 1] = t[1]; f[4 * q + 2] = t[2]; f[4 * q + 3] = t[3]; }
    asm volatile("s_waitcnt lgkmcnt(0)" ::: "memory");
}
struct Ctx {
    LAS char* lds; int tid, wid, lane, r32, hi;
    int trow;
    int qlo;
};
struct DmaOff { unsigned k, v0, v1; };
__device__ __forceinline__ DmaOff dma_off(int wid, int lane, size_t ld) {
    DmaOff d; const int kr = 4 * wid + (lane >> 4), kc = (lane & 15) ^ (kr & 7);
    d.k = (unsigned)(kr * ld + kc * 8) * 2u;
#pragma unroll
    for (int t = 0; t < 2; ++t) { const int sub = 2 * (wid + 8 * t) + (lane >> 5), kk = (sub >> 2) * 8 + ((lane & 31) >> 2), k = (kk & ~0xC) | ((kk & 4) << 1) | ((kk & 8) >> 1), c0 = (sub & 3) * 32 + (lane & 3) * 8;
        const unsigned o = (unsigned)(k * ld + c0) * 2u; if (t == 0) d.v0 = o; else d.v1 = o; }
    return d;
}
__device__ __forceinline__ void dma_tile(const DmaOff& d, const bf16_t* Kg, const bf16_t* Vg, size_t ld, LAS char* lds, int buf, int vbuf, int wid) {
    const char* kp = (const char*)Kg; const char* vp = (const char*)Vg;
    __builtin_amdgcn_global_load_lds((const unsigned*)(kp + d.k), (LAS unsigned*)(lds + L_K + buf * SHM + wid * 1024), 16, 0, 0);
    __builtin_amdgcn_global_load_lds((const unsigned*)(kp + d.k + 32 * ld * 2), (LAS unsigned*)(lds + L_K + buf * SHM + (wid + 8) * 1024), 16, 0, 0);
    __builtin_amdgcn_global_load_lds((const unsigned*)(vp + d.v0), (LAS unsigned*)(lds + L_V + vbuf * SHM + wid * 1024), 16, 0, 0);
    __builtin_amdgcn_global_load_lds((const unsigned*)(vp + d.v1), (LAS unsigned*)(lds + L_V + vbuf * SHM + (wid + 8) * 1024), 16, 0, 0);
}
__device__ __forceinline__ void dma_tile_v(const DmaOff& d, const bf16_t* Kg, const bf16_t* Vg, size_t ld, LAS char* lds, int kbuf, int voff, int wid) {
    const char* kp = (const char*)Kg; const char* vp = (const char*)Vg;
    __builtin_amdgcn_global_load_lds((const unsigned*)(kp + d.k), (LAS unsigned*)(lds + L_K + kbuf * SHM + wid * 1024), 16, 0, 0);
    __builtin_amdgcn_global_load_lds((const unsigned*)(kp + d.k + 32 * ld * 2), (LAS unsigned*)(lds + L_K + kbuf * SHM + (wid + 8) * 1024), 16, 0, 0);
    __builtin_amdgcn_global_load_lds((const unsigned*)(vp + d.v0), (LAS unsigned*)(lds + L_V + voff + wid * 1024), 16, 0, 0);
    __builtin_amdgcn_global_load_lds((const unsigned*)(vp + d.v1), (LAS unsigned*)(lds + L_V + voff + (wid + 8) * 1024), 16, 0, 0);
}
#define DMA_WAIT() asm volatile("s_waitcnt vmcnt(0)" ::: "memory")
constexpr float DEFER_THR = 8.f;
__device__ __forceinline__ void qkt_half(f32x16& p, const LAS char* Kb, int r32, int hi, const bf16x8 (&qr)[8], bool zero) {
    const LAS char* kb[4];
#pragma unroll
    for (int dd = 0; dd < 4; ++dd) kb[dd] = Kb + KSWZ(r32, (dd * 16 + hi * 8) * 2);
    { const bf16x8 b = *(const LAS bf16x8*)(kb[0]);
      if (zero) p = __builtin_amdgcn_mfma_f32_32x32x16_bf16(b, qr[0], (f32x16){0.f, 0.f, 0.f, 0.f, 0.f, 0.f, 0.f, 0.f, 0.f, 0.f, 0.f, 0.f, 0.f, 0.f, 0.f, 0.f}, 0, 0, 0);
      else p = __builtin_amdgcn_mfma_f32_32x32x16_bf16(b, qr[0], p, 0, 0, 0); }
#pragma unroll
    for (int d0 = 1; d0 < 8; ++d0) { const bf16x8 b = *(const LAS bf16x8*)(kb[d0 & 3] + (d0 >> 2) * 128);
        p = __builtin_amdgcn_mfma_f32_32x32x16_bf16(b, qr[d0], p, 0, 0, 0); }
}
__device__ __forceinline__ float max3f(float a, float b, float c) { float r; asm("v_max3_f32 %0, %1, %2, %3" : "=v"(r) : "v"(a), "v"(b), "v"(c)); return r; }
__device__ __forceinline__ bool sm_half(f32x16& p, float& m_reg, float& l_reg, float& alpha, bf16x8& pa0, bf16x8& pa1, float brow) {
    float pmax = max3f(p[0], p[1], p[2]);
#pragma unroll
    for (int r = 3; r < 15; r += 2) pmax = max3f(pmax, p[r], p[r + 1]);
    pmax = max3f(pmax, p[15], p[15]);
    { const auto rr = __builtin_amdgcn_permlane32_swap(__float_as_uint(pmax), __float_as_uint(pmax), false, false); pmax = max3f(__uint_as_float(rr[0]), __uint_as_float(rr[1]), __uint_as_float(rr[1])) + brow; }
    const bool upd = !__all(pmax - m_reg <= DEFER_THR);
    const float mx_ = max3f(m_reg, pmax, pmax);
    const float mn = upd ? mx_ : m_reg;
    alpha = __builtin_amdgcn_exp2f(m_reg - mn); m_reg = mn;
    f32x2 mn2 = {brow - mn, brow - mn}; asm("" : "+v"(mn2)); f32x2 ps2 = {0.f, 0.f};
#pragma unroll
    for (int r = 0; r < 16; r += 2) { f32x2 t = {p[r], p[r + 1]}; t += mn2; t.x = __builtin_amdgcn_exp2f(t.x); t.y = __builtin_amdgcn_exp2f(t.y); p[r] = t.x; p[r + 1] = t.y; ps2 += t; }
    float ps = pswap_sum(ps2.x + ps2.y);
    l_reg = l_reg * alpha + ps;
#define PK4(P, B_, OUT) do { unsigned a0 = cvtpk(P[B_+0], P[B_+1]), a1 = cvtpk(P[B_+2], P[B_+3]); \
        unsigned b0 = cvtpk(P[B_+4], P[B_+5]), b1 = cvtpk(P[B_+6], P[B_+7]); \
        auto r0 = __builtin_amdgcn_permlane32_swap(a0, b0, false, false); auto r1 = __builtin_amdgcn_permlane32_swap(a1, b1, false, false); \
        u32x4 w = {r0[0], r1[0], r0[1], r1[1]}; OUT = __builtin_bit_cast(bf16x8, w); } while (0)
    PK4(p, 0, pa0); PK4(p, 8, pa1);
#undef PK4
    return upd;
}
__device__ __forceinline__ void pv_half(f32x16 (&o)[4], int vb, bf16x8 pa0, bf16x8 pa1) {
#define TRRD(dst, off) asm volatile("ds_read_b64_tr_b16 %0, %1 offset:%2" : "=&v"(dst) : "v"(vb), "i"(off) : "memory")
#define PVH(dA, dB) do { s16x4 l0, h0, l1, h1, m0, n0, m1, n1; \
        TRRD(l0, (dA) * 512); TRRD(h0, (dA) * 512 + 2048); TRRD(m0, (dB) * 512); TRRD(n0, (dB) * 512 + 2048); \
        TRRD(l1, (dA) * 512 + 4096); TRRD(h1, (dA) * 512 + 6144); TRRD(m1, (dB) * 512 + 4096); TRRD(n1, (dB) * 512 + 6144); \
        asm volatile("s_waitcnt lgkmcnt(0)" ::: "memory"); SBAR(); \
        o[dA] = __builtin_amdgcn_mfma_f32_32x32x16_bf16(pa0, (bf16x8){l0[0], l0[1], l0[2], l0[3], h0[0], h0[1], h0[2], h0[3]}, o[dA], 0, 0, 0); \
        o[dB] = __builtin_amdgcn_mfma_f32_32x32x16_bf16(pa0, (bf16x8){m0[0], m0[1], m0[2], m0[3], n0[0], n0[1], n0[2], n0[3]}, o[dB], 0, 0, 0); \
        o[dA] = __builtin_amdgcn_mfma_f32_32x32x16_bf16(pa1, (bf16x8){l1[0], l1[1], l1[2], l1[3], h1[0], h1[1], h1[2], h1[3]}, o[dA], 0, 0, 0); \
        o[dB] = __builtin_amdgcn_mfma_f32_32x32x16_bf16(pa1, (bf16x8){m1[0], m1[1], m1[2], m1[3], n1[0], n1[1], n1[2], n1[3]}, o[dB], 0, 0, 0); } while (0)
    PVH(0, 1); PVH(2, 3);
#undef PVH
#undef TRRD
}
__device__ __forceinline__ bool sm_cheap(f32x16& p, float& l_reg, float& alpha, bf16x8& pa0, bf16x8& pa1) {
    alpha = 1.f; l_reg += p[0] + p[15];
    u32x4 w0 = {__builtin_bit_cast(unsigned, p[0]), __builtin_bit_cast(unsigned, p[1]), __builtin_bit_cast(unsigned, p[2]), __builtin_bit_cast(unsigned, p[3])};
    u32x4 w1 = {__builtin_bit_cast(unsigned, p[8]), __builtin_bit_cast(unsigned, p[9]), __builtin_bit_cast(unsigned, p[10]), __builtin_bit_cast(unsigned, p[11])};
    pa0 = __builtin_bit_cast(bf16x8, w0); pa1 = __builtin_bit_cast(bf16x8, w1); return false;
}
template <int VAR = 0, class F>
__device__ __forceinline__ void stream(const Ctx& C0, const bf16x8 (&qr)[8], const bf16_t* Kg, const bf16_t* Vg, size_t ld, unsigned mask, float& m_reg, float& l_reg, f32x16 (&o)[4], const F& f) {
    Ctx C = C0; { int tz = C0.tid; asm volatile("" : "+v"(tz)); C.tid = tz; C.lane = tz & 63; C.r32 = tz & 31; C.hi = (tz >> 5) & 1; }
    const int vb0 = (int)(uintptr_t)(C.lds + L_V) + v_rd_base(C.lane);
    LAS float* ws = (LAS float*)(C.lds + L_WS) + C.wid * 64;
    const DmaOff dof = dma_off(C.wid, C.lane, ld);
    unsigned rem = mask; int j = __builtin_ctz(rem); rem &= rem - 1;
    __syncthreads();
    dma_tile_v(dof, Kg + (size_t)j * 64 * ld, Vg + (size_t)j * 64 * ld, ld, C.lds, 0, 0, C.wid);
    DMA_WAIT();
    __syncthreads();
    int kb = 0, vprev = 2 * SHM, vcur = 0, vnext = SHM;
    bool more = rem != 0u; int jn = j;
    if (more) { jn = __builtin_ctz(rem); rem &= rem - 1; if (!(VAR & 1)) dma_tile_v(dof, Kg + (size_t)jn * 64 * ld, Vg + (size_t)jn * 64 * ld, ld, C.lds, 1, vnext, C.wid); }
#define ST_RESC(a) do { if (C.hi == 0) ws[C.r32] = (a); asm volatile("s_waitcnt lgkmcnt(0)" ::: "memory"); \
        _Pragma("unroll") for (int q = 0; q < 4; ++q) { const f32x4 t = *(const LAS f32x4*)(ws + 8 * q + 4 * C.hi); \
            _Pragma("unroll") for (int d = 0; d < 4; ++d) { o[d][4 * q] *= t[0]; o[d][4 * q + 1] *= t[1]; o[d][4 * q + 2] *= t[2]; o[d][4 * q + 3] *= t[3]; } } } while (0)
    f32x16 pA, pB; float alpha, browA, browB; bf16x8 pa0, pa1;
    bool zA = f.pre(pA, j, 0, browA);
    qkt_half(pA, C.lds + L_K, C.r32, C.hi, qr, zA);
    bool zB = f.pre(pB, j, 1, browB);
    bool first = true;
    for (;;) {
        if (!(VAR & 16)) qkt_half(pB, C.lds + L_K + kb * SHM + 32 * 256, C.r32, C.hi, qr, zB);
        const bool u0 = (VAR & 4) ? sm_cheap(pA, l_reg, alpha, pa0, pa1) : sm_half(pA, m_reg, l_reg, alpha, pa0, pa1, browA);
        if (u0 && !first) ST_RESC(alpha);
        first = false;
        if (!(VAR & 8)) pv_half(o, vb0 + vcur, pa0, pa1); else { o[0][0] += __builtin_bit_cast(float, (int)pa0[0] + (int)pa1[1]); }
        if (!(VAR & 32)) zA = f.pre(pA, jn, 0, browA);
        DMA_WAIT(); if (!(VAR & 2)) __syncthreads();
        if (!more) break;
        j = jn; kb ^= 1; { const int t_ = vprev; vprev = vcur; vcur = vnext; vnext = t_; }
        more = rem != 0u;
        if (more) { jn = __builtin_ctz(rem); rem &= rem - 1; if (!(VAR & 1)) dma_tile_v(dof, Kg + (size_t)jn * 64 * ld, Vg + (size_t)jn * 64 * ld, ld, C.lds, kb ^ 1, vnext, C.wid); }
        if (!(VAR & 16)) qkt_half(pA, C.lds + L_K + kb * SHM, C.r32, C.hi, qr, zA);
        const bool u1 = (VAR & 4) ? sm_cheap(pB, l_reg, alpha, pa0, pa1) : sm_half(pB, m_reg, l_reg, alpha, pa0, pa1, browB);
        if (u1) ST_RESC(alpha);
        if (!(VAR & 8)) pv_half(o, vb0 + vprev + 8192, pa0, pa1); else { o[1][0] += __builtin_bit_cast(float, (int)pa0[2] + (int)pa1[3]); }
        if (!(VAR & 32)) zB = f.pre(pB, j, 1, browB);
    }
    { const bool u1 = sm_half(pB, m_reg, l_reg, alpha, pa0, pa1, browB);
      if (u1) ST_RESC(alpha);
      pv_half(o, vb0 + vcur + 8192, pa0, pa1); }
    __syncthreads();
#undef ST_RESC
}
__device__ __forceinline__ void load_q(bf16x8 (&qr)[8], const bf16_t* qrow, const float* gain, int hi) {
    u32x4 raw[8]; float ss = 0.f;
#pragma unroll
    for (int d0 = 0; d0 < 8; ++d0) { raw[d0] = *(const u32x4*)(qrow + d0 * 16 + hi * 8);
#pragma unroll
        for (int e = 0; e < 4; ++e) { const float a = bf_lo(raw[d0][e]), b = bf_hi(raw[d0][e]); ss += a * a + b * b; } }
    ss = pswap_sum(ss);
    const float f = __builtin_amdgcn_rsqf(ss * (1.f / HD) + RMS_EPS) * (ATTN_SCALE * LOG2E);
#pragma unroll
    for (int d0 = 0; d0 < 8; ++d0) { const f32x4 g0 = *(const f32x4*)(gain + d0 * 16 + hi * 8), g1 = *(const f32x4*)(gain + d0 * 16 + hi * 8 + 4);
        u32x4 w; w.x = cvtpk(bf_lo(raw[d0].x) * f * g0[0], bf_hi(raw[d0].x) * f * g0[1]); w.y = cvtpk(bf_lo(raw[d0].y) * f * g0[2], bf_hi(raw[d0].y) * f * g0[3]);
        w.z = cvtpk(bf_lo(raw[d0].z) * f * g1[0], bf_hi(raw[d0].z) * f * g1[1]); w.w = cvtpk(bf_lo(raw[d0].w) * f * g1[2], bf_hi(raw[d0].w) * f * g1[3]);
        qr[d0] = __builtin_bit_cast(bf16x8, w); }
}
__device__ __forceinline__ void store_o(const f32x16 (&v)[4], const float (&w)[16], bf16_t* orow0, size_t ld, LAS char* lds, int wid, int lane_, bool accum) {
    int lane = lane_; asm volatile("" : "+v"(lane));
    const int r32 = lane & 31, hi = lane >> 5;
    LAS char* st = lds + wid * 8192;
    const bool odd = (r32 & 1) != 0;
#pragma unroll
    for (int r = 0; r < 16; r += 2) { LAS char* rowp = st + (crow(r, hi) + (odd ? 1 : 0)) * 256 + (r32 & ~1) * 2;
#pragma unroll
        for (int d = 0; d < 4; ++d) { const float a = v[d][r] * w[r], b = v[d][r + 1] * w[r + 1];
            const float recv = __builtin_bit_cast(float, __builtin_amdgcn_mov_dpp(__builtin_bit_cast(int, odd ? a : b), 0xB1, 0xF, 0xF, true));
            *(LAS unsigned*)(rowp + d * 64) = cvtpk(odd ? recv : a, odd ? b : recv); } }
    asm volatile("s_waitcnt lgkmcnt(0)" ::: "memory");
    u32x4 ov[8];
    if (accum) {
#pragma unroll
        for (int it = 0; it < 8; ++it) { const int id = it * 64 + lane, row = id >> 4, c16 = id & 15; ov[it] = *(const u32x4*)(orow0 + (size_t)row * ld + c16 * 8); } }
#pragma unroll
    for (int it = 0; it < 8; ++it) { const int id = it * 64 + lane, row = id >> 4, c16 = id & 15;
        u32x4 nv = *(const LAS u32x4*)(st + row * 256 + c16 * 16);
        if (accum) {
#pragma unroll
            for (int e = 0; e < 4; ++e) nv[e] = cvtpk(bf_lo(nv[e]) + bf_lo(ov[it][e]), bf_hi(nv[e]) + bf_hi(ov[it][e])); }
        *(u32x4*)(orow0 + (size_t)row * ld + c16 * 8) = nv; }
    asm volatile("s_waitcnt lgkmcnt(0)" ::: "memory");
}

struct Tensors {
    const bf16_t* PA; const float* GL; const bf16_t* KVM; const bf16_t* KC; const bf16_t* VC; const float* CUM; bf16_t* OC;
    const float* nsa_q_g; const float* fox_q_g; const float* mem_q_g; const float* rel_bias;
};

template <int TY> struct BiasUni {
    const Ctx* C; const LAS float* tb; int u; unsigned sel; int mode;
    __device__ __forceinline__ bool pre(f32x16& bv, int j, int half, float& brow) const {
        const float NEG = -__builtin_inff();
        const int dq = C->trow - 64 * j - 4 * C->hi - 32 * half;
        brow = 0.f;
        if constexpr (TY == 0) {
            const bool win = mode == 1; const bool on = win || ((sel >> j) & 1u);
            if (j + 3 <= u && !(win && j + 8 <= u)) {
                brow = on ? tb[128] : NEG; return true;
            } else {
#pragma unroll
                for (int q = 0; q < 4; ++q) {
#pragma unroll
                    for (int e = 0; e < 4; ++e) { const int r = 4 * q + e, c = e + 8 * q, rel = dq - c;
                        const bool ok = on && (unsigned)rel < 512u; const float b = tb[min(max(rel, 0), 128)];
                        bv[r] = ok ? b : NEG; }
                    SBAR(); }
            }
        } else if constexpr (TY == 1) {
            const LAS float* cb = (const LAS float*)(C->lds + L_CUM) + 64 * j + 4 * C->hi + 32 * half;
            const bool msk = 64 * j + 63 > C->qlo;
#pragma unroll
            for (int q = 0; q < 4; ++q) { const f32x4 a = *(const LAS f32x4*)(cb + 8 * q);
#pragma unroll
                for (int e = 0; e < 4; ++e) { const int r = 4 * q + e, c = e + 8 * q; bv[r] = (msk && dq - c < 0) ? NEG : a[e]; } }
        } else {
            return true;
        }
        return false;
    }
};

__device__ __forceinline__ void nsa_pre(Ctx& C, const Tensors& Tn, const bf16x8 (&qr)[8], int b, int g, int u, float g_c, bf16_t* orow0, unsigned& sel_out, unsigned& U_out) {
    { int tz = C.tid; asm volatile("" : "+v"(tz)); C.tid = tz; C.lane = tz & 63; C.r32 = tz & 31; C.hi = (tz >> 5) & 1; }
    const int hh = C.wid >> 1, pos = (C.wid & 1) * 32 + C.r32, head = g * 4 + hh;
    const LAS float* tb = (const LAS float*)(C.lds + L_TBL) + head * 132;
    LAS float* ws = (LAS float*)(C.lds + L_WS) + C.wid * 64;
    LAS unsigned* SEL = (LAS unsigned*)(C.lds + L_SEL);
    const float NEG = -__builtin_inff();
    const int vb0 = (int)(uintptr_t)(C.lds + L_V) + v_rd_base(C.lane);
    {
        const bf16_t* KCb = Tn.KC + (size_t)(b * 2 + g) * 128 * HD; const bf16_t* VCb = Tn.VC + (size_t)(b * 2 + g) * 128 * HD;
        const DmaOff dof = dma_off(C.wid, C.lane, HD);
        __syncthreads();
        if (C.tid < 65) SEL[C.tid] = 0u;
        dma_tile(dof, KCb, VCb, HD, C.lds, 0, 0, C.wid); dma_tile(dof, KCb + 64 * HD, VCb + 64 * HD, HD, C.lds, 1, 1, C.wid);
        DMA_WAIT();
        __syncthreads();
        f32x16 P[4];
        const int dq = C.trow - 31 - 64 * C.hi;
#pragma unroll
        for (int X = 0; X < 4; ++X)
#pragma unroll
            for (int r = 0; r < 16; ++r) { const int c = (r & 3) + 8 * (r >> 2), rel = dq - 16 * (32 * X + c);
                const float bb = tb[min(max(rel, 0), 128)]; P[X][r] = rel >= 0 ? bb : NEG; }
        qkt(P[0], P[1], C.lds + L_K, C.r32, C.hi, qr); qkt(P[2], P[3], C.lds + L_K + SHM, C.r32, C.hi, qr);
        float pmax = NEG;
#pragma unroll
        for (int X = 0; X < 4; ++X)
#pragma unroll
            for (int r = 0; r < 16; ++r) pmax = fmaxf(pmax, P[X][r]);
        pmax = pswap_max(pmax);
        const float mm = pmax == NEG ? 0.f : pmax;
        float ps = 0.f;
#pragma unroll
        for (int X = 0; X < 4; ++X)
#pragma unroll
            for (int r = 0; r < 16; ++r) { P[X][r] = __builtin_amdgcn_exp2f(P[X][r] - mm); ps += P[X][r]; }
        ps = pswap_sum(ps);
        const float inv = ps > 0.f ? 1.f / ps : 0.f;
        if (u >= 16) {
            LAS float* imp = (LAS float*)(C.lds + L_IMP) + (hh * 64 + pos) * 32;
            float bprev = 0.f;
#pragma unroll
            for (int X = 0; X < 4; ++X)
#pragma unroll
                for (int q = 0; q < 4; ++q) { const float b3 = 0.5f * P[X][4 * q + 3];
                    const float aG = P[X][4 * q] + P[X][4 * q + 1] + P[X][4 * q + 2] + b3;
                    const auto sw_ = __builtin_amdgcn_permlane32_swap(__float_as_uint(b3), __float_as_uint(b3), false, false);
                    const float bp = __uint_as_float(C.hi ? sw_[0] : sw_[1]);
                    const float val = aG + (C.hi ? bp : bprev);
                    imp[2 * (4 * X + q) + C.hi] = val * inv;
                    bprev = bp; }
        }
        f32x16 o[4] = {};
        bf16x8 pa0, pa1, pa2, pa3;
        pack_p(P[0], P[1], pa0, pa1, pa2, pa3); pv_tile(o, vb0, pa0, pa1, pa2, pa3);
        pack_p(P[2], P[3], pa0, pa1, pa2, pa3); pv_tile(o, vb0 + SHM, pa0, pa1, pa2, pa3);
        float w[16]; bcast_rows(w, g_c * inv, ws, C.r32, C.hi);
        __syncthreads();
        store_o(o, w, orow0, D, C.lds, C.wid, C.lane, false);
    }
    if (u >= 16) {
        const int p = C.tid & 63, jg = C.tid >> 6;
        const LAS float* i0 = (const LAS float*)(C.lds + L_IMP) + p * 32;
        float sc[32];
#pragma unroll
        for (int j4 = 0; j4 < 8; ++j4) { const f32x4 a = *(const LAS f32x4*)(i0 + 4 * j4), b2 = *(const LAS f32x4*)(i0 + 2048 + 4 * j4), c2 = *(const LAS f32x4*)(i0 + 4096 + 4 * j4), d2 = *(const LAS f32x4*)(i0 + 6144 + 4 * j4);
#pragma unroll
            for (int e = 0; e < 4; ++e) { const int j = 4 * j4 + e; const float s = ((a[e] + b2[e]) + c2[e]) + d2[e];
                const bool valid = j <= u, forced = j == 0 || j == u || j == u - 1;
                sc[j] = valid ? (forced ? 1e4f : s) : -1.f; } }
        unsigned bits = 0u;
#pragma unroll
        for (int e = 0; e < 4; ++e) { const int j = 4 * jg + e; float sj = 0.f;
#pragma unroll
            for (int k = 0; k < 32; ++k) sj = (k == j) ? sc[k] : sj;
            int rank = 0;
#pragma unroll
            for (int k = 0; k < 32; ++k) rank += (sc[k] > sj || (sc[k] == sj && k < j)) ? 1 : 0;
            if (j <= u && rank < 16) bits |= 1u << j; }
        ((LAS unsigned char*)(C.lds + L_NIB))[p * 8 + jg] = (unsigned char)(bits >> (4 * jg));
        __syncthreads();
        if (C.tid < 64) { const u32x2 nb = *(const LAS u32x2*)(C.lds + L_NIB + C.tid * 8); unsigned full = 0u;
#pragma unroll
            for (int k = 0; k < 4; ++k) { full |= ((nb.x >> (8 * k)) & 0xfu) << (4 * k); full |= ((nb.y >> (8 * k)) & 0xfu) << (16 + 4 * k); }
            SEL[C.tid] = full; unsigned un = full;
#pragma unroll
            for (int o = 1; o < 64; o <<= 1) un |= __shfl_xor(un, o);
            if (C.tid == 0) SEL[64] = un; }
    } else { if (C.tid < 65) SEL[C.tid] = (2u << u) - 1u; }
    __syncthreads();
    sel_out = SEL[pos]; U_out = SEL[64];
}
__device__ __forceinline__ int dequeue(LAS char* lds, unsigned* head, int tid) {
    if (tid == 0) *(LAS int*)(lds + L_Q) = (int)__hip_atomic_fetch_add(head, 1u, RLX_AGENT);
    __syncthreads();
    const int q = *(const LAS int*)(lds + L_Q);
    __syncthreads();
    return q;
}
#ifndef DBL_VAR
#define DBL_VAR 0
#endif
#ifndef DBL_STREAM
#define DBL_STREAM 0
#endif
#ifndef CONV_IN_P0
#define CONV_IN_P0 0
#endif
__device__ __forceinline__ void conv_some(const Frame& F, LAS char* lds, unsigned* chead, int n) {
    if (CONV_IN_P0) return;
    if (F.tid == 0) *(LAS int*)(lds + L_Q) = (int)__hip_atomic_fetch_add(chead, (unsigned)n, RLX_AGENT);
    __syncthreads();
    const int base = *(const LAS int*)(lds + L_Q);
    __syncthreads();
    conv_batch(F, base, base + n);
}
__device__ __forceinline__ void attn_phase(const Frame& F, LAS char* lds, const Tensors& Tn, unsigned* qhead) {
    Ctx C; C.lds = lds; C.tid = threadIdx.x; C.wid = __builtin_amdgcn_readfirstlane(C.tid >> 6); C.lane = C.tid & 63; C.r32 = C.lane & 31; C.hi = C.lane >> 5; C.trow = 0; C.qlo = 0;
    for (int i = C.tid; i < 8 * 129; i += 512) { const int head = i / 129, rel = i - head * 129; const int bk = rel < 128 ? T5B[rel] : 31;
        ((LAS float*)(lds + L_TBL))[head * 132 + rel] = Tn.rel_bias[bk * 8 + head] * LOG2E; }
    __syncthreads();
    LAS float* ws = (LAS float*)(lds + L_WS) + C.wid * 64;
#ifndef PASS_MASK
#define PASS_MASK 7
#endif
    int nconv = (int)((blockIdx.x >> 3) & 7) * 7;
    if (PASS_MASK & 1) for (;;) {
        conv_some(F, lds, qhead + 192, nconv); nconv = 9;
        const int q = dequeue(lds, qhead, C.tid); if (q >= 512) break;
        const int u = 31 - (q >> 4), b = (q >> 1) & 7, g = q & 1, head = g * 4 + (C.wid >> 1);
        C.qlo = 64 * u + (C.wid & 1) * 32; C.trow = C.qlo + C.r32;
        const size_t tok = (size_t)b * T + C.trow;
        bf16x8 qr[8]; load_q(qr, Tn.PA + tok * NPA + CQ_NSA + head * HD, Tn.nsa_q_g, C.hi);
        bf16_t* orow0 = Tn.OC + ((size_t)b * T + C.qlo) * D + head * HD;
        const LAS float* tb = (const LAS float*)(lds + L_TBL) + head * 132;
        const float* gl = Tn.GL + tok * LDG; const float g_c = fast_sigmoid(gl[head]), g_s = fast_sigmoid(gl[8 + head]), g_w = fast_sigmoid(gl[16 + head]);
        unsigned sel, U; nsa_pre(C, Tn, qr, b, g, u, g_c, orow0, sel, U);
        const bf16_t* PAb = Tn.PA + (size_t)b * T * NPA + g * HD;
        int br = 0;
        do {
            const unsigned mask = br ? (((2u << u) - 1u) & ~(u >= 9 ? ((1u << (u - 8)) - 1u) : 0u)) : U;
            f32x16 o[4] = {}; float m_reg = -1e30f, l_reg = 0.f;
            stream(C, qr, PAb + (br ? CK_WIN : CK_SLC), PAb + (br ? CV_WIN : CV_SLC), NPA, mask, m_reg, l_reg, o, BiasUni<0>{&C, tb, u, sel, br});
            float w[16]; bcast_rows(w, l_reg > 0.f ? (br ? g_w : g_s) / l_reg : 0.f, ws, C.r32, C.hi);
            store_o(o, w, orow0, D, lds, C.wid, C.lane, true);
#if DBL_STREAM
            { f32x16 o2[4] = {}; float m2 = -1e30f, l2 = 0.f; stream<DBL_VAR>(C, qr, PAb + (br ? CK_WIN : CK_SLC), PAb + (br ? CV_WIN : CV_SLC), NPA, mask, m2, l2, o2, BiasUni<0>{&C, tb, u, sel, br}); float sk = ((o2[0][0] + o2[1][0]) + (o2[2][0] + o2[3][0])) + l2 + m2; asm volatile("" :: "v"(sk)); }
#endif
            ++br; asm volatile("" : "+s"(br));
        } while (br < 2);
    }
    if (PASS_MASK & 2) for (;;) {
        const int q = dequeue(lds, qhead + 64, C.tid); if (q >= 256) break;
        const int qb = 7 - (q >> 5), b = (q >> 2) & 7, h = q & 3;
        C.qlo = 256 * qb + 32 * C.wid; C.trow = C.qlo + C.r32;
        const size_t tok = (size_t)b * T + C.trow;
        bf16x8 qr[8]; load_q(qr, Tn.PA + tok * NPA + CQ_FOX + h * HD, Tn.fox_q_g, C.hi);
        { LAS float* cl = (LAS float*)(lds + L_CUM); const float* cg = Tn.CUM + (size_t)(b * 4 + h) * T;
          for (int i = C.tid; i < 256 * (qb + 1); i += 512) cl[i] = -cg[i] * LOG2E; }
        const bf16_t* PAb = Tn.PA + (size_t)b * T * NPA + h * HD;
        const unsigned mask = qb == 7 ? 0xffffffffu : ((1u << (4 * qb + 4)) - 1u);
        f32x16 o[4] = {}; float m_reg = -1e30f, l_reg = 0.f;
        stream(C, qr, PAb + CK_FOX, PAb + CV_FOX, NPA, mask, m_reg, l_reg, o, BiasUni<1>{&C, nullptr, 0, 0u, 2});
        float w[16]; bcast_rows(w, l_reg > 0.f ? 1.f / l_reg : 0.f, ws, C.r32, C.hi);
        store_o(o, w, Tn.OC + ((size_t)b * T + C.qlo) * D + 1024 + h * HD, D, lds, C.wid, C.lane, false);
#if DBL_STREAM
        { f32x16 o2[4] = {}; float m2 = -1e30f, l2 = 0.f; stream<DBL_VAR>(C, qr, PAb + CK_FOX, PAb + CV_FOX, NPA, mask, m2, l2, o2, BiasUni<1>{&C, nullptr, 0, 0u, 2}); float sk = ((o2[0][0] + o2[1][0]) + (o2[2][0] + o2[3][0])) + l2 + m2; asm volatile("" :: "v"(sk)); }
#endif
        conv_some(F, lds, qhead + 192, 6);
    }
    if (PASS_MASK & 4) for (;;) {
        const int q = dequeue(lds, qhead + 128, C.tid); if (q >= 256) break;
        const int qb = q & 7, h = (q >> 3) & 3, b = q >> 5;
        C.qlo = 256 * qb + 32 * C.wid; C.trow = C.qlo + C.r32;
        const size_t tok = (size_t)b * T + C.trow;
        bf16x8 qr[8]; load_q(qr, Tn.PA + tok * NPA + CQ_MEM + h * HD, Tn.mem_q_g, C.hi);
        const bf16_t* Kb = Tn.KVM + (size_t)b * MEMT * 1024 + h * HD;
        f32x16 o[4] = {}; float m_reg = -1e30f, l_reg = 0.f;
        stream(C, qr, Kb, Kb + 512, 1024, 0xfu, m_reg, l_reg, o, BiasUni<2>{&C, nullptr, 0, 0u, 3});
        float w[16]; bcast_rows(w, l_reg > 0.f ? 1.f / l_reg : 0.f, ws, C.r32, C.hi);
        store_o(o, w, Tn.OC + ((size_t)b * T + C.qlo) * D + 1536 + h * HD, D, lds, C.wid, C.lane, false);
#if DBL_STREAM
        { f32x16 o2[4] = {}; float m2 = -1e30f, l2 = 0.f; stream<DBL_VAR>(C, qr, Kb, Kb + 512, 1024, 0xfu, m2, l2, o2, BiasUni<2>{&C, nullptr, 0, 0u, 3}); float sk = ((o2[0][0] + o2[1][0]) + (o2[2][0] + o2[3][0])) + l2 + m2; asm volatile("" :: "v"(sk)); }
#endif
        conv_some(F, lds, qhead + 192, 2);
    }
    if (!CONV_IN_P0) for (;;) {
        if (F.tid == 0) *(LAS int*)(lds + L_Q) = (int)__hip_atomic_fetch_add(qhead + 192, 8u, RLX_AGENT);
        __syncthreads();
        const int base = *(const LAS int*)(lds + L_Q);
        __syncthreads();
        if (base >= 3 * 65 * 64) break;
        conv_batch(F, base, base + 8);
    }
}
#undef KSWZ
#undef SBAR
}

__device__ __forceinline__ void p0_prologue(Frame& F) {
    LAS float* scr = (LAS float*)(F.lds + 40960 + F.wave * 8704);
    unsigned char* ws = F.ws; const int lane = F.lane;
    if (F.gw < 128) { const int kv = F.gw >> 6, j = F.gw & 63; const float* pe = F.in(kv ? I_PE_V : I_PE_K) + 64 * j; const float* w = F.in(kv ? I_W_CV : I_W_CK) + (size_t)64 * j * 128; float a0 = 0.f, a1 = 0.f;
#pragma unroll 16
        for (int k = 0; k < 64; ++k) { const float p = pe[k]; a0 += p * w[(size_t)k * 128 + lane]; a1 += p * w[(size_t)k * 128 + 64 + lane]; }
        float* cb = (float*)(ws + WS_CBIAS) + (size_t)(kv * 64 + j) * 128; cb[lane] = a0; cb[64 + lane] = a1; }
    constexpr int S0 = 32 * 8, S1 = S0 + 64;
    bf16_t* WinT = (bf16_t*)(ws + WS_WINT);
    for (int it = F.gw; it < S1; it += F.NGW) {
        if (it < S0) { const int kb = it >> 3, nb = it & 7; tr_item(F.in(I_W_IN), W_IN_COLS, 64 * kb, 10752 + 32 * nb, WinCol{}, WinT, D, 0, IdCol{}, scr, lane); }
        else {
            const int r = it - S0, kb = r >> 1, nb = r & 1, k0 = 64 * kb, n0 = 32 * nb; const float* W = F.in(I_W_ROUTER);
#pragma unroll 8
            for (int i = 0; i < 32; ++i) { const int kk = 2 * i + (lane >> 5); scr[kk * 33 + (lane & 31)] = W[(size_t)(k0 + kk) * NE + n0 + (lane & 31)]; }
            LDS_WAIT(); asm volatile("" ::: "memory");
            const int c8 = lane & 7; bf16_t* Whi = (bf16_t*)(ws + WS_WRT); bf16_t* Wlo = Whi + (size_t)NE * D;
#pragma unroll
            for (int j = 0; j < 4; ++j) { const int n = (lane >> 3) + 8 * j; const LAS float* s = scr + (8 * c8) * 33 + n; unsigned h[4], l[4];
#pragma unroll
                for (int q = 0; q < 4; ++q) { const float a = s[(2 * q) * 33], b = s[(2 * q + 1) * 33]; h[q] = cvtpk(a, b); l[q] = cvtpk(a - bf_lo(h[q]), b - bf_hi(h[q])); }
                *(u32x4*)(Whi + (size_t)(n0 + n) * D + k0 + 8 * c8) = (u32x4){h[0], h[1], h[2], h[3]};
                *(u32x4*)(Wlo + (size_t)(n0 + n) * D + k0 + 8 * c8) = (u32x4){l[0], l[1], l[2], l[3]}; }
            LDS_WAIT(); asm volatile("" ::: "memory");
        }
    }
    {
        LAS unsigned* T32 = (LAS unsigned*)F.lds;
        int t = blockIdx.x; f32x4 v[8]; Tr8Desc d = tr8w_decode(F, t < TR8W_NTILES ? t : 0);
        if (t < TR8W_NTILES) tr8_load(d, v, F.wave, lane);
        while (t < TR8W_NTILES) {
            tr8_to_lds(v, d.scale, T32, F.wave, lane);
            __syncthreads();
            const int tn = t + F.G; const Tr8Desc dn = tr8w_decode(F, tn < TR8W_NTILES ? tn : 0);
            if (tn < TR8W_NTILES) tr8_load(dn, v, F.wave, lane);
            tr8_from_lds(d, T32, F.wave, lane);
            __syncthreads();
            t = tn; d = dn;
        }
    }
    {
        LAS unsigned* T32 = (LAS unsigned*)F.lds;
        constexpr int NT0 = TR_FIRST_EXPERT;
        int t = blockIdx.x; f32x4 v[8]; TrDesc d = tr_decode(F, t < NT0 ? t : 0);
        if (t < NT0) tr_load(d, v, F.wave, lane);
        while (t < NT0) {
            tr_to_lds(v, T32, F.wave, lane);
            __syncthreads();
            const int tn = t + F.G; const TrDesc dn = tr_decode(F, tn < NT0 ? tn : 0);
            if (tn < NT0) tr_load(dn, v, F.wave, lane);
            tr_from_lds(d, T32, F.wave, lane);
            __syncthreads();
            t = tn; d = dn;
        }
    }
    if (CONV_IN_P0) { __syncthreads(); for (int base = blockIdx.x * 8; base < 3 * 65 * 64; base += F.G * 8) conv_batch(F, base, base + 8); }
    bf16_t* A3 = (bf16_t*)(ws + WS_A3); unsigned char* H8 = ws + WS_H8;
    for (int m = F.gw; m < M + MROWS; m += F.NGW) {
        if (m < M) rms_row_both(F.in(I_X) + (size_t)m * D, F.in(I_NORM_ATTN_G), A3 + (size_t)m * D, H8 + (size_t)m * D, lane);
        else rms_row_bf16(F.in(I_MEM) + (size_t)(m - M) * D, F.in(I_NORM_MEM_G), A3 + (size_t)m * D, lane);
    }
}

__device__ __forceinline__ void p2_thin(Frame& F) {
    unsigned char* ws = F.ws; const int lane = F.lane;
    bf16_t* PA = (bf16_t*)(ws + WS_PA); bf16_t* KVM = (bf16_t*)(ws + WS_KVMEM); const float* GL = (const float*)(ws + WS_GL);
    {
        LAS float* part = (LAS float*)F.lds;
        LAS float* red = (LAS float*)(F.lds + 65536);
        const int i16 = lane & 15, kg = lane >> 4, w = F.wave;
        for (int item = blockIdx.x; item < 256; item += F.G) {
            const int kv = item & 1, rt = (item >> 1) & 7, bg = item >> 4, b = bg >> 1, g = bg & 1;
            const int n = 16 * rt + i16, ne = n < 127 ? n : 126;
            const bf16_t* Ab = PA + ((size_t)(b * T + 16 * ne + 4 * w) * NPA + (kv ? CV_CMP : CK_CMP) + g * HD) + 8 * kg;
            const bf16_t* Bb = (const bf16_t*)(ws + (kv ? WS_WCV : WS_WCK)) + (size_t)i16 * 4096 + 512 * w + 8 * kg;
            f32x4 acc[8];
#pragma unroll
            for (int nt = 0; nt < 8; ++nt) acc[nt] = (f32x4){0.f, 0.f, 0.f, 0.f};
#pragma unroll 2
            for (int s = 0; s < 16; ++s) { const bf16x8 a = *(const bf16x8*)(Ab + (size_t)(s >> 2) * NPA + 32 * (s & 3));
#pragma unroll
                for (int nt = 0; nt < 8; ++nt) { const bf16x8 bb = *(const bf16x8*)(Bb + (size_t)nt * 16 * 4096 + 32 * s); acc[nt] = __builtin_amdgcn_mfma_f32_16x16x32_bf16(a, bb, acc[nt], 0, 0, 0); } }
            __syncthreads();
#pragma unroll
            for (int nt = 0; nt < 8; ++nt) *(LAS f32x4*)(part + ((w * 8 + nt) * 64 + lane) * 4) = acc[nt];
            __syncthreads();
            f32x4 t = {0.f, 0.f, 0.f, 0.f};
#pragma unroll
            for (int ww = 0; ww < 8; ++ww) t += *(const LAS f32x4*)(part + ((ww * 8 + w) * 64 + lane) * 4);
            const int e = 16 * w + i16; float cb = 0.f;
#pragma unroll 16
            for (int j = 0; j < 64; ++j) cb += ((const float*)(ws + WS_CBIAS))[(size_t)(kv * 64 + j) * 128 + e];
#pragma unroll
            for (int r = 0; r < 4; ++r) t[r] += cb;
            float scl[4] = {1.f, 1.f, 1.f, 1.f};
            if (kv == 0) {
#pragma unroll
                for (int r = 0; r < 4; ++r) { float q = t[r] * t[r]; q += __shfl_xor(q, 1); q += __shfl_xor(q, 2); q += __shfl_xor(q, 4); q += __shfl_xor(q, 8); if (i16 == 0) red[w * 16 + 4 * kg + r] = q; }
            }
            __syncthreads();
            if (kv == 0) { const float kgain = F.in(I_NSA_K_G)[e];
#pragma unroll
                for (int r = 0; r < 4; ++r) { float q = 0.f;
#pragma unroll
                    for (int ww = 0; ww < 8; ++ww) q += red[ww * 16 + 4 * kg + r];
                    scl[r] = __builtin_amdgcn_rsqf(q * (1.f / HD) + RMS_EPS) * kgain; } }
            bf16_t* Ob = (bf16_t*)(ws + (kv ? WS_VC : WS_KC)) + (size_t)bg * 128 * HD;
#pragma unroll
            for (int r = 0; r < 4; ++r) { const int nn = 16 * rt + 4 * kg + r; const float v = nn < 127 ? t[r] * scl[r] : 0.f; Ob[(size_t)nn * HD + e] = (bf16_t)(cvtpk(v, 0.f) & 0xffffu); }
        }
    }
#pragma unroll 2
    for (int row = F.gw; row < M; row += F.NGW) {
        const int hd = lane >> 3, col = (hd < 2 ? CK_SLC + hd * HD : (hd < 4 ? CK_WIN + (hd - 2) * HD : CK_FOX + (hd - 4) * HD)) + (lane & 7) * 16;
        bf16_t* p = PA + (size_t)row * NPA + col; const u32x4 r0 = *(const u32x4*)p, r1 = *(const u32x4*)(p + 8);
        float ss = 0.f;
#pragma unroll
        for (int e = 0; e < 4; ++e) { ss += bf_lo(r0[e]) * bf_lo(r0[e]) + bf_hi(r0[e]) * bf_hi(r0[e]) + bf_lo(r1[e]) * bf_lo(r1[e]) + bf_hi(r1[e]) * bf_hi(r1[e]); }
        ss += __shfl_xor(ss, 1); ss += __shfl_xor(ss, 2); ss += __shfl_xor(ss, 4);
        const float rstd = __builtin_amdgcn_rsqf(ss * (1.f / HD) + RMS_EPS); const float* gn = F.in(hd < 4 ? I_NSA_K_G : I_FOX_K_G) + (lane & 7) * 16;
        u32x4 o0, o1;
#pragma unroll
        for (int e = 0; e < 4; ++e) { o0[e] = cvtpk(bf_lo(r0[e]) * rstd * gn[2 * e], bf_hi(r0[e]) * rstd * gn[2 * e + 1]); o1[e] = cvtpk(bf_lo(r1[e]) * rstd * gn[8 + 2 * e], bf_hi(r1[e]) * rstd * gn[8 + 2 * e + 1]); }
        *(u32x4*)p = o0; *(u32x4*)(p + 8) = o1;
    }
    for (int mr = F.gw; mr < MROWS; mr += F.NGW) {
        bf16_t* p = KVM + (size_t)mr * 1024 + (lane >> 4) * HD + (lane & 15) * 8; const u32x4 r0 = *(const u32x4*)p; float ss = 0.f;
#pragma unroll
        for (int e = 0; e < 4; ++e) ss += bf_lo(r0[e]) * bf_lo(r0[e]) + bf_hi(r0[e]) * bf_hi(r0[e]);
        ss += __shfl_xor(ss, 1); ss += __shfl_xor(ss, 2); ss += __shfl_xor(ss, 4); ss += __shfl_xor(ss, 8);
        const float rstd = __builtin_amdgcn_rsqf(ss * (1.f / HD) + RMS_EPS); const float* gn = F.in(I_MEM_K_G) + (lane & 15) * 8; u32x4 o0;
#pragma unroll
        for (int e = 0; e < 4; ++e) o0[e] = cvtpk(bf_lo(r0[e]) * rstd * gn[2 * e], bf_hi(r0[e]) * rstd * gn[2 * e + 1]);
        *(u32x4*)p = o0;
    }
    for (int seq = F.gw; seq < 32; seq += F.NGW) {
        const int b = seq >> 2, h = seq & 3; const float bf = F.in(I_FOX_B_F)[h]; float v[32]; float run = 0.f;
#pragma unroll
        for (int i = 0; i < 32; ++i) { const float x = GL[(size_t)(b * T + 32 * lane + i) * LDG + 24 + h] + bf;
            const float ls = fminf(x, 0.f) - log1pf(__expf(-fabsf(x))); run += ls; v[i] = run; }
        float incl = run;
#pragma unroll
        for (int o = 1; o < 64; o <<= 1) { const float t = __shfl_up(incl, o); if (lane >= o) incl += t; }
        const float excl = incl - run; float* cp = (float*)(ws + WS_CUM) + (size_t)seq * T + 32 * lane;
#pragma unroll
        for (int i = 0; i < 32; ++i) cp[i] = v[i] + excl;
    }
}

constexpr int CW_COARSE = 16384;
constexpr int P6_WSTR = 136;
constexpr int P6_WBUF = 2 * 64 * P6_WSTR * 2;
static_assert(2 * P6_WBUF <= RING_BYTES, "P6 chunk buffers inside the ring region");
__device__ __forceinline__ void p6_router(Frame& F) {
    unsigned char* ws = F.ws; const int lane = F.lane, i16 = lane & 15, kg = lane >> 4, row = i16 & 7;
    unsigned char* H2 = (unsigned char*)(ws + WS_A3); const bf16_t* X1 = (const bf16_t*)(ws + WS_X1B); const float* gain = F.in(I_NORM_FFN_G);
    const bf16_t* Wg = (const bf16_t*)(ws + WS_WRT);
    const float rb = F.in(I_ROUTER_BIAS)[lane];
    unsigned* coarse = (unsigned*)(ws + WS_CTL) + CW_COARSE;
    if (F.gw == 0) {
#pragma unroll
        for (int q = 0; q < 2; ++q) *(u32x4*)(H2 + (size_t)M * D + 32 * lane + 16 * q) = (u32x4){0u, 0u, 0u, 0u}; }
    for (int item = blockIdx.x; item < M / 64; item += F.G) {
        const int tok0 = item * 64 + F.wave * 8;
        float myr = 0.f;
#pragma unroll 2
        for (int i = 0; i < 8; ++i) { const bf16_t* xr = X1 + (size_t)(tok0 + i) * D; float ss = 0.f;
#pragma unroll
            for (int j = 0; j < 4; ++j) { const u32x4 v = *(const u32x4*)(xr + 8 * lane + 512 * j);
#pragma unroll
                for (int e = 0; e < 4; ++e) ss += bf_lo(v[e]) * bf_lo(v[e]) + bf_hi(v[e]) * bf_hi(v[e]); }
            const float r = __builtin_amdgcn_rsqf(wave_sum(ss) * (1.f / D) + RMS_EPS); if (row == i) myr = r; }
        f32x4 acc[4] = {{0.f, 0.f, 0.f, 0.f}, {0.f, 0.f, 0.f, 0.f}, {0.f, 0.f, 0.f, 0.f}, {0.f, 0.f, 0.f, 0.f}};
        const bf16_t* xr = X1 + (size_t)(tok0 + row) * D + 8 * kg; unsigned char* hr = H2 + (size_t)(tok0 + row) * D + 8 * kg;
        u32x4 wst[4];
#define P6_LOADW(ch) do { _Pragma("unroll") for (int i = 0; i < 4; ++i) { const int p = F.tid + 512 * i; wst[i] = *(const u32x4*)(Wg + (size_t)(p >> 4) * D + 128 * (ch) + 8 * (p & 15)); } } while (0)
#define P6_STOREW(bf) do { _Pragma("unroll") for (int i = 0; i < 4; ++i) { const int p = F.tid + 512 * i; *(LAS u32x4*)(F.lds + (bf) * P6_WBUF + ((p >> 4) * P6_WSTR + 8 * (p & 15)) * 2) = wst[i]; } } while (0)
        P6_LOADW(0);
        __syncthreads();
        P6_STOREW(0);
        __syncthreads();
        for (int ch = 0; ch < 16; ++ch) {
            if (ch < 15) P6_LOADW(ch + 1);
            const LAS unsigned char* wb = F.lds + (ch & 1) * P6_WBUF + (i16 * P6_WSTR + 8 * kg) * 2;
#pragma unroll 2
            for (int s = 0; s < 4; ++s) { const int k = 128 * ch + 32 * s;
                const u32x4 xb = *(const u32x4*)(xr + k); const f32x4 g0 = *(const f32x4*)(gain + k + 8 * kg), g1 = *(const f32x4*)(gain + k + 8 * kg + 4);
                const float xn[8] = {bf_lo(xb.x) * myr * g0.x, bf_hi(xb.x) * myr * g0.y, bf_lo(xb.y) * myr * g0.z, bf_hi(xb.y) * myr * g0.w, bf_lo(xb.z) * myr * g1.x, bf_hi(xb.z) * myr * g1.y, bf_lo(xb.w) * myr * g1.z, bf_hi(xb.w) * myr * g1.w};
                u32x4 h, l;
#pragma unroll
                for (int q = 0; q < 4; ++q) { h[q] = cvtpk(xn[2 * q], xn[2 * q + 1]); l[q] = cvtpk(xn[2 * q] - bf_lo(h[q]), xn[2 * q + 1] - bf_hi(h[q])); }
                if (i16 < 8) *(u32x2*)(hr + k) = (u32x2){pk_fp8x4(xn[0], xn[1], xn[2], xn[3]), pk_fp8x4(xn[4], xn[5], xn[6], xn[7])};
                const bf16x8 ah = __builtin_bit_cast(bf16x8, h), al = __builtin_bit_cast(bf16x8, l);
#pragma unroll
                for (int nt = 0; nt < 4; ++nt) { const LAS unsigned char* wp = wb + (16 * nt * P6_WSTR + 32 * s) * 2;
                    const bf16x8 bh = *(const LAS bf16x8*)wp, bl = *(const LAS bf16x8*)(wp + 64 * P6_WSTR * 2);
                    acc[nt] = __builtin_amdgcn_mfma_f32_16x16x32_bf16(ah, bh, acc[nt], 0, 0, 0);
                    acc[nt] = __builtin_amdgcn_mfma_f32_16x16x32_bf16(al, bh, acc[nt], 0, 0, 0);
                    acc[nt] = __builtin_amdgcn_mfma_f32_16x16x32_bf16(ah, bl, acc[nt], 0, 0, 0); }
            }
            if (ch < 15) P6_STOREW((ch + 1) & 1);
            __syncthreads();
        }
#undef P6_LOADW
#undef P6_STOREW
        LAS float* lg = (LAS float*)(F.lds + F.wave * 4096);
        if (kg < 2) {
#pragma unroll
            for (int nt = 0; nt < 4; ++nt)
#pragma unroll
                for (int r = 0; r < 4; ++r) lg[(4 * kg + r) * 64 + 16 * nt + i16] = acc[nt][r]; }
        LDS_WAIT(); asm volatile("" ::: "memory");
        int cnt = 0;
        u32x2* asg = (u32x2*)(ws + WS_ASG);
        for (int tt = 0; tt < 8; ++tt) {
            const float sc = 1.f / (1.f + __expf(-lg[tt * 64 + lane])); const float key = sc + rb;
            lg[512 + lane] = key; LDS_WAIT(); asm volatile("" ::: "memory");
            int rank = 0;
#pragma unroll
            for (int q = 0; q < 16; ++q) { const f32x4 kk = *(const LAS f32x4*)(lg + 512 + 4 * q);
#pragma unroll
                for (int e = 0; e < 4; ++e) { const int eo = 4 * q + e; rank += (kk[e] > key || (kk[e] == key && eo < lane)) ? 1 : 0; } }
            LDS_WAIT(); asm volatile("" ::: "memory");
            const bool selx = rank < TOPK;
            const float ssum = wave_sum(selx ? sc : 0.f);
            const unsigned long long bal = __ballot(selx);
            if (selx) { const int k = __popcll(bal & ((1ull << lane) - 1ull));
                asg[(size_t)(tok0 + tt) * TOPK + k] = (u32x2){(unsigned)lane | ((unsigned)cnt << 8), __float_as_uint(sc / ssum * 2.5f)}; ++cnt; }
        }
        const int wi = item * 8 + F.wave;
        ((int*)(ws + WS_HIST))[wi * 64 + lane] = cnt;
        __hip_atomic_fetch_add(coarse + (wi >> 5) * 64 + lane, (unsigned)cnt, RLX_AGENT);
    }
}
__device__ __forceinline__ void p7_slots(Frame& F) {
    unsigned char* ws = F.ws; const int lane = F.lane;
    const int* hist = (const int*)(ws + WS_HIST); const u32x2* asg = (const u32x2*)(ws + WS_ASG); const unsigned* coarse = (const unsigned*)(ws + WS_CTL) + CW_COARSE;
    int* rowasg = (int*)(ws + WS_ROWASG); int* rowtok = (int*)(ws + WS_ROWTOK); float* rowg = (float*)(ws + WS_ROWG);
    for (int wi = F.gw; wi < M / 8; wi += F.NGW) {
        const int grp = wi >> 5; int base = 0, total = 0;
#pragma unroll 8
        for (int g = 0; g < 64; ++g) { const int cv = (int)coarse[g * 64 + lane]; total += cv; base += g < grp ? cv : 0; }
        for (int i = grp * 32; i < wi; ++i) base += hist[i * 64 + lane];
        const int padded = (total + 255) & ~255;
        int incl = padded;
#pragma unroll
        for (int o = 1; o < 64; o <<= 1) { const int t = __shfl_up(incl, o); if (lane >= o) incl += t; }
        const int pstart = incl - padded, rtot = __shfl(incl, 63);
        const int my = pstart + base;
        { const int tok = wi * 8 + (lane >> 3), k = lane & 7; const u32x2 rec = asg[(size_t)tok * TOPK + k];
          const int e = rec.x & 255, rl = rec.x >> 8; const int dest = __shfl(my, e) + rl;
          rowasg[dest] = tok * ASG_PER_TOK + k; rowtok[dest] = tok; rowg[dest] = __uint_as_float(rec.y); }
        if (lane < 8) { const int tok = wi * 8 + lane, dest = rtot + tok; rowasg[dest] = tok * ASG_PER_TOK + 8; rowtok[dest] = tok; rowg[dest] = 1.f; }
        if (wi == 0) { for (int sl = pstart + total; sl < pstart + padded; ++sl) { rowasg[sl] = -1; rowtok[sl] = M; rowg[sl] = 0.f; }
                       ((int*)(ws + WS_CNT))[lane] = total; }
    }
}
__device__ __forceinline__ int build_blocks(Frame& F, LAS unsigned char* blk_e, LAS int* tmp) {
    const int* cnt = (const int*)(F.ws + WS_CNT);
    if (F.tid < NEX) tmp[F.tid] = F.tid < NE ? (cnt[F.tid] + 255) >> 8 : M / 256;
    __syncthreads();
    if (F.tid < NEX) { int st = 0; for (int e = 0; e < F.tid; ++e) st += tmp[e]; const int nb = tmp[F.tid]; for (int i = 0; i < nb; ++i) blk_e[st + i] = (unsigned char)F.tid; if (F.tid == NEX - 1) tmp[NEX] = st + nb; }
    __syncthreads();
    return tmp[NEX];
}
__device__ __forceinline__ void p10_combine(Frame& F) {
    const unsigned char* Y = (const unsigned char*)(F.ws + WS_Y); float* O = F.out; const bf16_t* X1 = (const bf16_t*)(F.ws + WS_X1B); const int lane = F.lane;
    for (int tok = F.gw; tok < M; tok += F.NGW) {
#pragma unroll
        for (int c = 0; c < 2; ++c) { const int col = 16 * lane + 1024 * c; float* op = O + (size_t)tok * D + col;
            const u32x4 xa = *(const u32x4*)(X1 + (size_t)tok * D + col), xb = *(const u32x4*)(X1 + (size_t)tok * D + col + 8);
            const f32x4 x0 = {bf_lo(xa.x), bf_hi(xa.x), bf_lo(xa.y), bf_hi(xa.y)}, x1 = {bf_lo(xa.z), bf_hi(xa.z), bf_lo(xa.w), bf_hi(xa.w)}, x2 = {bf_lo(xb.x), bf_hi(xb.x), bf_lo(xb.y), bf_hi(xb.y)}, x3 = {bf_lo(xb.z), bf_hi(xb.z), bf_lo(xb.w), bf_hi(xb.w)};
            u32x4 y[ASG_PER_TOK];
#pragma unroll
            for (int k = 0; k < ASG_PER_TOK; ++k) y[k] = *(const u32x4*)(Y + ((size_t)tok * ASG_PER_TOK + k) * D + col);
            float a[16];
#pragma unroll
            for (int e = 0; e < 16; ++e) a[e] = 0.f;
#pragma unroll
            for (int k = 0; k < ASG_PER_TOK; ++k)
#pragma unroll
                for (int q = 0; q < 4; ++q) { const auto lo = __builtin_amdgcn_cvt_pk_f32_fp8((int)y[k][q], false); const auto hi = __builtin_amdgcn_cvt_pk_f32_fp8((int)y[k][q], true);
                    a[4 * q] += lo[0]; a[4 * q + 1] += lo[1]; a[4 * q + 2] += hi[0]; a[4 * q + 3] += hi[1]; }
            const float r = 1.f / Y_SCALE;
            *(f32x4*)op = (f32x4){x0[0] + a[0] * r, x0[1] + a[1] * r, x0[2] + a[2] * r, x0[3] + a[3] * r};
            *(f32x4*)(op + 4) = (f32x4){x1[0] + a[4] * r, x1[1] + a[5] * r, x1[2] + a[6] * r, x1[3] + a[7] * r};
            *(f32x4*)(op + 8) = (f32x4){x2[0] + a[8] * r, x2[1] + a[9] * r, x2[2] + a[10] * r, x2[3] + a[11] * r};
            *(f32x4*)(op + 12) = (f32x4){x3[0] + a[12] * r, x3[1] + a[13] * r, x3[2] + a[14] * r, x3[3] + a[15] * r}; }
    }
}

constexpr int N_PHASES = 11;
struct Args { const float* in[31]; float* out; unsigned char* ws; int ph_lo, ph_hi, use_bar, pad; };
__global__ void __launch_bounds__(512, 2) mega(Args args) {
    extern __shared__ __attribute__((aligned(16))) unsigned char lds_raw[];
    LAS unsigned char* lds = (LAS unsigned char*)lds_raw;
    Frame F; F.lds = lds; F.tid = threadIdx.x; F.lane = F.tid & 63; F.wave = __builtin_amdgcn_readfirstlane(F.tid >> 6); F.G = gridDim.x;
    F.gw = blockIdx.x * 8 + F.wave; F.NGW = F.G * 8; F.out = args.out; F.ws = args.ws;
    unsigned char* ws = args.ws;
    unsigned* ctl = (unsigned*)(ws + WS_CTL);
    for (int u = F.tid; u < 256; u += 512) ((LAS unsigned*)(lds + LDSCTL_OFF))[u] = 0u;
    __syncthreads();
    XcdBarrier bar; bar.bar = ctl + CW_BAR; bar.x = 0; bar.st = nullptr;
    if (args.use_bar) bar = xcd_barrier_post(ctl + CW_BAR, (volatile LAS unsigned*)(lds + LDSCTL_OFF));
    const int lo = args.ph_lo, hi = args.ph_hi;
#ifndef PH_MASK
#define PH_MASK 0x7ff
#endif
#define IN(k) (((PH_MASK >> (k)) & 1) && lo <= (k) && (k) < hi)
#define SEAM(k) do { if (IN(k) && IN((k) + 1)) xcd_barrier(bar); } while (0)
    const int c = (int)blockIdx.x;
#ifndef REP_PHASE
#define REP_PHASE -1
#endif
#define RUN(k, ...) do { if (IN(k)) { const int rep = 0; (void)rep; __VA_ARGS__ } if (REP_PHASE == (k) && IN(k)) { xcd_barrier(bar); const int rep = 1; (void)rep; __VA_ARGS__ } } while (0)
    RUN(0, p0_prologue(F); ); SEAM(0);
    RUN(1,
        Epi1 E{(bf16_t*)(ws + WS_PA), (unsigned char*)(ws + WS_PG), (float*)(ws + WS_GL), (bf16_t*)(ws + WS_KVMEM)};
        { Sched1 S; S.o.init(64, NB16 + 1); S.A = (const char*)(ws + WS_A3); S.Bt = (const char*)(ws + WS_WINT); S.G = F.G; S.c = c; S.fp8 = 0;
          pg8::gemm_phase<Epi1, Sched1, false, false>(lds, 2 * D, 2 * D, S, E); }
        { Sched1 S; S.o.init(64, 24 + NF8); S.A = (const char*)(ws + WS_H8); S.Bt = (const char*)(ws + WS_WIN8); S.G = F.G; S.c = c; S.fp8 = 1;
          pg8::gemm_phase<Epi1, Sched1, false, true>(lds, D, D, S, E); }
    ); SEAM(1);
    RUN(2, p2_thin(F); ); SEAM(2);
    RUN(3,
        att::Tensors Tn{(const bf16_t*)(ws + WS_PA), (const float*)(ws + WS_GL), (const bf16_t*)(ws + WS_KVMEM), (const bf16_t*)(ws + WS_KC), (const bf16_t*)(ws + WS_VC), (const float*)(ws + WS_CUM),
                        (bf16_t*)(ws + WS_A3), F.in(I_NSA_Q_G), F.in(I_FOX_Q_G), F.in(I_MEM_Q_G), F.in(I_REL_BIAS)};
        att::attn_phase(F, (LAS char*)lds, Tn, ctl + CW_QUEUE + rep * 256);
    ); SEAM(3);
    RUN(4,
        Sched4 S; S.o.init(64, 8); S.A = (const char*)(ws + WS_A3); S.Bt = (const char*)(ws + WS_WOT); S.G = F.G; S.c = c;
        Epi4 E{(const unsigned char*)(ws + WS_PG), (bf16_t*)(ws + WS_PA)};
        pg8::gemm_phase<Epi4, Sched4, false>(lds, 2 * D, 2 * D, S, E);
    ); SEAM(4);
    RUN(5,
        Sched5 S; S.o.init(64, 8); S.A = (const char*)(ws + WS_PA); S.Bt = (const char*)(ws + WS_WOUTT); S.G = F.G; S.c = c;
        Epi5 E{F.in(I_X), (bf16_t*)(ws + WS_X1B)};
        pg8::gemm_phase<Epi5, Sched5, false>(lds, 2 * D, 2 * D, S, E);
    ); SEAM(5);
    RUN(6, p6_router(F); ); SEAM(6);
    RUN(7, p7_slots(F); ); SEAM(7);
    RUN(8,
        LAS unsigned char* blk_e = lds + EPI_OFF; LAS int* tmp = (LAS int*)(lds + EPI_OFF + 1024);
        const int nblk = build_blocks(F, blk_e, tmp);
        SchedMoe S{blk_e, nblk, F.G, c, 2, (const char*)(ws + WS_A3), (const char*)(ws + WS_WGU), (const int*)(ws + WS_ROWTOK), true};
        Epi8 E{(unsigned char*)(ws + WS_PG)};
        pg8::gemm_phase<Epi8, SchedMoe, true, true>(lds, D, D, S, E);
    ); SEAM(8);
    RUN(9,
        LAS unsigned char* blk_e = lds + EPI_OFF; LAS int* tmp = (LAS int*)(lds + EPI_OFF + 1024);
        const int nblk = build_blocks(F, blk_e, tmp);
        SchedMoe S{blk_e, nblk, F.G, c, 3, (const char*)(ws + WS_PG), (const char*)(ws + WS_WD), nullptr, false};
        Epi9 E{(const int*)(ws + WS_ROWASG), (const float*)(ws + WS_ROWG), (unsigned char*)(ws + WS_Y)};
        pg8::gemm_phase<Epi9, SchedMoe, false, true>(lds, DE, DE, S, E);
    ); SEAM(9);
    RUN(10, p10_combine(F); );
#undef RUN
#undef IN
#undef SEAM
}

#ifndef MK_PER_PHASE
#define MK_PER_PHASE 0
#endif
extern "C" void kernel_launch(void* const* d_in, const int* in_sizes, int n_in, void* d_out, int out_size, void* d_ws, size_t ws_size, hipStream_t stream) {
    static int grid = 0;
    if (grid == 0) {
        if (n_in != N_IN || in_sizes[0] != M * D || out_size != M * D || ws_size < WS_END) { fprintf(stderr, "kernel_launch: unexpected shapes (n_in %d, in0 %d, out %d, ws %zu; need ws >= %zu)\n", n_in, n_in > 0 ? in_sizes[0] : -1, out_size, ws_size, (size_t)WS_END); grid = -1; return; }
        int dev = 0, cus = 0, per_cu = 0;
        if (hipGetDevice(&dev) != hipSuccess || hipDeviceGetAttribute(&cus, hipDeviceAttributeMultiprocessorCount, dev) != hipSuccess) { grid = -1; return; }
        if (hipFuncSetAttribute((const void*)mega, hipFuncAttributeMaxDynamicSharedMemorySize, LDS_BYTES) != hipSuccess) { fprintf(stderr, "kernel_launch: hipFuncSetAttribute failed\n"); grid = -1; return; }
        if (hipOccupancyMaxActiveBlocksPerMultiprocessor(&per_cu, (const void*)mega, 512, LDS_BYTES) != hipSuccess || per_cu < 1) fprintf(stderr, "kernel_launch: occupancy query says %d\n", per_cu);
        (void)hipGetLastError();
        grid = cus;
    }
    if (grid < 0) return;
    (void)hipMemsetAsync((char*)d_ws + WS_CTL, 0, CTL_ZERO_BYTES, stream);
    Args a{};
    for (int i = 0; i < 31; ++i) a.in[i] = (const float*)d_in[i];
    a.out = (float*)d_out; a.ws = (unsigned char*)d_ws; a.pad = 0;
#if MK_PER_PHASE
    for (int p = 0; p < N_PHASES; ++p) { a.ph_lo = p; a.ph_hi = p + 1; a.use_bar = 0; hipLaunchKernelGGL(mega, dim3(grid), dim3(512), LDS_BYTES, stream, a); }
#else
    a.ph_lo = 0; a.ph_hi = N_PHASES; a.use_bar = 1; hipLaunchKernelGGL(mega, dim3(grid), dim3(512), LDS_BYTES, stream, a);
#endif
}
```

```cpp
#include <hip/hip_runtime.h>
#include <cstdio>
#include <cstdint>

#define LAS __attribute__((address_space(3)))
#define GAS __attribute__((address_space(1)))
typedef unsigned short bf16_t;
typedef short bf16x8 __attribute__((ext_vector_type(8)));
typedef short s16x4 __attribute__((ext_vector_type(4)));
typedef float f32x2 __attribute__((ext_vector_type(2)));
typedef float f32x4 __attribute__((ext_vector_type(4)));
typedef float f32x16 __attribute__((ext_vector_type(16)));
typedef unsigned u32x2 __attribute__((ext_vector_type(2)));
typedef unsigned u32x4 __attribute__((ext_vector_type(4)));
typedef GAS unsigned gu32;

constexpr int NB = 8, T = 2048, D = 2048, M = NB * T;
constexpr int HD = 128;
constexpr int MEMT = 256, MROWS = NB * MEMT;
constexpr int NE = 64, TOPK = 8, DE = 512, NEX = NE + 1;
constexpr int W_IN_COLS = 10780;
constexpr int NPA = 4608, NPG = 6144, NPAD = 11008;
constexpr int LDG = 32;
constexpr float RMS_EPS = 1e-6f;
constexpr float LOG2E = 1.4426950408889634f;
constexpr float ATTN_SCALE = 0.08838834764831845f;
constexpr int CQ_NSA = 0, CK_CMP = 1024, CV_CMP = 1280, CK_SLC = 1536, CV_SLC = 1792, CK_WIN = 2048, CV_WIN = 2304;
constexpr int CQ_FOX = 2560, CK_FOX = 3072, CV_FOX = 3584, CQ_MEM = 4096;
constexpr int ASG_PER_TOK = 9;
constexpr int MAXSLOT = M * TOPK + NE * 256 + M;

constexpr size_t MiB = 1u << 20;
constexpr size_t WS_CTL = 0, CTL_ZERO_BYTES = 1 * MiB;
constexpr size_t WS_GL = 1 * MiB;
constexpr size_t WS_KVMEM = 3 * MiB;
constexpr size_t WS_KC = 7 * MiB, WS_VC = WS_KC + 512 * 1024;
constexpr size_t WS_CUM = 8 * MiB;
constexpr size_t WS_CBIAS = WS_CUM + 256 * 1024;
constexpr size_t WS_HIST = WS_CUM + 512 * 1024;
constexpr size_t WS_ASG = 9 * MiB;
constexpr size_t WS_ROWASG = 10 * MiB;
constexpr size_t WS_ROWG = 11 * MiB;
constexpr size_t WS_CNT = 12 * MiB;
constexpr size_t WS_WRT = 12 * MiB + 256 * 1024;
constexpr size_t WS_WCK = 13 * MiB, WS_WCV = 14 * MiB;
constexpr size_t WS_WOT = 16 * MiB;
constexpr size_t WS_WOUTT = 24 * MiB;
constexpr size_t WS_WD = 32 * MiB;
constexpr size_t WS_PG = WS_WD + (size_t)NEX * 2 * MiB;
constexpr size_t WS_Y = WS_PG + 192 * MiB;
constexpr size_t WS_WGU = WS_Y;
constexpr size_t WS_WINT = WS_WGU + (size_t)NEX * 4 * MiB;
constexpr size_t WS_PA = WS_WINT + 47 * MiB;
constexpr size_t WS_A3 = WS_PA + 144 * MiB;
constexpr size_t WS_WIN8 = WS_Y + 578 * MiB;
constexpr size_t WS_H8 = WS_WIN8 + 24 * MiB;
constexpr size_t WS_END = WS_H8 + 32 * MiB;
constexpr size_t WS_X1B = WS_PA + 64 * MiB;
static_assert(WS_A3 + (size_t)(M + MROWS) * D * 2 <= WS_Y + 576 * MiB, "ws map");
static_assert((size_t)MAXSLOT * DE * 2 <= 192 * MiB, "hid fits projG");
static_assert((size_t)MAXSLOT * 4 <= 1 * MiB, "row tables");

constexpr int CW_BAR = 4096;
constexpr int CW_QUEUE = 8192;

constexpr int RING_BYTES = 131072;
constexpr int LDSCTL_OFF = RING_BYTES;
constexpr int EPI_OFF = RING_BYTES + 1024;
constexpr int LDS_BYTES = RING_BYTES + 1024 + 8192 + 4096;

#define RLX_AGENT __ATOMIC_RELAXED, __HIP_MEMORY_SCOPE_AGENT
__device__ __forceinline__ unsigned cvtpk(float lo, float hi) { unsigned r; asm volatile("v_cvt_pk_bf16_f32 %0, %1, %2" : "=v"(r) : "v"(lo), "v"(hi)); return r; }
__device__ __forceinline__ float bf_lo(unsigned u) { return __uint_as_float(u << 16); }
__device__ __forceinline__ float bf_hi(unsigned u) { return __uint_as_float(u & 0xffff0000u); }
__device__ __forceinline__ float wave_sum(float v) {
#pragma unroll
    for (int o = 1; o < 64; o <<= 1) v += __shfl_xor(v, o);
    return v;
}
constexpr float WGU_SCALE = 32.f, WD_SCALE = 16.f, WIN_SCALE = 32.f;
__device__ __forceinline__ unsigned pk_fp8x4(float a, float b, float c, float d) { int w = 0; w = __builtin_amdgcn_cvt_pk_fp8_f32(a, b, w, false); w = __builtin_amdgcn_cvt_pk_fp8_f32(c, d, w, true); return (unsigned)w; }
__device__ __forceinline__ float fast_sigmoid(float x) { return __builtin_amdgcn_rcpf(1.f + __builtin_amdgcn_exp2f(-x * LOG2E)); }

#define XB_TMO      128
#define XB_XCNT(j)  (256  + 64 * (j))
#define XB_XSUB(j)  (1280 + 64 * (j))
#define XB_XGEN(j)  (2304 + 64 * (j))
#define XB_TOP      3328
#define XB_TOPGEN   3392
#define XCD_BAR_WORDS 3456
#define XB_SPIN_CAP (1u << 18)
__device__ __forceinline__ unsigned xb_ld(unsigned* p)              { return __hip_atomic_load(p, __ATOMIC_RELAXED, __HIP_MEMORY_SCOPE_AGENT); }
__device__ __forceinline__ unsigned xb_add(unsigned* p, unsigned v) { return __hip_atomic_fetch_add(p, v, __ATOMIC_RELAXED, __HIP_MEMORY_SCOPE_AGENT); }
__device__ __forceinline__ unsigned xb_xcc_id() { return (unsigned)__builtin_amdgcn_s_getreg((3 << 11) | 20) & 0xFu; }
#define XB_SPIN(cond, bar) do { unsigned _sp = 0; while (cond) { __builtin_amdgcn_s_sleep(1); \
    if ((++_sp & 255u) == 0u) { if (xb_ld(&(bar)[XB_TMO])) break; if (_sp > XB_SPIN_CAP) { atomicAdd(&(bar)[XB_TMO], 1u); break; } } } } while (0)
struct XcdBarrier { unsigned* bar; unsigned x; volatile LAS unsigned* st; };
__device__ __forceinline__ XcdBarrier xcd_barrier_post(unsigned* bar, volatile LAS unsigned* st) {
    XcdBarrier b; b.bar = bar; b.x = xb_xcc_id(); b.st = st;
    if (threadIdx.x == 0) (void)xb_add(&bar[XB_XCNT(b.x)], 1u);
    return b;
}
__device__ __forceinline__ void xcd_barrier_complete(unsigned* bar, unsigned x, unsigned& nloc, unsigned& nx) {
    const unsigned G = gridDim.x * gridDim.y * gridDim.z;
    unsigned sum, cnt, mine, sp = 0u;
    for (;;) {
        sum = 0u; cnt = 0u; mine = 0u;
#pragma unroll
        for (unsigned j = 0; j < 16; ++j) { const unsigned c = xb_ld(&bar[XB_XCNT(j)]); sum += c; cnt += (c > 0u) ? 1u : 0u; mine = (j == x) ? c : mine; }
        if (sum == G) break;
        __builtin_amdgcn_s_sleep(1);
        if ((++sp & 255u) == 0u) { if (xb_ld(&bar[XB_TMO])) break; if (sp > XB_SPIN_CAP) { atomicAdd(&bar[XB_TMO], 1u); break; } }
    }
    nloc = mine > 0u ? mine : 1u; nx = cnt > 0u ? cnt : 1u;
}
__device__ __forceinline__ void xcd_barrier(const XcdBarrier& b) {
    asm volatile("s_waitcnt vmcnt(0)" ::: "memory");
    __syncthreads();
    if (threadIdx.x == 0) {
        unsigned* bar = b.bar;
        __builtin_amdgcn_s_waitcnt(0);
        unsigned nloc = b.st[0], nx = b.st[1];
        if (nloc == 0u) { xcd_barrier_complete(bar, b.x, nloc, nx); b.st[0] = nloc; b.st[1] = nx; }
        const unsigned old = xb_add(&bar[XB_XSUB(b.x)], 1u);
        const unsigned gen = old / nloc;
        if (old + 1u == (gen + 1u) * nloc) {
            __builtin_amdgcn_fence(__ATOMIC_RELEASE, "agent");
            asm volatile("s_waitcnt vmcnt(0)" ::: "memory");
            const unsigned og = xb_add(&bar[XB_TOP], 1u);
            const unsigned tg = og / nx;
            if (og + 1u == (tg + 1u) * nx) xb_add(&bar[XB_TOPGEN], 1u);
            else XB_SPIN(xb_ld(&bar[XB_TOPGEN]) == tg, bar);
            __builtin_amdgcn_fence(__ATOMIC_ACQUIRE, "agent");
            xb_add(&bar[XB_XGEN(b.x)], 1u);
            asm volatile("s_waitcnt vmcnt(0)" ::: "memory");
        } else {
            XB_SPIN(xb_ld(&bar[XB_XGEN(b.x)]) == gen, bar);
            __builtin_amdgcn_fence(__ATOMIC_ACQUIRE, "agent");
            asm volatile("s_waitcnt vmcnt(0)" ::: "memory");
        }
    }
    __syncthreads();
}

namespace pg8 {
constexpr int BM = 256, BK = 64, HALF = 128, HTB = HALF * BK * 2, STAGE_BYTES = 8 * HTB, NXCD = 8, WGM = 8;
__host__ __device__ __forceinline__ int lds_byte(int r, int c) { const int st = (r >> 4) * 2 + (c >> 5), rr = r & 15, cc = c & 31, ob = rr * 64 + cc * 2; return st * 1024 + (ob ^ (((ob >> 9) & 1) << 5)); }
__host__ __device__ __forceinline__ void stage_rc(int b, int& R, int& C) { const int st = b / 1024, sb = b % 1024, swz = sb ^ (((sb >> 9) & 1) << 5); R = (st >> 1) * 16 + swz / 64; C = (st & 1) * 32 + (swz % 64) / 2; }
__host__ __device__ __forceinline__ int perm32(int rho) { const int n = rho >> 4, i = rho & 15; return 8 * (i >> 2) + 4 * n + (i & 3); }

template <bool FP8> struct FragSel { struct A4 { bf16x8 f[4][2]; }; struct B2 { bf16x8 f[2][2]; }; };
template <> struct FragSel<true> { typedef int v8i_ __attribute__((ext_vector_type(8))); struct A4 { v8i_ f[4]; }; struct B2 { v8i_ f[2]; }; };
struct Unit { const char* A; const char* B; const int* ridx; int nt, pm, pn, aux; };

template <class Epi, class Sched, bool GATHER, bool FP8 = false>
__device__ __forceinline__ void gemm_phase(LAS unsigned char* lds, const int lda, const int ldb, const Sched& S, const Epi& E) {
    const int tid = threadIdx.x, wid = __builtin_amdgcn_readfirstlane(tid >> 6), lane = tid & 63, wr = wid >> 2, wc = wid & 3, fr = lane & 15, fq = lane >> 4;
    unsigned voffA[2], voffB[2]; int RA[2], CA[2];
#pragma unroll
    for (int i = 0; i < 2; ++i) { int R, C; stage_rc(tid * 16 + i * 8192, R, C); const int Rb = (R & ~31) + perm32(R & 31);
        RA[i] = R; CA[i] = C; voffA[i] = (unsigned)(R * lda + 2 * C); voffB[i] = (unsigned)(Rb * ldb + 2 * C); }
    const size_t kstep = (size_t)(BK * 2);
    const size_t hstepA = (size_t)HALF * lda, hstepB = (size_t)HALF * ldb;
    const unsigned ldsw = (unsigned)wid * 1024u;
    const int aoff = lds_byte(wr * 64 + fr, fq * 8), boff = lds_byte(wc * 32 + fr, fq * 8);
#define PG8_SA(b, h) (((b) * 2 + (h)) * HTB)
#define PG8_SB(b, h) ((4 + (b) * 2 + (h)) * HTB)
#define PG8_STG(bufoff, gptr, v0, v1) do { \
        __builtin_amdgcn_global_load_lds((const unsigned*)((const char*)(gptr) + (v0)), (LAS unsigned*)(lds + (bufoff) + ldsw), 16, 0, 0); \
        __builtin_amdgcn_global_load_lds((const unsigned*)((const char*)(gptr) + (v1)), (LAS unsigned*)(lds + (bufoff) + ldsw + 8192), 16, 0, 0); } while (0)
#define PG8_STB(b, h, kp) PG8_STG(PG8_SB(b, h), (kp) + (h) * hstepB, voffB[0], voffB[1])
#define PG8_STA_CUR(b, h, kp) do { if constexpr (GATHER) PG8_STG(PG8_SA(b, h), (kp), vg[h][0], vg[h][1]); else PG8_STG(PG8_SA(b, h), (kp) + (h) * hstepA, voffA[0], voffA[1]); } while (0)
#define PG8_STA_SEL(b, h, kp) do { if constexpr (GATHER) { const unsigned s0_ = last ? nvg[h][0] : vg[h][0], s1_ = last ? nvg[h][1] : vg[h][1]; PG8_STG(PG8_SA(b, h), (kp), s0_, s1_); } \
        else PG8_STG(PG8_SA(b, h), (kp) + (h) * hstepA, voffA[0], voffA[1]); } while (0)
#define PG8_LD16(off) (*(const LAS u32x4*)(lds + (off)))
#define PG8_LDA(dst, b, h) do { _Pragma("unroll") for (int m = 0; m < 4; ++m) { if constexpr (FP8) { const u32x4 lo_ = PG8_LD16(PG8_SA(b, h) + aoff + m * 2048), hi_ = PG8_LD16(PG8_SA(b, h) + aoff + m * 2048 + 1024); \
            dst.f[m] = __builtin_bit_cast(v8i_, __builtin_shufflevector(lo_, hi_, 0, 1, 2, 3, 4, 5, 6, 7)); } \
        else { _Pragma("unroll") for (int k = 0; k < 2; ++k) dst.f[m][k] = *(const LAS bf16x8*)(lds + PG8_SA(b, h) + aoff + m * 2048 + k * 1024); } } } while (0)
#define PG8_LDB(dst, b, h) do { _Pragma("unroll") for (int n = 0; n < 2; ++n) { if constexpr (FP8) { const u32x4 lo_ = PG8_LD16(PG8_SB(b, h) + boff + n * 2048), hi_ = PG8_LD16(PG8_SB(b, h) + boff + n * 2048 + 1024); \
            dst.f[n] = __builtin_bit_cast(v8i_, __builtin_shufflevector(lo_, hi_, 0, 1, 2, 3, 4, 5, 6, 7)); } \
        else { _Pragma("unroll") for (int k = 0; k < 2; ++k) dst.f[n][k] = *(const LAS bf16x8*)(lds + PG8_SB(b, h) + boff + n * 2048 + k * 1024); } } } while (0)
#define PG8_MMA(ai, bj, At, Bt) do { __builtin_amdgcn_s_setprio(1); _Pragma("unroll") for (int m = 0; m < 4; ++m) _Pragma("unroll") for (int n = 0; n < 2; ++n) { \
        if constexpr (FP8) asm volatile("v_mfma_scale_f32_16x16x128_f8f6f4 %0, %1, %2, %0, %3, %3 op_sel_hi:[0,0,0]" : "+v"(acc[ai][bj][m][n]) : "v"(Bt.f[n]), "v"(At.f[m]), "v"(fp8_one)); \
        else { _Pragma("unroll") for (int k = 0; k < 2; ++k) acc[ai][bj][m][n] = __builtin_amdgcn_mfma_f32_16x16x32_bf16(Bt.f[n][k], At.f[m][k], acc[ai][bj][m][n], 0, 0, 0); } } \
        __builtin_amdgcn_s_setprio(0); } while (0)
#define PG8_WAIT_V(n) asm volatile("s_waitcnt vmcnt(" #n ")" ::: "memory")
#define PG8_WAIT_L(n) asm volatile("s_waitcnt lgkmcnt(" #n ")" ::: "memory")
#define PG8_BAR __builtin_amdgcn_s_barrier()
#define PG8_SCHED __builtin_amdgcn_sched_barrier(0)
#define PG8_LOADIDX(dst, u) do { if constexpr (GATHER) { _Pragma("unroll") for (int h = 0; h < 2; ++h) _Pragma("unroll") for (int i = 0; i < 2; ++i) \
        dst[h][i] = (unsigned)(u).ridx[h * HALF + RA[i]] * (unsigned)lda + (unsigned)(CA[i] * 2); } } while (0)
    Unit cur, nxt; int ui = 0;
    if (!S.next(0, cur)) return;
#define PG8_PIN_ACC() do { _Pragma("unroll") for (int a_ = 0; a_ < 2; ++a_) _Pragma("unroll") for (int b_ = 0; b_ < 2; ++b_) \
        asm volatile("" : "+v"(acc[a_][b_][0][0]), "+v"(acc[a_][b_][0][1]), "+v"(acc[a_][b_][1][0]), "+v"(acc[a_][b_][1][1]), "+v"(acc[a_][b_][2][0]), "+v"(acc[a_][b_][2][1]), "+v"(acc[a_][b_][3][0]), "+v"(acc[a_][b_][3][1])); } while (0)

    f32x4 acc[2][2][4][2];
    E.init(acc, cur, wr, wc, fr, fq);
    typedef int v8i_ __attribute__((ext_vector_type(8)));
    typedef typename pg8::FragSel<FP8>::A4 FragA; typedef typename pg8::FragSel<FP8>::B2 FragB;
    FragA At; FragB B0, B1;
    int fp8_one = 0x7f7f7f7f; if constexpr (FP8) asm volatile("" : "+v"(fp8_one));
    unsigned vg[2][2] = {{0u, 0u}, {0u, 0u}}, nvg[2][2] = {{0u, 0u}, {0u, 0u}};
    const char* cA = cur.A; const char* cB = cur.B;
    PG8_LOADIDX(vg, cur);
    { const bool last = false; (void)last;
      PG8_STB(0, 0, cB); PG8_STB(0, 1, cB); PG8_STA_CUR(0, 0, cA); PG8_STA_CUR(0, 1, cA);
      if (wr == 1) PG8_BAR;
      PG8_WAIT_V(2); PG8_BAR;
      PG8_STB(1, 0, cB + kstep); PG8_STA_CUR(1, 0, cA + kstep); PG8_STB(1, 1, cB + kstep);
      PG8_WAIT_V(6); PG8_BAR; }
    if constexpr (Epi::INIT_LOADS) PG8_PIN_ACC();
    for (;;) {
        const bool has_next = S.next(ui + 1, nxt);
        const char* nA = has_next ? nxt.A : cA; const char* nB = has_next ? nxt.B : cB;
        if constexpr (GATHER) { if (has_next) { PG8_LOADIDX(nvg, nxt); } else { nvg[0][0] = vg[0][0]; nvg[0][1] = vg[0][1]; nvg[1][0] = vg[1][0]; nvg[1][1] = vg[1][1]; } }
        const int nt = cur.nt;
        for (int t = 0; t < nt; t += 2) {
            const bool last = (t == nt - 2);
            const char* a1 = cA + (size_t)(t + 1) * kstep;
            const char* a2 = last ? nA : cA + (size_t)(t + 2) * kstep; const char* b2 = last ? nB : cB + (size_t)(t + 2) * kstep;
            const char* a3 = a2 + kstep; const char* b3 = b2 + kstep;
            PG8_LDB(B0, 0, 0); PG8_LDB(B1, 0, 1); PG8_SCHED; PG8_LDA(At, 0, 0); PG8_STA_CUR(1, 1, a1);
            PG8_WAIT_V(8); PG8_WAIT_L(0); PG8_BAR; PG8_MMA(0, 0, At, B0); PG8_MMA(0, 1, At, B1); PG8_BAR; PG8_SCHED;
            PG8_LDA(At, 0, 1); PG8_STB(0, 0, b2); PG8_STB(0, 1, b2); PG8_STA_SEL(0, 0, a2);
            PG8_WAIT_V(8); PG8_WAIT_L(0); PG8_BAR; PG8_MMA(1, 0, At, B0); PG8_MMA(1, 1, At, B1); PG8_BAR; PG8_SCHED;
            PG8_LDB(B0, 1, 0); PG8_LDB(B1, 1, 1); PG8_SCHED; PG8_LDA(At, 1, 0); PG8_STA_SEL(0, 1, a2);
            PG8_WAIT_V(8); PG8_WAIT_L(0); PG8_BAR; PG8_MMA(0, 0, At, B0); PG8_MMA(0, 1, At, B1); PG8_BAR; PG8_SCHED;
            PG8_LDA(At, 1, 1); PG8_STB(1, 0, b3); PG8_STB(1, 1, b3); PG8_STA_SEL(1, 0, a3);
            PG8_WAIT_V(8); PG8_WAIT_L(0); PG8_BAR; PG8_MMA(1, 0, At, B0); PG8_MMA(1, 1, At, B1); PG8_BAR; PG8_SCHED;
        }
        if (wr == 0) PG8_BAR;
        if constexpr (FP8) { asm volatile("s_nop 15\n\ts_nop 15\n\ts_nop 15" ::: "memory"); PG8_PIN_ACC(); }
        E(acc, cur, wr, wc, fr, fq);
        if (!has_next) break;
        E.init(acc, nxt, wr, wc, fr, fq);
        if constexpr (Epi::INIT_LOADS) PG8_PIN_ACC();
        cur = nxt; cA = nA; cB = nB; ++ui;
        if constexpr (GATHER) { vg[0][0] = nvg[0][0]; vg[0][1] = nvg[0][1]; vg[1][0] = nvg[1][0]; vg[1][1] = nvg[1][1]; }
        if (wr == 1) PG8_BAR;
    }
    PG8_WAIT_V(0);
    PG8_BAR;
#undef PG8_SA
#undef PG8_SB
#undef PG8_STG
#undef PG8_STB
#undef PG8_STA_CUR
#undef PG8_STA_SEL
#undef PG8_LDA
#undef PG8_LD16
#undef PG8_LDB
#undef PG8_MMA
#undef PG8_WAIT_V
#undef PG8_WAIT_L
#undef PG8_BAR
#undef PG8_SCHED
#undef PG8_LOADIDX
#undef PG8_PIN_ACC
}
}

#define EPI_ZERO_INIT static constexpr bool INIT_LOADS = false; __device__ __forceinline__ void init(f32x4 (&acc)[2][2][4][2], const pg8::Unit&, int, int, int, int) const { \
        _Pragma("unroll") for (int a = 0; a < 2; ++a) _Pragma("unroll") for (int b = 0; b < 2; ++b) _Pragma("unroll") for (int m = 0; m < 4; ++m) _Pragma("unroll") for (int n = 0; n < 2; ++n) acc[a][b][m][n] = (f32x4){0.f, 0.f, 0.f, 0.f}; }
constexpr size_t WS_ROWTOK = 15 * MiB;
struct TileOrder {
    int nM, nN, nwg;
    __device__ __forceinline__ void init(int nM_, int nN_) { nM = nM_; nN = nN_; nwg = nM_ * nN_; }
    __device__ __forceinline__ void decode(int L, int& pm, int& pn) const {
        int wgid = L; { const int q = nwg / pg8::NXCD, r = nwg % pg8::NXCD, xcd = wgid % pg8::NXCD, off = wgid / pg8::NXCD; wgid = (xcd < r ? xcd * (q + 1) : r * (q + 1) + (xcd - r) * q) + off; }
        const int nig = pg8::WGM * nN, gid = wgid / nig, fm = gid * pg8::WGM, gsz = (nM - fm) < pg8::WGM ? (nM - fm) : pg8::WGM;
        pm = fm + ((wgid % nig) % gsz); pn = (wgid % nig) / gsz;
    }
};
#ifndef P1_FP8_MASK
#define P1_FP8_MASK 0x3FFFFu
#endif
constexpr unsigned FP8M = P1_FP8_MASK & 0x3ffffu;
constexpr int NF8 = __builtin_popcount(FP8M), NB16 = 18 - NF8;
__device__ __forceinline__ int nth_set(unsigned m, int n) { for (int i = 0; i < n; ++i) m &= m - 1; return __builtin_ctz(m); }
struct Sched1 {
    TileOrder o; const char* A; const char* Bt; int G, c, fp8;
    __device__ __forceinline__ bool next(int i, pg8::Unit& u) const {
        const int L = i * G + c; int pm, pn;
        if (fp8) { constexpr int NT8 = 64 * (24 + NF8), NBU = 64 * NB16 + 32;
            int L8 = L;
            if (NBU < G) { const int RB = NT8 / G, rem = NT8 - RB * G, nfree = G - NBU;
                if (c < NBU) { if (i >= RB - 1) return false; }
                else if (i >= RB) { const int e = (i - RB) * nfree + (c - NBU); if (e >= NBU + rem) return false; L8 = e < NBU ? (RB - 1) * G + e : RB * G + (e - NBU); } }
            if (L8 >= NT8) return false; o.decode(L8, pm, pn);
            u.A = A + (size_t)pm * 256 * D; u.B = Bt + (size_t)pn * 256 * D; u.nt = D / 128; pn = pn < 24 ? pn + 18 : nth_set(FP8M, pn - 24); u.aux = 1; }
        else { if (L < 64 * NB16) { o.decode(L, pm, pn); pn = nth_set(~FP8M & 0x3ffffu, pn); } else if (L < 64 * NB16 + 32) { const int r = L - 64 * NB16; pm = 64 + (r >> 2); pn = 43 + (r & 3); } else return false;
            u.A = A + (size_t)pm * 256 * D * 2; u.B = Bt + (size_t)pn * 256 * D * 2; u.nt = D / 64; u.aux = 0; }
        u.ridx = nullptr; u.pm = pm; u.pn = pn; return true;
    }
};
struct Epi1 {
    EPI_ZERO_INIT
    bf16_t* PA; unsigned char* PG8; float* GL; bf16_t* KVM;
    __device__ __forceinline__ void operator()(const f32x4 (&acc)[2][2][4][2], const pg8::Unit& u, int wr, int wc, int fr, int fq) const {
        const int pn = u.pn; int row0 = u.pm * 256 + wr * 64 + fr;
        if (pn == 42) {
            if (wc == 0) {
#pragma unroll
                for (int ai = 0; ai < 2; ++ai)
#pragma unroll
                    for (int m = 0; m < 4; ++m) { float* p = GL + (size_t)(row0 + ai * 128 + m * 16) * LDG + 8 * fq; *(f32x4*)p = acc[ai][0][m][0]; *(f32x4*)(p + 4) = acc[ai][0][m][1]; }
            }
            return;
        }
        if (pn >= 18 && pn < 42) {
            unsigned char* gb = PG8 + (pn - 18) * 256 + wc * 32 + 8 * fq;
#pragma unroll
            for (int ai = 0; ai < 2; ++ai)
#pragma unroll
                for (int m = 0; m < 4; ++m) { unsigned char* rowp = gb + (size_t)(row0 + ai * 128 + m * 16) * NPG;
#pragma unroll
                    for (int bj = 0; bj < 2; ++bj) { const f32x4 v0 = acc[ai][bj][m][0] * (1.f / WIN_SCALE), v1 = acc[ai][bj][m][1] * (1.f / WIN_SCALE); unsigned w0 = 0u, w1 = 0u;
                        w0 = __builtin_amdgcn_cvt_pk_u8_f32(fast_sigmoid(v0[0]) * 255.f, 0, w0); w0 = __builtin_amdgcn_cvt_pk_u8_f32(fast_sigmoid(v0[1]) * 255.f, 1, w0);
                        w0 = __builtin_amdgcn_cvt_pk_u8_f32(fast_sigmoid(v0[2]) * 255.f, 2, w0); w0 = __builtin_amdgcn_cvt_pk_u8_f32(fast_sigmoid(v0[3]) * 255.f, 3, w0);
                        w1 = __builtin_amdgcn_cvt_pk_u8_f32(fast_sigmoid(v1[0]) * 255.f, 0, w1); w1 = __builtin_amdgcn_cvt_pk_u8_f32(fast_sigmoid(v1[1]) * 255.f, 1, w1);
                        w1 = __builtin_amdgcn_cvt_pk_u8_f32(fast_sigmoid(v1[2]) * 255.f, 2, w1); w1 = __builtin_amdgcn_cvt_pk_u8_f32(fast_sigmoid(v1[3]) * 255.f, 3, w1);
                        *(u32x2*)(rowp + bj * 128) = (u32x2){w0, w1}; } }
            return;
        }
        bf16_t* base; int ld;
        if (pn < 18) { base = PA + pn * 256; ld = NPA; }
        else { base = KVM + (pn - 43) * 256; ld = 1024; row0 -= M; }
        base += wc * 32 + 8 * fq;
        const float sc = u.aux ? 1.f / WIN_SCALE : 1.f;
#pragma unroll
        for (int ai = 0; ai < 2; ++ai)
#pragma unroll
            for (int m = 0; m < 4; ++m) { bf16_t* rowp = base + (size_t)(row0 + ai * 128 + m * 16) * ld;
#pragma unroll
                for (int bj = 0; bj < 2; ++bj) { const f32x4 v0 = acc[ai][bj][m][0] * sc, v1 = acc[ai][bj][m][1] * sc;
                    u32x4 w; w.x = cvtpk(v0[0], v0[1]); w.y = cvtpk(v0[2], v0[3]); w.z = cvtpk(v1[0], v1[1]); w.w = cvtpk(v1[2], v1[3]);
                    *(u32x4*)(rowp + bj * 128) = w; } }
    }
};
struct Sched4 {
    TileOrder o; const char* A; const char* Bt; int G, c;
    __device__ __forceinline__ bool next(int i, pg8::Unit& u) const {
        const int it = i / 3, br = i - it * 3, L = it * G + c; if (L >= 64 * 8) return false;
        int pm, pn; o.decode(L, pm, pn);
        const int koff = br == 0 ? 0 : (br == 1 ? 1024 : 1536);
        u.A = A + ((size_t)pm * 256 * D + koff) * 2; u.B = Bt + ((size_t)pn * 256 * D + koff) * 2; u.ridx = nullptr; u.nt = br == 0 ? 16 : 8; u.pm = pm; u.pn = pn; u.aux = br; return true;
    }
};
struct Epi4 {
    EPI_ZERO_INIT
    const unsigned char* PG8; bf16_t* Z;
    __device__ __forceinline__ void operator()(const f32x4 (&acc)[2][2][4][2], const pg8::Unit& u, int wr, int wc, int fr, int fq) const {
        const int row0 = u.pm * 256 + wr * 64 + fr, col0 = u.pn * 256 + wc * 32 + 8 * fq, br = u.aux;
#pragma unroll
        for (int ai = 0; ai < 2; ++ai) {
            u32x2 gv[4][2]; u32x4 zv[4][2];
#pragma unroll
            for (int m = 0; m < 4; ++m) { const size_t row = (size_t)(row0 + ai * 128 + m * 16);
#pragma unroll
                for (int bj = 0; bj < 2; ++bj) { const int col = col0 + bj * 128; gv[m][bj] = *(const u32x2*)(PG8 + row * NPG + br * D + col);
                    if (br > 0) zv[m][bj] = *(const u32x4*)(Z + row * D + col); else zv[m][bj] = (u32x4){0u, 0u, 0u, 0u}; } }
#pragma unroll
            for (int m = 0; m < 4; ++m) { const size_t row = (size_t)(row0 + ai * 128 + m * 16);
#pragma unroll
                for (int bj = 0; bj < 2; ++bj) { const int col = col0 + bj * 128; const u32x2 g = gv[m][bj]; const u32x4 z = zv[m][bj]; const float gs = 1.f / 255.f;
                    f32x4 v0 = acc[ai][bj][m][0] * gs, v1 = acc[ai][bj][m][1] * gs;
                    v0[0] = v0[0] * (float)(g.x & 0xffu) + bf_lo(z.x); v0[1] = v0[1] * (float)((g.x >> 8) & 0xffu) + bf_hi(z.x); v0[2] = v0[2] * (float)((g.x >> 16) & 0xffu) + bf_lo(z.y); v0[3] = v0[3] * (float)(g.x >> 24) + bf_hi(z.y);
                    v1[0] = v1[0] * (float)(g.y & 0xffu) + bf_lo(z.z); v1[1] = v1[1] * (float)((g.y >> 8) & 0xffu) + bf_hi(z.z); v1[2] = v1[2] * (float)((g.y >> 16) & 0xffu) + bf_lo(z.w); v1[3] = v1[3] * (float)(g.y >> 24) + bf_hi(z.w);
                    u32x4 w; w.x = cvtpk(v0[0], v0[1]); w.y = cvtpk(v0[2], v0[3]); w.z = cvtpk(v1[0], v1[1]); w.w = cvtpk(v1[2], v1[3]);
                    *(u32x4*)(Z + row * D + col) = w; } }
        }
    }
};
struct Sched5 {
    TileOrder o; const char* A; const char* Bt; int G, c;
    __device__ __forceinline__ bool next(int i, pg8::Unit& u) const {
        const int L = i * G + c; if (L >= 64 * 8) return false;
        int pm, pn; o.decode(L, pm, pn);
        u.A = A + (size_t)pm * 256 * D * 2; u.B = Bt + (size_t)pn * 256 * D * 2; u.ridx = nullptr; u.nt = D / 64; u.pm = pm; u.pn = pn; u.aux = 0; return true;
    }
};
struct Epi5 {
    static constexpr bool INIT_LOADS = true;
    const float* X; bf16_t* O;
    __device__ __forceinline__ void init(f32x4 (&acc)[2][2][4][2], const pg8::Unit& u, int wr, int wc, int fr, int fq) const {
        const int row0 = u.pm * 256 + wr * 64 + fr, col0 = u.pn * 256 + wc * 32 + 8 * fq;
#pragma unroll
        for (int ai = 0; ai < 2; ++ai)
#pragma unroll
            for (int m = 0; m < 4; ++m) { const size_t off = (size_t)(row0 + ai * 128 + m * 16) * D + col0;
#pragma unroll
                for (int bj = 0; bj < 2; ++bj) { acc[ai][bj][m][0] = *(const f32x4*)(X + off + bj * 128); acc[ai][bj][m][1] = *(const f32x4*)(X + off + bj * 128 + 4); } }
    }
    __device__ __forceinline__ void operator()(const f32x4 (&acc)[2][2][4][2], const pg8::Unit& u, int wr, int wc, int fr, int fq) const {
        const int row0 = u.pm * 256 + wr * 64 + fr, col0 = u.pn * 256 + wc * 32 + 8 * fq;
#pragma unroll
        for (int ai = 0; ai < 2; ++ai)
#pragma unroll
            for (int m = 0; m < 4; ++m) { const size_t off = (size_t)(row0 + ai * 128 + m * 16) * D + col0;
#pragma unroll
                for (int bj = 0; bj < 2; ++bj) { const f32x4 v0 = acc[ai][bj][m][0], v1 = acc[ai][bj][m][1];
                    u32x4 w; w.x = cvtpk(v0[0], v0[1]); w.y = cvtpk(v0[2], v0[3]); w.z = cvtpk(v1[0], v1[1]); w.w = cvtpk(v1[2], v1[3]);
                    *(u32x4*)(O + off + bj * 128) = w; } }
    }
};
struct SchedMoe {
    const LAS unsigned char* blk_e; int nblk, G, c, npn_shift;
    const char* A; const char* W; const int* rowtok; bool up;
    __device__ __forceinline__ bool next(int i, pg8::Unit& u) const {
        int L; if (G == 256) L = ((i * 8 + (c & 7)) * 32 + (c >> 3)); else L = i * G + c;
        const int blk = L >> npn_shift, pn = L & ((1 << npn_shift) - 1);
        if (blk >= nblk) { if (G != 256) return false; return false; }
        const int e = blk_e[blk];
        if (up) { u.A = A; u.ridx = rowtok + blk * 256; u.B = W + ((size_t)e * 1024 + pn * 256) * D; u.nt = D / 128; }
        else    { u.A = A + (size_t)blk * 256 * DE; u.ridx = nullptr; u.B = W + ((size_t)e * D + pn * 256) * DE; u.nt = DE / 128; }
        u.pm = blk; u.pn = pn; u.aux = e; return true;
    }
};
struct Epi8 {  EPI_ZERO_INIT
    unsigned char* HID;
    __device__ __forceinline__ void operator()(const f32x4 (&acc)[2][2][4][2], const pg8::Unit& u, int wr, int wc, int fr, int fq) const {
        const int row0 = u.pm * 256 + wr * 64 + fr, col0 = u.pn * 128 + wc * 32 + 8 * fq; const float rs = 1.f / WGU_SCALE;
#pragma unroll
        for (int ai = 0; ai < 2; ++ai)
#pragma unroll
            for (int m = 0; m < 4; ++m) { float h[8];
#pragma unroll
                for (int e = 0; e < 4; ++e) { const float g0 = acc[ai][0][m][0][e] * rs, g1 = acc[ai][0][m][1][e] * rs;
                    h[e] = __builtin_amdgcn_fmed3f(g0 * fast_sigmoid(g0) * (acc[ai][1][m][0][e] * rs), -440.f, 440.f); h[4 + e] = __builtin_amdgcn_fmed3f(g1 * fast_sigmoid(g1) * (acc[ai][1][m][1][e] * rs), -440.f, 440.f); }
                *(u32x2*)(HID + (size_t)(row0 + ai * 128 + m * 16) * DE + col0) = (u32x2){pk_fp8x4(h[0], h[1], h[2], h[3]), pk_fp8x4(h[4], h[5], h[6], h[7])}; }
    }
};
constexpr float Y_SCALE = 16.f;
struct Epi9 {  EPI_ZERO_INIT
    const int* rowasg; const float* rowg; unsigned char* Y;
    __device__ __forceinline__ void operator()(const f32x4 (&acc)[2][2][4][2], const pg8::Unit& u, int wr, int wc, int fr, int fq) const {
        const int row0 = u.pm * 256 + wr * 64 + fr, col0 = u.pn * 256 + wc * 32 + 8 * fq;
        int asg[2][4]; float g[2][4];
#pragma unroll
        for (int ai = 0; ai < 2; ++ai)
#pragma unroll
            for (int m = 0; m < 4; ++m) { const int slot = row0 + ai * 128 + m * 16; asg[ai][m] = rowasg[slot]; g[ai][m] = rowg[slot] * (Y_SCALE / WD_SCALE); }
#pragma unroll
        for (int ai = 0; ai < 2; ++ai)
#pragma unroll
            for (int m = 0; m < 4; ++m) {
                if (asg[ai][m] >= 0) { unsigned char* yp = Y + (size_t)asg[ai][m] * D + col0; const float gg = g[ai][m];
#pragma unroll
                    for (int bj = 0; bj < 2; ++bj) { f32x4 v0 = acc[ai][bj][m][0] * gg, v1 = acc[ai][bj][m][1] * gg;
#pragma unroll
                        for (int e = 0; e < 4; ++e) { v0[e] = __builtin_amdgcn_fmed3f(v0[e], -440.f, 440.f); v1[e] = __builtin_amdgcn_fmed3f(v1[e], -440.f, 440.f); }
                        int w0 = 0, w1 = 0;
                        w0 = __builtin_amdgcn_cvt_pk_fp8_f32(v0[0], v0[1], w0, false); w0 = __builtin_amdgcn_cvt_pk_fp8_f32(v0[2], v0[3], w0, true);
                        w1 = __builtin_amdgcn_cvt_pk_fp8_f32(v1[0], v1[1], w1, false); w1 = __builtin_amdgcn_cvt_pk_fp8_f32(v1[2], v1[3], w1, true);
                        *(u32x2*)(yp + bj * 128) = (u32x2){(unsigned)w0, (unsigned)w1}; } } }
    }
};

struct Frame {
    LAS unsigned char* lds; int tid, lane, wave, G, gw, NGW;
    float* out; unsigned char* ws;
    __device__ __forceinline__ const float* in(int i) const { return ((const float* const __attribute__((address_space(4)))*)__builtin_amdgcn_kernarg_segment_ptr())[i]; }
};
#define LDS_WAIT() asm volatile("s_waitcnt lgkmcnt(0)" ::: "memory")
template <class SrcCol, class DstRow>
__device__ __forceinline__ void tr_item(const float* W, size_t ldw, int k0, int n0, const SrcCol& sc, bf16_t* WT, size_t ldt, int kd0, const DstRow& dr, LAS float* scr, int lane) {
    const int c = sc(n0 + (lane & 31));
#pragma unroll 8
    for (int i = 0; i < 32; ++i) { const int kk = 2 * i + (lane >> 5); scr[kk * 33 + (lane & 31)] = c >= 0 ? W[(size_t)(k0 + kk) * ldw + c] : 0.f; }
    LDS_WAIT(); asm volatile("" ::: "memory");
    const int c8 = lane & 7;
#pragma unroll
    for (int j = 0; j < 4; ++j) { const int n = (lane >> 3) + 8 * j; const LAS float* s = scr + (8 * c8) * 33 + n;
        u32x4 o; o.x = cvtpk(s[0 * 33], s[1 * 33]); o.y = cvtpk(s[2 * 33], s[3 * 33]); o.z = cvtpk(s[4 * 33], s[5 * 33]); o.w = cvtpk(s[6 * 33], s[7 * 33]);
        *(u32x4*)(WT + (size_t)dr(n0 + n) * ldt + kd0 + k0 + 8 * c8) = o; }
    LDS_WAIT(); asm volatile("" ::: "memory");
}
struct IdCol { __device__ __forceinline__ int operator()(int n) const { return n; } };
struct OffRow { int off; __device__ __forceinline__ int operator()(int n) const { return off + n; } };
struct WinCol {
    __device__ __forceinline__ int operator()(int n) const {
        if (n < 2560) return n; if (n < 4096) return 2584 + (n - 2560); if (n < 4608) return 4124 + (n - 4096); if (n < 10752) return 4636 + (n - 4608);
        if (n < 10776) return 2560 + (n - 10752); if (n < 10780) return 4120 + (n - 10776); return -1; }
};
struct GuRow { int up; __device__ __forceinline__ int operator()(int j) const { return (j >> 7) * 256 + up * 128 + (j & 127); } };
__device__ __forceinline__ void rms_row_bf16(const float* xrow, const float* gain, bf16_t* orow, int lane) {
    f32x4 v[8]; float s = 0.f;
#pragma unroll
    for (int j = 0; j < 8; ++j) { v[j] = *(const f32x4*)(xrow + 4 * lane + 256 * j); s += (v[j].x * v[j].x + v[j].y * v[j].y) + (v[j].z * v[j].z + v[j].w * v[j].w); }
    const float rstd = __builtin_amdgcn_rsqf(wave_sum(s) * (1.f / D) + RMS_EPS);
#pragma unroll
    for (int j = 0; j < 8; ++j) { const f32x4 g = *(const f32x4*)(gain + 4 * lane + 256 * j);
        u32x2 o; o.x = cvtpk(v[j].x * rstd * g.x, v[j].y * rstd * g.y); o.y = cvtpk(v[j].z * rstd * g.z, v[j].w * rstd * g.w);
        *(u32x2*)(orow + 4 * lane + 256 * j) = o; }
}
__device__ __forceinline__ void rms_row_both(const float* xrow, const float* gain, bf16_t* orow, unsigned char* orow8, int lane) {
    f32x4 v[8]; float s = 0.f;
#pragma unroll
    for (int j = 0; j < 8; ++j) { v[j] = *(const f32x4*)(xrow + 4 * lane + 256 * j); s += (v[j].x * v[j].x + v[j].y * v[j].y) + (v[j].z * v[j].z + v[j].w * v[j].w); }
    const float rstd = __builtin_amdgcn_rsqf(wave_sum(s) * (1.f / D) + RMS_EPS);
#pragma unroll
    for (int j = 0; j < 8; ++j) { const f32x4 g = *(const f32x4*)(gain + 4 * lane + 256 * j); const float a = v[j].x * rstd * g.x, b = v[j].y * rstd * g.y, c = v[j].z * rstd * g.z, d = v[j].w * rstd * g.w;
        u32x2 o; o.x = cvtpk(a, b); o.y = cvtpk(c, d); *(u32x2*)(orow + 4 * lane + 256 * j) = o;
        *(unsigned*)(orow8 + 4 * lane + 256 * j) = pk_fp8x4(a, b, c, d); }
}
__device__ __forceinline__ float dot2c_bf16(float acc, unsigned a, unsigned b) { asm("v_dot2c_f32_bf16 %0, %1, %2" : "+v"(acc) : "v"(a), "v"(b)); return acc; }
template <bool WRITE_BF16>
__device__ __forceinline__ void rms_row_logits(const float* xrow, const float* gain, bf16_t* orow, unsigned char* orow8, float* glrow, const LAS unsigned char* WL, int lane) {
    f32x4 v[8]; float s = 0.f;
#pragma unroll
    for (int j = 0; j < 8; ++j) { v[j] = *(const f32x4*)(xrow + 4 * lane + 256 * j); s += (v[j].x * v[j].x + v[j].y * v[j].y) + (v[j].z * v[j].z + v[j].w * v[j].w); }
    const float rstd = __builtin_amdgcn_rsqf(wave_sum(s) * (1.f / D) + RMS_EPS);
    u32x2 hb[8];
#pragma unroll
    for (int j = 0; j < 8; ++j) { const f32x4 g = *(const f32x4*)(gain + 4 * lane + 256 * j); const float a = v[j].x * rstd * g.x, b = v[j].y * rstd * g.y, c = v[j].z * rstd * g.z, d = v[j].w * rstd * g.w;
        hb[j].x = cvtpk(a, b); hb[j].y = cvtpk(c, d); if (WRITE_BF16) *(u32x2*)(orow + 4 * lane + 256 * j) = hb[j];
        *(unsigned*)(orow8 + 4 * lane + 256 * j) = pk_fp8x4(a, b, c, d); }
    float lg[32];
#pragma unroll
    for (int c = 0; c < 32; ++c) lg[c] = 0.f;
#pragma unroll
    for (int j = 0; j < 8; ++j) {
        u32x2 w[28];
#pragma unroll
        for (int c = 0; c < 28; ++c) w[c] = *(const LAS u32x2*)(WL + (size_t)(c * 2048 + 4 * lane + 256 * j) * 2);
        asm volatile("s_waitcnt lgkmcnt(0)" ::: "memory"); __builtin_amdgcn_sched_barrier(0);
#pragma unroll
        for (int c = 0; c < 28; ++c) { lg[c] = dot2c_bf16(lg[c], hb[j].x, w[c].x); lg[c] = dot2c_bf16(lg[c], hb[j].y, w[c].y); }
        __builtin_amdgcn_sched_barrier(0); }
    float r1[16];
#pragma unroll
    for (int i = 0; i < 16; ++i) { const auto sw = __builtin_amdgcn_permlane32_swap(__float_as_uint(lg[i]), __float_as_uint(lg[i + 16]), false, false); r1[i] = __uint_as_float(sw[0]) + __uint_as_float(sw[1]); }
    float r2[8];
#pragma unroll
    for (int i = 0; i < 8; ++i) { const auto sw = __builtin_amdgcn_permlane16_swap(__float_as_uint(r1[i]), __float_as_uint(r1[i + 8]), false, false); r2[i] = __uint_as_float(sw[0]) + __uint_as_float(sw[1]); }
#pragma unroll
    for (int i = 0; i < 8; ++i) {
        float t = r2[i];
        t += __builtin_bit_cast(float, __builtin_amdgcn_update_dpp(0, __builtin_bit_cast(int, t), 0x128, 0xF, 0xF, false));
        t += __builtin_bit_cast(float, __builtin_amdgcn_update_dpp(0, __builtin_bit_cast(int, t), 0x124, 0xF, 0xF, false));
        t += __builtin_bit_cast(float, __builtin_amdgcn_update_dpp(0, __builtin_bit_cast(int, t), 0x122, 0xF, 0xF, false));
        t += __builtin_bit_cast(float, __builtin_amdgcn_update_dpp(0, __builtin_bit_cast(int, t), 0x121, 0xF, 0xF, false));
        r2[i] = t; }
    if ((lane & 15) == 0) { float* p = glrow + 8 * (lane >> 4); *(f32x4*)p = (f32x4){r2[0], r2[1], r2[2], r2[3]}; *(f32x4*)(p + 4) = (f32x4){r2[4], r2[5], r2[6], r2[7]}; }
}
enum { I_X = 0, I_MEM, I_NORM_ATTN_G, I_W_IN, I_PE_K, I_W_CK, I_PE_V, I_W_CV, I_NSA_Q_G, I_NSA_K_G, I_REL_BIAS, I_FOX_B_F, I_FOX_Q_G, I_FOX_K_G, I_NORM_MEM_G, I_W_MEM_KV,
       I_MEM_Q_G, I_MEM_K_G, I_W_O_NSA, I_W_O_FOX, I_W_O_MEM, I_W_OUT, I_NORM_FFN_G, I_W_ROUTER, I_ROUTER_BIAS, I_WE_GATE, I_WE_UP, I_WE_DOWN, I_WS_GATE, I_WS_UP, I_WS_DOWN, N_IN };

struct TrDesc { const float* src; bf16_t* dst; unsigned ldw, ldt; };
__device__ __forceinline__ TrDesc tr_decode(const Frame& F, int t) {
    unsigned char* ws = F.ws; TrDesc d;
    bf16_t* WinT = (bf16_t*)(ws + WS_WINT); bf16_t* WkvT = WinT + (size_t)NPAD * D; bf16_t* WoT = (bf16_t*)(ws + WS_WOT);
    bf16_t* Wgu = (bf16_t*)(ws + WS_WGU); bf16_t* Wd = (bf16_t*)(ws + WS_WD);
    constexpr int T0 = 16 * 2 * NB16, T1 = T0 + 128, T2 = T1 + 128, T3 = T2 + 64, T4 = T3 + 64, T5 = T4 + 256, T6 = T5 + 32, T7 = T6 + 32, T8 = T7 + 65 * 64, T9 = T8 + 65 * 64;
    if (t < T0) { constexpr int NU = NB16 ? 2 * NB16 : 1; const int kt = t / NU, nt = t - kt * NU, n0 = 256 * nth_set(~FP8M & 0x3ffffu, nt >> 1) + 128 * (nt & 1); const int sc = WinCol{}(n0);
        d.src = F.in(I_W_IN) + (size_t)(128 * kt) * W_IN_COLS + sc; d.ldw = W_IN_COLS; d.dst = WinT + (size_t)n0 * D + 128 * kt; d.ldt = D; }
    else if (t < T1) { const int r = t - T0, kt = r >> 3, nt = r & 7; d.src = F.in(I_W_MEM_KV) + (size_t)(128 * kt) * 1024 + 128 * nt; d.ldw = 1024; d.dst = WkvT + (size_t)(128 * nt) * D + 128 * kt; d.ldt = D; }
    else if (t < T2) { const int r = t - T1, kt = r >> 4, nt = r & 15; d.src = F.in(I_W_O_NSA) + (size_t)(128 * kt) * D + 128 * nt; d.ldw = D; d.dst = WoT + (size_t)(128 * nt) * D + 128 * kt; d.ldt = D; }
    else if (t < T4) { const int mm = t >= T3, r = t - (mm ? T3 : T2), kt = r >> 4, nt = r & 15; d.src = F.in(mm ? I_W_O_MEM : I_W_O_FOX) + (size_t)(128 * kt) * D + 128 * nt; d.ldw = D; d.dst = WoT + (size_t)(128 * nt) * D + (mm ? 1536 : 1024) + 128 * kt; d.ldt = D; }
    else if (t < T5) { const int r = t - T4, kt = r >> 4, nt = r & 15; d.src = F.in(I_W_OUT) + (size_t)(128 * kt) * D + 128 * nt; d.ldw = D; d.dst = (bf16_t*)(ws + WS_WOUTT) + (size_t)(128 * nt) * D + 128 * kt; d.ldt = D; }
    else if (t < T7) { const int v = t >= T6, kt = t - (v ? T6 : T5); d.src = F.in(v ? I_W_CV : I_W_CK) + (size_t)(128 * kt) * 128; d.ldw = 128; d.dst = (bf16_t*)(ws + (v ? WS_WCV : WS_WCK)) + 128 * kt; d.ldt = 4096; }
    else if (t < T8) { const int r = t - T7, e = r >> 6, rr = r & 63, kt = rr >> 2, nt = rr & 3, up = 0;
        const float* W = e < NE ? F.in(I_WE_GATE) + (size_t)e * D * DE : F.in(I_WS_GATE);
        d.src = W + (size_t)(128 * kt) * DE + 128 * nt; d.ldw = DE; d.dst = Wgu + ((size_t)e * 1024 + 256 * nt + 128 * up) * D + 128 * kt; d.ldt = D; }
    else if (t < T9) { const int r = t - T8, e = r >> 6, rr = r & 63, kt = rr >> 2, nt = rr & 3, up = 1;
        const float* W = e < NE ? F.in(I_WE_UP) + (size_t)e * D * DE : F.in(I_WS_UP);
        d.src = W + (size_t)(128 * kt) * DE + 128 * nt; d.ldw = DE; d.dst = Wgu + ((size_t)e * 1024 + 256 * nt + 128 * up) * D + 128 * kt; d.ldt = D; }
    else { const int r = t - T9, e = r >> 6, rr = r & 63, kt = rr >> 4, nt = rr & 15;
        const float* W = e < NE ? F.in(I_WE_DOWN) + (size_t)e * DE * D : F.in(I_WS_DOWN);
        d.src = W + (size_t)(128 * kt) * D + 128 * nt; d.ldw = D; d.dst = Wd + ((size_t)e * D + 128 * nt) * DE + 128 * kt; d.ldt = DE; }
    return d;
}
constexpr int TR_NTILES = 16 * 84 + 128 + 128 + 64 + 64 + 256 + 32 + 32 + 3 * 65 * 64;
__device__ __forceinline__ void tr_load(const TrDesc& d, f32x4 (&v)[8], int wave, int lane) {
#pragma unroll
    for (int i = 0; i < 4; ++i) { const int q = wave + 8 * i, n4 = (q & 3) * 8 + (lane & 7), kp = (q >> 2) * 8 + (lane >> 3);
        const float* p = d.src + (size_t)(2 * kp) * d.ldw + 4 * n4; v[2 * i] = __builtin_nontemporal_load((const f32x4*)p); v[2 * i + 1] = __builtin_nontemporal_load((const f32x4*)(p + d.ldw)); }
}
__device__ __forceinline__ void tr_to_lds(const f32x4 (&v)[8], LAS unsigned* T32, int wave, int lane) {
#pragma unroll
    for (int i = 0; i < 4; ++i) { const int q = wave + 8 * i, n4 = (q & 3) * 8 + (lane & 7), kp = (q >> 2) * 8 + (lane >> 3);
#pragma unroll
        for (int e = 0; e < 4; ++e) T32[(4 * n4 + e) * 65 + kp] = cvtpk(v[2 * i][e], v[2 * i + 1][e]); }
}
__device__ __forceinline__ void tr_from_lds(const TrDesc& d, const LAS unsigned* T32, int wave, int lane) {
    const int c = lane & 15, nn = lane >> 4;
#pragma unroll
    for (int i = 0; i < 4; ++i) { const int n = wave * 16 + 4 * i + nn; const LAS unsigned* r = T32 + n * 65 + 4 * c;
        const u32x4 o = {r[0], r[1], r[2], r[3]};
        __builtin_nontemporal_store(o, (u32x4*)(d.dst + (size_t)n * d.ldt + 8 * c)); }
}
constexpr int TR_FIRST_EXPERT = 16 * 2 * NB16 + 128 + 128 + 64 + 64 + 256 + 32 + 32;
constexpr int TR8W_NTILES = 16 * (48 + 2 * NF8);
struct Tr8Desc { const float* src; unsigned char* dst; unsigned ldw, ldt; float scale; };
__device__ __forceinline__ Tr8Desc tr8_decode(const Frame& F, int t) {
    unsigned char* ws = F.ws; Tr8Desc d; unsigned char* Wgu = ws + WS_WGU; unsigned char* Wd = ws + WS_WD;
    constexpr int TG = 65 * 64;
    if (t < 2 * TG) { const int up = t >= TG, r = t - (up ? TG : 0), e = r >> 6, rr = r & 63, kt = rr >> 2, nt = rr & 3;
        const float* W = e < NE ? F.in(up ? I_WE_UP : I_WE_GATE) + (size_t)e * D * DE : F.in(up ? I_WS_UP : I_WS_GATE);
        d.src = W + (size_t)(128 * kt) * DE + 128 * nt; d.ldw = DE; d.dst = Wgu + ((size_t)e * 1024 + 256 * nt + 128 * up) * D + 128 * kt; d.ldt = D; d.scale = WGU_SCALE; }
    else { const int r = t - 2 * TG, e = r >> 6, rr = r & 63, kt = rr >> 4, nt = rr & 15;
        const float* W = e < NE ? F.in(I_WE_DOWN) + (size_t)e * DE * D : F.in(I_WS_DOWN);
        d.src = W + (size_t)(128 * kt) * D + 128 * nt; d.ldw = D; d.dst = Wd + ((size_t)e * D + 128 * nt) * DE + 128 * kt; d.ldt = DE; d.scale = WD_SCALE; }
    return d;
}
__device__ __forceinline__ Tr8Desc tr8w_decode(const Frame& F, int t) {
    Tr8Desc d; d.scale = WIN_SCALE; d.ldt = D; constexpr int NU = 48 + 2 * NF8; const int kt = t / NU, nt = t - kt * NU, n0 = nt < 48 ? 4608 + 128 * nt : 256 * nth_set(FP8M, (nt - 48) >> 1) + 128 * (nt & 1); const int sc = WinCol{}(n0);
    d.src = F.in(I_W_IN) + (size_t)(128 * kt) * W_IN_COLS + sc; d.ldw = W_IN_COLS; d.dst = F.ws + WS_WIN8 + (size_t)(128 * nt) * D + 128 * kt;
    return d;
}
__device__ __forceinline__ void tr8_load(const Tr8Desc& d, f32x4 (&v)[8], int wave, int lane) {
#pragma unroll
    for (int i = 0; i < 2; ++i) { const int q = wave + 8 * i, n4 = (q & 3) * 8 + (lane & 7), kq = (q >> 2) * 8 + (lane >> 3);
        const float* p = d.src + (size_t)(4 * kq) * d.ldw + 4 * n4;
#pragma unroll
        for (int r = 0; r < 4; ++r) v[4 * i + r] = __builtin_nontemporal_load((const f32x4*)(p + (size_t)r * d.ldw)); }
}
__device__ __forceinline__ void tr8_to_lds(const f32x4 (&v)[8], float sc, LAS unsigned* T32, int wave, int lane) {
#pragma unroll
    for (int i = 0; i < 2; ++i) { const int q = wave + 8 * i, n4 = (q & 3) * 8 + (lane & 7), kq = (q >> 2) * 8 + (lane >> 3);
#pragma unroll
        for (int e = 0; e < 4; ++e) T32[(4 * n4 + e) * 33 + kq] = pk_fp8x4(v[4 * i][e] * sc, v[4 * i + 1][e] * sc, v[4 * i + 2][e] * sc, v[4 * i + 3][e] * sc); }
}
__device__ __forceinline__ void tr8_from_lds(const Tr8Desc& d, const LAS unsigned* T32, int wave, int lane) {
    const int c = lane & 7, nn = lane >> 3;
#pragma unroll
    for (int i = 0; i < 2; ++i) { const int n = wave * 16 + 8 * i + nn; const LAS unsigned* r = T32 + n * 33 + 4 * c;
        const u32x4 o = {r[0], r[1], r[2], r[3]};
        __builtin_nontemporal_store(o, (u32x4*)(d.dst + (size_t)n * d.ldt + 16 * c)); }
}
__device__ __forceinline__ void conv_batch(const Frame& F, int first, int end) {
    constexpr int NT8 = 3 * 65 * 64;
    if (end > NT8) end = NT8;
    if (first >= end) return;
    LAS unsigned* I0 = (LAS unsigned*)F.lds; LAS unsigned* I1 = I0 + 128 * 33; const int lane = F.lane;
    f32x4 r0[8], r1[8], r2[8], r3[8];
    int t = first;
    tr8_load(tr8_decode(F, t), r0, F.wave, lane);
    if (t + 1 < end) tr8_load(tr8_decode(F, t + 1), r1, F.wave, lane);
    if (t + 2 < end) tr8_load(tr8_decode(F, t + 2), r2, F.wave, lane);
    if (t + 3 < end) tr8_load(tr8_decode(F, t + 3), r3, F.wave, lane);
    __syncthreads();
    tr8_to_lds(r0, tr8_decode(F, t).scale, I0, F.wave, lane);
    __syncthreads();
#define CB_STEP(RF, RN, IC, IN) { \
        if (t + 4 < end) tr8_load(tr8_decode(F, t + 4), RF, F.wave, lane); \
        if (t + 1 < end) tr8_to_lds(RN, tr8_decode(F, t + 1).scale, IN, F.wave, lane); \
        tr8_from_lds(tr8_decode(F, t), IC, F.wave, lane); \
        __syncthreads(); \
        if (++t >= end) break; }
    for (;;) {
        CB_STEP(r0, r1, I0, I1)
        CB_STEP(r1, r2, I1, I0)
        CB_STEP(r2, r3, I0, I1)
        CB_STEP(r3, r0, I1, I0)
    }
#undef CB_STEP
}

namespace att {
constexpr int SHM = 16384;
constexpr int L_V = 0, L_K = 3 * SHM;
constexpr int L_WS = 5 * SHM;
constexpr int L_TBL = L_WS + 2048;
constexpr int L_SEL = L_TBL + 8 * 132 * 4;
constexpr int L_NIB = L_SEL + 512;
constexpr int L_CUM = L_SEL + 1024;
constexpr int L_IMP = L_CUM;
constexpr int L_ORD = L_IMP + 32768;
constexpr int L_Q = L_ORD + 2048;
constexpr int L_END = L_Q + 64;
static_assert(L_END <= RING_BYTES, "attention LDS map");
__constant__ unsigned char T5B[128] = {0, 1, 2, 3, 4, 5, 6, 7, 8, 9, 10, 11, 12, 13, 14, 15, 16, 16, 16, 17, 17, 18, 18, 18, 19, 19, 19, 20, 20, 20, 20, 21, 21, 21, 21, 22, 22, 22, 22, 22, 23, 23, 23, 23, 23, 23, 24, 24, 24, 24, 24, 24, 25, 25, 25, 25, 25, 25, 25, 26, 26, 26, 26, 26, 26, 26, 26, 27, 27, 27, 27, 27, 27, 27, 27, 27, 27, 28, 28, 28, 28, 28, 28, 28, 28, 28, 28, 29, 29, 29, 29, 29, 29, 29, 29, 29, 29, 29, 29, 30, 30, 30, 30, 30, 30, 30, 30, 30, 30, 30, 30, 30, 30, 31, 31, 31, 31, 31, 31, 31, 31, 31, 31, 31, 31, 31, 31, 31};

#define KSWZ(row, colB) ((row) * 256 + ((colB) ^ (((row) & 7) << 4)))
#define SBAR() __builtin_amdgcn_sched_barrier(0)
__device__ __forceinline__ int v_st(int k, int c) { const int kk = (k & ~0xC) | ((k & 4) << 1) | ((k & 8) >> 1); return ((kk >> 3) * 4 + (c >> 5)) * 512 + ((kk & 7) * 32 + (c & 31)) * 2; }
__device__ __forceinline__ int v_rd_base(int lane) { return ((lane & 3) << 3) | (((lane >> 2) & 3) << 6) | (((lane >> 4) & 1) << 5) | (((lane >> 5) & 1) << 8); }
__device__ __forceinline__ int crow(int r, int hi) { return (r & 3) + 8 * (r >> 2) + 4 * hi; }
__device__ __forceinline__ float pswap_max(float v) { auto rr = __builtin_amdgcn_permlane32_swap(__float_as_uint(v), __float_as_uint(v), false, false); return fmaxf(__uint_as_float(rr[0]), __uint_as_float(rr[1])); }
__device__ __forceinline__ float pswap_sum(float v) { auto rr = __builtin_amdgcn_permlane32_swap(__float_as_uint(v), __float_as_uint(v), false, false); return __uint_as_float(rr[0]) + __uint_as_float(rr[1]); }

__device__ __forceinline__ void qkt(f32x16& p0, f32x16& p1, const LAS char* Kb, int r32, int hi, const bf16x8 (&qr)[8]) {
    const LAS char* kb[4];
#pragma unroll
    for (int dd = 0; dd < 4; ++dd) kb[dd] = Kb + KSWZ(r32, (dd * 16 + hi * 8) * 2);
#pragma unroll
    for (int d0 = 0; d0 < 8; ++d0) { const LAS char* a = kb[d0 & 3] + (d0 >> 2) * 128;
        const bf16x8 b0 = *(const LAS bf16x8*)a;
        const bf16x8 b1 = *(const LAS bf16x8*)(a + 32 * 256);
        p0 = __builtin_amdgcn_mfma_f32_32x32x16_bf16(b0, qr[d0], p0, 0, 0, 0);
        p1 = __builtin_amdgcn_mfma_f32_32x32x16_bf16(b1, qr[d0], p1, 0, 0, 0);
#ifdef QKT_SPLIT
        if ((d0 & (QKT_SPLIT - 1)) == QKT_SPLIT - 1 && d0 != 7) SBAR();
#endif
    }
}
__device__ __forceinline__ void pv_tile(f32x16 (&o)[4], int vb, bf16x8 pa0, bf16x8 pa1, bf16x8 pa2, bf16x8 pa3) {
#define TRRD(dst, off) asm volatile("ds_read_b64_tr_b16 %0, %1 offset:%2" : "=&v"(dst) : "v"(vb), "i"(off) : "memory")
#define PV_D0(d0) do { s16x4 l0, l1, l2, l3, h0, h1, h2, h3; constexpr int b_ = (d0) * 512; \
        TRRD(l0, b_); TRRD(h0, b_ + 2048); TRRD(l1, b_ + 4096); TRRD(h1, b_ + 6144); TRRD(l2, b_ + 8192); TRRD(h2, b_ + 10240); TRRD(l3, b_ + 12288); TRRD(h3, b_ + 14336); \
        asm volatile("s_waitcnt lgkmcnt(0)" ::: "memory"); SBAR(); \
        o[d0] = __builtin_amdgcn_mfma_f32_32x32x16_bf16(pa0, (bf16x8){l0[0], l0[1], l0[2], l0[3], h0[0], h0[1], h0[2], h0[3]}, o[d0], 0, 0, 0); \
        o[d0] = __builtin_amdgcn_mfma_f32_32x32x16_bf16(pa1, (bf16x8){l1[0], l1[1], l1[2], l1[3], h1[0], h1[1], h1[2], h1[3]}, o[d0], 0, 0, 0); \
        o[d0] = __builtin_amdgcn_mfma_f32_32x32x16_bf16(pa2, (bf16x8){l2[0], l2[1], l2[2], l2[3], h2[0], h2[1], h2[2], h2[3]}, o[d0], 0, 0, 0); \
        o[d0] = __builtin_amdgcn_mfma_f32_32x32x16_bf16(pa3, (bf16x8){l3[0], l3[1], l3[2], l3[3], h3[0], h3[1], h3[2], h3[3]}, o[d0], 0, 0, 0); } while (0)
    PV_D0(0); PV_D0(1); PV_D0(2); PV_D0(3);
#undef PV_D0
#undef TRRD
}
__device__ __forceinline__ void pack_p(const f32x16& p0, const f32x16& p1, bf16x8& pa0, bf16x8& pa1, bf16x8& pa2, bf16x8& pa3) {
#define PK4(P, B_, OUT) do { unsigned a0 = cvtpk(P[B_+0], P[B_+1]), a1 = cvtpk(P[B_+2], P[B_+3]); \
        unsigned b0 = cvtpk(P[B_+4], P[B_+5]), b1 = cvtpk(P[B_+6], P[B_+7]); \
        auto r0 = __builtin_amdgcn_permlane32_swap(a0, b0, false, false); auto r1 = __builtin_amdgcn_permlane32_swap(a1, b1, false, false); \
        u32x4 w = {r0[0], r1[0], r0[1], r1[1]}; OUT = __builtin_bit_cast(bf16x8, w); } while (0)
    PK4(p0, 0, pa0); PK4(p0, 8, pa1); PK4(p1, 0, pa2); PK4(p1, 8, pa3);
#undef PK4
}
__device__ __forceinline__ void bcast_rows(float (&f)[16], float v, LAS float* ws, int r32, int hi) {
    if (hi == 0) ws[r32] = v;
    asm volatile("s_waitcnt lgkmcnt(0)" ::: "memory");
#pragma unroll
    for (int q = 0; q < 4; ++q) { const f32x4 t = *(const LAS f32x4*)(ws + 8 * q + 4 * hi); f[4 * q] = t[0]; f[4 * q + 1] = t[1]; f[4 * q + 2] = t[2]; f[4 * q + 3] = t[3]; }
    asm volatile("s_waitcnt lgkmcnt(0)" ::: "memory");
}
struct Ctx {
    LAS char* lds; int tid, wid, lane, r32, hi;
    int trow;
    int qlo;
};
struct DmaOff { unsigned k, v0, v1; };
__device__ __forceinline__ DmaOff dma_off(int wid, int lane, size_t ld) {
    DmaOff d; const int kr = 4 * wid + (lane >> 4), kc = (lane & 15) ^ (kr & 7);
    d.k = (unsigned)(kr * ld + kc * 8) * 2u;
#pragma unroll
    for (int t = 0; t < 2; ++t) { const int sub = 2 * (wid + 8 * t) + (lane >> 5), kk = (sub >> 2) * 8 + ((lane & 31) >> 2), k = (kk & ~0xC) | ((kk & 4) << 1) | ((kk & 8) >> 1), c0 = (sub & 3) * 32 + (lane & 3) * 8;
        const unsigned o = (unsigned)(k * ld + c0) * 2u; if (t == 0) d.v0 = o; else d.v1 = o; }
    return d;
}
__device__ __forceinline__ void dma_tile(const DmaOff& d, const bf16_t* Kg, const bf16_t* Vg, size_t ld, LAS char* lds, int buf, int vbuf, int wid) {
    const char* kp = (const char*)Kg; const char* vp = (const char*)Vg;
    __builtin_amdgcn_global_load_lds((const unsigned*)(kp + d.k), (LAS unsigned*)(lds + L_K + buf * SHM + wid * 1024), 16, 0, 0);
    __builtin_amdgcn_global_load_lds((const unsigned*)(kp + d.k + 32 * ld * 2), (LAS unsigned*)(lds + L_K + buf * SHM + (wid + 8) * 1024), 16, 0, 0);
    __builtin_amdgcn_global_load_lds((const unsigned*)(vp + d.v0), (LAS unsigned*)(lds + L_V + vbuf * SHM + wid * 1024), 16, 0, 0);
    __builtin_amdgcn_global_load_lds((const unsigned*)(vp + d.v1), (LAS unsigned*)(lds + L_V + vbuf * SHM + (wid + 8) * 1024), 16, 0, 0);
}
__device__ __forceinline__ void dma_tile_v(const DmaOff& d, const bf16_t* Kg, const bf16_t* Vg, size_t ld, LAS char* lds, int kbuf, int voff, int wid) {
    const char* kp = (const char*)Kg; const char* vp = (const char*)Vg;
    __builtin_amdgcn_global_load_lds((const unsigned*)(kp + d.k), (LAS unsigned*)(lds + L_K + kbuf * SHM + wid * 1024), 16, 0, 0);
    __builtin_amdgcn_global_load_lds((const unsigned*)(kp + d.k + 32 * ld * 2), (LAS unsigned*)(lds + L_K + kbuf * SHM + (wid + 8) * 1024), 16, 0, 0);
    __builtin_amdgcn_global_load_lds((const unsigned*)(vp + d.v0), (LAS unsigned*)(lds + L_V + voff + wid * 1024), 16, 0, 0);
    __builtin_amdgcn_global_load_lds((const unsigned*)(vp + d.v1), (LAS unsigned*)(lds + L_V + voff + (wid + 8) * 1024), 16, 0, 0);
}
#define DMA_WAIT() asm volatile("s_waitcnt vmcnt(0)" ::: "memory")
constexpr float DEFER_THR = 8.f;
__device__ __forceinline__ void qkt_half(f32x16& p, const LAS char* Kb, int r32, int hi, const bf16x8 (&qr)[8], bool zero) {
    const LAS char* kb[4];
#pragma unroll
    for (int dd = 0; dd < 4; ++dd) kb[dd] = Kb + KSWZ(r32, (dd * 16 + hi * 8) * 2);
    { const bf16x8 b = *(const LAS bf16x8*)(kb[0]);
      if (zero) p = __builtin_amdgcn_mfma_f32_32x32x16_bf16(b, qr[0], (f32x16){0.f, 0.f, 0.f, 0.f, 0.f, 0.f, 0.f, 0.f, 0.f, 0.f, 0.f, 0.f, 0.f, 0.f, 0.f, 0.f}, 0, 0, 0);
      else p = __builtin_amdgcn_mfma_f32_32x32x16_bf16(b, qr[0], p, 0, 0, 0); }
#pragma unroll
    for (int d0 = 1; d0 < 8; ++d0) { const bf16x8 b = *(const LAS bf16x8*)(kb[d0 & 3] + (d0 >> 2) * 128);
        p = __builtin_amdgcn_mfma_f32_32x32x16_bf16(b, qr[d0], p, 0, 0, 0); }
}
__device__ __forceinline__ float max3f(float a, float b, float c) { float r; asm("v_max3_f32 %0, %1, %2, %3" : "=v"(r) : "v"(a), "v"(b), "v"(c)); return r; }
__device__ __forceinline__ bool sm_half(f32x16& p, float& m_reg, float& l_reg, float& alpha, bf16x8& pa0, bf16x8& pa1, float brow) {
    float pmax = max3f(p[0], p[1], p[2]);
#pragma unroll
    for (int r = 3; r < 15; r += 2) pmax = max3f(pmax, p[r], p[r + 1]);
    pmax = max3f(pmax, p[15], p[15]);
    { const auto rr = __builtin_amdgcn_permlane32_swap(__float_as_uint(pmax), __float_as_uint(pmax), false, false); pmax = max3f(__uint_as_float(rr[0]), __uint_as_float(rr[1]), __uint_as_float(rr[1])) + brow; }
    const bool upd = !__all(pmax - m_reg <= DEFER_THR);
    const float mx_ = max3f(m_reg, pmax, pmax);
    const float mn = upd ? mx_ : m_reg;
    alpha = __builtin_amdgcn_exp2f(m_reg - mn); m_reg = mn;
    f32x2 mn2 = {brow - mn, brow - mn}; asm("" : "+v"(mn2)); f32x2 ps2 = {0.f, 0.f};
#pragma unroll
    for (int r = 0; r < 16; r += 2) { f32x2 t = {p[r], p[r + 1]}; t += mn2; t.x = __builtin_amdgcn_exp2f(t.x); t.y = __builtin_amdgcn_exp2f(t.y); p[r] = t.x; p[r + 1] = t.y; ps2 += t; }
    float ps = pswap_sum(ps2.x + ps2.y);
    l_reg = l_reg * alpha + ps;
#define PK4(P, B_, OUT) do { unsigned a0 = cvtpk(P[B_+0], P[B_+1]), a1 = cvtpk(P[B_+2], P[B_+3]); \
        unsigned b0 = cvtpk(P[B_+4], P[B_+5]), b1 = cvtpk(P[B_+6], P[B_+7]); \
        auto r0 = __builtin_amdgcn_permlane32_swap(a0, b0, false, false); auto r1 = __builtin_amdgcn_permlane32_swap(a1, b1, false, false); \
        u32x4 w = {r0[0], r1[0], r0[1], r1[1]}; OUT = __builtin_bit_cast(bf16x8, w); } while (0)
    PK4(p, 0, pa0); PK4(p, 8, pa1);
#undef PK4
    return upd;
}
__device__ __forceinline__ void pv_half(f32x16 (&o)[4], int vb, bf16x8 pa0, bf16x8 pa1) {
#define TRRD(dst, off) asm volatile("ds_read_b64_tr_b16 %0, %1 offset:%2" : "=&v"(dst) : "v"(vb), "i"(off) : "memory")
#define PVH(dA, dB) do { s16x4 l0, h0, l1, h1, m0, n0, m1, n1; \
        TRRD(l0, (dA) * 512); TRRD(h0, (dA) * 512 + 2048); TRRD(m0, (dB) * 512); TRRD(n0, (dB) * 512 + 2048); \
        TRRD(l1, (dA) * 512 + 4096); TRRD(h1, (dA) * 512 + 6144); TRRD(m1, (dB) * 512 + 4096); TRRD(n1, (dB) * 512 + 6144); \
        asm volatile("s_waitcnt lgkmcnt(0)" ::: "memory"); SBAR(); \
        o[dA] = __builtin_amdgcn_mfma_f32_32x32x16_bf16(pa0, (bf16x8){l0[0], l0[1], l0[2], l0[3], h0[0], h0[1], h0[2], h0[3]}, o[dA], 0, 0, 0); \
        o[dB] = __builtin_amdgcn_mfma_f32_32x32x16_bf16(pa0, (bf16x8){m0[0], m0[1], m0[2], m0[3], n0[0], n0[1], n0[2], n0[3]}, o[dB], 0, 0, 0); \
        o[dA] = __builtin_amdgcn_mfma_f32_32x32x16_bf16(pa1, (bf16x8){l1[0], l1[1], l1[2], l1[3], h1[0], h1[1], h1[2], h1[3]}, o[dA], 0, 0, 0); \
        o[dB] = __builtin_amdgcn_mfma_f32_32x32x16_bf16(pa1, (bf16x8){m1[0], m1[1], m1[2], m1[3], n1[0], n1[1], n1[2], n1[3]}, o[dB], 0, 0, 0); } while (0)
    PVH(0, 1); PVH(2, 3);
#undef PVH
#undef TRRD
}
__device__ __forceinline__ bool sm_cheap(f32x16& p, float& l_reg, float& alpha, bf16x8& pa0, bf16x8& pa1) {
    alpha = 1.f; l_reg += p[0] + p[15];
    u32x4 w0 = {__builtin_bit_cast(unsigned, p[0]), __builtin_bit_cast(unsigned, p[1]), __builtin_bit_cast(unsigned, p[2]), __builtin_bit_cast(unsigned, p[3])};
    u32x4 w1 = {__builtin_bit_cast(unsigned, p[8]), __builtin_bit_cast(unsigned, p[9]), __builtin_bit_cast(unsigned, p[10]), __builtin_bit_cast(unsigned, p[11])};
    pa0 = __builtin_bit_cast(bf16x8, w0); pa1 = __builtin_bit_cast(bf16x8, w1); return false;
}
template <int VAR = 0, class F>
__device__ __forceinline__ void stream(const Ctx& C0, const bf16x8 (&qr)[8], const bf16_t* Kg, const bf16_t* Vg, size_t ld, unsigned mask, float& m_reg, float& l_reg, f32x16 (&o)[4], const F& f) {
    Ctx C = C0; { int tz = C0.tid; asm volatile("" : "+v"(tz)); C.tid = tz; C.lane = tz & 63; C.r32 = tz & 31; C.hi = (tz >> 5) & 1; }
    const int vb0 = (int)(uintptr_t)(C.lds + L_V) + v_rd_base(C.lane);
    LAS float* ws = (LAS float*)(C.lds + L_WS) + C.wid * 64;
    const DmaOff dof = dma_off(C.wid, C.lane, ld);
    unsigned rem = mask; int j = __builtin_ctz(rem); rem &= rem - 1;
    __syncthreads();
    dma_tile_v(dof, Kg + (size_t)j * 64 * ld, Vg + (size_t)j * 64 * ld, ld, C.lds, 0, 0, C.wid);
    DMA_WAIT();
    __syncthreads();
    int kb = 0, vprev = 2 * SHM, vcur = 0, vnext = SHM;
    bool more = rem != 0u; int jn = j;
    if (more) { jn = __builtin_ctz(rem); rem &= rem - 1; if (!(VAR & 1)) dma_tile_v(dof, Kg + (size_t)jn * 64 * ld, Vg + (size_t)jn * 64 * ld, ld, C.lds, 1, vnext, C.wid); }
#define ST_RESC(a) do { if (C.hi == 0) ws[C.r32] = (a); asm volatile("s_waitcnt lgkmcnt(0)" ::: "memory"); \
        _Pragma("unroll") for (int q = 0; q < 4; ++q) { const f32x4 t = *(const LAS f32x4*)(ws + 8 * q + 4 * C.hi); \
            _Pragma("unroll") for (int d = 0; d < 4; ++d) { o[d][4 * q] *= t[0]; o[d][4 * q + 1] *= t[1]; o[d][4 * q + 2] *= t[2]; o[d][4 * q + 3] *= t[3]; } } } while (0)
    f32x16 pA, pB; float alpha, browA, browB; bf16x8 pa0, pa1;
    bool zA = f.pre(pA, j, 0, browA);
    qkt_half(pA, C.lds + L_K, C.r32, C.hi, qr, zA);
    bool zB = f.pre(pB, j, 1, browB);
    bool first = true;
    for (;;) {
        if (!(VAR & 16)) qkt_half(pB, C.lds + L_K + kb * SHM + 32 * 256, C.r32, C.hi, qr, zB);
        const bool u0 = (VAR & 4) ? sm_cheap(pA, l_reg, alpha, pa0, pa1) : sm_half(pA, m_reg, l_reg, alpha, pa0, pa1, browA);
        if (u0 && !first) ST_RESC(alpha);
        first = false;
        if (!(VAR & 8)) pv_half(o, vb0 + vcur, pa0, pa1); else { o[0][0] += __builtin_bit_cast(float, (int)pa0[0] + (int)pa1[1]); }
        if (!(VAR & 32)) zA = f.pre(pA, jn, 0, browA);
        DMA_WAIT(); if (!(VAR & 2)) __syncthreads();
        if (!more) break;
        j = jn; kb ^= 1; { const int t_ = vprev; vprev = vcur; vcur = vnext; vnext = t_; }
        more = rem != 0u;
        if (more) { jn = __builtin_ctz(rem); rem &= rem - 1; if (!(VAR & 1)) dma_tile_v(dof, Kg + (size_t)jn * 64 * ld, Vg + (size_t)jn * 64 * ld, ld, C.lds, kb ^ 1, vnext, C.wid); }
        if (!(VAR & 16)) qkt_half(pA, C.lds + L_K + kb * SHM, C.r32, C.hi, qr, zA);
        const bool u1 = (VAR & 4) ? sm_cheap(pB, l_reg, alpha, pa0, pa1) : sm_half(pB, m_reg, l_reg, alpha, pa0, pa1, browB);
        if (u1) ST_RESC(alpha);
        if (!(VAR & 8)) pv_half(o, vb0 + vprev + 8192, pa0, pa1); else { o[1][0] += __builtin_bit_cast(float, (int)pa0[2] + (int)pa1[3]); }
        if (!(VAR & 32)) zB = f.pre(pB, j, 1, browB);
    }
    { const bool u1 = sm_half(pB, m_reg, l_reg, alpha, pa0, pa1, browB);
      if (u1) ST_RESC(alpha);
      pv_half(o, vb0 + vcur + 8192, pa0, pa1); }
    __syncthreads();
#undef ST_RESC
}
__device__ __forceinline__ void load_q(bf16x8 (&qr)[8], const bf16_t* qrow, const float* gain, int hi) {
    u32x4 raw[8]; float ss = 0.f;
#pragma unroll
    for (int d0 = 0; d0 < 8; ++d0) { raw[d0] = *(const u32x4*)(qrow + d0 * 16 + hi * 8);
#pragma unroll
        for (int e = 0; e < 4; ++e) { const float a = bf_lo(raw[d0][e]), b = bf_hi(raw[d0][e]); ss += a * a + b * b; } }
    ss = pswap_sum(ss);
    const float f = __builtin_amdgcn_rsqf(ss * (1.f / HD) + RMS_EPS) * (ATTN_SCALE * LOG2E);
#pragma unroll
    for (int d0 = 0; d0 < 8; ++d0) { const f32x4 g0 = *(const f32x4*)(gain + d0 * 16 + hi * 8), g1 = *(const f32x4*)(gain + d0 * 16 + hi * 8 + 4);
        u32x4 w; w.x = cvtpk(bf_lo(raw[d0].x) * f * g0[0], bf_hi(raw[d0].x) * f * g0[1]); w.y = cvtpk(bf_lo(raw[d0].y) * f * g0[2], bf_hi(raw[d0].y) * f * g0[3]);
        w.z = cvtpk(bf_lo(raw[d0].z) * f * g1[0], bf_hi(raw[d0].z) * f * g1[1]); w.w = cvtpk(bf_lo(raw[d0].w) * f * g1[2], bf_hi(raw[d0].w) * f * g1[3]);
        qr[d0] = __builtin_bit_cast(bf16x8, w); }
}
__device__ __forceinline__ void store_o(const f32x16 (&v)[4], const float (&w)[16], bf16_t* orow0, size_t ld, LAS char* lds, int wid, int lane_, bool accum) {
    int lane = lane_; asm volatile("" : "+v"(lane));
    const int r32 = lane & 31, hi = lane >> 5;
    LAS char* st = lds + wid * 8192;
    const bool odd = (r32 & 1) != 0;
#pragma unroll
    for (int r = 0; r < 16; r += 2) { LAS char* rowp = st + (crow(r, hi) + (odd ? 1 : 0)) * 256 + (r32 & ~1) * 2;
#pragma unroll
        for (int d = 0; d < 4; ++d) { const float a = v[d][r] * w[r], b = v[d][r + 1] * w[r + 1];
            const float recv = __builtin_bit_cast(float, __builtin_amdgcn_mov_dpp(__builtin_bit_cast(int, odd ? a : b), 0xB1, 0xF, 0xF, true));
            *(LAS unsigned*)(rowp + d * 64) = cvtpk(odd ? recv : a, odd ? b : recv); } }
    asm volatile("s_waitcnt lgkmcnt(0)" ::: "memory");
    u32x4 ov[8];
    if (accum) {
#pragma unroll
        for (int it = 0; it < 8; ++it) { const int id = it * 64 + lane, row = id >> 4, c16 = id & 15; ov[it] = *(const u32x4*)(orow0 + (size_t)row * ld + c16 * 8); } }
#pragma unroll
    for (int it = 0; it < 8; ++it) { const int id = it * 64 + lane, row = id >> 4, c16 = id & 15;
        u32x4 nv = *(const LAS u32x4*)(st + row * 256 + c16 * 16);
        if (accum) {
#pragma unroll
            for (int e = 0; e < 4; ++e) nv[e] = cvtpk(bf_lo(nv[e]) + bf_lo(ov[it][e]), bf_hi(nv[e]) + bf_hi(ov[it][e])); }
        *(u32x4*)(orow0 + (size_t)row * ld + c16 * 8) = nv; }
    asm volatile("s_waitcnt lgkmcnt(0)" ::: "memory");
}

struct Tensors {
    const bf16_t* PA; const float* GL; const bf16_t* KVM; const bf16_t* KC; const bf16_t* VC; const float* CUM; bf16_t* OC;
    const float* nsa_q_g; const float* fox_q_g; const float* mem_q_g; const float* rel_bias;
};

template <int TY> struct BiasUni {
    const Ctx* C; const LAS float* tb; int u; unsigned sel; int mode;
    __device__ __forceinline__ bool pre(f32x16& bv, int j, int half, float& brow) const {
        const float NEG = -__builtin_inff();
        const int dq = C->trow - 64 * j - 4 * C->hi - 32 * half;
        brow = 0.f;
        if constexpr (TY == 0) {
            const bool win = mode == 1; const bool on = win || ((sel >> j) & 1u);
            if (j + 3 <= u && !(win && j + 8 <= u)) {
                brow = on ? tb[128] : NEG; return true;
            } else {
#pragma unroll
                for (int q = 0; q < 4; ++q) {
#pragma unroll
                    for (int e = 0; e < 4; ++e) { const int r = 4 * q + e, c = e + 8 * q, rel = dq - c;
                        const bool ok = on && (unsigned)rel < 512u; const float b = tb[min(max(rel, 0), 128)];
                        bv[r] = ok ? b : NEG; }
                    SBAR(); }
            }
        } else if constexpr (TY == 1) {
            const LAS float* cb = (const LAS float*)(C->lds + L_CUM) + 64 * j + 4 * C->hi + 32 * half;
            const bool msk = 64 * j + 63 > C->qlo;
#pragma unroll
            for (int q = 0; q < 4; ++q) { const f32x4 a = *(const LAS f32x4*)(cb + 8 * q);
#pragma unroll
                for (int e = 0; e < 4; ++e) { const int r = 4 * q + e, c = e + 8 * q; bv[r] = (msk && dq - c < 0) ? NEG : a[e]; } }
        } else {
            return true;
        }
        return false;
    }
};

__device__ __forceinline__ void nsa_pre(Ctx& C, const Tensors& Tn, const bf16x8 (&qr)[8], int b, int g, int u, float g_c, bf16_t* orow0, unsigned& sel_out, unsigned& U_out) {
    { int tz = C.tid; asm volatile("" : "+v"(tz)); C.tid = tz; C.lane = tz & 63; C.r32 = tz & 31; C.hi = (tz >> 5) & 1; }
    const int hh = C.wid >> 1, pos = (C.wid & 1) * 32 + C.r32, head = g * 4 + hh;
    const LAS float* tb = (const LAS float*)(C.lds + L_TBL) + head * 132;
    LAS float* ws = (LAS float*)(C.lds + L_WS) + C.wid * 64;
    LAS unsigned* SEL = (LAS unsigned*)(C.lds + L_SEL);
    const float NEG = -__builtin_inff();
    const int vb0 = (int)(uintptr_t)(C.lds + L_V) + v_rd_base(C.lane);
    {
        const bf16_t* KCb = Tn.KC + (size_t)(b * 2 + g) * 128 * HD; const bf16_t* VCb = Tn.VC + (size_t)(b * 2 + g) * 128 * HD;
        const DmaOff dof = dma_off(C.wid, C.lane, HD);
        __syncthreads();
        if (C.tid < 65) SEL[C.tid] = 0u;
        dma_tile(dof, KCb, VCb, HD, C.lds, 0, 0, C.wid); dma_tile(dof, KCb + 64 * HD, VCb + 64 * HD, HD, C.lds, 1, 1, C.wid);
        DMA_WAIT();
        __syncthreads();
        f32x16 P[4];
        const int dq = C.trow - 31 - 64 * C.hi;
#pragma unroll
        for (int X = 0; X < 4; ++X)
#pragma unroll
            for (int r = 0; r < 16; ++r) { const int c = (r & 3) + 8 * (r >> 2), rel = dq - 16 * (32 * X + c);
                const float bb = tb[min(max(rel, 0), 128)]; P[X][r] = rel >= 0 ? bb : NEG; }
        qkt(P[0], P[1], C.lds + L_K, C.r32, C.hi, qr); qkt(P[2], P[3], C.lds + L_K + SHM, C.r32, C.hi, qr);
        float pmax = NEG;
#pragma unroll
        for (int X = 0; X < 4; ++X)
#pragma unroll
            for (int r = 0; r < 16; ++r) pmax = fmaxf(pmax, P[X][r]);
        pmax = pswap_max(pmax);
        const float mm = pmax == NEG ? 0.f : pmax;
        float ps = 0.f;
#pragma unroll
        for (int X = 0; X < 4; ++X)
#pragma unroll
            for (int r = 0; r < 16; ++r) { P[X][r] = __builtin_amdgcn_exp2f(P[X][r] - mm); ps += P[X][r]; }
        ps = pswap_sum(ps);
        const float inv = ps > 0.f ? 1.f / ps : 0.f;
        if (u >= 16) {
            LAS float* imp = (LAS float*)(C.lds + L_IMP) + (hh * 64 + pos) * 32;
            float bprev = 0.f;
#pragma unroll
            for (int X = 0; X < 4; ++X)
#pragma unroll
                for (int q = 0; q < 4; ++q) { const float b3 = 0.5f * P[X][4 * q + 3];
                    const float aG = P[X][4 * q] + P[X][4 * q + 1] + P[X][4 * q + 2] + b3;
                    const auto sw_ = __builtin_amdgcn_permlane32_swap(__float_as_uint(b3), __float_as_uint(b3), false, false);
                    const float bp = __uint_as_float(C.hi ? sw_[0] : sw_[1]);
                    const float val = aG + (C.hi ? bp : bprev);
                    imp[2 * (4 * X + q) + C.hi] = val * inv;
                    bprev = bp; }
        }
        f32x16 o[4] = {};
        bf16x8 pa0, pa1, pa2, pa3;
        pack_p(P[0], P[1], pa0, pa1, pa2, pa3); pv_tile(o, vb0, pa0, pa1, pa2, pa3);
        pack_p(P[2], P[3], pa0, pa1, pa2, pa3); pv_tile(o, vb0 + SHM, pa0, pa1, pa2, pa3);
        float w[16]; bcast_rows(w, g_c * inv, ws, C.r32, C.hi);
        __syncthreads();
        store_o(o, w, orow0, D, C.lds, C.wid, C.lane, false);
    }
    if (u >= 16) {
        const int p = C.tid & 63, jg = C.tid >> 6;
        const LAS float* i0 = (const LAS float*)(C.lds + L_IMP) + p * 32;
        float sc[32];
#pragma unroll
        for (int j4 = 0; j4 < 8; ++j4) { const f32x4 a = *(const LAS f32x4*)(i0 + 4 * j4), b2 = *(const LAS f32x4*)(i0 + 2048 + 4 * j4), c2 = *(const LAS f32x4*)(i0 + 4096 + 4 * j4), d2 = *(const LAS f32x4*)(i0 + 6144 + 4 * j4);
#pragma unroll
            for (int e = 0; e < 4; ++e) { const int j = 4 * j4 + e; const float s = ((a[e] + b2[e]) + c2[e]) + d2[e];
                const bool valid = j <= u, forced = j == 0 || j == u || j == u - 1;
                sc[j] = valid ? (forced ? 1e4f : s) : -1.f; } }
        unsigned bits = 0u;
#pragma unroll
        for (int e = 0; e < 4; ++e) { const int j = 4 * jg + e; float sj = 0.f;
#pragma unroll
            for (int k = 0; k < 32; ++k) sj = (k == j) ? sc[k] : sj;
            int rank = 0;
#pragma unroll
            for (int k = 0; k < 32; ++k) rank += (sc[k] > sj || (sc[k] == sj && k < j)) ? 1 : 0;
            if (j <= u && rank < 16) bits |= 1u << j; }
        ((LAS unsigned char*)(C.lds + L_NIB))[p * 8 + jg] = (unsigned char)(bits >> (4 * jg));
        __syncthreads();
        if (C.tid < 64) { const u32x2 nb = *(const LAS u32x2*)(C.lds + L_NIB + C.tid * 8); unsigned full = 0u;
#pragma unroll
            for (int k = 0; k < 4; ++k) { full |= ((nb.x >> (8 * k)) & 0xfu) << (4 * k); full |= ((nb.y >> (8 * k)) & 0xfu) << (16 + 4 * k); }
            SEL[C.tid] = full; unsigned un = full;
#pragma unroll
            for (int o = 1; o < 64; o <<= 1) un |= __shfl_xor(un, o);
            if (C.tid == 0) SEL[64] = un; }
    } else { if (C.tid < 65) SEL[C.tid] = (2u << u) - 1u; }
    __syncthreads();
    sel_out = SEL[pos]; U_out = SEL[64];
}
__device__ __forceinline__ int dequeue(LAS char* lds, unsigned* head, int tid) {
    if (tid == 0) *(LAS int*)(lds + L_Q) = (int)__hip_atomic_fetch_add(head, 1u, RLX_AGENT);
    __syncthreads();
    const int q = *(const LAS int*)(lds + L_Q);
    __syncthreads();
    return q;
}
#ifndef DBL_VAR
#define DBL_VAR 0
#endif
#ifndef DBL_STREAM
#define DBL_STREAM 0
#endif
#ifndef CONV_IN_P0
#define CONV_IN_P0 0
#endif
__device__ __forceinline__ void conv_some(const Frame& F, LAS char* lds, unsigned* chead, int n) {
    if (CONV_IN_P0) return;
    if (F.tid == 0) *(LAS int*)(lds + L_Q) = (int)__hip_atomic_fetch_add(chead, (unsigned)n, RLX_AGENT);
    __syncthreads();
    const int base = *(const LAS int*)(lds + L_Q);
    __syncthreads();
    conv_batch(F, base, base + n);
}
__device__ __forceinline__ void attn_phase(const Frame& F, LAS char* lds, const Tensors& Tn, unsigned* qhead) {
    Ctx C; C.lds = lds; C.tid = threadIdx.x; C.wid = __builtin_amdgcn_readfirstlane(C.tid >> 6); C.lane = C.tid & 63; C.r32 = C.lane & 31; C.hi = C.lane >> 5; C.trow = 0; C.qlo = 0;
    for (int i = C.tid; i < 8 * 129; i += 512) { const int head = i / 129, rel = i - head * 129; const int bk = rel < 128 ? T5B[rel] : 31;
        ((LAS float*)(lds + L_TBL))[head * 132 + rel] = Tn.rel_bias[bk * 8 + head] * LOG2E; }
    __syncthreads();
    LAS float* ws = (LAS float*)(lds + L_WS) + C.wid * 64;
#ifndef PASS_MASK
#define PASS_MASK 7
#endif
    int nconv = (int)((blockIdx.x >> 3) & 7) * 7;
    if (PASS_MASK & 1) for (;;) {
        conv_some(F, lds, qhead + 192, nconv); nconv = 9;
        const int q = dequeue(lds, qhead, C.tid); if (q >= 512) break;
        const int u = 31 - (q >> 4), b = (q >> 1) & 7, g = q & 1, head = g * 4 + (C.wid >> 1);
        C.qlo = 64 * u + (C.wid & 1) * 32; C.trow = C.qlo + C.r32;
        const size_t tok = (size_t)b * T + C.trow;
        bf16x8 qr[8]; load_q(qr, Tn.PA + tok * NPA + CQ_NSA + head * HD, Tn.nsa_q_g, C.hi);
        bf16_t* orow0 = Tn.OC + ((size_t)b * T + C.qlo) * D + head * HD;
        const LAS float* tb = (const LAS float*)(lds + L_TBL) + head * 132;
        const float* gl = Tn.GL + tok * LDG; const float g_c = fast_sigmoid(gl[head]), g_s = fast_sigmoid(gl[8 + head]), g_w = fast_sigmoid(gl[16 + head]);
        unsigned sel, U; nsa_pre(C, Tn, qr, b, g, u, g_c, orow0, sel, U);
        const bf16_t* PAb = Tn.PA + (size_t)b * T * NPA + g * HD;
        int br = 0;
        do {
            const unsigned mask = br ? (((2u << u) - 1u) & ~(u >= 9 ? ((1u << (u - 8)) - 1u) : 0u)) : U;
            f32x16 o[4] = {}; float m_reg = -1e30f, l_reg = 0.f;
            stream(C, qr, PAb + (br ? CK_WIN : CK_SLC), PAb + (br ? CV_WIN : CV_SLC), NPA, mask, m_reg, l_reg, o, BiasUni<0>{&C, tb, u, sel, br});
            float w[16]; bcast_rows(w, l_reg > 0.f ? (br ? g_w : g_s) / l_reg : 0.f, ws, C.r32, C.hi);
            store_o(o, w, orow0, D, lds, C.wid, C.lane, true);
#if DBL_STREAM
            { f32x16 o2[4] = {}; float m2 = -1e30f, l2 = 0.f; stream<DBL_VAR>(C, qr, PAb + (br ? CK_WIN : CK_SLC), PAb + (br ? CV_WIN : CV_SLC), NPA, mask, m2, l2, o2, BiasUni<0>{&C, tb, u, sel, br}); float sk = ((o2[0][0] + o2[1][0]) + (o2[2][0] + o2[3][0])) + l2 + m2; asm volatile("" :: "v"(sk)); }
#endif
            ++br; asm volatile("" : "+s"(br));
        } while (br < 2);
    }
    if (PASS_MASK & 2) for (;;) {
        const int q = dequeue(lds, qhead + 64, C.tid); if (q >= 256) break;
        const int qb = 7 - (q >> 5), b = (q >> 2) & 7, h = q & 3;
        C.qlo = 256 * qb + 32 * C.wid; C.trow = C.qlo + C.r32;
        const size_t tok = (size_t)b * T + C.trow;
        bf16x8 qr[8]; load_q(qr, Tn.PA + tok * NPA + CQ_FOX + h * HD, Tn.fox_q_g, C.hi);
        { LAS float* cl = (LAS float*)(lds + L_CUM); const float* cg = Tn.CUM + (size_t)(b * 4 + h) * T;
          for (int i = C.tid; i < 256 * (qb + 1); i += 512) cl[i] = -cg[i] * LOG2E; }
        const bf16_t* PAb = Tn.PA + (size_t)b * T * NPA + h * HD;
        const unsigned mask = qb == 7 ? 0xffffffffu : ((1u << (4 * qb + 4)) - 1u);
        f32x16 o[4] = {}; float m_reg = -1e30f, l_reg = 0.f;
        stream(C, qr, PAb + CK_FOX, PAb + CV_FOX, NPA, mask, m_reg, l_reg, o, BiasUni<1>{&C, nullptr, 0, 0u, 2});
        float w[16]; bcast_rows(w, l_reg > 0.f ? 1.f / l_reg : 0.f, ws, C.r32, C.hi);
        store_o(o, w, Tn.OC + ((size_t)b * T + C.qlo) * D + 1024 + h * HD, D, lds, C.wid, C.lane, false);
#if DBL_STREAM
        { f32x16 o2[4] = {}; float m2 = -1e30f, l2 = 0.f; stream<DBL_VAR>(C, qr, PAb + CK_FOX, PAb + CV_FOX, NPA, mask, m2, l2, o2, BiasUni<1>{&C, nullptr, 0, 0u, 2}); float sk = ((o2[0][0] + o2[1][0]) + (o2[2][0] + o2[3][0])) + l2 + m2; asm volatile("" :: "v"(sk)); }
#endif
        conv_some(F, lds, qhead + 192, 6);
    }
    if (PASS_MASK & 4) for (;;) {
        const int q = dequeue(lds, qhead + 128, C.tid); if (q >= 256) break;
        const int qb = q & 7, h = (q >> 3) & 3, b = q >> 5;
        C.qlo = 256 * qb + 32 * C.wid; C.trow = C.qlo + C.r32;
        const size_t tok = (size_t)b * T + C.trow;
        bf16x8 qr[8]; load_q(qr, Tn.PA + tok * NPA + CQ_MEM + h * HD, Tn.mem_q_g, C.hi);
        const bf16_t* Kb = Tn.KVM + (size_t)b * MEMT * 1024 + h * HD;
        f32x16 o[4] = {}; float m_reg = -1e30f, l_reg = 0.f;
        stream(C, qr, Kb, Kb + 512, 1024, 0xfu, m_reg, l_reg, o, BiasUni<2>{&C, nullptr, 0, 0u, 3});
        float w[16]; bcast_rows(w, l_reg > 0.f ? 1.f / l_reg : 0.f, ws, C.r32, C.hi);
        store_o(o, w, Tn.OC + ((size_t)b * T + C.qlo) * D + 1536 + h * HD, D, lds, C.wid, C.lane, false);
#if DBL_STREAM
        { f32x16 o2[4] = {}; float m2 = -1e30f, l2 = 0.f; stream<DBL_VAR>(C, qr, Kb, Kb + 512, 1024, 0xfu, m2, l2, o2, BiasUni<2>{&C, nullptr, 0, 0u, 3}); float sk = ((o2[0][0] + o2[1][0]) + (o2[2][0] + o2[3][0])) + l2 + m2; asm volatile("" :: "v"(sk)); }
#endif
        conv_some(F, lds, qhead + 192, 2);
    }
    if (!CONV_IN_P0) for (;;) {
        if (F.tid == 0) *(LAS int*)(lds + L_Q) = (int)__hip_atomic_fetch_add(qhead + 192, 8u, RLX_AGENT);
        __syncthreads();
        const int base = *(const LAS int*)(lds + L_Q);
        __syncthreads();
        if (base >= 3 * 65 * 64) break;
        conv_batch(F, base, base + 8);
    }
}
#undef KSWZ
#undef SBAR
}

__device__ __forceinline__ void p0_prologue(Frame& F) {
    LAS float* scr = (LAS float*)(F.lds + 40960 + F.wave * 8704);
    unsigned char* ws = F.ws; const int lane = F.lane;
    if (F.gw < 128) { const int kv = F.gw >> 6, j = F.gw & 63; const float* pe = F.in(kv ? I_PE_V : I_PE_K) + 64 * j; const float* w = F.in(kv ? I_W_CV : I_W_CK) + (size_t)64 * j * 128; float a0 = 0.f, a1 = 0.f;
#pragma unroll 16
        for (int k = 0; k < 64; ++k) { const float p = pe[k]; a0 += p * w[(size_t)k * 128 + lane]; a1 += p * w[(size_t)k * 128 + 64 + lane]; }
        float* cb = (float*)(ws + WS_CBIAS) + (size_t)(kv * 64 + j) * 128; cb[lane] = a0; cb[64 + lane] = a1; }
    constexpr int S0 = 32 * 8, S1 = S0 + 64;
    bf16_t* WinT = (bf16_t*)(ws + WS_WINT);
    for (int it = F.gw; it < S1; it += F.NGW) {
        if (it < S0) { }
        else {
            const int r = it - S0, kb = r >> 1, nb = r & 1, k0 = 64 * kb, n0 = 32 * nb; const float* W = F.in(I_W_ROUTER);
#pragma unroll 8
            for (int i = 0; i < 32; ++i) { const int kk = 2 * i + (lane >> 5); scr[kk * 33 + (lane & 31)] = W[(size_t)(k0 + kk) * NE + n0 + (lane & 31)]; }
            LDS_WAIT(); asm volatile("" ::: "memory");
            const int c8 = lane & 7; bf16_t* Whi = (bf16_t*)(ws + WS_WRT); bf16_t* Wlo = Whi + (size_t)NE * D;
#pragma unroll
            for (int j = 0; j < 4; ++j) { const int n = (lane >> 3) + 8 * j; const LAS float* s = scr + (8 * c8) * 33 + n; unsigned h[4], l[4];
#pragma unroll
                for (int q = 0; q < 4; ++q) { const float a = s[(2 * q) * 33], b = s[(2 * q + 1) * 33]; h[q] = cvtpk(a, b); l[q] = cvtpk(a - bf_lo(h[q]), b - bf_hi(h[q])); }
                *(u32x4*)(Whi + (size_t)(n0 + n) * D + k0 + 8 * c8) = (u32x4){h[0], h[1], h[2], h[3]};
                *(u32x4*)(Wlo + (size_t)(n0 + n) * D + k0 + 8 * c8) = (u32x4){l[0], l[1], l[2], l[3]}; }
            LDS_WAIT(); asm volatile("" ::: "memory");
        }
    }
    {
        LAS unsigned* T32 = (LAS unsigned*)F.lds;
        int t = blockIdx.x; f32x4 v[8]; Tr8Desc d = tr8w_decode(F, t < TR8W_NTILES ? t : 0);
        if (t < TR8W_NTILES) tr8_load(d, v, F.wave, lane);
        while (t < TR8W_NTILES) {
            tr8_to_lds(v, d.scale, T32, F.wave, lane);
            __syncthreads();
            const int tn = t + F.G; const Tr8Desc dn = tr8w_decode(F, tn < TR8W_NTILES ? tn : 0);
            if (tn < TR8W_NTILES) tr8_load(dn, v, F.wave, lane);
            tr8_from_lds(d, T32, F.wave, lane);
            __syncthreads();
            t = tn; d = dn;
        }
    }
    {
        LAS unsigned* T32 = (LAS unsigned*)F.lds;
        constexpr int NT0 = TR_FIRST_EXPERT;
        int t = blockIdx.x; f32x4 v[8]; TrDesc d = tr_decode(F, t < NT0 ? t : 0);
        if (t < NT0) tr_load(d, v, F.wave, lane);
        while (t < NT0) {
            tr_to_lds(v, T32, F.wave, lane);
            __syncthreads();
            const int tn = t + F.G; const TrDesc dn = tr_decode(F, tn < NT0 ? tn : 0);
            if (tn < NT0) tr_load(dn, v, F.wave, lane);
            tr_from_lds(d, T32, F.wave, lane);
            __syncthreads();
            t = tn; d = dn;
        }
    }
    if (CONV_IN_P0) { __syncthreads(); for (int base = blockIdx.x * 8; base < 3 * 65 * 64; base += F.G * 8) conv_batch(F, base, base + 8); }
    __syncthreads();
    { const float* W = F.in(I_W_IN); LAS unsigned* WL32 = (LAS unsigned*)F.lds;
      for (int kp = F.tid; kp < 1024; kp += 512) { const float* r0 = W + (size_t)(2 * kp) * W_IN_COLS; const float* r1 = r0 + W_IN_COLS;
#pragma unroll
          for (int q = 0; q < 7; ++q) { const int sc = q < 6 ? 2560 + 4 * q : 4120; const f32x4 a = *(const f32x4*)(r0 + sc), b = *(const f32x4*)(r1 + sc);
#pragma unroll
              for (int e = 0; e < 4; ++e) WL32[(4 * q + e) * 1024 + kp] = cvtpk(a[e], b[e]); } } }
    __syncthreads();
    bf16_t* A3 = (bf16_t*)(ws + WS_A3); unsigned char* H8 = ws + WS_H8;
    for (int m = F.gw; m < M + MROWS; m += F.NGW) {
        if (m < M) rms_row_logits<(NB16 > 0)>(F.in(I_X) + (size_t)m * D, F.in(I_NORM_ATTN_G), A3 + (size_t)m * D, H8 + (size_t)m * D, (float*)(ws + WS_GL) + (size_t)m * LDG, (const LAS unsigned char*)F.lds, lane);
        else rms_row_bf16(F.in(I_MEM) + (size_t)(m - M) * D, F.in(I_NORM_MEM_G), A3 + (size_t)m * D, lane);
    }
}

__device__ __forceinline__ void p2_thin(Frame& F) {
    unsigned char* ws = F.ws; const int lane = F.lane;
    bf16_t* PA = (bf16_t*)(ws + WS_PA); bf16_t* KVM = (bf16_t*)(ws + WS_KVMEM); const float* GL = (const float*)(ws + WS_GL);
    {
        LAS float* part = (LAS float*)F.lds;
        LAS float* red = (LAS float*)(F.lds + 65536);
        const int i16 = lane & 15, kg = lane >> 4, w = F.wave;
        for (int item = blockIdx.x; item < 256; item += F.G) {
            const int kv = item & 1, rt = (item >> 1) & 7, bg = item >> 4, b = bg >> 1, g = bg & 1;
            const int n = 16 * rt + i16, ne = n < 127 ? n : 126;
            const bf16_t* Ab = PA + ((size_t)(b * T + 16 * ne + 4 * w) * NPA + (kv ? CV_CMP : CK_CMP) + g * HD) + 8 * kg;
            const bf16_t* Bb = (const bf16_t*)(ws + (kv ? WS_WCV : WS_WCK)) + (size_t)i16 * 4096 + 512 * w + 8 * kg;
            f32x4 acc[8];
#pragma unroll
            for (int nt = 0; nt < 8; ++nt) acc[nt] = (f32x4){0.f, 0.f, 0.f, 0.f};
#pragma unroll 2
            for (int s = 0; s < 16; ++s) { const bf16x8 a = *(const bf16x8*)(Ab + (size_t)(s >> 2) * NPA + 32 * (s & 3));
#pragma unroll
                for (int nt = 0; nt < 8; ++nt) { const bf16x8 bb = *(const bf16x8*)(Bb + (size_t)nt * 16 * 4096 + 32 * s); acc[nt] = __builtin_amdgcn_mfma_f32_16x16x32_bf16(a, bb, acc[nt], 0, 0, 0); } }
            __syncthreads();
#pragma unroll
            for (int nt = 0; nt < 8; ++nt) *(LAS f32x4*)(part + ((w * 8 + nt) * 64 + lane) * 4) = acc[nt];
            __syncthreads();
            f32x4 t = {0.f, 0.f, 0.f, 0.f};
#pragma unroll
            for (int ww = 0; ww < 8; ++ww) t += *(const LAS f32x4*)(part + ((ww * 8 + w) * 64 + lane) * 4);
            const int e = 16 * w + i16; float cb = 0.f;
#pragma unroll 16
            for (int j = 0; j < 64; ++j) cb += ((const float*)(ws + WS_CBIAS))[(size_t)(kv * 64 + j) * 128 + e];
#pragma unroll
            for (int r = 0; r < 4; ++r) t[r] += cb;
            float scl[4] = {1.f, 1.f, 1.f, 1.f};
            if (kv == 0) {
#pragma unroll
                for (int r = 0; r < 4; ++r) { float q = t[r] * t[r]; q += __shfl_xor(q, 1); q += __shfl_xor(q, 2); q += __shfl_xor(q, 4); q += __shfl_xor(q, 8); if (i16 == 0) red[w * 16 + 4 * kg + r] = q; }
            }
            __syncthreads();
            if (kv == 0) { const float kgain = F.in(I_NSA_K_G)[e];
#pragma unroll
                for (int r = 0; r < 4; ++r) { float q = 0.f;
#pragma unroll
                    for (int ww = 0; ww < 8; ++ww) q += red[ww * 16 + 4 * kg + r];
                    scl[r] = __builtin_amdgcn_rsqf(q * (1.f / HD) + RMS_EPS) * kgain; } }
            bf16_t* Ob = (bf16_t*)(ws + (kv ? WS_VC : WS_KC)) + (size_t)bg * 128 * HD;
#pragma unroll
            for (int r = 0; r < 4; ++r) { const int nn = 16 * rt + 4 * kg + r; const float v = nn < 127 ? t[r] * scl[r] : 0.f; Ob[(size_t)nn * HD + e] = (bf16_t)(cvtpk(v, 0.f) & 0xffffu); }
        }
    }
#pragma unroll 2
    for (int row = F.gw; row < M; row += F.NGW) {
        const int hd = lane >> 3, col = (hd < 2 ? CK_SLC + hd * HD : (hd < 4 ? CK_WIN + (hd - 2) * HD : CK_FOX + (hd - 4) * HD)) + (lane & 7) * 16;
        bf16_t* p = PA + (size_t)row * NPA + col; const u32x4 r0 = *(const u32x4*)p, r1 = *(const u32x4*)(p + 8);
        float ss = 0.f;
#pragma unroll
        for (int e = 0; e < 4; ++e) { ss += bf_lo(r0[e]) * bf_lo(r0[e]) + bf_hi(r0[e]) * bf_hi(r0[e]) + bf_lo(r1[e]) * bf_lo(r1[e]) + bf_hi(r1[e]) * bf_hi(r1[e]); }
        ss += __shfl_xor(ss, 1); ss += __shfl_xor(ss, 2); ss += __shfl_xor(ss, 4);
        const float rstd = __builtin_amdgcn_rsqf(ss * (1.f / HD) + RMS_EPS); const float* gn = F.in(hd < 4 ? I_NSA_K_G : I_FOX_K_G) + (lane & 7) * 16;
        u32x4 o0, o1;
#pragma unroll
        for (int e = 0; e < 4; ++e) { o0[e] = cvtpk(bf_lo(r0[e]) * rstd * gn[2 * e], bf_hi(r0[e]) * rstd * gn[2 * e + 1]); o1[e] = cvtpk(bf_lo(r1[e]) * rstd * gn[8 + 2 * e], bf_hi(r1[e]) * rstd * gn[8 + 2 * e + 1]); }
        *(u32x4*)p = o0; *(u32x4*)(p + 8) = o1;
    }
    for (int mr = F.gw; mr < MROWS; mr += F.NGW) {
        bf16_t* p = KVM + (size_t)mr * 1024 + (lane >> 4) * HD + (lane & 15) * 8; const u32x4 r0 = *(const u32x4*)p; float ss = 0.f;
#pragma unroll
        for (int e = 0; e < 4; ++e) ss += bf_lo(r0[e]) * bf_lo(r0[e]) + bf_hi(r0[e]) * bf_hi(r0[e]);
        ss += __shfl_xor(ss, 1); ss += __shfl_xor(ss, 2); ss += __shfl_xor(ss, 4); ss += __shfl_xor(ss, 8);
        const float rstd = __builtin_amdgcn_rsqf(ss * (1.f / HD) + RMS_EPS); const float* gn = F.in(I_MEM_K_G) + (lane & 15) * 8; u32x4 o0;
#pragma unroll
        for (int e = 0; e < 4; ++e) o0[e] = cvtpk(bf_lo(r0[e]) * rstd * gn[2 * e], bf_hi(r0[e]) * rstd * gn[2 * e + 1]);
        *(u32x4*)p = o0;
    }
    for (int seq = F.gw; seq < 32; seq += F.NGW) {
        const int b = seq >> 2, h = seq & 3; const float bf = F.in(I_FOX_B_F)[h]; float v[32]; float run = 0.f;
#pragma unroll
        for (int i = 0; i < 32; ++i) { const float x = GL[(size_t)(b * T + 32 * lane + i) * LDG + 24 + h] + bf;
            const float ls = fminf(x, 0.f) - log1pf(__expf(-fabsf(x))); run += ls; v[i] = run; }
        float incl = run;
#pragma unroll
        for (int o = 1; o < 64; o <<= 1) { const float t = __shfl_up(incl, o); if (lane >= o) incl += t; }
        const float excl = incl - run; float* cp = (float*)(ws + WS_CUM) + (size_t)seq * T + 32 * lane;
#pragma unroll
        for (int i = 0; i < 32; ++i) cp[i] = v[i] + excl;
    }
}

constexpr int CW_COARSE = 16384;
constexpr int P6_WSTR = 136;
constexpr int P6_WBUF = 2 * 64 * P6_WSTR * 2;
static_assert(2 * P6_WBUF <= RING_BYTES, "P6 chunk buffers inside the ring region");
__device__ __forceinline__ void p6_router(Frame& F) {
    unsigned char* ws = F.ws; const int lane = F.lane, i16 = lane & 15, kg = lane >> 4, row = i16 & 7;
    unsigned char* H2 = (unsigned char*)(ws + WS_A3); const bf16_t* X1 = (const bf16_t*)(ws + WS_X1B); const float* gain = F.in(I_NORM_FFN_G);
    const bf16_t* Wg = (const bf16_t*)(ws + WS_WRT);
    const float rb = F.in(I_ROUTER_BIAS)[lane];
    unsigned* coarse = (unsigned*)(ws + WS_CTL) + CW_COARSE;
    if (F.gw == 0) {
#pragma unroll
        for (int q = 0; q < 2; ++q) *(u32x4*)(H2 + (size_t)M * D + 32 * lane + 16 * q) = (u32x4){0u, 0u, 0u, 0u}; }
    for (int item = blockIdx.x; item < M / 64; item += F.G) {
        const int tok0 = item * 64 + F.wave * 8;
        float myr = 0.f;
#pragma unroll 2
        for (int i = 0; i < 8; ++i) { const bf16_t* xr = X1 + (size_t)(tok0 + i) * D; float ss = 0.f;
#pragma unroll
            for (int j = 0; j < 4; ++j) { const u32x4 v = *(const u32x4*)(xr + 8 * lane + 512 * j);
#pragma unroll
                for (int e = 0; e < 4; ++e) ss += bf_lo(v[e]) * bf_lo(v[e]) + bf_hi(v[e]) * bf_hi(v[e]); }
            const float r = __builtin_amdgcn_rsqf(wave_sum(ss) * (1.f / D) + RMS_EPS); if (row == i) myr = r; }
        f32x4 acc[4] = {{0.f, 0.f, 0.f, 0.f}, {0.f, 0.f, 0.f, 0.f}, {0.f, 0.f, 0.f, 0.f}, {0.f, 0.f, 0.f, 0.f}};
        const bf16_t* xr = X1 + (size_t)(tok0 + row) * D + 8 * kg; unsigned char* hr = H2 + (size_t)(tok0 + row) * D + 8 * kg;
        u32x4 wst[4];
#define P6_LOADW(ch) do { _Pragma("unroll") for (int i = 0; i < 4; ++i) { const int p = F.tid + 512 * i; wst[i] = *(const u32x4*)(Wg + (size_t)(p >> 4) * D + 128 * (ch) + 8 * (p & 15)); } } while (0)
#define P6_STOREW(bf) do { _Pragma("unroll") for (int i = 0; i < 4; ++i) { const int p = F.tid + 512 * i; *(LAS u32x4*)(F.lds + (bf) * P6_WBUF + ((p >> 4) * P6_WSTR + 8 * (p & 15)) * 2) = wst[i]; } } while (0)
        P6_LOADW(0);
        __syncthreads();
        P6_STOREW(0);
        __syncthreads();
        for (int ch = 0; ch < 16; ++ch) {
            if (ch < 15) P6_LOADW(ch + 1);
            const LAS unsigned char* wb = F.lds + (ch & 1) * P6_WBUF + (i16 * P6_WSTR + 8 * kg) * 2;
#pragma unroll 2
            for (int s = 0; s < 4; ++s) { const int k = 128 * ch + 32 * s;
                const u32x4 xb = *(const u32x4*)(xr + k); const f32x4 g0 = *(const f32x4*)(gain + k + 8 * kg), g1 = *(const f32x4*)(gain + k + 8 * kg + 4);
                const float xn[8] = {bf_lo(xb.x) * myr * g0.x, bf_hi(xb.x) * myr * g0.y, bf_lo(xb.y) * myr * g0.z, bf_hi(xb.y) * myr * g0.w, bf_lo(xb.z) * myr * g1.x, bf_hi(xb.z) * myr * g1.y, bf_lo(xb.w) * myr * g1.z, bf_hi(xb.w) * myr * g1.w};
                u32x4 h, l;
#pragma unroll
                for (int q = 0; q < 4; ++q) { h[q] = cvtpk(xn[2 * q], xn[2 * q + 1]); l[q] = cvtpk(xn[2 * q] - bf_lo(h[q]), xn[2 * q + 1] - bf_hi(h[q])); }
                if (i16 < 8) *(u32x2*)(hr + k) = (u32x2){pk_fp8x4(xn[0], xn[1], xn[2], xn[3]), pk_fp8x4(xn[4], xn[5], xn[6], xn[7])};
                const bf16x8 ah = __builtin_bit_cast(bf16x8, h), al = __builtin_bit_cast(bf16x8, l);
#pragma unroll
                for (int nt = 0; nt < 4; ++nt) { const LAS unsigned char* wp = wb + (16 * nt * P6_WSTR + 32 * s) * 2;
                    const bf16x8 bh = *(const LAS bf16x8*)wp, bl = *(const LAS bf16x8*)(wp + 64 * P6_WSTR * 2);
                    acc[nt] = __builtin_amdgcn_mfma_f32_16x16x32_bf16(ah, bh, acc[nt], 0, 0, 0);
                    acc[nt] = __builtin_amdgcn_mfma_f32_16x16x32_bf16(al, bh, acc[nt], 0, 0, 0);
                    acc[nt] = __builtin_amdgcn_mfma_f32_16x16x32_bf16(ah, bl, acc[nt], 0, 0, 0); }
            }
            if (ch < 15) P6_STOREW((ch + 1) & 1);
            __syncthreads();
        }
#undef P6_LOADW
#undef P6_STOREW
        LAS float* lg = (LAS float*)(F.lds + F.wave * 4096);
        if (kg < 2) {
#pragma unroll
            for (int nt = 0; nt < 4; ++nt)
#pragma unroll
                for (int r = 0; r < 4; ++r) lg[(4 * kg + r) * 64 + 16 * nt + i16] = acc[nt][r]; }
        LDS_WAIT(); asm volatile("" ::: "memory");
        int cnt = 0;
        u32x2* asg = (u32x2*)(ws + WS_ASG);
        for (int tt = 0; tt < 8; ++tt) {
            const float sc = 1.f / (1.f + __expf(-lg[tt * 64 + lane])); const float key = sc + rb;
            lg[512 + lane] = key; LDS_WAIT(); asm volatile("" ::: "memory");
            int rank = 0;
#pragma unroll
            for (int q = 0; q < 16; ++q) { const f32x4 kk = *(const LAS f32x4*)(lg + 512 + 4 * q);
#pragma unroll
                for (int e = 0; e < 4; ++e) { const int eo = 4 * q + e; rank += (kk[e] > key || (kk[e] == key && eo < lane)) ? 1 : 0; } }
            LDS_WAIT(); asm volatile("" ::: "memory");
            const bool selx = rank < TOPK;
            const float ssum = wave_sum(selx ? sc : 0.f);
            const unsigned long long bal = __ballot(selx);
            if (selx) { const int k = __popcll(bal & ((1ull << lane) - 1ull));
                asg[(size_t)(tok0 + tt) * TOPK + k] = (u32x2){(unsigned)lane | ((unsigned)cnt << 8), __float_as_uint(sc / ssum * 2.5f)}; ++cnt; }
        }
        const int wi = item * 8 + F.wave;
        ((int*)(ws + WS_HIST))[wi * 64 + lane] = cnt;
        __hip_atomic_fetch_add(coarse + (wi >> 5) * 64 + lane, (unsigned)cnt, RLX_AGENT);
    }
}
__device__ __forceinline__ void p7_slots(Frame& F) {
    unsigned char* ws = F.ws; const int lane = F.lane;
    const int* hist = (const int*)(ws + WS_HIST); const u32x2* asg = (const u32x2*)(ws + WS_ASG); const unsigned* coarse = (const unsigned*)(ws + WS_CTL) + CW_COARSE;
    int* rowasg = (int*)(ws + WS_ROWASG); int* rowtok = (int*)(ws + WS_ROWTOK); float* rowg = (float*)(ws + WS_ROWG);
    for (int wi = F.gw; wi < M / 8; wi += F.NGW) {
        const int grp = wi >> 5; int base = 0, total = 0;
#pragma unroll 8
        for (int g = 0; g < 64; ++g) { const int cv = (int)coarse[g * 64 + lane]; total += cv; base += g < grp ? cv : 0; }
        for (int i = grp * 32; i < wi; ++i) base += hist[i * 64 + lane];
        const int padded = (total + 255) & ~255;
        int incl = padded;
#pragma unroll
        for (int o = 1; o < 64; o <<= 1) { const int t = __shfl_up(incl, o); if (lane >= o) incl += t; }
        const int pstart = incl - padded, rtot = __shfl(incl, 63);
        const int my = pstart + base;
        { const int tok = wi * 8 + (lane >> 3), k = lane & 7; const u32x2 rec = asg[(size_t)tok * TOPK + k];
          const int e = rec.x & 255, rl = rec.x >> 8; const int dest = __shfl(my, e) + rl;
          rowasg[dest] = tok * ASG_PER_TOK + k; rowtok[dest] = tok; rowg[dest] = __uint_as_float(rec.y); }
        if (lane < 8) { const int tok = wi * 8 + lane, dest = rtot + tok; rowasg[dest] = tok * ASG_PER_TOK + 8; rowtok[dest] = tok; rowg[dest] = 1.f; }
        if (wi == 0) { for (int sl = pstart + total; sl < pstart + padded; ++sl) { rowasg[sl] = -1; rowtok[sl] = M; rowg[sl] = 0.f; }
                       ((int*)(ws + WS_CNT))[lane] = total; }
    }
}
__device__ __forceinline__ int build_blocks(Frame& F, LAS unsigned char* blk_e, LAS int* tmp) {
    const int* cnt = (const int*)(F.ws + WS_CNT);
    if (F.tid < NEX) tmp[F.tid] = F.tid < NE ? (cnt[F.tid] + 255) >> 8 : M / 256;
    __syncthreads();
    if (F.tid < NEX) { int st = 0; for (int e = 0; e < F.tid; ++e) st += tmp[e]; const int nb = tmp[F.tid]; for (int i = 0; i < nb; ++i) blk_e[st + i] = (unsigned char)F.tid; if (F.tid == NEX - 1) tmp[NEX] = st + nb; }
    __syncthreads();
    return tmp[NEX];
}
__device__ __forceinline__ void p10_combine(Frame& F) {
    const unsigned char* Y = (const unsigned char*)(F.ws + WS_Y); float* O = F.out; const bf16_t* X1 = (const bf16_t*)(F.ws + WS_X1B); const int lane = F.lane;
    for (int tok = F.gw; tok < M; tok += F.NGW) {
#pragma unroll
        for (int c = 0; c < 2; ++c) { const int col = 16 * lane + 1024 * c; float* op = O + (size_t)tok * D + col;
            const u32x4 xa = *(const u32x4*)(X1 + (size_t)tok * D + col), xb = *(const u32x4*)(X1 + (size_t)tok * D + col + 8);
            const f32x4 x0 = {bf_lo(xa.x), bf_hi(xa.x), bf_lo(xa.y), bf_hi(xa.y)}, x1 = {bf_lo(xa.z), bf_hi(xa.z), bf_lo(xa.w), bf_hi(xa.w)}, x2 = {bf_lo(xb.x), bf_hi(xb.x), bf_lo(xb.y), bf_hi(xb.y)}, x3 = {bf_lo(xb.z), bf_hi(xb.z), bf_lo(xb.w), bf_hi(xb.w)};
            u32x4 y[ASG_PER_TOK];
#pragma unroll
            for (int k = 0; k < ASG_PER_TOK; ++k) y[k] = *(const u32x4*)(Y + ((size_t)tok * ASG_PER_TOK + k) * D + col);
            float a[16];
#pragma unroll
            for (int e = 0; e < 16; ++e) a[e] = 0.f;
#pragma unroll
            for (int k = 0; k < ASG_PER_TOK; ++k)
#pragma unroll
                for (int q = 0; q < 4; ++q) { const auto lo = __builtin_amdgcn_cvt_pk_f32_fp8((int)y[k][q], false); const auto hi = __builtin_amdgcn_cvt_pk_f32_fp8((int)y[k][q], true);
                    a[4 * q] += lo[0]; a[4 * q + 1] += lo[1]; a[4 * q + 2] += hi[0]; a[4 * q + 3] += hi[1]; }
            const float r = 1.f / Y_SCALE;
            *(f32x4*)op = (f32x4){x0[0] + a[0] * r, x0[1] + a[1] * r, x0[2] + a[2] * r, x0[3] + a[3] * r};
            *(f32x4*)(op + 4) = (f32x4){x1[0] + a[4] * r, x1[1] + a[5] * r, x1[2] + a[6] * r, x1[3] + a[7] * r};
            *(f32x4*)(op + 8) = (f32x4){x2[0] + a[8] * r, x2[1] + a[9] * r, x2[2] + a[10] * r, x2[3] + a[11] * r};
            *(f32x4*)(op + 12) = (f32x4){x3[0] + a[12] * r, x3[1] + a[13] * r, x3[2] + a[14] * r, x3[3] + a[15] * r}; }
    }
}

constexpr int N_PHASES = 11;
struct Args { const float* in[31]; float* out; unsigned char* ws; int ph_lo, ph_hi, use_bar, pad; };
__global__ void __launch_bounds__(512, 2) mega(Args args) {
    extern __shared__ __attribute__((aligned(16))) unsigned char lds_raw[];
    LAS unsigned char* lds = (LAS unsigned char*)lds_raw;
    Frame F; F.lds = lds; F.tid = threadIdx.x; F.lane = F.tid & 63; F.wave = __builtin_amdgcn_readfirstlane(F.tid >> 6); F.G = gridDim.x;
    F.gw = blockIdx.x * 8 + F.wave; F.NGW = F.G * 8; F.out = args.out; F.ws = args.ws;
    unsigned char* ws = args.ws;
    unsigned* ctl = (unsigned*)(ws + WS_CTL);
    for (int u = F.tid; u < 256; u += 512) ((LAS unsigned*)(lds + LDSCTL_OFF))[u] = 0u;
    __syncthreads();
    XcdBarrier bar; bar.bar = ctl + CW_BAR; bar.x = 0; bar.st = nullptr;
    if (args.use_bar) bar = xcd_barrier_post(ctl + CW_BAR, (volatile LAS unsigned*)(lds + LDSCTL_OFF));
    const int lo = args.ph_lo, hi = args.ph_hi;
#ifndef PH_MASK
#define PH_MASK 0x7ff
#endif
#define IN(k) (((PH_MASK >> (k)) & 1) && lo <= (k) && (k) < hi)
#define SEAM(k) do { if (IN(k) && IN((k) + 1)) xcd_barrier(bar); } while (0)
    const int c = (int)blockIdx.x;
#ifndef REP_PHASE
#define REP_PHASE -1
#endif
#define RUN(k, ...) do { if (IN(k)) { const int rep = 0; (void)rep; __VA_ARGS__ } if (REP_PHASE == (k) && IN(k)) { xcd_barrier(bar); const int rep = 1; (void)rep; __VA_ARGS__ } } while (0)
    RUN(0, p0_prologue(F); ); SEAM(0);
    RUN(1,
        Epi1 E{(bf16_t*)(ws + WS_PA), (unsigned char*)(ws + WS_PG), (float*)(ws + WS_GL), (bf16_t*)(ws + WS_KVMEM)};
        { Sched1 S; S.o.init(64, NB16 ? NB16 : 1); S.A = (const char*)(ws + WS_A3); S.Bt = (const char*)(ws + WS_WINT); S.G = F.G; S.c = c; S.fp8 = 0;
          pg8::gemm_phase<Epi1, Sched1, false, false>(lds, 2 * D, 2 * D, S, E); }
        { Sched1 S; S.o.init(64, 24 + NF8); S.A = (const char*)(ws + WS_H8); S.Bt = (const char*)(ws + WS_WIN8); S.G = F.G; S.c = c; S.fp8 = 1;
          pg8::gemm_phase<Epi1, Sched1, false, true>(lds, D, D, S, E); }
    ); SEAM(1);
    RUN(2, p2_thin(F); ); SEAM(2);
    RUN(3,
        att::Tensors Tn{(const bf16_t*)(ws + WS_PA), (const float*)(ws + WS_GL), (const bf16_t*)(ws + WS_KVMEM), (const bf16_t*)(ws + WS_KC), (const bf16_t*)(ws + WS_VC), (const float*)(ws + WS_CUM),
                        (bf16_t*)(ws + WS_A3), F.in(I_NSA_Q_G), F.in(I_FOX_Q_G), F.in(I_MEM_Q_G), F.in(I_REL_BIAS)};
        att::attn_phase(F, (LAS char*)lds, Tn, ctl + CW_QUEUE + rep * 256);
    ); SEAM(3);
    RUN(4,
        Sched4 S; S.o.init(64, 8); S.A = (const char*)(ws + WS_A3); S.Bt = (const char*)(ws + WS_WOT); S.G = F.G; S.c = c;
        Epi4 E{(const unsigned char*)(ws + WS_PG), (bf16_t*)(ws + WS_PA)};
        pg8::gemm_phase<Epi4, Sched4, false>(lds, 2 * D, 2 * D, S, E);
    ); SEAM(4);
    RUN(5,
        Sched5 S; S.o.init(64, 8); S.A = (const char*)(ws + WS_PA); S.Bt = (const char*)(ws + WS_WOUTT); S.G = F.G; S.c = c;
        Epi5 E{F.in(I_X), (bf16_t*)(ws + WS_X1B)};
        pg8::gemm_phase<Epi5, Sched5, false>(lds, 2 * D, 2 * D, S, E);
    ); SEAM(5);
    RUN(6, p6_router(F); ); SEAM(6);
    RUN(7, p7_slots(F); ); SEAM(7);
    RUN(8,
        LAS unsigned char* blk_e = lds + EPI_OFF; LAS int* tmp = (LAS int*)(lds + EPI_OFF + 1024);
        const int nblk = build_blocks(F, blk_e, tmp);
        SchedMoe S{blk_e, nblk, F.G, c, 2, (const char*)(ws + WS_A3), (const char*)(ws + WS_WGU), (const int*)(ws + WS_ROWTOK), true};
        Epi8 E{(unsigned char*)(ws + WS_PG)};
        pg8::gemm_phase<Epi8, SchedMoe, true, true>(lds, D, D, S, E);
    ); SEAM(8);
    RUN(9,
        LAS unsigned char* blk_e = lds + EPI_OFF; LAS int* tmp = (LAS int*)(lds + EPI_OFF + 1024);
        const int nblk = build_blocks(F, blk_e, tmp);
        SchedMoe S{blk_e, nblk, F.G, c, 3, (const char*)(ws + WS_PG), (const char*)(ws + WS_WD), nullptr, false};
        Epi9 E{(const int*)(ws + WS_ROWASG), (const float*)(ws + WS_ROWG), (unsigned char*)(ws + WS_Y)};
        pg8::gemm_phase<Epi9, SchedMoe, false, true>(lds, DE, DE, S, E);
    ); SEAM(9);
    RUN(10, p10_combine(F); );
#undef RUN
#undef IN
#undef SEAM
}

#ifndef MK_PER_PHASE
#define MK_PER_PHASE 0
#endif
extern "C" void kernel_launch(void* const* d_in, const int* in_sizes, int n_in, void* d_out, int out_size, void* d_ws, size_t ws_size, hipStream_t stream) {
    static int grid = 0;
    if (grid == 0) {
        if (n_in != N_IN || in_sizes[0] != M * D || out_size != M * D || ws_size < WS_END) { fprintf(stderr, "kernel_launch: unexpected shapes (n_in %d, in0 %d, out %d, ws %zu; need ws >= %zu)\n", n_in, n_in > 0 ? in_sizes[0] : -1, out_size, ws_size, (size_t)WS_END); grid = -1; return; }
        int dev = 0, cus = 0, per_cu = 0;
        if (hipGetDevice(&dev) != hipSuccess || hipDeviceGetAttribute(&cus, hipDeviceAttributeMultiprocessorCount, dev) != hipSuccess) { grid = -1; return; }
        if (hipFuncSetAttribute((const void*)mega, hipFuncAttributeMaxDynamicSharedMemorySize, LDS_BYTES) != hipSuccess) { fprintf(stderr, "kernel_launch: hipFuncSetAttribute failed\n"); grid = -1; return; }
        if (hipOccupancyMaxActiveBlocksPerMultiprocessor(&per_cu, (const void*)mega, 512, LDS_BYTES) != hipSuccess || per_cu < 1) fprintf(stderr, "kernel_launch: occupancy query says %d\n", per_cu);
        (void)hipGetLastError();
        grid = cus;
    }
    if (grid < 0) return;
    (void)hipMemsetAsync((char*)d_ws + WS_CTL, 0, CTL_ZERO_BYTES, stream);
    Args a{};
    for (int i = 0; i < 31; ++i) a.in[i] = (const float*)d_in[i];
    a.out = (float*)d_out; a.ws = (unsigned char*)d_ws; a.pad = 0;
#if MK_PER_PHASE
    for (int p = 0; p < N_PHASES; ++p) { a.ph_lo = p; a.ph_hi = p + 1; a.use_bar = 0; hipLaunchKernelGGL(mega, dim3(grid), dim3(512), LDS_BYTES, stream, a); }
#else
    a.ph_lo = 0; a.ph_hi = N_PHASES; a.use_bar = 1; hipLaunchKernelGGL(mega, dim3(grid), dim3(512), LDS_BYTES, stream, a);
#endif
}
```

```cpp
#include <hip/hip_runtime.h>
#include <cstdio>
#include <cstdint>

#define LAS __attribute__((address_space(3)))
#define GAS __attribute__((address_space(1)))
typedef unsigned short bf16_t;
typedef short bf16x8 __attribute__((ext_vector_type(8)));
typedef short s16x4 __attribute__((ext_vector_type(4)));
typedef float f32x2 __attribute__((ext_vector_type(2)));
typedef float f32x4 __attribute__((ext_vector_type(4)));
typedef float f32x16 __attribute__((ext_vector_type(16)));
typedef unsigned u32x2 __attribute__((ext_vector_type(2)));
typedef unsigned u32x4 __attribute__((ext_vector_type(4)));
typedef GAS unsigned gu32;

constexpr int NB = 8, T = 2048, D = 2048, M = NB * T;
constexpr int HD = 128;
constexpr int MEMT = 256, MROWS = NB * MEMT;
constexpr int NE = 64, TOPK = 8, DE = 512, NEX = NE + 1;
constexpr int W_IN_COLS = 10780;
constexpr int NPA = 4608, NPG = 6144, NPAD = 11008;
constexpr int LDG = 32;
constexpr float RMS_EPS = 1e-6f;
constexpr float LOG2E = 1.4426950408889634f;
constexpr float ATTN_SCALE = 0.08838834764831845f;
constexpr int CQ_NSA = 0, CK_CMP = 1024, CV_CMP = 1280, CK_SLC = 1536, CV_SLC = 1792, CK_WIN = 2048, CV_WIN = 2304;
constexpr int CQ_FOX = 2560, CK_FOX = 3072, CV_FOX = 3584, CQ_MEM = 4096;
constexpr int ASG_PER_TOK = 9;
constexpr int MAXSLOT = M * TOPK + NE * 256 + M;

constexpr size_t MiB = 1u << 20;
constexpr size_t WS_CTL = 0, CTL_ZERO_BYTES = 1 * MiB;
constexpr size_t WS_GL = 1 * MiB;
constexpr size_t WS_KVMEM = 3 * MiB;
constexpr size_t WS_KC = 7 * MiB, WS_VC = WS_KC + 512 * 1024;
constexpr size_t WS_CUM = 8 * MiB;
constexpr size_t WS_CBIAS = WS_CUM + 256 * 1024;
constexpr size_t WS_HIST = WS_CUM + 512 * 1024;
constexpr size_t WS_ASG = 9 * MiB;
constexpr size_t WS_ROWASG = 10 * MiB;
constexpr size_t WS_ROWG = 11 * MiB;
constexpr size_t WS_CNT = 12 * MiB;
constexpr size_t WS_WRT = 12 * MiB + 256 * 1024;
constexpr size_t WS_WCK = 13 * MiB, WS_WCV = 14 * MiB;
constexpr size_t WS_WOT = 16 * MiB;
constexpr size_t WS_WOUTT = 24 * MiB;
constexpr size_t WS_WD = 32 * MiB;
constexpr size_t WS_PG = WS_WD + (size_t)NEX * 2 * MiB;
constexpr size_t WS_Y = WS_PG + 192 * MiB;
constexpr size_t WS_WGU = WS_Y;
constexpr size_t WS_WINT = WS_WGU + (size_t)NEX * 4 * MiB;
constexpr size_t WS_PA = WS_WINT + 47 * MiB;
constexpr size_t WS_A3 = WS_PA + 144 * MiB;
constexpr size_t WS_WIN8 = WS_Y + 578 * MiB;
constexpr size_t WS_H8 = WS_WIN8 + 24 * MiB;
constexpr size_t WS_END = WS_H8 + 32 * MiB;
constexpr size_t WS_X1B = WS_PA + 64 * MiB;
static_assert(WS_A3 + (size_t)(M + MROWS) * D * 2 <= WS_Y + 576 * MiB, "ws map");
static_assert((size_t)MAXSLOT * DE * 2 <= 192 * MiB, "hid fits projG");
static_assert((size_t)MAXSLOT * 4 <= 1 * MiB, "row tables");

constexpr int CW_BAR = 4096;
constexpr int CW_QUEUE = 8192;

constexpr int RING_BYTES = 131072;
constexpr int LDSCTL_OFF = RING_BYTES;
constexpr int EPI_OFF = RING_BYTES + 1024;
constexpr int LDS_BYTES = RING_BYTES + 1024 + 8192 + 4096;

#define RLX_AGENT __ATOMIC_RELAXED, __HIP_MEMORY_SCOPE_AGENT
__device__ __forceinline__ unsigned cvtpk(float lo, float hi) { unsigned r; asm volatile("v_cvt_pk_bf16_f32 %0, %1, %2" : "=v"(r) : "v"(lo), "v"(hi)); return r; }
__device__ __forceinline__ float bf_lo(unsigned u) { return __uint_as_float(u << 16); }
__device__ __forceinline__ float bf_hi(unsigned u) { return __uint_as_float(u & 0xffff0000u); }
__device__ __forceinline__ float wave_sum(float v) {
#pragma unroll
    for (int o = 1; o < 64; o <<= 1) v += __shfl_xor(v, o);
    return v;
}
constexpr float WGU_SCALE = 32.f, WD_SCALE = 16.f, WIN_SCALE = 32.f;
__device__ __forceinline__ unsigned pk_fp8x4(float a, float b, float c, float d) { int w = 0; w = __builtin_amdgcn_cvt_pk_fp8_f32(a, b, w, false); w = __builtin_amdgcn_cvt_pk_fp8_f32(c, d, w, true); return (unsigned)w; }
__device__ __forceinline__ float fast_sigmoid(float x) { return __builtin_amdgcn_rcpf(1.f + __builtin_amdgcn_exp2f(-x * LOG2E)); }

#define XB_TMO      128
#define XB_XCNT(j)  (256  + 64 * (j))
#define XB_XSUB(j)  (1280 + 64 * (j))
#define XB_XGEN(j)  (2304 + 64 * (j))
#define XB_TOP      3328
#define XB_TOPGEN   3392
#define XCD_BAR_WORDS 3456
#define XB_SPIN_CAP (1u << 18)
__device__ __forceinline__ unsigned xb_ld(unsigned* p)              { return __hip_atomic_load(p, __ATOMIC_RELAXED, __HIP_MEMORY_SCOPE_AGENT); }
__device__ __forceinline__ unsigned xb_add(unsigned* p, unsigned v) { return __hip_atomic_fetch_add(p, v, __ATOMIC_RELAXED, __HIP_MEMORY_SCOPE_AGENT); }
__device__ __forceinline__ unsigned xb_xcc_id() { return (unsigned)__builtin_amdgcn_s_getreg((3 << 11) | 20) & 0xFu; }
#define XB_SPIN(cond, bar) do { unsigned _sp = 0; while (cond) { __builtin_amdgcn_s_sleep(1); \
    if ((++_sp & 255u) == 0u) { if (xb_ld(&(bar)[XB_TMO])) break; if (_sp > XB_SPIN_CAP) { atomicAdd(&(bar)[XB_TMO], 1u); break; } } } } while (0)
struct XcdBarrier { unsigned* bar; unsigned x; volatile LAS unsigned* st; };
__device__ __forceinline__ XcdBarrier xcd_barrier_post(unsigned* bar, volatile LAS unsigned* st) {
    XcdBarrier b; b.bar = bar; b.x = xb_xcc_id(); b.st = st;
    if (threadIdx.x == 0) (void)xb_add(&bar[XB_XCNT(b.x)], 1u);
    return b;
}
__device__ __forceinline__ void xcd_barrier_complete(unsigned* bar, unsigned x, unsigned& nloc, unsigned& nx) {
    const unsigned G = gridDim.x * gridDim.y * gridDim.z;
    unsigned sum, cnt, mine, sp = 0u;
    for (;;) {
        sum = 0u; cnt = 0u; mine = 0u;
#pragma unroll
        for (unsigned j = 0; j < 16; ++j) { const unsigned c = xb_ld(&bar[XB_XCNT(j)]); sum += c; cnt += (c > 0u) ? 1u : 0u; mine = (j == x) ? c : mine; }
        if (sum == G) break;
        __builtin_amdgcn_s_sleep(1);
        if ((++sp & 255u) == 0u) { if (xb_ld(&bar[XB_TMO])) break; if (sp > XB_SPIN_CAP) { atomicAdd(&bar[XB_TMO], 1u); break; } }
    }
    nloc = mine > 0u ? mine : 1u; nx = cnt > 0u ? cnt : 1u;
}
__device__ __forceinline__ void xcd_barrier(const XcdBarrier& b) {
    asm volatile("s_waitcnt vmcnt(0)" ::: "memory");
    __syncthreads();
    if (threadIdx.x == 0) {
        unsigned* bar = b.bar;
        __builtin_amdgcn_s_waitcnt(0);
        unsigned nloc = b.st[0], nx = b.st[1];
        if (nloc == 0u) { xcd_barrier_complete(bar, b.x, nloc, nx); b.st[0] = nloc; b.st[1] = nx; }
        const unsigned old = xb_add(&bar[XB_XSUB(b.x)], 1u);
        const unsigned gen = old / nloc;
        if (old + 1u == (gen + 1u) * nloc) {
            __builtin_amdgcn_fence(__ATOMIC_RELEASE, "agent");
            asm volatile("s_waitcnt vmcnt(0)" ::: "memory");
            const unsigned og = xb_add(&bar[XB_TOP], 1u);
            const unsigned tg = og / nx;
            if (og + 1u == (tg + 1u) * nx) xb_add(&bar[XB_TOPGEN], 1u);
            else XB_SPIN(xb_ld(&bar[XB_TOPGEN]) == tg, bar);
            __builtin_amdgcn_fence(__ATOMIC_ACQUIRE, "agent");
            xb_add(&bar[XB_XGEN(b.x)], 1u);
            asm volatile("s_waitcnt vmcnt(0)" ::: "memory");
        } else {
            XB_SPIN(xb_ld(&bar[XB_XGEN(b.x)]) == gen, bar);
            __builtin_amdgcn_fence(__ATOMIC_ACQUIRE, "agent");
            asm volatile("s_waitcnt vmcnt(0)" ::: "memory");
        }
    }
    __syncthreads();
}

namespace pg8 {
constexpr int BM = 256, BK = 64, HALF = 128, HTB = HALF * BK * 2, STAGE_BYTES = 8 * HTB, NXCD = 8, WGM = 8;
__host__ __device__ __forceinline__ int lds_byte(int r, int c) { const int st = (r >> 4) * 2 + (c >> 5), rr = r & 15, cc = c & 31, ob = rr * 64 + cc * 2; return st * 1024 + (ob ^ (((ob >> 9) & 1) << 5)); }
__host__ __device__ __forceinline__ void stage_rc(int b, int& R, int& C) { const int st = b / 1024, sb = b % 1024, swz = sb ^ (((sb >> 9) & 1) << 5); R = (st >> 1) * 16 + swz / 64; C = (st & 1) * 32 + (swz % 64) / 2; }
__host__ __device__ __forceinline__ int perm32(int rho) { const int n = rho >> 4, i = rho & 15; return 8 * (i >> 2) + 4 * n + (i & 3); }

template <bool FP8> struct FragSel { struct A4 { bf16x8 f[4][2]; }; struct B2 { bf16x8 f[2][2]; }; };
template <> struct FragSel<true> { typedef int v8i_ __attribute__((ext_vector_type(8))); struct A4 { v8i_ f[4]; }; struct B2 { v8i_ f[2]; }; };
struct Unit { const char* A; const char* B; const int* ridx; int nt, pm, pn, aux; };

template <class Epi, class Sched, bool GATHER, bool FP8 = false>
__device__ __forceinline__ void gemm_phase(LAS unsigned char* lds, const int lda, const int ldb, const Sched& S, const Epi& E) {
    const int tid = threadIdx.x, wid = __builtin_amdgcn_readfirstlane(tid >> 6), lane = tid & 63, wr = wid >> 2, wc = wid & 3, fr = lane & 15, fq = lane >> 4;
    unsigned voffA[2], voffB[2]; int RA[2], CA[2];
#pragma unroll
    for (int i = 0; i < 2; ++i) { int R, C; stage_rc(tid * 16 + i * 8192, R, C); const int Rb = (R & ~31) + perm32(R & 31);
        RA[i] = R; CA[i] = C; voffA[i] = (unsigned)(R * lda + 2 * C); voffB[i] = (unsigned)(Rb * ldb + 2 * C); }
    const size_t kstep = (size_t)(BK * 2);
    const size_t hstepA = (size_t)HALF * lda, hstepB = (size_t)HALF * ldb;
    const unsigned ldsw = (unsigned)wid * 1024u;
    const int aoff = lds_byte(wr * 64 + fr, fq * 8), boff = lds_byte(wc * 32 + fr, fq * 8);
#define PG8_SA(b, h) (((b) * 2 + (h)) * HTB)
#define PG8_SB(b, h) ((4 + (b) * 2 + (h)) * HTB)
#define PG8_STG(bufoff, gptr, v0, v1) do { \
        __builtin_amdgcn_global_load_lds((const unsigned*)((const char*)(gptr) + (v0)), (LAS unsigned*)(lds + (bufoff) + ldsw), 16, 0, 0); \
        __builtin_amdgcn_global_load_lds((const unsigned*)((const char*)(gptr) + (v1)), (LAS unsigned*)(lds + (bufoff) + ldsw + 8192), 16, 0, 0); } while (0)
#define PG8_STB(b, h, kp) PG8_STG(PG8_SB(b, h), (kp) + (h) * hstepB, voffB[0], voffB[1])
#define PG8_STA_CUR(b, h, kp) do { if constexpr (GATHER) PG8_STG(PG8_SA(b, h), (kp), vg[h][0], vg[h][1]); else PG8_STG(PG8_SA(b, h), (kp) + (h) * hstepA, voffA[0], voffA[1]); } while (0)
#define PG8_STA_SEL(b, h, kp) do { if constexpr (GATHER) { const unsigned s0_ = last ? nvg[h][0] : vg[h][0], s1_ = last ? nvg[h][1] : vg[h][1]; PG8_STG(PG8_SA(b, h), (kp), s0_, s1_); } \
        else PG8_STG(PG8_SA(b, h), (kp) + (h) * hstepA, voffA[0], voffA[1]); } while (0)
#define PG8_LD16(off) (*(const LAS u32x4*)(lds + (off)))
#define PG8_LDA(dst, b, h) do { _Pragma("unroll") for (int m = 0; m < 4; ++m) { if constexpr (FP8) { const u32x4 lo_ = PG8_LD16(PG8_SA(b, h) + aoff + m * 2048), hi_ = PG8_LD16(PG8_SA(b, h) + aoff + m * 2048 + 1024); \
            dst.f[m] = __builtin_bit_cast(v8i_, __builtin_shufflevector(lo_, hi_, 0, 1, 2, 3, 4, 5, 6, 7)); } \
        else { _Pragma("unroll") for (int k = 0; k < 2; ++k) dst.f[m][k] = *(const LAS bf16x8*)(lds + PG8_SA(b, h) + aoff + m * 2048 + k * 1024); } } } while (0)
#define PG8_LDB(dst, b, h) do { _Pragma("unroll") for (int n = 0; n < 2; ++n) { if constexpr (FP8) { const u32x4 lo_ = PG8_LD16(PG8_SB(b, h) + boff + n * 2048), hi_ = PG8_LD16(PG8_SB(b, h) + boff + n * 2048 + 1024); \
            dst.f[n] = __builtin_bit_cast(v8i_, __builtin_shufflevector(lo_, hi_, 0, 1, 2, 3, 4, 5, 6, 7)); } \
        else { _Pragma("unroll") for (int k = 0; k < 2; ++k) dst.f[n][k] = *(const LAS bf16x8*)(lds + PG8_SB(b, h) + boff + n * 2048 + k * 1024); } } } while (0)
#define PG8_MMA(ai, bj, At, Bt) do { __builtin_amdgcn_s_setprio(1); _Pragma("unroll") for (int m = 0; m < 4; ++m) _Pragma("unroll") for (int n = 0; n < 2; ++n) { \
        if constexpr (FP8) asm volatile("v_mfma_scale_f32_16x16x128_f8f6f4 %0, %1, %2, %0, %3, %3 op_sel_hi:[0,0,0]" : "+v"(acc[ai][bj][m][n]) : "v"(Bt.f[n]), "v"(At.f[m]), "v"(fp8_one)); \
        else { _Pragma("unroll") for (int k = 0; k < 2; ++k) acc[ai][bj][m][n] = __builtin_amdgcn_mfma_f32_16x16x32_bf16(Bt.f[n][k], At.f[m][k], acc[ai][bj][m][n], 0, 0, 0); } } \
        __builtin_amdgcn_s_setprio(0); } while (0)
#define PG8_WAIT_V(n) asm volatile("s_waitcnt vmcnt(" #n ")" ::: "memory")
#define PG8_WAIT_L(n) asm volatile("s_waitcnt lgkmcnt(" #n ")" ::: "memory")
#define PG8_BAR __builtin_amdgcn_s_barrier()
#define PG8_SCHED __builtin_amdgcn_sched_barrier(0)
#define PG8_LOADIDX(dst, u) do { if constexpr (GATHER) { _Pragma("unroll") for (int h = 0; h < 2; ++h) _Pragma("unroll") for (int i = 0; i < 2; ++i) \
        dst[h][i] = (unsigned)(u).ridx[h * HALF + RA[i]] * (unsigned)lda + (unsigned)(CA[i] * 2); } } while (0)
    Unit cur, nxt; int ui = 0;
    if (!S.next(0, cur)) return;
#define PG8_PIN_ACC() do { _Pragma("unroll") for (int a_ = 0; a_ < 2; ++a_) _Pragma("unroll") for (int b_ = 0; b_ < 2; ++b_) \
        asm volatile("" : "+v"(acc[a_][b_][0][0]), "+v"(acc[a_][b_][0][1]), "+v"(acc[a_][b_][1][0]), "+v"(acc[a_][b_][1][1]), "+v"(acc[a_][b_][2][0]), "+v"(acc[a_][b_][2][1]), "+v"(acc[a_][b_][3][0]), "+v"(acc[a_][b_][3][1])); } while (0)

    f32x4 acc[2][2][4][2];
    E.init(acc, cur, wr, wc, fr, fq);
    typedef int v8i_ __attribute__((ext_vector_type(8)));
    typedef typename pg8::FragSel<FP8>::A4 FragA; typedef typename pg8::FragSel<FP8>::B2 FragB;
    FragA At; FragB B0, B1;
    int fp8_one = 0x7f7f7f7f; if constexpr (FP8) asm volatile("" : "+v"(fp8_one));
    unsigned vg[2][2] = {{0u, 0u}, {0u, 0u}}, nvg[2][2] = {{0u, 0u}, {0u, 0u}};
    const char* cA = cur.A; const char* cB = cur.B;
    PG8_LOADIDX(vg, cur);
    { const bool last = false; (void)last;
      PG8_STB(0, 0, cB); PG8_STB(0, 1, cB); PG8_STA_CUR(0, 0, cA); PG8_STA_CUR(0, 1, cA);
      if (wr == 1) PG8_BAR;
      PG8_WAIT_V(2); PG8_BAR;
      PG8_STB(1, 0, cB + kstep); PG8_STA_CUR(1, 0, cA + kstep); PG8_STB(1, 1, cB + kstep);
      PG8_WAIT_V(6); PG8_BAR; }
    if constexpr (Epi::INIT_LOADS) PG8_PIN_ACC();
    for (;;) {
        const bool has_next = S.next(ui + 1, nxt);
        const char* nA = has_next ? nxt.A : cA; const char* nB = has_next ? nxt.B : cB;
        if constexpr (GATHER) { if (has_next) { PG8_LOADIDX(nvg, nxt); } else { nvg[0][0] = vg[0][0]; nvg[0][1] = vg[0][1]; nvg[1][0] = vg[1][0]; nvg[1][1] = vg[1][1]; } }
        const int nt = cur.nt;
        for (int t = 0; t < nt; t += 2) {
            const bool last = (t == nt - 2);
            const char* a1 = cA + (size_t)(t + 1) * kstep;
            const char* a2 = last ? nA : cA + (size_t)(t + 2) * kstep; const char* b2 = last ? nB : cB + (size_t)(t + 2) * kstep;
            const char* a3 = a2 + kstep; const char* b3 = b2 + kstep;
            PG8_LDB(B0, 0, 0); PG8_LDB(B1, 0, 1); PG8_SCHED; PG8_LDA(At, 0, 0); PG8_STA_CUR(1, 1, a1);
            PG8_WAIT_V(8); PG8_WAIT_L(0); PG8_BAR; PG8_MMA(0, 0, At, B0); PG8_MMA(0, 1, At, B1); PG8_BAR; PG8_SCHED;
            PG8_LDA(At, 0, 1); PG8_STB(0, 0, b2); PG8_STB(0, 1, b2); PG8_STA_SEL(0, 0, a2);
            PG8_WAIT_V(8); PG8_WAIT_L(0); PG8_BAR; PG8_MMA(1, 0, At, B0); PG8_MMA(1, 1, At, B1); PG8_BAR; PG8_SCHED;
            PG8_LDB(B0, 1, 0); PG8_LDB(B1, 1, 1); PG8_SCHED; PG8_LDA(At, 1, 0); PG8_STA_SEL(0, 1, a2);
            PG8_WAIT_V(8); PG8_WAIT_L(0); PG8_BAR; PG8_MMA(0, 0, At, B0); PG8_MMA(0, 1, At, B1); PG8_BAR; PG8_SCHED;
            PG8_LDA(At, 1, 1); PG8_STB(1, 0, b3); PG8_STB(1, 1, b3); PG8_STA_SEL(1, 0, a3);
            PG8_WAIT_V(8); PG8_WAIT_L(0); PG8_BAR; PG8_MMA(1, 0, At, B0); PG8_MMA(1, 1, At, B1); PG8_BAR; PG8_SCHED;
        }
        if (wr == 0) PG8_BAR;
        if constexpr (FP8) { asm volatile("s_nop 15\n\ts_nop 15\n\ts_nop 15" ::: "memory"); PG8_PIN_ACC(); }
        E(acc, cur, wr, wc, fr, fq);
        if (!has_next) break;
        E.init(acc, nxt, wr, wc, fr, fq);
        if constexpr (Epi::INIT_LOADS) PG8_PIN_ACC();
        cur = nxt; cA = nA; cB = nB; ++ui;
        if constexpr (GATHER) { vg[0][0] = nvg[0][0]; vg[0][1] = nvg[0][1]; vg[1][0] = nvg[1][0]; vg[1][1] = nvg[1][1]; }
        if (wr == 1) PG8_BAR;
    }
    PG8_WAIT_V(0);
    PG8_BAR;
#undef PG8_SA
#undef PG8_SB
#undef PG8_STG
#undef PG8_STB
#undef PG8_STA_CUR
#undef PG8_STA_SEL
#undef PG8_LDA
#undef PG8_LD16
#undef PG8_LDB
#undef PG8_MMA
#undef PG8_WAIT_V
#undef PG8_WAIT_L
#undef PG8_BAR
#undef PG8_SCHED
#undef PG8_LOADIDX
#undef PG8_PIN_ACC
}
}

#define EPI_ZERO_INIT static constexpr bool INIT_LOADS = false; __device__ __forceinline__ void init(f32x4 (&acc)[2][2][4][2], const pg8::Unit&, int, int, int, int) const { \
        _Pragma("unroll") for (int a = 0; a < 2; ++a) _Pragma("unroll") for (int b = 0; b < 2; ++b) _Pragma("unroll") for (int m = 0; m < 4; ++m) _Pragma("unroll") for (int n = 0; n < 2; ++n) acc[a][b][m][n] = (f32x4){0.f, 0.f, 0.f, 0.f}; }
constexpr size_t WS_ROWTOK = 15 * MiB;
struct TileOrder {
    int nM, nN, nwg;
    __device__ __forceinline__ void init(int nM_, int nN_) { nM = nM_; nN = nN_; nwg = nM_ * nN_; }
    __device__ __forceinline__ void decode(int L, int& pm, int& pn) const {
        int wgid = L; { const int q = nwg / pg8::NXCD, r = nwg % pg8::NXCD, xcd = wgid % pg8::NXCD, off = wgid / pg8::NXCD; wgid = (xcd < r ? xcd * (q + 1) : r * (q + 1) + (xcd - r) * q) + off; }
        const int nig = pg8::WGM * nN, gid = wgid / nig, fm = gid * pg8::WGM, gsz = (nM - fm) < pg8::WGM ? (nM - fm) : pg8::WGM;
        pm = fm + ((wgid % nig) % gsz); pn = (wgid % nig) / gsz;
    }
};
#ifndef P1_FP8_MASK
#define P1_FP8_MASK 0x3FFFFu
#endif
constexpr unsigned FP8M = P1_FP8_MASK & 0x3ffffu;
constexpr int NF8 = __builtin_popcount(FP8M), NB16 = 18 - NF8;
__device__ __forceinline__ int nth_set(unsigned m, int n) { for (int i = 0; i < n; ++i) m &= m - 1; return __builtin_ctz(m); }
struct Sched1 {
    TileOrder o; const char* A; const char* Bt; int G, c, fp8;
    __device__ __forceinline__ bool next(int i, pg8::Unit& u) const {
        const int L = i * G + c; int pm, pn;
        if (fp8) { constexpr int NT8 = 64 * (24 + NF8), NBU = 64 * NB16 + 32;
            int L8 = L;
            if (NBU < G) { const int RB = NT8 / G, rem = NT8 - RB * G, nfree = G - NBU;
                if (c < NBU) { if (i >= RB - 1) return false; }
                else if (i >= RB) { const int e = (i - RB) * nfree + (c - NBU); if (e >= NBU + rem) return false; L8 = e < NBU ? (RB - 1) * G + e : RB * G + (e - NBU); } }
            if (L8 >= NT8) return false; o.decode(L8, pm, pn);
            u.A = A + (size_t)pm * 256 * D; u.B = Bt + (size_t)pn * 256 * D; u.nt = D / 128; pn = pn < 24 ? pn + 18 : nth_set(FP8M, pn - 24); u.aux = 1; }
        else { if (L < 64 * NB16) { o.decode(L, pm, pn); pn = nth_set(~FP8M & 0x3ffffu, pn); } else if (L < 64 * NB16 + 32) { const int r = L - 64 * NB16; pm = 64 + (r >> 2); pn = 43 + (r & 3); } else return false;
            u.A = A + (size_t)pm * 256 * D * 2; u.B = Bt + (size_t)pn * 256 * D * 2; u.nt = D / 64; u.aux = 0; }
        u.ridx = nullptr; u.pm = pm; u.pn = pn; return true;
    }
};
struct Epi1 {
    EPI_ZERO_INIT
    bf16_t* PA; unsigned char* PG8; float* GL; bf16_t* KVM;
    __device__ __forceinline__ void operator()(const f32x4 (&acc)[2][2][4][2], const pg8::Unit& u, int wr, int wc, int fr, int fq) const {
        const int pn = u.pn; int row0 = u.pm * 256 + wr * 64 + fr;
        if (pn == 42) {
            if (wc == 0) {
#pragma unroll
                for (int ai = 0; ai < 2; ++ai)
#pragma unroll
                    for (int m = 0; m < 4; ++m) { float* p = GL + (size_t)(row0 + ai * 128 + m * 16) * LDG + 8 * fq; *(f32x4*)p = acc[ai][0][m][0]; *(f32x4*)(p + 4) = acc[ai][0][m][1]; }
            }
            return;
        }
        if (pn >= 18 && pn < 42) {
            unsigned char* gb = PG8 + (pn - 18) * 256 + wc * 32 + 8 * fq;
#pragma unroll
            for (int ai = 0; ai < 2; ++ai)
#pragma unroll
                for (int m = 0; m < 4; ++m) { unsigned char* rowp = gb + (size_t)(row0 + ai * 128 + m * 16) * NPG;
#pragma unroll
                    for (int bj = 0; bj < 2; ++bj) { const f32x4 v0 = acc[ai][bj][m][0] * (1.f / WIN_SCALE), v1 = acc[ai][bj][m][1] * (1.f / WIN_SCALE); unsigned w0 = 0u, w1 = 0u;
                        w0 = __builtin_amdgcn_cvt_pk_u8_f32(fast_sigmoid(v0[0]) * 255.f, 0, w0); w0 = __builtin_amdgcn_cvt_pk_u8_f32(fast_sigmoid(v0[1]) * 255.f, 1, w0);
                        w0 = __builtin_amdgcn_cvt_pk_u8_f32(fast_sigmoid(v0[2]) * 255.f, 2, w0); w0 = __builtin_amdgcn_cvt_pk_u8_f32(fast_sigmoid(v0[3]) * 255.f, 3, w0);
                        w1 = __builtin_amdgcn_cvt_pk_u8_f32(fast_sigmoid(v1[0]) * 255.f, 0, w1); w1 = __builtin_amdgcn_cvt_pk_u8_f32(fast_sigmoid(v1[1]) * 255.f, 1, w1);
                        w1 = __builtin_amdgcn_cvt_pk_u8_f32(fast_sigmoid(v1[2]) * 255.f, 2, w1); w1 = __builtin_amdgcn_cvt_pk_u8_f32(fast_sigmoid(v1[3]) * 255.f, 3, w1);
                        *(u32x2*)(rowp + bj * 128) = (u32x2){w0, w1}; } }
            return;
        }
        bf16_t* base; int ld;
        if (pn < 18) { base = PA + pn * 256; ld = NPA; }
        else { base = KVM + (pn - 43) * 256; ld = 1024; row0 -= M; }
        base += wc * 32 + 8 * fq;
        const float sc = u.aux ? 1.f / WIN_SCALE : 1.f;
#pragma unroll
        for (int ai = 0; ai < 2; ++ai)
#pragma unroll
            for (int m = 0; m < 4; ++m) { bf16_t* rowp = base + (size_t)(row0 + ai * 128 + m * 16) * ld;
#pragma unroll
                for (int bj = 0; bj < 2; ++bj) { const f32x4 v0 = acc[ai][bj][m][0] * sc, v1 = acc[ai][bj][m][1] * sc;
                    u32x4 w; w.x = cvtpk(v0[0], v0[1]); w.y = cvtpk(v0[2], v0[3]); w.z = cvtpk(v1[0], v1[1]); w.w = cvtpk(v1[2], v1[3]);
                    *(u32x4*)(rowp + bj * 128) = w; } }
    }
};
struct Sched4 {
    TileOrder o; const char* A; const char* Bt; int G, c;
    __device__ __forceinline__ bool next(int i, pg8::Unit& u) const {
        const int it = i / 3, br = i - it * 3, L = it * G + c; if (L >= 64 * 8) return false;
        int pm, pn; o.decode(L, pm, pn);
        const int koff = br == 0 ? 0 : (br == 1 ? 1024 : 1536);
        u.A = A + ((size_t)pm * 256 * D + koff) * 2; u.B = Bt + ((size_t)pn * 256 * D + koff) * 2; u.ridx = nullptr; u.nt = br == 0 ? 16 : 8; u.pm = pm; u.pn = pn; u.aux = br; return true;
    }
};
struct Epi4 {
    EPI_ZERO_INIT
    const unsigned char* PG8; bf16_t* Z;
    __device__ __forceinline__ void operator()(const f32x4 (&acc)[2][2][4][2], const pg8::Unit& u, int wr, int wc, int fr, int fq) const {
        const int row0 = u.pm * 256 + wr * 64 + fr, col0 = u.pn * 256 + wc * 32 + 8 * fq, br = u.aux;
#pragma unroll
        for (int ai = 0; ai < 2; ++ai) {
            u32x2 gv[4][2]; u32x4 zv[4][2];
#pragma unroll
            for (int m = 0; m < 4; ++m) { const size_t row = (size_t)(row0 + ai * 128 + m * 16);
#pragma unroll
                for (int bj = 0; bj < 2; ++bj) { const int col = col0 + bj * 128; gv[m][bj] = *(const u32x2*)(PG8 + row * NPG + br * D + col);
                    if (br > 0) zv[m][bj] = *(const u32x4*)(Z + row * D + col); else zv[m][bj] = (u32x4){0u, 0u, 0u, 0u}; } }
#pragma unroll
            for (int m = 0; m < 4; ++m) { const size_t row = (size_t)(row0 + ai * 128 + m * 16);
#pragma unroll
                for (int bj = 0; bj < 2; ++bj) { const int col = col0 + bj * 128; const u32x2 g = gv[m][bj]; const u32x4 z = zv[m][bj]; const float gs = 1.f / 255.f;
                    f32x4 v0 = acc[ai][bj][m][0] * gs, v1 = acc[ai][bj][m][1] * gs;
                    v0[0] = v0[0] * (float)(g.x & 0xffu) + bf_lo(z.x); v0[1] = v0[1] * (float)((g.x >> 8) & 0xffu) + bf_hi(z.x); v0[2] = v0[2] * (float)((g.x >> 16) & 0xffu) + bf_lo(z.y); v0[3] = v0[3] * (float)(g.x >> 24) + bf_hi(z.y);
                    v1[0] = v1[0] * (float)(g.y & 0xffu) + bf_lo(z.z); v1[1] = v1[1] * (float)((g.y >> 8) & 0xffu) + bf_hi(z.z); v1[2] = v1[2] * (float)((g.y >> 16) & 0xffu) + bf_lo(z.w); v1[3] = v1[3] * (float)(g.y >> 24) + bf_hi(z.w);
                    u32x4 w; w.x = cvtpk(v0[0], v0[1]); w.y = cvtpk(v0[2], v0[3]); w.z = cvtpk(v1[0], v1[1]); w.w = cvtpk(v1[2], v1[3]);
                    *(u32x4*)(Z + row * D + col) = w; } }
        }
    }
};
struct Sched5 {
    TileOrder o; const char* A; const char* Bt; int G, c;
    __device__ __forceinline__ bool next(int i, pg8::Unit& u) const {
        const int L = i * G + c; if (L >= 64 * 8) return false;
        int pm, pn; o.decode(L, pm, pn);
        u.A = A + (size_t)pm * 256 * D * 2; u.B = Bt + (size_t)pn * 256 * D * 2; u.ridx = nullptr; u.nt = D / 64; u.pm = pm; u.pn = pn; u.aux = 0; return true;
    }
};
struct Epi5 {
    static constexpr bool INIT_LOADS = true;
    const float* X; bf16_t* O;
    __device__ __forceinline__ void init(f32x4 (&acc)[2][2][4][2], const pg8::Unit& u, int wr, int wc, int fr, int fq) const {
        const int row0 = u.pm * 256 + wr * 64 + fr, col0 = u.pn * 256 + wc * 32 + 8 * fq;
#pragma unroll
        for (int ai = 0; ai < 2; ++ai)
#pragma unroll
            for (int m = 0; m < 4; ++m) { const size_t off = (size_t)(row0 + ai * 128 + m * 16) * D + col0;
#pragma unroll
                for (int bj = 0; bj < 2; ++bj) { acc[ai][bj][m][0] = *(const f32x4*)(X + off + bj * 128); acc[ai][bj][m][1] = *(const f32x4*)(X + off + bj * 128 + 4); } }
    }
    __device__ __forceinline__ void operator()(const f32x4 (&acc)[2][2][4][2], const pg8::Unit& u, int wr, int wc, int fr, int fq) const {
        const int row0 = u.pm * 256 + wr * 64 + fr, col0 = u.pn * 256 + wc * 32 + 8 * fq;
#pragma unroll
        for (int ai = 0; ai < 2; ++ai)
#pragma unroll
            for (int m = 0; m < 4; ++m) { const size_t off = (size_t)(row0 + ai * 128 + m * 16) * D + col0;
#pragma unroll
                for (int bj = 0; bj < 2; ++bj) { const f32x4 v0 = acc[ai][bj][m][0], v1 = acc[ai][bj][m][1];
                    u32x4 w; w.x = cvtpk(v0[0], v0[1]); w.y = cvtpk(v0[2], v0[3]); w.z = cvtpk(v1[0], v1[1]); w.w = cvtpk(v1[2], v1[3]);
                    *(u32x4*)(O + off + bj * 128) = w; } }
    }
};
struct SchedMoe {
    const LAS unsigned char* blk_e; int nblk, G, c, npn_shift;
    const char* A; const char* W; const int* rowtok; bool up;
    __device__ __forceinline__ bool next(int i, pg8::Unit& u) const {
        int L; if (G == 256) L = ((i * 8 + (c & 7)) * 32 + (c >> 3)); else L = i * G + c;
        const int blk = L >> npn_shift, pn = L & ((1 << npn_shift) - 1);
        if (blk >= nblk) { if (G != 256) return false; return false; }
        const int e = blk_e[blk];
        if (up) { u.A = A; u.ridx = rowtok + blk * 256; u.B = W + ((size_t)e * 1024 + pn * 256) * D; u.nt = D / 128; }
        else    { u.A = A + (size_t)blk * 256 * DE; u.ridx = nullptr; u.B = W + ((size_t)e * D + pn * 256) * DE; u.nt = DE / 128; }
        u.pm = blk; u.pn = pn; u.aux = e; return true;
    }
};
struct Epi8 {  EPI_ZERO_INIT
    unsigned char* HID;
    __device__ __forceinline__ void operator()(const f32x4 (&acc)[2][2][4][2], const pg8::Unit& u, int wr, int wc, int fr, int fq) const {
        const int row0 = u.pm * 256 + wr * 64 + fr, col0 = u.pn * 128 + wc * 32 + 8 * fq; const float rs = 1.f / WGU_SCALE;
#pragma unroll
        for (int ai = 0; ai < 2; ++ai)
#pragma unroll
            for (int m = 0; m < 4; ++m) { float h[8];
#pragma unroll
                for (int e = 0; e < 4; ++e) { const float g0 = acc[ai][0][m][0][e] * rs, g1 = acc[ai][0][m][1][e] * rs;
                    h[e] = __builtin_amdgcn_fmed3f(g0 * fast_sigmoid(g0) * (acc[ai][1][m][0][e] * rs), -440.f, 440.f); h[4 + e] = __builtin_amdgcn_fmed3f(g1 * fast_sigmoid(g1) * (acc[ai][1][m][1][e] * rs), -440.f, 440.f); }
                *(u32x2*)(HID + (size_t)(row0 + ai * 128 + m * 16) * DE + col0) = (u32x2){pk_fp8x4(h[0], h[1], h[2], h[3]), pk_fp8x4(h[4], h[5], h[6], h[7])}; }
    }
};
constexpr float Y_SCALE = 16.f;
struct Epi9 {  EPI_ZERO_INIT
    const int* rowasg; const float* rowg; unsigned char* Y;
    __device__ __forceinline__ void operator()(const f32x4 (&acc)[2][2][4][2], const pg8::Unit& u, int wr, int wc, int fr, int fq) const {
        const int row0 = u.pm * 256 + wr * 64 + fr, col0 = u.pn * 256 + wc * 32 + 8 * fq;
        int asg[2][4]; float g[2][4];
#pragma unroll
        for (int ai = 0; ai < 2; ++ai)
#pragma unroll
            for (int m = 0; m < 4; ++m) { const int slot = row0 + ai * 128 + m * 16; asg[ai][m] = rowasg[slot]; g[ai][m] = rowg[slot] * (Y_SCALE / WD_SCALE); }
#pragma unroll
        for (int ai = 0; ai < 2; ++ai)
#pragma unroll
            for (int m = 0; m < 4; ++m) {
                if (asg[ai][m] >= 0) { unsigned char* yp = Y + (size_t)asg[ai][m] * D + col0; const float gg = g[ai][m];
#pragma unroll
                    for (int bj = 0; bj < 2; ++bj) { f32x4 v0 = acc[ai][bj][m][0] * gg, v1 = acc[ai][bj][m][1] * gg;
#pragma unroll
                        for (int e = 0; e < 4; ++e) { v0[e] = __builtin_amdgcn_fmed3f(v0[e], -440.f, 440.f); v1[e] = __builtin_amdgcn_fmed3f(v1[e], -440.f, 440.f); }
                        int w0 = 0, w1 = 0;
                        w0 = __builtin_amdgcn_cvt_pk_fp8_f32(v0[0], v0[1], w0, false); w0 = __builtin_amdgcn_cvt_pk_fp8_f32(v0[2], v0[3], w0, true);
                        w1 = __builtin_amdgcn_cvt_pk_fp8_f32(v1[0], v1[1], w1, false); w1 = __builtin_amdgcn_cvt_pk_fp8_f32(v1[2], v1[3], w1, true);
                        *(u32x2*)(yp + bj * 128) = (u32x2){(unsigned)w0, (unsigned)w1}; } } }
    }
};

struct Frame {
    LAS unsigned char* lds; int tid, lane, wave, G, gw, NGW;
    float* out; unsigned char* ws;
    __device__ __forceinline__ const float* in(int i) const { return ((const float* const __attribute__((address_space(4)))*)__builtin_amdgcn_kernarg_segment_ptr())[i]; }
};
#define LDS_WAIT() asm volatile("s_waitcnt lgkmcnt(0)" ::: "memory")
template <class SrcCol, class DstRow>
__device__ __forceinline__ void tr_item(const float* W, size_t ldw, int k0, int n0, const SrcCol& sc, bf16_t* WT, size_t ldt, int kd0, const DstRow& dr, LAS float* scr, int lane) {
    const int c = sc(n0 + (lane & 31));
#pragma unroll 8
    for (int i = 0; i < 32; ++i) { const int kk = 2 * i + (lane >> 5); scr[kk * 33 + (lane & 31)] = c >= 0 ? W[(size_t)(k0 + kk) * ldw + c] : 0.f; }
    LDS_WAIT(); asm volatile("" ::: "memory");
    const int c8 = lane & 7;
#pragma unroll
    for (int j = 0; j < 4; ++j) { const int n = (lane >> 3) + 8 * j; const LAS float* s = scr + (8 * c8) * 33 + n;
        u32x4 o; o.x = cvtpk(s[0 * 33], s[1 * 33]); o.y = cvtpk(s[2 * 33], s[3 * 33]); o.z = cvtpk(s[4 * 33], s[5 * 33]); o.w = cvtpk(s[6 * 33], s[7 * 33]);
        *(u32x4*)(WT + (size_t)dr(n0 + n) * ldt + kd0 + k0 + 8 * c8) = o; }
    LDS_WAIT(); asm volatile("" ::: "memory");
}
struct IdCol { __device__ __forceinline__ int operator()(int n) const { return n; } };
struct OffRow { int off; __device__ __forceinline__ int operator()(int n) const { return off + n; } };
struct WinCol {
    __device__ __forceinline__ int operator()(int n) const {
        if (n < 2560) return n; if (n < 4096) return 2584 + (n - 2560); if (n < 4608) return 4124 + (n - 4096); if (n < 10752) return 4636 + (n - 4608);
        if (n < 10776) return 2560 + (n - 10752); if (n < 10780) return 4120 + (n - 10776); return -1; }
};
struct GuRow { int up; __device__ __forceinline__ int operator()(int j) const { return (j >> 7) * 256 + up * 128 + (j & 127); } };
__device__ __forceinline__ void rms_row_bf16(const float* xrow, const float* gain, bf16_t* orow, int lane) {
    f32x4 v[8]; float s = 0.f;
#pragma unroll
    for (int j = 0; j < 8; ++j) { v[j] = *(const f32x4*)(xrow + 4 * lane + 256 * j); s += (v[j].x * v[j].x + v[j].y * v[j].y) + (v[j].z * v[j].z + v[j].w * v[j].w); }
    const float rstd = __builtin_amdgcn_rsqf(wave_sum(s) * (1.f / D) + RMS_EPS);
#pragma unroll
    for (int j = 0; j < 8; ++j) { const f32x4 g = *(const f32x4*)(gain + 4 * lane + 256 * j);
        u32x2 o; o.x = cvtpk(v[j].x * rstd * g.x, v[j].y * rstd * g.y); o.y = cvtpk(v[j].z * rstd * g.z, v[j].w * rstd * g.w);
        *(u32x2*)(orow + 4 * lane + 256 * j) = o; }
}
__device__ __forceinline__ void rms_row_both(const float* xrow, const float* gain, bf16_t* orow, unsigned char* orow8, int lane) {
    f32x4 v[8]; float s = 0.f;
#pragma unroll
    for (int j = 0; j < 8; ++j) { v[j] = *(const f32x4*)(xrow + 4 * lane + 256 * j); s += (v[j].x * v[j].x + v[j].y * v[j].y) + (v[j].z * v[j].z + v[j].w * v[j].w); }
    const float rstd = __builtin_amdgcn_rsqf(wave_sum(s) * (1.f / D) + RMS_EPS);
#pragma unroll
    for (int j = 0; j < 8; ++j) { const f32x4 g = *(const f32x4*)(gain + 4 * lane + 256 * j); const float a = v[j].x * rstd * g.x, b = v[j].y * rstd * g.y, c = v[j].z * rstd * g.z, d = v[j].w * rstd * g.w;
        u32x2 o; o.x = cvtpk(a, b); o.y = cvtpk(c, d); *(u32x2*)(orow + 4 * lane + 256 * j) = o;
        *(unsigned*)(orow8 + 4 * lane + 256 * j) = pk_fp8x4(a, b, c, d); }
}
__device__ __forceinline__ float dot2c_bf16(float acc, unsigned a, unsigned b) { asm("v_dot2c_f32_bf16 %0, %1, %2" : "+v"(acc) : "v"(a), "v"(b)); return acc; }
template <bool WRITE_BF16>
__device__ __forceinline__ void rms_row_logits(const float* xrow, const float* gain, bf16_t* orow, unsigned char* orow8, float* glrow, const LAS unsigned char* WL, int lane) {
    f32x4 v[8]; float s = 0.f;
#pragma unroll
    for (int j = 0; j < 8; ++j) { v[j] = *(const f32x4*)(xrow + 4 * lane + 256 * j); s += (v[j].x * v[j].x + v[j].y * v[j].y) + (v[j].z * v[j].z + v[j].w * v[j].w); }
    const float rstd = __builtin_amdgcn_rsqf(wave_sum(s) * (1.f / D) + RMS_EPS);
    u32x2 hb[8];
#pragma unroll
    for (int j = 0; j < 8; ++j) { const f32x4 g = *(const f32x4*)(gain + 4 * lane + 256 * j); const float a = v[j].x * rstd * g.x, b = v[j].y * rstd * g.y, c = v[j].z * rstd * g.z, d = v[j].w * rstd * g.w;
        hb[j].x = cvtpk(a, b); hb[j].y = cvtpk(c, d); if (WRITE_BF16) *(u32x2*)(orow + 4 * lane + 256 * j) = hb[j];
        *(unsigned*)(orow8 + 4 * lane + 256 * j) = pk_fp8x4(a, b, c, d); }
    float lg[32];
#pragma unroll
    for (int c = 0; c < 32; ++c) lg[c] = 0.f;
#pragma unroll
    for (int j = 0; j < 8; ++j) {
        u32x2 w[28];
#pragma unroll
        for (int c = 0; c < 28; ++c) w[c] = *(const LAS u32x2*)(WL + (size_t)(c * 2048 + 4 * lane + 256 * j) * 2);
        asm volatile("s_waitcnt lgkmcnt(0)" ::: "memory"); __builtin_amdgcn_sched_barrier(0);
#pragma unroll
        for (int c = 0; c < 28; ++c) { lg[c] = dot2c_bf16(lg[c], hb[j].x, w[c].x); lg[c] = dot2c_bf16(lg[c], hb[j].y, w[c].y); }
        __builtin_amdgcn_sched_barrier(0); }
    float r1[16];
#pragma unroll
    for (int i = 0; i < 16; ++i) { const auto sw = __builtin_amdgcn_permlane32_swap(__float_as_uint(lg[i]), __float_as_uint(lg[i + 16]), false, false); r1[i] = __uint_as_float(sw[0]) + __uint_as_float(sw[1]); }
    float r2[8];
#pragma unroll
    for (int i = 0; i < 8; ++i) { const auto sw = __builtin_amdgcn_permlane16_swap(__float_as_uint(r1[i]), __float_as_uint(r1[i + 8]), false, false); r2[i] = __uint_as_float(sw[0]) + __uint_as_float(sw[1]); }
#pragma unroll
    for (int i = 0; i < 8; ++i) {
        float t = r2[i];
        t += __builtin_bit_cast(float, __builtin_amdgcn_update_dpp(0, __builtin_bit_cast(int, t), 0x128, 0xF, 0xF, false));
        t += __builtin_bit_cast(float, __builtin_amdgcn_update_dpp(0, __builtin_bit_cast(int, t), 0x124, 0xF, 0xF, false));
        t += __builtin_bit_cast(float, __builtin_amdgcn_update_dpp(0, __builtin_bit_cast(int, t), 0x122, 0xF, 0xF, false));
        t += __builtin_bit_cast(float, __builtin_amdgcn_update_dpp(0, __builtin_bit_cast(int, t), 0x121, 0xF, 0xF, false));
        r2[i] = t; }
    if ((lane & 15) == 0) { float* p = glrow + 8 * (lane >> 4); *(f32x4*)p = (f32x4){r2[0], r2[1], r2[2], r2[3]}; *(f32x4*)(p + 4) = (f32x4){r2[4], r2[5], r2[6], r2[7]}; }
}
enum { I_X = 0, I_MEM, I_NORM_ATTN_G, I_W_IN, I_PE_K, I_W_CK, I_PE_V, I_W_CV, I_NSA_Q_G, I_NSA_K_G, I_REL_BIAS, I_FOX_B_F, I_FOX_Q_G, I_FOX_K_G, I_NORM_MEM_G, I_W_MEM_KV,
       I_MEM_Q_G, I_MEM_K_G, I_W_O_NSA, I_W_O_FOX, I_W_O_MEM, I_W_OUT, I_NORM_FFN_G, I_W_ROUTER, I_ROUTER_BIAS, I_WE_GATE, I_WE_UP, I_WE_DOWN, I_WS_GATE, I_WS_UP, I_WS_DOWN, N_IN };

struct TrDesc { const float* src; bf16_t* dst; unsigned ldw, ldt; };
__device__ __forceinline__ TrDesc tr_decode(const Frame& F, int t) {
    unsigned char* ws = F.ws; TrDesc d;
    bf16_t* WinT = (bf16_t*)(ws + WS_WINT); bf16_t* WkvT = WinT + (size_t)NPAD * D; bf16_t* WoT = (bf16_t*)(ws + WS_WOT);
    bf16_t* Wgu = (bf16_t*)(ws + WS_WGU); bf16_t* Wd = (bf16_t*)(ws + WS_WD);
    constexpr int T0 = 16 * 2 * NB16, T1 = T0 + 128, T2 = T1 + 128, T3 = T2 + 64, T4 = T3 + 64, T5 = T4 + 256, T6 = T5 + 32, T7 = T6 + 32, T8 = T7 + 65 * 64, T9 = T8 + 65 * 64;
    if (t < T0) { constexpr int NU = NB16 ? 2 * NB16 : 1; const int kt = t / NU, nt = t - kt * NU, n0 = 256 * nth_set(~FP8M & 0x3ffffu, nt >> 1) + 128 * (nt & 1); const int sc = WinCol{}(n0);
        d.src = F.in(I_W_IN) + (size_t)(128 * kt) * W_IN_COLS + sc; d.ldw = W_IN_COLS; d.dst = WinT + (size_t)n0 * D + 128 * kt; d.ldt = D; }
    else if (t < T1) { const int r = t - T0, kt = r >> 3, nt = r & 7; d.src = F.in(I_W_MEM_KV) + (size_t)(128 * kt) * 1024 + 128 * nt; d.ldw = 1024; d.dst = WkvT + (size_t)(128 * nt) * D + 128 * kt; d.ldt = D; }
    else if (t < T2) { const int r = t - T1, kt = r >> 4, nt = r & 15; d.src = F.in(I_W_O_NSA) + (size_t)(128 * kt) * D + 128 * nt; d.ldw = D; d.dst = WoT + (size_t)(128 * nt) * D + 128 * kt; d.ldt = D; }
    else if (t < T4) { const int mm = t >= T3, r = t - (mm ? T3 : T2), kt = r >> 4, nt = r & 15; d.src = F.in(mm ? I_W_O_MEM : I_W_O_FOX) + (size_t)(128 * kt) * D + 128 * nt; d.ldw = D; d.dst = WoT + (size_t)(128 * nt) * D + (mm ? 1536 : 1024) + 128 * kt; d.ldt = D; }
    else if (t < T5) { const int r = t - T4, kt = r >> 4, nt = r & 15; d.src = F.in(I_W_OUT) + (size_t)(128 * kt) * D + 128 * nt; d.ldw = D; d.dst = (bf16_t*)(ws + WS_WOUTT) + (size_t)(128 * nt) * D + 128 * kt; d.ldt = D; }
    else if (t < T7) { const int v = t >= T6, kt = t - (v ? T6 : T5); d.src = F.in(v ? I_W_CV : I_W_CK) + (size_t)(128 * kt) * 128; d.ldw = 128; d.dst = (bf16_t*)(ws + (v ? WS_WCV : WS_WCK)) + 128 * kt; d.ldt = 4096; }
    else if (t < T8) { const int r = t - T7, e = r >> 6, rr = r & 63, kt = rr >> 2, nt = rr & 3, up = 0;
        const float* W = e < NE ? F.in(I_WE_GATE) + (size_t)e * D * DE : F.in(I_WS_GATE);
        d.src = W + (size_t)(128 * kt) * DE + 128 * nt; d.ldw = DE; d.dst = Wgu + ((size_t)e * 1024 + 256 * nt + 128 * up) * D + 128 * kt; d.ldt = D; }
    else if (t < T9) { const int r = t - T8, e = r >> 6, rr = r & 63, kt = rr >> 2, nt = rr & 3, up = 1;
        const float* W = e < NE ? F.in(I_WE_UP) + (size_t)e * D * DE : F.in(I_WS_UP);
        d.src = W + (size_t)(128 * kt) * DE + 128 * nt; d.ldw = DE; d.dst = Wgu + ((size_t)e * 1024 + 256 * nt + 128 * up) * D + 128 * kt; d.ldt = D; }
    else { const int r = t - T9, e = r >> 6, rr = r & 63, kt = rr >> 4, nt = rr & 15;
        const float* W = e < NE ? F.in(I_WE_DOWN) + (size_t)e * DE * D : F.in(I_WS_DOWN);
        d.src = W + (size_t)(128 * kt) * D + 128 * nt; d.ldw = D; d.dst = Wd + ((size_t)e * D + 128 * nt) * DE + 128 * kt; d.ldt = DE; }
    return d;
}
constexpr int TR_NTILES = 16 * 84 + 128 + 128 + 64 + 64 + 256 + 32 + 32 + 3 * 65 * 64;
__device__ __forceinline__ void tr_load(const TrDesc& d, f32x4 (&v)[8], int wave, int lane) {
#pragma unroll
    for (int i = 0; i < 4; ++i) { const int q = wave + 8 * i, n4 = (q & 3) * 8 + (lane & 7), kp = (q >> 2) * 8 + (lane >> 3);
        const float* p = d.src + (size_t)(2 * kp) * d.ldw + 4 * n4; v[2 * i] = __builtin_nontemporal_load((const f32x4*)p); v[2 * i + 1] = __builtin_nontemporal_load((const f32x4*)(p + d.ldw)); }
}
__device__ __forceinline__ void tr_to_lds(const f32x4 (&v)[8], LAS unsigned* T32, int wave, int lane) {
#pragma unroll
    for (int i = 0; i < 4; ++i) { const int q = wave + 8 * i, n4 = (q & 3) * 8 + (lane & 7), kp = (q >> 2) * 8 + (lane >> 3);
#pragma unroll
        for (int e = 0; e < 4; ++e) T32[(4 * n4 + e) * 65 + kp] = cvtpk(v[2 * i][e], v[2 * i + 1][e]); }
}
__device__ __forceinline__ void tr_from_lds(const TrDesc& d, const LAS unsigned* T32, int wave, int lane) {
    const int c = lane & 15, nn = lane >> 4;
#pragma unroll
    for (int i = 0; i < 4; ++i) { const int n = wave * 16 + 4 * i + nn; const LAS unsigned* r = T32 + n * 65 + 4 * c;
        const u32x4 o = {r[0], r[1], r[2], r[3]};
        __builtin_nontemporal_store(o, (u32x4*)(d.dst + (size_t)n * d.ldt + 8 * c)); }
}
constexpr int TR_FIRST_EXPERT = 16 * 2 * NB16 + 128 + 128 + 64 + 64 + 256 + 32 + 32;
constexpr int TR8W_NTILES = 16 * (48 + 2 * NF8);
struct Tr8Desc { const float* src; unsigned char* dst; unsigned ldw, ldt; float scale; };
__device__ __forceinline__ Tr8Desc tr8_decode(const Frame& F, int t) {
    unsigned char* ws = F.ws; Tr8Desc d; unsigned char* Wgu = ws + WS_WGU; unsigned char* Wd = ws + WS_WD;
    constexpr int TG = 65 * 64;
    if (t < 2 * TG) { const int up = t >= TG, r = t - (up ? TG : 0), e = r >> 6, rr = r & 63, kt = rr >> 2, nt = rr & 3;
        const float* W = e < NE ? F.in(up ? I_WE_UP : I_WE_GATE) + (size_t)e * D * DE : F.in(up ? I_WS_UP : I_WS_GATE);
        d.src = W + (size_t)(128 * kt) * DE + 128 * nt; d.ldw = DE; d.dst = Wgu + ((size_t)e * 1024 + 256 * nt + 128 * up) * D + 128 * kt; d.ldt = D; d.scale = WGU_SCALE; }
    else { const int r = t - 2 * TG, e = r >> 6, rr = r & 63, kt = rr >> 4, nt = rr & 15;
        const float* W = e < NE ? F.in(I_WE_DOWN) + (size_t)e * DE * D : F.in(I_WS_DOWN);
        d.src = W + (size_t)(128 * kt) * D + 128 * nt; d.ldw = D; d.dst = Wd + ((size_t)e * D + 128 * nt) * DE + 128 * kt; d.ldt = DE; d.scale = WD_SCALE; }
    return d;
}
__device__ __forceinline__ Tr8Desc tr8w_decode(const Frame& F, int t) {
    Tr8Desc d; d.scale = WIN_SCALE; d.ldt = D; constexpr int NU = 48 + 2 * NF8; const int kt = t / NU, nt = t - kt * NU, n0 = nt < 48 ? 4608 + 128 * nt : 256 * nth_set(FP8M, (nt - 48) >> 1) + 128 * (nt & 1); const int sc = WinCol{}(n0);
    d.src = F.in(I_W_IN) + (size_t)(128 * kt) * W_IN_COLS + sc; d.ldw = W_IN_COLS; d.dst = F.ws + WS_WIN8 + (size_t)(128 * nt) * D + 128 * kt;
    return d;
}
__device__ __forceinline__ void tr8_load(const Tr8Desc& d, f32x4 (&v)[8], int wave, int lane) {
#pragma unroll
    for (int i = 0; i < 2; ++i) { const int q = wave + 8 * i, n4 = (q & 3) * 8 + (lane & 7), kq = (q >> 2) * 8 + (lane >> 3);
        const float* p = d.src + (size_t)(4 * kq) * d.ldw + 4 * n4;
#pragma unroll
        for (int r = 0; r < 4; ++r) v[4 * i + r] = __builtin_nontemporal_load((const f32x4*)(p + (size_t)r * d.ldw)); }
}
__device__ __forceinline__ void tr8_to_lds(const f32x4 (&v)[8], float sc, LAS unsigned* T32, int wave, int lane) {
#pragma unroll
    for (int i = 0; i < 2; ++i) { const int q = wave + 8 * i, n4 = (q & 3) * 8 + (lane & 7), kq = (q >> 2) * 8 + (lane >> 3);
#pragma unroll
        for (int e = 0; e < 4; ++e) T32[(4 * n4 + e) * 33 + kq] = pk_fp8x4(v[4 * i][e] * sc, v[4 * i + 1][e] * sc, v[4 * i + 2][e] * sc, v[4 * i + 3][e] * sc); }
}
__device__ __forceinline__ void tr8_from_lds(const Tr8Desc& d, const LAS unsigned* T32, int wave, int lane) {
    const int c = lane & 7, nn = lane >> 3;
#pragma unroll
    for (int i = 0; i < 2; ++i) { const int n = wave * 16 + 8 * i + nn; const LAS unsigned* r = T32 + n * 33 + 4 * c;
        const u32x4 o = {r[0], r[1], r[2], r[3]};
        __builtin_nontemporal_store(o, (u32x4*)(d.dst + (size_t)n * d.ldt + 16 * c)); }
}
__device__ __forceinline__ void conv_batch(const Frame& F, int first, int end) {
    constexpr int NT8 = 3 * 65 * 64;
    if (end > NT8) end = NT8;
    if (first >= end) return;
    LAS unsigned* I0 = (LAS unsigned*)F.lds; LAS unsigned* I1 = I0 + 128 * 33; const int lane = F.lane;
    f32x4 r0[8], r1[8], r2[8], r3[8];
    int t = first;
    tr8_load(tr8_decode(F, t), r0, F.wave, lane);
    if (t + 1 < end) tr8_load(tr8_decode(F, t + 1), r1, F.wave, lane);
    if (t + 2 < end) tr8_load(tr8_decode(F, t + 2), r2, F.wave, lane);
    if (t + 3 < end) tr8_load(tr8_decode(F, t + 3), r3, F.wave, lane);
    __syncthreads();
    tr8_to_lds(r0, tr8_decode(F, t).scale, I0, F.wave, lane);
    __syncthreads();
#define CB_STEP(RF, RN, IC, IN) { \
        if (t + 4 < end) tr8_load(tr8_decode(F, t + 4), RF, F.wave, lane); \
        if (t + 1 < end) tr8_to_lds(RN, tr8_decode(F, t + 1).scale, IN, F.wave, lane); \
        tr8_from_lds(tr8_decode(F, t), IC, F.wave, lane); \
        __syncthreads(); \
        if (++t >= end) break; }
    for (;;) {
        CB_STEP(r0, r1, I0, I1)
        CB_STEP(r1, r2, I1, I0)
        CB_STEP(r2, r3, I0, I1)
        CB_STEP(r3, r0, I1, I0)
    }
#undef CB_STEP
}

namespace att {
constexpr int SHM = 16384;
constexpr int L_V = 0, L_K = 3 * SHM;
constexpr int L_WS = 5 * SHM;
constexpr int L_TBL = L_WS + 2048;
constexpr int L_SEL = L_TBL + 8 * 132 * 4;
constexpr int L_NIB = L_SEL + 512;
constexpr int L_CUM = L_SEL + 1024;
constexpr int L_IMP = L_CUM;
constexpr int L_ORD = L_IMP + 32768;
constexpr int L_Q = L_ORD + 2048;
constexpr int L_END = L_Q + 64;
static_assert(L_END <= RING_BYTES, "attention LDS map");
__constant__ unsigned char T5B[128] = {0, 1, 2, 3, 4, 5, 6, 7, 8, 9, 10, 11, 12, 13, 14, 15, 16, 16, 16, 17, 17, 18, 18, 18, 19, 19, 19, 20, 20, 20, 20, 21, 21, 21, 21, 22, 22, 22, 22, 22, 23, 23, 23, 23, 23, 23, 24, 24, 24, 24, 24, 24, 25, 25, 25, 25, 25, 25, 25, 26, 26, 26, 26, 26, 26, 26, 26, 27, 27, 27, 27, 27, 27, 27, 27, 27, 27, 28, 28, 28, 28, 28, 28, 28, 28, 28, 28, 29, 29, 29, 29, 29, 29, 29, 29, 29, 29, 29, 29, 30, 30, 30, 30, 30, 30, 30, 30, 30, 30, 30, 30, 30, 30, 31, 31, 31, 31, 31, 31, 31, 31, 31, 31, 31, 31, 31, 31, 31};

#define KSWZ(row, colB) ((row) * 256 + ((colB) ^ (((row) & 7) << 4)))
#define SBAR() __builtin_amdgcn_sched_barrier(0)
__device__ __forceinline__ int v_st(int k, int c) { const int kk = (k & ~0xC) | ((k & 4) << 1) | ((k & 8) >> 1); return ((kk >> 3) * 4 + (c >> 5)) * 512 + ((kk & 7) * 32 + (c & 31)) * 2; }
__device__ __forceinline__ int v_rd_base(int lane) { return ((lane & 3) << 3) | (((lane >> 2) & 3) << 6) | (((lane >> 4) & 1) << 5) | (((lane >> 5) & 1) << 8); }
__device__ __forceinline__ int crow(int r, int hi) { return (r & 3) + 8 * (r >> 2) + 4 * hi; }
__device__ __forceinline__ float pswap_max(float v) { auto rr = __builtin_amdgcn_permlane32_swap(__float_as_uint(v), __float_as_uint(v), false, false); return fmaxf(__uint_as_float(rr[0]), __uint_as_float(rr[1])); }
__device__ __forceinline__ float pswap_sum(float v) { auto rr = __builtin_amdgcn_permlane32_swap(__float_as_uint(v), __float_as_uint(v), false, false); return __uint_as_float(rr[0]) + __uint_as_float(rr[1]); }

__device__ __forceinline__ void qkt(f32x16& p0, f32x16& p1, const LAS char* Kb, int r32, int hi, const bf16x8 (&qr)[8]) {
    const LAS char* kb[4];
#pragma unroll
    for (int dd = 0; dd < 4; ++dd) kb[dd] = Kb + KSWZ(r32, (dd * 16 + hi * 8) * 2);
#pragma unroll
    for (int d0 = 0; d0 < 8; ++d0) { const LAS char* a = kb[d0 & 3] + (d0 >> 2) * 128;
        const bf16x8 b0 = *(const LAS bf16x8*)a;
        const bf16x8 b1 = *(const LAS bf16x8*)(a + 32 * 256);
        p0 = __builtin_amdgcn_mfma_f32_32x32x16_bf16(b0, qr[d0], p0, 0, 0, 0);
        p1 = __builtin_amdgcn_mfma_f32_32x32x16_bf16(b1, qr[d0], p1, 0, 0, 0);
#ifdef QKT_SPLIT
        if ((d0 & (QKT_SPLIT - 1)) == QKT_SPLIT - 1 && d0 != 7) SBAR();
#endif
    }
}
__device__ __forceinline__ void pv_tile(f32x16 (&o)[4], int vb, bf16x8 pa0, bf16x8 pa1, bf16x8 pa2, bf16x8 pa3) {
#define TRRD(dst, off) asm volatile("ds_read_b64_tr_b16 %0, %1 offset:%2" : "=&v"(dst) : "v"(vb), "i"(off) : "memory")
#define PV_D0(d0) do { s16x4 l0, l1, l2, l3, h0, h1, h2, h3; constexpr int b_ = (d0) * 512; \
        TRRD(l0, b_); TRRD(h0, b_ + 2048); TRRD(l1, b_ + 4096); TRRD(h1, b_ + 6144); TRRD(l2, b_ + 8192); TRRD(h2, b_ + 10240); TRRD(l3, b_ + 12288); TRRD(h3, b_ + 14336); \
        asm volatile("s_waitcnt lgkmcnt(0)" ::: "memory"); SBAR(); \
        o[d0] = __builtin_amdgcn_mfma_f32_32x32x16_bf16(pa0, (bf16x8){l0[0], l0[1], l0[2], l0[3], h0[0], h0[1], h0[2], h0[3]}, o[d0], 0, 0, 0); \
        o[d0] = __builtin_amdgcn_mfma_f32_32x32x16_bf16(pa1, (bf16x8){l1[0], l1[1], l1[2], l1[3], h1[0], h1[1], h1[2], h1[3]}, o[d0], 0, 0, 0); \
        o[d0] = __builtin_amdgcn_mfma_f32_32x32x16_bf16(pa2, (bf16x8){l2[0], l2[1], l2[2], l2[3], h2[0], h2[1], h2[2], h2[3]}, o[d0], 0, 0, 0); \
        o[d0] = __builtin_amdgcn_mfma_f32_32x32x16_bf16(pa3, (bf16x8){l3[0], l3[1], l3[2], l3[3], h3[0], h3[1], h3[2], h3[3]}, o[d0], 0, 0, 0); } while (0)
    PV_D0(0); PV_D0(1); PV_D0(2); PV_D0(3);
#undef PV_D0
#undef TRRD
}
__device__ __forceinline__ void pack_p(const f32x16& p0, const f32x16& p1, bf16x8& pa0, bf16x8& pa1, bf16x8& pa2, bf16x8& pa3) {
#define PK4(P, B_, OUT) do { unsigned a0 = cvtpk(P[B_+0], P[B_+1]), a1 = cvtpk(P[B_+2], P[B_+3]); \
        unsigned b0 = cvtpk(P[B_+4], P[B_+5]), b1 = cvtpk(P[B_+6], P[B_+7]); \
        auto r0 = __builtin_amdgcn_permlane32_swap(a0, b0, false, false); auto r1 = __builtin_amdgcn_permlane32_swap(a1, b1, false, false); \
        u32x4 w = {r0[0], r1[0], r0[1], r1[1]}; OUT = __builtin_bit_cast(bf16x8, w); } while (0)
    PK4(p0, 0, pa0); PK4(p0, 8, pa1); PK4(p1, 0, pa2); PK4(p1, 8, pa3);
#undef PK4
}
__device__ __forceinline__ void bcast_rows(float (&f)[16], float v, LAS float* ws, int r32, int hi) {
    if (hi == 0) ws[r32] = v;
    asm volatile("s_waitcnt lgkmcnt(0)" ::: "memory");
#pragma unroll
    for (int q = 0; q < 4; ++q) { const f32x4 t = *(const LAS f32x4*)(ws + 8 * q + 4 * hi); f[4 * q] = t[0]; f[4 * q + 1] = t[1]; f[4 * q + 2] = t[2]; f[4 * q + 3] = t[3]; }
    asm volatile("s_waitcnt lgkmcnt(0)" ::: "memory");
}
struct Ctx {
    LAS char* lds; int tid, wid, lane, r32, hi;
    int trow;
    int qlo;
};
struct DmaOff { unsigned k, v0, v1; };
__device__ __forceinline__ DmaOff dma_off(int wid, int lane, size_t ld) {
    DmaOff d; const int kr = 4 * wid + (lane >> 4), kc = (lane & 15) ^ (kr & 7);
    d.k = (unsigned)(kr * ld + kc * 8) * 2u;
#pragma unroll
    for (int t = 0; t < 2; ++t) { const int sub = 2 * (wid + 8 * t) + (lane >> 5), kk = (sub >> 2) * 8 + ((lane & 31) >> 2), k = (kk & ~0xC) | ((kk & 4) << 1) | ((kk & 8) >> 1), c0 = (sub & 3) * 32 + (lane & 3) * 8;
        const unsigned o = (unsigned)(k * ld + c0) * 2u; if (t == 0) d.v0 = o; else d.v1 = o; }
    return d;
}
__device__ __forceinline__ void dma_tile(const DmaOff& d, const bf16_t* Kg, const bf16_t* Vg, size_t ld, LAS char* lds, int buf, int vbuf, int wid) {
    const char* kp = (const char*)Kg; const char* vp = (const char*)Vg;
    __builtin_amdgcn_global_load_lds((const unsigned*)(kp + d.k), (LAS unsigned*)(lds + L_K + buf * SHM + wid * 1024), 16, 0, 0);
    __builtin_amdgcn_global_load_lds((const unsigned*)(kp + d.k + 32 * ld * 2), (LAS unsigned*)(lds + L_K + buf * SHM + (wid + 8) * 1024), 16, 0, 0);
    __builtin_amdgcn_global_load_lds((const unsigned*)(vp + d.v0), (LAS unsigned*)(lds + L_V + vbuf * SHM + wid * 1024), 16, 0, 0);
    __builtin_amdgcn_global_load_lds((const unsigned*)(vp + d.v1), (LAS unsigned*)(lds + L_V + vbuf * SHM + (wid + 8) * 1024), 16, 0, 0);
}
__device__ __forceinline__ void dma_tile_v(const DmaOff& d, const bf16_t* Kg, const bf16_t* Vg, size_t ld, LAS char* lds, int kbuf, int voff, int wid) {
    const char* kp = (const char*)Kg; const char* vp = (const char*)Vg;
    __builtin_amdgcn_global_load_lds((const unsigned*)(kp + d.k), (LAS unsigned*)(lds + L_K + kbuf * SHM + wid * 1024), 16, 0, 0);
    __builtin_amdgcn_global_load_lds((const unsigned*)(kp + d.k + 32 * ld * 2), (LAS unsigned*)(lds + L_K + kbuf * SHM + (wid + 8) * 1024), 16, 0, 0);
    __builtin_amdgcn_global_load_lds((const unsigned*)(vp + d.v0), (LAS unsigned*)(lds + L_V + voff + wid * 1024), 16, 0, 0);
    __builtin_amdgcn_global_load_lds((const unsigned*)(vp + d.v1), (LAS unsigned*)(lds + L_V + voff + (wid + 8) * 1024), 16, 0, 0);
}
#define DMA_WAIT() asm volatile("s_waitcnt vmcnt(0)" ::: "memory")
constexpr float DEFER_THR = 8.f;
__device__ __forceinline__ void qkt_half(f32x16& p, const LAS char* Kb, int r32, int hi, const bf16x8 (&qr)[8], bool zero) {
    const LAS char* kb[4];
#pragma unroll
    for (int dd = 0; dd < 4; ++dd) kb[dd] = Kb + KSWZ(r32, (dd * 16 + hi * 8) * 2);
    { const bf16x8 b = *(const LAS bf16x8*)(kb[0]);
      if (zero) p = __builtin_amdgcn_mfma_f32_32x32x16_bf16(b, qr[0], (f32x16){0.f, 0.f, 0.f, 0.f, 0.f, 0.f, 0.f, 0.f, 0.f, 0.f, 0.f, 0.f, 0.f, 0.f, 0.f, 0.f}, 0, 0, 0);
      else p = __builtin_amdgcn_mfma_f32_32x32x16_bf16(b, qr[0], p, 0, 0, 0); }
#pragma unroll
    for (int d0 = 1; d0 < 8; ++d0) { const bf16x8 b = *(const LAS bf16x8*)(kb[d0 & 3] + (d0 >> 2) * 128);
        p = __builtin_amdgcn_mfma_f32_32x32x16_bf16(b, qr[d0], p, 0, 0, 0); }
}
__device__ __forceinline__ float max3f(float a, float b, float c) { float r; asm("v_max3_f32 %0, %1, %2, %3" : "=v"(r) : "v"(a), "v"(b), "v"(c)); return r; }
__device__ __forceinline__ bool sm_half(f32x16& p, float& m_reg, float& l_reg, float& alpha, bf16x8& pa0, bf16x8& pa1, float brow) {
    float pmax = max3f(p[0], p[1], p[2]);
#pragma unroll
    for (int r = 3; r < 15; r += 2) pmax = max3f(pmax, p[r], p[r + 1]);
    pmax = max3f(pmax, p[15], p[15]);
    { const auto rr = __builtin_amdgcn_permlane32_swap(__float_as_uint(pmax), __float_as_uint(pmax), false, false); pmax = max3f(__uint_as_float(rr[0]), __uint_as_float(rr[1]), __uint_as_float(rr[1])) + brow; }
    const bool upd = !__all(pmax - m_reg <= DEFER_THR);
    const float mx_ = max3f(m_reg, pmax, pmax);
    const float mn = upd ? mx_ : m_reg;
    alpha = __builtin_amdgcn_exp2f(m_reg - mn); m_reg = mn;
    f32x2 mn2 = {brow - mn, brow - mn}; asm("" : "+v"(mn2)); f32x2 ps2 = {0.f, 0.f};
#pragma unroll
    for (int r = 0; r < 16; r += 2) { f32x2 t = {p[r], p[r + 1]}; t += mn2; t.x = __builtin_amdgcn_exp2f(t.x); t.y = __builtin_amdgcn_exp2f(t.y); p[r] = t.x; p[r + 1] = t.y; ps2 += t; }
    float ps = pswap_sum(ps2.x + ps2.y);
    l_reg = l_reg * alpha + ps;
#define PK4(P, B_, OUT) do { unsigned a0 = cvtpk(P[B_+0], P[B_+1]), a1 = cvtpk(P[B_+2], P[B_+3]); \
        unsigned b0 = cvtpk(P[B_+4], P[B_+5]), b1 = cvtpk(P[B_+6], P[B_+7]); \
        auto r0 = __builtin_amdgcn_permlane32_swap(a0, b0, false, false); auto r1 = __builtin_amdgcn_permlane32_swap(a1, b1, false, false); \
        u32x4 w = {r0[0], r1[0], r0[1], r1[1]}; OUT = __builtin_bit_cast(bf16x8, w); } while (0)
    PK4(p, 0, pa0); PK4(p, 8, pa1);
#undef PK4
    return upd;
}
__device__ __forceinline__ void pv_half(f32x16 (&o)[4], int vb, bf16x8 pa0, bf16x8 pa1) {
#define TRRD(dst, off) asm volatile("ds_read_b64_tr_b16 %0, %1 offset:%2" : "=&v"(dst) : "v"(vb), "i"(off) : "memory")
#define PVH(dA, dB) do { s16x4 l0, h0, l1, h1, m0, n0, m1, n1; \
        TRRD(l0, (dA) * 512); TRRD(h0, (dA) * 512 + 2048); TRRD(m0, (dB) * 512); TRRD(n0, (dB) * 512 + 2048); \
        TRRD(l1, (dA) * 512 + 4096); TRRD(h1, (dA) * 512 + 6144); TRRD(m1, (dB) * 512 + 4096); TRRD(n1, (dB) * 512 + 6144); \
        asm volatile("s_waitcnt lgkmcnt(0)" ::: "memory"); SBAR(); \
        o[dA] = __builtin_amdgcn_mfma_f32_32x32x16_bf16(pa0, (bf16x8){l0[0], l0[1], l0[2], l0[3], h0[0], h0[1], h0[2], h0[3]}, o[dA], 0, 0, 0); \
        o[dB] = __builtin_amdgcn_mfma_f32_32x32x16_bf16(pa0, (bf16x8){m0[0], m0[1], m0[2], m0[3], n0[0], n0[1], n0[2], n0[3]}, o[dB], 0, 0, 0); \
        o[dA] = __builtin_amdgcn_mfma_f32_32x32x16_bf16(pa1, (bf16x8){l1[0], l1[1], l1[2], l1[3], h1[0], h1[1], h1[2], h1[3]}, o[dA], 0, 0, 0); \
        o[dB] = __builtin_amdgcn_mfma_f32_32x32x16_bf16(pa1, (bf16x8){m1[0], m1[1], m1[2], m1[3], n1[0], n1[1], n1[2], n1[3]}, o[dB], 0, 0, 0); } while (0)
    PVH(0, 1); PVH(2, 3);
#undef PVH
#undef TRRD
}
__device__ __forceinline__ bool sm_cheap(f32x16& p, float& l_reg, float& alpha, bf16x8& pa0, bf16x8& pa1) {
    alpha = 1.f; l_reg += p[0] + p[15];
    u32x4 w0 = {__builtin_bit_cast(unsigned, p[0]), __builtin_bit_cast(unsigned, p[1]), __builtin_bit_cast(unsigned, p[2]), __builtin_bit_cast(unsigned, p[3])};
    u32x4 w1 = {__builtin_bit_cast(unsigned, p[8]), __builtin_bit_cast(unsigned, p[9]), __builtin_bit_cast(unsigned, p[10]), __builtin_bit_cast(unsigned, p[11])};
    pa0 = __builtin_bit_cast(bf16x8, w0); pa1 = __builtin_bit_cast(bf16x8, w1); return false;
}
template <int VAR = 0, class F>
__device__ __forceinline__ void stream(const Ctx& C0, const bf16x8 (&qr)[8], const bf16_t* Kg, const bf16_t* Vg, size_t ld, unsigned mask, float& m_reg, float& l_reg, f32x16 (&o)[4], const F& f) {
    Ctx C = C0; { int tz = C0.tid; asm volatile("" : "+v"(tz)); C.tid = tz; C.lane = tz & 63; C.r32 = tz & 31; C.hi = (tz >> 5) & 1; }
    const int vb0 = (int)(uintptr_t)(C.lds + L_V) + v_rd_base(C.lane);
    LAS float* ws = (LAS float*)(C.lds + L_WS) + C.wid * 64;
    const DmaOff dof = dma_off(C.wid, C.lane, ld);
    unsigned rem = mask; int j = __builtin_ctz(rem); rem &= rem - 1;
    __syncthreads();
    dma_tile_v(dof, Kg + (size_t)j * 64 * ld, Vg + (size_t)j * 64 * ld, ld, C.lds, 0, 0, C.wid);
    DMA_WAIT();
    __syncthreads();
    int kb = 0, vprev = 2 * SHM, vcur = 0, vnext = SHM;
    bool more = rem != 0u; int jn = j;
    if (more) { jn = __builtin_ctz(rem); rem &= rem - 1; if (!(VAR & 1)) dma_tile_v(dof, Kg + (size_t)jn * 64 * ld, Vg + (size_t)jn * 64 * ld, ld, C.lds, 1, vnext, C.wid); }
#define ST_RESC(a) do { if (C.hi == 0) ws[C.r32] = (a); asm volatile("s_waitcnt lgkmcnt(0)" ::: "memory"); \
        _Pragma("unroll") for (int q = 0; q < 4; ++q) { const f32x4 t = *(const LAS f32x4*)(ws + 8 * q + 4 * C.hi); \
            _Pragma("unroll") for (int d = 0; d < 4; ++d) { o[d][4 * q] *= t[0]; o[d][4 * q + 1] *= t[1]; o[d][4 * q + 2] *= t[2]; o[d][4 * q + 3] *= t[3]; } } } while (0)
    f32x16 pA, pB; float alpha, browA, browB; bf16x8 pa0, pa1;
    bool zA = f.pre(pA, j, 0, browA);
    qkt_half(pA, C.lds + L_K, C.r32, C.hi, qr, zA);
    bool zB = f.pre(pB, j, 1, browB);
    bool first = true;
    for (;;) {
        if (!(VAR & 16)) qkt_half(pB, C.lds + L_K + kb * SHM + 32 * 256, C.r32, C.hi, qr, zB);
        const bool u0 = (VAR & 4) ? sm_cheap(pA, l_reg, alpha, pa0, pa1) : sm_half(pA, m_reg, l_reg, alpha, pa0, pa1, browA);
        if (u0 && !first) ST_RESC(alpha);
        first = false;
        if (!(VAR & 8)) pv_half(o, vb0 + vcur, pa0, pa1); else { o[0][0] += __builtin_bit_cast(float, (int)pa0[0] + (int)pa1[1]); }
        if (!(VAR & 32)) zA = f.pre(pA, jn, 0, browA);
        DMA_WAIT(); if (!(VAR & 2)) __syncthreads();
        if (!more) break;
        j = jn; kb ^= 1; { const int t_ = vprev; vprev = vcur; vcur = vnext; vnext = t_; }
        more = rem != 0u;
        if (more) { jn = __builtin_ctz(rem); rem &= rem - 1; if (!(VAR & 1)) dma_tile_v(dof, Kg + (size_t)jn * 64 * ld, Vg + (size_t)jn * 64 * ld, ld, C.lds, kb ^ 1, vnext, C.wid); }
        if (!(VAR & 16)) qkt_half(pA, C.lds + L_K + kb * SHM, C.r32, C.hi, qr, zA);
        const bool u1 = (VAR & 4) ? sm_cheap(pB, l_reg, alpha, pa0, pa1) : sm_half(pB, m_reg, l_reg, alpha, pa0, pa1, browB);
        if (u1) ST_RESC(alpha);
        if (!(VAR & 8)) pv_half(o, vb0 + vprev + 8192, pa0, pa1); else { o[1][0] += __builtin_bit_cast(float, (int)pa0[2] + (int)pa1[3]); }
        if (!(VAR & 32)) zB = f.pre(pB, j, 1, browB);
    }
    { const bool u1 = sm_half(pB, m_reg, l_reg, alpha, pa0, pa1, browB);
      if (u1) ST_RESC(alpha);
      pv_half(o, vb0 + vcur + 8192, pa0, pa1); }
    __syncthreads();
#undef ST_RESC
}
__device__ __forceinline__ void load_q(bf16x8 (&qr)[8], const bf16_t* qrow, const float* gain, int hi) {
    u32x4 raw[8]; float ss = 0.f;
#pragma unroll
    for (int d0 = 0; d0 < 8; ++d0) { raw[d0] = *(const u32x4*)(qrow + d0 * 16 + hi * 8);
#pragma unroll
        for (int e = 0; e < 4; ++e) { const float a = bf_lo(raw[d0][e]), b = bf_hi(raw[d0][e]); ss += a * a + b * b; } }
    ss = pswap_sum(ss);
    const float f = __builtin_amdgcn_rsqf(ss * (1.f / HD) + RMS_EPS) * (ATTN_SCALE * LOG2E);
#pragma unroll
    for (int d0 = 0; d0 < 8; ++d0) { const f32x4 g0 = *(const f32x4*)(gain + d0 * 16 + hi * 8), g1 = *(const f32x4*)(gain + d0 * 16 + hi * 8 + 4);
        u32x4 w; w.x = cvtpk(bf_lo(raw[d0].x) * f * g0[0], bf_hi(raw[d0].x) * f * g0[1]); w.y = cvtpk(bf_lo(raw[d0].y) * f * g0[2], bf_hi(raw[d0].y) * f * g0[3]);
        w.z = cvtpk(bf_lo(raw[d0].z) * f * g1[0], bf_hi(raw[d0].z) * f * g1[1]); w.w = cvtpk(bf_lo(raw[d0].w) * f * g1[2], bf_hi(raw[d0].w) * f * g1[3]);
        qr[d0] = __builtin_bit_cast(bf16x8, w); }
}
__device__ __forceinline__ void store_o(const f32x16 (&v)[4], const float (&w)[16], bf16_t* orow0, size_t ld, LAS char* lds, int wid, int lane_, bool accum) {
    int lane = lane_; asm volatile("" : "+v"(lane));
    const int r32 = lane & 31, hi = lane >> 5;
    LAS char* st = lds + wid * 8192;
    const bool odd = (r32 & 1) != 0;
#pragma unroll
    for (int r = 0; r < 16; r += 2) { LAS char* rowp = st + (crow(r, hi) + (odd ? 1 : 0)) * 256 + (r32 & ~1) * 2;
#pragma unroll
        for (int d = 0; d < 4; ++d) { const float a = v[d][r] * w[r], b = v[d][r + 1] * w[r + 1];
            const float recv = __builtin_bit_cast(float, __builtin_amdgcn_mov_dpp(__builtin_bit_cast(int, odd ? a : b), 0xB1, 0xF, 0xF, true));
            *(LAS unsigned*)(rowp + d * 64) = cvtpk(odd ? recv : a, odd ? b : recv); } }
    asm volatile("s_waitcnt lgkmcnt(0)" ::: "memory");
    u32x4 ov[8];
    if (accum) {
#pragma unroll
        for (int it = 0; it < 8; ++it) { const int id = it * 64 + lane, row = id >> 4, c16 = id & 15; ov[it] = *(const u32x4*)(orow0 + (size_t)row * ld + c16 * 8); } }
#pragma unroll
    for (int it = 0; it < 8; ++it) { const int id = it * 64 + lane, row = id >> 4, c16 = id & 15;
        u32x4 nv = *(const LAS u32x4*)(st + row * 256 + c16 * 16);
        if (accum) {
#pragma unroll
            for (int e = 0; e < 4; ++e) nv[e] = cvtpk(bf_lo(nv[e]) + bf_lo(ov[it][e]), bf_hi(nv[e]) + bf_hi(ov[it][e])); }
        *(u32x4*)(orow0 + (size_t)row * ld + c16 * 8) = nv; }
    asm volatile("s_waitcnt lgkmcnt(0)" ::: "memory");
}

struct Tensors {
    const bf16_t* PA; const float* GL; const bf16_t* KVM; const bf16_t* KC; const bf16_t* VC; const float* CUM; bf16_t* OC;
    const float* nsa_q_g; const float* fox_q_g; const float* mem_q_g; const float* rel_bias;
};

template <int TY> struct BiasUni {
    const Ctx* C; const LAS float* tb; int u; unsigned sel; int mode;
    __device__ __forceinline__ bool pre(f32x16& bv, int j, int half, float& brow) const {
        const float NEG = -__builtin_inff();
        const int dq = C->trow - 64 * j - 4 * C->hi - 32 * half;
        brow = 0.f;
        if constexpr (TY == 0) {
            const bool win = mode == 1; const bool on = win || ((sel >> j) & 1u);
            if (j + 3 <= u && !(win && j + 8 <= u)) {
                brow = on ? tb[128] : NEG; return true;
            } else {
#pragma unroll
                for (int q = 0; q < 4; ++q) {
#pragma unroll
                    for (int e = 0; e < 4; ++e) { const int r = 4 * q + e, c = e + 8 * q, rel = dq - c;
                        const bool ok = on && (unsigned)rel < 512u; const float b = tb[min(max(rel, 0), 128)];
                        bv[r] = ok ? b : NEG; }
                    SBAR(); }
            }
        } else if constexpr (TY == 1) {
            const LAS float* cb = (const LAS float*)(C->lds + L_CUM) + 64 * j + 4 * C->hi + 32 * half;
            const bool msk = 64 * j + 63 > C->qlo;
#pragma unroll
            for (int q = 0; q < 4; ++q) { const f32x4 a = *(const LAS f32x4*)(cb + 8 * q);
#pragma unroll
                for (int e = 0; e < 4; ++e) { const int r = 4 * q + e, c = e + 8 * q; bv[r] = (msk && dq - c < 0) ? NEG : a[e]; } }
        } else {
            return true;
        }
        return false;
    }
};

__device__ __forceinline__ void nsa_pre(Ctx& C, const Tensors& Tn, const bf16x8 (&qr)[8], int b, int g, int u, float g_c, bf16_t* orow0, unsigned& sel_out, unsigned& U_out) {
    { int tz = C.tid; asm volatile("" : "+v"(tz)); C.tid = tz; C.lane = tz & 63; C.r32 = tz & 31; C.hi = (tz >> 5) & 1; }
    const int hh = C.wid >> 1, pos = (C.wid & 1) * 32 + C.r32, head = g * 4 + hh;
    const LAS float* tb = (const LAS float*)(C.lds + L_TBL) + head * 132;
    LAS float* ws = (LAS float*)(C.lds + L_WS) + C.wid * 64;
    LAS unsigned* SEL = (LAS unsigned*)(C.lds + L_SEL);
    const float NEG = -__builtin_inff();
    const int vb0 = (int)(uintptr_t)(C.lds + L_V) + v_rd_base(C.lane);
    {
        const bf16_t* KCb = Tn.KC + (size_t)(b * 2 + g) * 128 * HD; const bf16_t* VCb = Tn.VC + (size_t)(b * 2 + g) * 128 * HD;
        const DmaOff dof = dma_off(C.wid, C.lane, HD);
        __syncthreads();
        if (C.tid < 65) SEL[C.tid] = 0u;
        dma_tile(dof, KCb, VCb, HD, C.lds, 0, 0, C.wid); dma_tile(dof, KCb + 64 * HD, VCb + 64 * HD, HD, C.lds, 1, 1, C.wid);
        DMA_WAIT();
        __syncthreads();
        f32x16 P[4];
        const int dq = C.trow - 31 - 64 * C.hi;
#pragma unroll
        for (int X = 0; X < 4; ++X)
#pragma unroll
            for (int r = 0; r < 16; ++r) { const int c = (r & 3) + 8 * (r >> 2), rel = dq - 16 * (32 * X + c);
                const float bb = tb[min(max(rel, 0), 128)]; P[X][r] = rel >= 0 ? bb : NEG; }
        qkt(P[0], P[1], C.lds + L_K, C.r32, C.hi, qr); qkt(P[2], P[3], C.lds + L_K + SHM, C.r32, C.hi, qr);
        float pmax = NEG;
#pragma unroll
        for (int X = 0; X < 4; ++X)
#pragma unroll
            for (int r = 0; r < 16; ++r) pmax = fmaxf(pmax, P[X][r]);
        pmax = pswap_max(pmax);
        const float mm = pmax == NEG ? 0.f : pmax;
        float ps = 0.f;
#pragma unroll
        for (int X = 0; X < 4; ++X)
#pragma unroll
            for (int r = 0; r < 16; ++r) { P[X][r] = __builtin_amdgcn_exp2f(P[X][r] - mm); ps += P[X][r]; }
        ps = pswap_sum(ps);
        const float inv = ps > 0.f ? 1.f / ps : 0.f;
        if (u >= 16) {
            LAS float* imp = (LAS float*)(C.lds + L_IMP) + (hh * 64 + pos) * 32;
            float bprev = 0.f;
#pragma unroll
            for (int X = 0; X < 4; ++X)
#pragma unroll
                for (int q = 0; q < 4; ++q) { const float b3 = 0.5f * P[X][4 * q + 3];
                    const float aG = P[X][4 * q] + P[X][4 * q + 1] + P[X][4 * q + 2] + b3;
                    const auto sw_ = __builtin_amdgcn_permlane32_swap(__float_as_uint(b3), __float_as_uint(b3), false, false);
                    const float bp = __uint_as_float(C.hi ? sw_[0] : sw_[1]);
                    const float val = aG + (C.hi ? bp : bprev);
                    imp[2 * (4 * X + q) + C.hi] = val * inv;
                    bprev = bp; }
        }
        f32x16 o[4] = {};
        bf16x8 pa0, pa1, pa2, pa3;
        pack_p(P[0], P[1], pa0, pa1, pa2, pa3); pv_tile(o, vb0, pa0, pa1, pa2, pa3);
        pack_p(P[2], P[3], pa0, pa1, pa2, pa3); pv_tile(o, vb0 + SHM, pa0, pa1, pa2, pa3);
        float w[16]; bcast_rows(w, g_c * inv, ws, C.r32, C.hi);
        __syncthreads();
        store_o(o, w, orow0, D, C.lds, C.wid, C.lane, false);
    }
    if (u >= 16) {
        const int p = C.tid & 63, jg = C.tid >> 6;
        const LAS float* i0 = (const LAS float*)(C.lds + L_IMP) + p * 32;
        float sc[32];
#pragma unroll
        for (int j4 = 0; j4 < 8; ++j4) { const f32x4 a = *(const LAS f32x4*)(i0 + 4 * j4), b2 = *(const LAS f32x4*)(i0 + 2048 + 4 * j4), c2 = *(const LAS f32x4*)(i0 + 4096 + 4 * j4), d2 = *(const LAS f32x4*)(i0 + 6144 + 4 * j4);
#pragma unroll
            for (int e = 0; e < 4; ++e) { const int j = 4 * j4 + e; const float s = ((a[e] + b2[e]) + c2[e]) + d2[e];
                const bool valid = j <= u, forced = j == 0 || j == u || j == u - 1;
                sc[j] = valid ? (forced ? 1e4f : s) : -1.f; } }
        unsigned bits = 0u;
#pragma unroll
        for (int e = 0; e < 4; ++e) { const int j = 4 * jg + e; float sj = 0.f;
#pragma unroll
            for (int k = 0; k < 32; ++k) sj = (k == j) ? sc[k] : sj;
            int rank = 0;
#pragma unroll
            for (int k = 0; k < 32; ++k) rank += (sc[k] > sj || (sc[k] == sj && k < j)) ? 1 : 0;
            if (j <= u && rank < 16) bits |= 1u << j; }
        ((LAS unsigned char*)(C.lds + L_NIB))[p * 8 + jg] = (unsigned char)(bits >> (4 * jg));
        __syncthreads();
        if (C.tid < 64) { const u32x2 nb = *(const LAS u32x2*)(C.lds + L_NIB + C.tid * 8); unsigned full = 0u;
#pragma unroll
            for (int k = 0; k < 4; ++k) { full |= ((nb.x >> (8 * k)) & 0xfu) << (4 * k); full |= ((nb.y >> (8 * k)) & 0xfu) << (16 + 4 * k); }
            SEL[C.tid] = full; unsigned un = full;
#pragma unroll
            for (int o = 1; o < 64; o <<= 1) un |= __shfl_xor(un, o);
            if (C.tid == 0) SEL[64] = un; }
    } else { if (C.tid < 65) SEL[C.tid] = (2u << u) - 1u; }
    __syncthreads();
    sel_out = SEL[pos]; U_out = SEL[64];
}
__device__ __forceinline__ int dequeue(LAS char* lds, unsigned* head, int tid) {
    if (tid == 0) *(LAS int*)(lds + L_Q) = (int)__hip_atomic_fetch_add(head, 1u, RLX_AGENT);
    __syncthreads();
    const int q = *(const LAS int*)(lds + L_Q);
    __syncthreads();
    return q;
}
#ifndef DBL_VAR
#define DBL_VAR 0
#endif
#ifndef DBL_STREAM
#define DBL_STREAM 0
#endif
#ifndef CONV_IN_P0
#define CONV_IN_P0 0
#endif
__device__ __forceinline__ void conv_some(const Frame& F, LAS char* lds, unsigned* chead, int n) {
    if (CONV_IN_P0) return;
    if (F.tid == 0) *(LAS int*)(lds + L_Q) = (int)__hip_atomic_fetch_add(chead, (unsigned)n, RLX_AGENT);
    __syncthreads();
    const int base = *(const LAS int*)(lds + L_Q);
    __syncthreads();
    conv_batch(F, base, base + n);
}
__device__ __forceinline__ void attn_phase(const Frame& F, LAS char* lds, const Tensors& Tn, unsigned* qhead) {
    Ctx C; C.lds = lds; C.tid = threadIdx.x; C.wid = __builtin_amdgcn_readfirstlane(C.tid >> 6); C.lane = C.tid & 63; C.r32 = C.lane & 31; C.hi = C.lane >> 5; C.trow = 0; C.qlo = 0;
    for (int i = C.tid; i < 8 * 129; i += 512) { const int head = i / 129, rel = i - head * 129; const int bk = rel < 128 ? T5B[rel] : 31;
        ((LAS float*)(lds + L_TBL))[head * 132 + rel] = Tn.rel_bias[bk * 8 + head] * LOG2E; }
    __syncthreads();
    LAS float* ws = (LAS float*)(lds + L_WS) + C.wid * 64;
#ifndef PASS_MASK
#define PASS_MASK 7
#endif
    int nconv = (int)((blockIdx.x >> 3) & 7) * 7;
    if (PASS_MASK & 1) for (;;) {
        conv_some(F, lds, qhead + 192, nconv); nconv = 9;
        const int q = dequeue(lds, qhead, C.tid); if (q >= 512) break;
        const int u = 31 - (q >> 4), b = (q >> 1) & 7, g = q & 1, head = g * 4 + (C.wid >> 1);
        C.qlo = 64 * u + (C.wid & 1) * 32; C.trow = C.qlo + C.r32;
        const size_t tok = (size_t)b * T + C.trow;
        bf16x8 qr[8]; load_q(qr, Tn.PA + tok * NPA + CQ_NSA + head * HD, Tn.nsa_q_g, C.hi);
        bf16_t* orow0 = Tn.OC + ((size_t)b * T + C.qlo) * D + head * HD;
        const LAS float* tb = (const LAS float*)(lds + L_TBL) + head * 132;
        const float* gl = Tn.GL + tok * LDG; const float g_c = fast_sigmoid(gl[head]), g_s = fast_sigmoid(gl[8 + head]), g_w = fast_sigmoid(gl[16 + head]);
        unsigned sel, U; nsa_pre(C, Tn, qr, b, g, u, g_c, orow0, sel, U);
        const bf16_t* PAb = Tn.PA + (size_t)b * T * NPA + g * HD;
        int br = 0;
        do {
            const unsigned mask = br ? (((2u << u) - 1u) & ~(u >= 9 ? ((1u << (u - 8)) - 1u) : 0u)) : U;
            f32x16 o[4] = {}; float m_reg = -1e30f, l_reg = 0.f;
            stream(C, qr, PAb + (br ? CK_WIN : CK_SLC), PAb + (br ? CV_WIN : CV_SLC), NPA, mask, m_reg, l_reg, o, BiasUni<0>{&C, tb, u, sel, br});
            float w[16]; bcast_rows(w, l_reg > 0.f ? (br ? g_w : g_s) / l_reg : 0.f, ws, C.r32, C.hi);
            store_o(o, w, orow0, D, lds, C.wid, C.lane, true);
#if DBL_STREAM
            { f32x16 o2[4] = {}; float m2 = -1e30f, l2 = 0.f; stream<DBL_VAR>(C, qr, PAb + (br ? CK_WIN : CK_SLC), PAb + (br ? CV_WIN : CV_SLC), NPA, mask, m2, l2, o2, BiasUni<0>{&C, tb, u, sel, br}); float sk = ((o2[0][0] + o2[1][0]) + (o2[2][0] + o2[3][0])) + l2 + m2; asm volatile("" :: "v"(sk)); }
#endif
            ++br; asm volatile("" : "+s"(br));
        } while (br < 2);
    }
    if (PASS_MASK & 2) for (;;) {
        const int q = dequeue(lds, qhead + 64, C.tid); if (q >= 256) break;
        const int qb = 7 - (q >> 5), b = (q >> 2) & 7, h = q & 3;
        C.qlo = 256 * qb + 32 * C.wid; C.trow = C.qlo + C.r32;
        const size_t tok = (size_t)b * T + C.trow;
        bf16x8 qr[8]; load_q(qr, Tn.PA + tok * NPA + CQ_FOX + h * HD, Tn.fox_q_g, C.hi);
        { LAS float* cl = (LAS float*)(lds + L_CUM); const float* cg = Tn.CUM + (size_t)(b * 4 + h) * T;
          for (int i = C.tid; i < 256 * (qb + 1); i += 512) cl[i] = -cg[i] * LOG2E; }
        const bf16_t* PAb = Tn.PA + (size_t)b * T * NPA + h * HD;
        const unsigned mask = qb == 7 ? 0xffffffffu : ((1u << (4 * qb + 4)) - 1u);
        f32x16 o[4] = {}; float m_reg = -1e30f, l_reg = 0.f;
        stream(C, qr, PAb + CK_FOX, PAb + CV_FOX, NPA, mask, m_reg, l_reg, o, BiasUni<1>{&C, nullptr, 0, 0u, 2});
        float w[16]; bcast_rows(w, l_reg > 0.f ? 1.f / l_reg : 0.f, ws, C.r32, C.hi);
        store_o(o, w, Tn.OC + ((size_t)b * T + C.qlo) * D + 1024 + h * HD, D, lds, C.wid, C.lane, false);
#if DBL_STREAM
        { f32x16 o2[4] = {}; float m2 = -1e30f, l2 = 0.f; stream<DBL_VAR>(C, qr, PAb + CK_FOX, PAb + CV_FOX, NPA, mask, m2, l2, o2, BiasUni<1>{&C, nullptr, 0, 0u, 2}); float sk = ((o2[0][0] + o2[1][0]) + (o2[2][0] + o2[3][0])) + l2 + m2; asm volatile("" :: "v"(sk)); }
#endif
        conv_some(F, lds, qhead + 192, 6);
    }
    if (PASS_MASK & 4) for (;;) {
        const int q = dequeue(lds, qhead + 128, C.tid); if (q >= 256) break;
        const int qb = q & 7, h = (q >> 3) & 3, b = q >> 5;
        C.qlo = 256 * qb + 32 * C.wid; C.trow = C.qlo + C.r32;
        const size_t tok = (size_t)b * T + C.trow;
        bf16x8 qr[8]; load_q(qr, Tn.PA + tok * NPA + CQ_MEM + h * HD, Tn.mem_q_g, C.hi);
        const bf16_t* Kb = Tn.KVM + (size_t)b * MEMT * 1024 + h * HD;
        f32x16 o[4] = {}; float m_reg = -1e30f, l_reg = 0.f;
        stream(C, qr, Kb, Kb + 512, 1024, 0xfu, m_reg, l_reg, o, BiasUni<2>{&C, nullptr, 0, 0u, 3});
        float w[16]; bcast_rows(w, l_reg > 0.f ? 1.f / l_reg : 0.f, ws, C.r32, C.hi);
        store_o(o, w, Tn.OC + ((size_t)b * T + C.qlo) * D + 1536 + h * HD, D, lds, C.wid, C.lane, false);
#if DBL_STREAM
        { f32x16 o2[4] = {}; float m2 = -1e30f, l2 = 0.f; stream<DBL_VAR>(C, qr, Kb, Kb + 512, 1024, 0xfu, m2, l2, o2, BiasUni<2>{&C, nullptr, 0, 0u, 3}); float sk = ((o2[0][0] + o2[1][0]) + (o2[2][0] + o2[3][0])) + l2 + m2; asm volatile("" :: "v"(sk)); }
#endif
        conv_some(F, lds, qhead + 192, 2);
    }
    if (!CONV_IN_P0) for (;;) {
        if (F.tid == 0) *(LAS int*)(lds + L_Q) = (int)__hip_atomic_fetch_add(qhead + 192, 8u, RLX_AGENT);
        __syncthreads();
        const int base = *(const LAS int*)(lds + L_Q);
        __syncthreads();
        if (base >= 3 * 65 * 64) break;
        conv_batch(F, base, base + 8);
    }
}
#undef KSWZ
#undef SBAR
}

__device__ __forceinline__ void p0_prologue(Frame& F) {
    LAS float* scr = (LAS float*)(F.lds + 40960 + F.wave * 8704);
    unsigned char* ws = F.ws; const int lane = F.lane;
    if (F.gw < 128) { const int kv = F.gw >> 6, j = F.gw & 63; const float* pe = F.in(kv ? I_PE_V : I_PE_K) + 64 * j; const float* w = F.in(kv ? I_W_CV : I_W_CK) + (size_t)64 * j * 128; float a0 = 0.f, a1 = 0.f;
#pragma unroll 16
        for (int k = 0; k < 64; ++k) { const float p = pe[k]; a0 += p * w[(size_t)k * 128 + lane]; a1 += p * w[(size_t)k * 128 + 64 + lane]; }
        float* cb = (float*)(ws + WS_CBIAS) + (size_t)(kv * 64 + j) * 128; cb[lane] = a0; cb[64 + lane] = a1; }
    constexpr int S0 = 32 * 8, S1 = S0 + 64;
    bf16_t* WinT = (bf16_t*)(ws + WS_WINT);
    for (int it = F.gw; it < S1; it += F.NGW) {
        if (it < S0) { }
        else {
            const int r = it - S0, kb = r >> 1, nb = r & 1, k0 = 64 * kb, n0 = 32 * nb; const float* W = F.in(I_W_ROUTER);
#pragma unroll 8
            for (int i = 0; i < 32; ++i) { const int kk = 2 * i + (lane >> 5); scr[kk * 33 + (lane & 31)] = W[(size_t)(k0 + kk) * NE + n0 + (lane & 31)]; }
            LDS_WAIT(); asm volatile("" ::: "memory");
            const int c8 = lane & 7; bf16_t* Whi = (bf16_t*)(ws + WS_WRT); bf16_t* Wlo = Whi + (size_t)NE * D;
#pragma unroll
            for (int j = 0; j < 4; ++j) { const int n = (lane >> 3) + 8 * j; const LAS float* s = scr + (8 * c8) * 33 + n; unsigned h[4], l[4];
#pragma unroll
                for (int q = 0; q < 4; ++q) { const float a = s[(2 * q) * 33], b = s[(2 * q + 1) * 33]; h[q] = cvtpk(a, b); l[q] = cvtpk(a - bf_lo(h[q]), b - bf_hi(h[q])); }
                *(u32x4*)(Whi + (size_t)(n0 + n) * D + k0 + 8 * c8) = (u32x4){h[0], h[1], h[2], h[3]};
                *(u32x4*)(Wlo + (size_t)(n0 + n) * D + k0 + 8 * c8) = (u32x4){l[0], l[1], l[2], l[3]}; }
            LDS_WAIT(); asm volatile("" ::: "memory");
        }
    }
    {
        LAS unsigned* T32 = (LAS unsigned*)F.lds;
        int t = blockIdx.x; f32x4 v[8]; Tr8Desc d = tr8w_decode(F, t < TR8W_NTILES ? t : 0);
        if (t < TR8W_NTILES) tr8_load(d, v, F.wave, lane);
        while (t < TR8W_NTILES) {
            tr8_to_lds(v, d.scale, T32, F.wave, lane);
            __syncthreads();
            const int tn = t + F.G; const Tr8Desc dn = tr8w_decode(F, tn < TR8W_NTILES ? tn : 0);
            if (tn < TR8W_NTILES) tr8_load(dn, v, F.wave, lane);
            tr8_from_lds(d, T32, F.wave, lane);
            __syncthreads();
            t = tn; d = dn;
        }
    }
    {
        LAS unsigned* T32 = (LAS unsigned*)F.lds;
        constexpr int NT0 = TR_FIRST_EXPERT;
        int t = blockIdx.x; f32x4 v[8]; TrDesc d = tr_decode(F, t < NT0 ? t : 0);
        if (t < NT0) tr_load(d, v, F.wave, lane);
        while (t < NT0) {
            tr_to_lds(v, T32, F.wave, lane);
            __syncthreads();
            const int tn = t + F.G; const TrDesc dn = tr_decode(F, tn < NT0 ? tn : 0);
            if (tn < NT0) tr_load(dn, v, F.wave, lane);
            tr_from_lds(d, T32, F.wave, lane);
            __syncthreads();
            t = tn; d = dn;
        }
    }
    if (CONV_IN_P0) { __syncthreads(); for (int base = blockIdx.x * 8; base < 3 * 65 * 64; base += F.G * 8) conv_batch(F, base, base + 8); }
    __syncthreads();
    bf16_t* A3 = (bf16_t*)(ws + WS_A3); unsigned char* H8 = ws + WS_H8;
    {
        constexpr int TSTR = 4096 + 16;
        LAS unsigned char* tile = F.lds; LAS float* red = (LAS float*)(F.lds + 16 * TSTR);
        const int w = F.wave, fr = lane & 15, fq = lane >> 4;
        bf16x8 Bf[8][2];
        { const float* W = F.in(I_W_IN);
#pragma unroll
          for (int c = 0; c < 8; ++c)
#pragma unroll
              for (int hf = 0; hf < 2; ++hf) { const int j = fr + 16 * hf, sc = j < 24 ? 2560 + j : (j < 28 ? 4120 + (j - 24) : -1); const float* p = W + (size_t)(256 * w + 32 * c + 8 * fq) * W_IN_COLS + (sc >= 0 ? sc : 0);
                  float x[8];
#pragma unroll
                  for (int e = 0; e < 8; ++e) x[e] = sc >= 0 ? p[(size_t)e * W_IN_COLS] : 0.f;
                  u32x4 pk = {cvtpk(x[0], x[1]), cvtpk(x[2], x[3]), cvtpk(x[4], x[5]), cvtpk(x[6], x[7])}; Bf[c][hf] = __builtin_bit_cast(bf16x8, pk); } }
        const float* X = F.in(I_X); const float* gain = F.in(I_NORM_ATTN_G); float* GLp = (float*)(ws + WS_GL);
        for (int m0 = blockIdx.x * 16; m0 < M; m0 += F.G * 16) {
#pragma unroll
            for (int r = 0; r < 2; ++r) { const int m = m0 + 2 * w + r; const float* xrow = X + (size_t)m * D;
                f32x4 v[8]; float ss = 0.f;
#pragma unroll
                for (int j = 0; j < 8; ++j) { v[j] = *(const f32x4*)(xrow + 4 * lane + 256 * j); ss += (v[j].x * v[j].x + v[j].y * v[j].y) + (v[j].z * v[j].z + v[j].w * v[j].w); }
                const float rstd = __builtin_amdgcn_rsqf(wave_sum(ss) * (1.f / D) + RMS_EPS);
#pragma unroll
                for (int j = 0; j < 8; ++j) { const f32x4 g = *(const f32x4*)(gain + 4 * lane + 256 * j); const float a = v[j].x * rstd * g.x, b = v[j].y * rstd * g.y, c = v[j].z * rstd * g.z, d = v[j].w * rstd * g.w;
                    u32x2 o; o.x = cvtpk(a, b); o.y = cvtpk(c, d);
                    *(LAS u32x2*)(tile + (2 * w + r) * TSTR + (4 * lane + 256 * j) * 2) = o;
                    if (NB16 > 0) *(u32x2*)(A3 + (size_t)m * D + 4 * lane + 256 * j) = o;
                    *(unsigned*)(H8 + (size_t)m * D + 4 * lane + 256 * j) = pk_fp8x4(a, b, c, d); } }
            __syncthreads();
            f32x4 a0 = {0.f, 0.f, 0.f, 0.f}, a1 = {0.f, 0.f, 0.f, 0.f};
#pragma unroll
            for (int c = 0; c < 8; ++c) { const bf16x8 af = *(const LAS bf16x8*)(tile + fr * TSTR + (256 * w + 32 * c + 8 * fq) * 2);
                a0 = __builtin_amdgcn_mfma_f32_16x16x32_bf16(af, Bf[c][0], a0, 0, 0, 0); a1 = __builtin_amdgcn_mfma_f32_16x16x32_bf16(af, Bf[c][1], a1, 0, 0, 0); }
#pragma unroll
            for (int r = 0; r < 4; ++r) { red[(w * 16 + 4 * fq + r) * 32 + fr] = a0[r]; red[(w * 16 + 4 * fq + r) * 32 + 16 + fr] = a1[r]; }
            __syncthreads();
            { const int row = F.tid >> 5, col = F.tid & 31; float sacc = 0.f;
#pragma unroll
              for (int ww = 0; ww < 8; ++ww) sacc += red[(ww * 16 + row) * 32 + col];
              GLp[(size_t)(m0 + row) * LDG + col] = sacc; }
            asm volatile("s_waitcnt vmcnt(0) lgkmcnt(0)" ::: "memory");
            __syncthreads();
        }
        for (int m = M + F.gw; m < M + MROWS; m += F.NGW) rms_row_bf16(F.in(I_MEM) + (size_t)(m - M) * D, F.in(I_NORM_MEM_G), A3 + (size_t)m * D, lane);
    }
}

__device__ __forceinline__ void p2_thin(Frame& F) {
    unsigned char* ws = F.ws; const int lane = F.lane;
    bf16_t* PA = (bf16_t*)(ws + WS_PA); bf16_t* KVM = (bf16_t*)(ws + WS_KVMEM); const float* GL = (const float*)(ws + WS_GL);
    {
        LAS float* part = (LAS float*)F.lds;
        LAS float* red = (LAS float*)(F.lds + 65536);
        const int i16 = lane & 15, kg = lane >> 4, w = F.wave;
        for (int item = blockIdx.x; item < 256; item += F.G) {
            const int kv = item & 1, rt = (item >> 1) & 7, bg = item >> 4, b = bg >> 1, g = bg & 1;
            const int n = 16 * rt + i16, ne = n < 127 ? n : 126;
            const bf16_t* Ab = PA + ((size_t)(b * T + 16 * ne + 4 * w) * NPA + (kv ? CV_CMP : CK_CMP) + g * HD) + 8 * kg;
            const bf16_t* Bb = (const bf16_t*)(ws + (kv ? WS_WCV : WS_WCK)) + (size_t)i16 * 4096 + 512 * w + 8 * kg;
            f32x4 acc[8];
#pragma unroll
            for (int nt = 0; nt < 8; ++nt) acc[nt] = (f32x4){0.f, 0.f, 0.f, 0.f};
#pragma unroll 2
            for (int s = 0; s < 16; ++s) { const bf16x8 a = *(const bf16x8*)(Ab + (size_t)(s >> 2) * NPA + 32 * (s & 3));
#pragma unroll
                for (int nt = 0; nt < 8; ++nt) { const bf16x8 bb = *(const bf16x8*)(Bb + (size_t)nt * 16 * 4096 + 32 * s); acc[nt] = __builtin_amdgcn_mfma_f32_16x16x32_bf16(a, bb, acc[nt], 0, 0, 0); } }
            __syncthreads();
#pragma unroll
            for (int nt = 0; nt < 8; ++nt) *(LAS f32x4*)(part + ((w * 8 + nt) * 64 + lane) * 4) = acc[nt];
            __syncthreads();
            f32x4 t = {0.f, 0.f, 0.f, 0.f};
#pragma unroll
            for (int ww = 0; ww < 8; ++ww) t += *(const LAS f32x4*)(part + ((ww * 8 + w) * 64 + lane) * 4);
            const int e = 16 * w + i16; float cb = 0.f;
#pragma unroll 16
            for (int j = 0; j < 64; ++j) cb += ((const float*)(ws + WS_CBIAS))[(size_t)(kv * 64 + j) * 128 + e];
#pragma unroll
            for (int r = 0; r < 4; ++r) t[r] += cb;
            float scl[4] = {1.f, 1.f, 1.f, 1.f};
            if (kv == 0) {
#pragma unroll
                for (int r = 0; r < 4; ++r) { float q = t[r] * t[r]; q += __shfl_xor(q, 1); q += __shfl_xor(q, 2); q += __shfl_xor(q, 4); q += __shfl_xor(q, 8); if (i16 == 0) red[w * 16 + 4 * kg + r] = q; }
            }
            __syncthreads();
            if (kv == 0) { const float kgain = F.in(I_NSA_K_G)[e];
#pragma unroll
                for (int r = 0; r < 4; ++r) { float q = 0.f;
#pragma unroll
                    for (int ww = 0; ww < 8; ++ww) q += red[ww * 16 + 4 * kg + r];
                    scl[r] = __builtin_amdgcn_rsqf(q * (1.f / HD) + RMS_EPS) * kgain; } }
            bf16_t* Ob = (bf16_t*)(ws + (kv ? WS_VC : WS_KC)) + (size_t)bg * 128 * HD;
#pragma unroll
            for (int r = 0; r < 4; ++r) { const int nn = 16 * rt + 4 * kg + r; const float v = nn < 127 ? t[r] * scl[r] : 0.f; Ob[(size_t)nn * HD + e] = (bf16_t)(cvtpk(v, 0.f) & 0xffffu); }
        }
    }
#pragma unroll 2
    for (int row = F.gw; row < M; row += F.NGW) {
        const int hd = lane >> 3, col = (hd < 2 ? CK_SLC + hd * HD : (hd < 4 ? CK_WIN + (hd - 2) * HD : CK_FOX + (hd - 4) * HD)) + (lane & 7) * 16;
        bf16_t* p = PA + (size_t)row * NPA + col; const u32x4 r0 = *(const u32x4*)p, r1 = *(const u32x4*)(p + 8);
        float ss = 0.f;
#pragma unroll
        for (int e = 0; e < 4; ++e) { ss += bf_lo(r0[e]) * bf_lo(r0[e]) + bf_hi(r0[e]) * bf_hi(r0[e]) + bf_lo(r1[e]) * bf_lo(r1[e]) + bf_hi(r1[e]) * bf_hi(r1[e]); }
        ss += __shfl_xor(ss, 1); ss += __shfl_xor(ss, 2); ss += __shfl_xor(ss, 4);
        const float rstd = __builtin_amdgcn_rsqf(ss * (1.f / HD) + RMS_EPS); const float* gn = F.in(hd < 4 ? I_NSA_K_G : I_FOX_K_G) + (lane & 7) * 16;
        u32x4 o0, o1;
#pragma unroll
        for (int e = 0; e < 4; ++e) { o0[e] = cvtpk(bf_lo(r0[e]) * rstd * gn[2 * e], bf_hi(r0[e]) * rstd * gn[2 * e + 1]); o1[e] = cvtpk(bf_lo(r1[e]) * rstd * gn[8 + 2 * e], bf_hi(r1[e]) * rstd * gn[8 + 2 * e + 1]); }
        *(u32x4*)p = o0; *(u32x4*)(p + 8) = o1;
    }
    for (int mr = F.gw; mr < MROWS; mr += F.NGW) {
        bf16_t* p = KVM + (size_t)mr * 1024 + (lane >> 4) * HD + (lane & 15) * 8; const u32x4 r0 = *(const u32x4*)p; float ss = 0.f;
#pragma unroll
        for (int e = 0; e < 4; ++e) ss += bf_lo(r0[e]) * bf_lo(r0[e]) + bf_hi(r0[e]) * bf_hi(r0[e]);
        ss += __shfl_xor(ss, 1); ss += __shfl_xor(ss, 2); ss += __shfl_xor(ss, 4); ss += __shfl_xor(ss, 8);
        const float rstd = __builtin_amdgcn_rsqf(ss * (1.f / HD) + RMS_EPS); const float* gn = F.in(I_MEM_K_G) + (lane & 15) * 8; u32x4 o0;
#pragma unroll
        for (int e = 0; e < 4; ++e) o0[e] = cvtpk(bf_lo(r0[e]) * rstd * gn[2 * e], bf_hi(r0[e]) * rstd * gn[2 * e + 1]);
        *(u32x4*)p = o0;
    }
    for (int seq = F.gw; seq < 32; seq += F.NGW) {
        const int b = seq >> 2, h = seq & 3; const float bf = F.in(I_FOX_B_F)[h]; float v[32]; float run = 0.f;
#pragma unroll
        for (int i = 0; i < 32; ++i) { const float x = GL[(size_t)(b * T + 32 * lane + i) * LDG + 24 + h] + bf;
            const float ls = fminf(x, 0.f) - log1pf(__expf(-fabsf(x))); run += ls; v[i] = run; }
        float incl = run;
#pragma unroll
        for (int o = 1; o < 64; o <<= 1) { const float t = __shfl_up(incl, o); if (lane >= o) incl += t; }
        const float excl = incl - run; float* cp = (float*)(ws + WS_CUM) + (size_t)seq * T + 32 * lane;
#pragma unroll
        for (int i = 0; i < 32; ++i) cp[i] = v[i] + excl;
    }
}

constexpr int CW_COARSE = 16384;
constexpr int P6_WSTR = 136;
constexpr int P6_WBUF = 2 * 64 * P6_WSTR * 2;
static_assert(2 * P6_WBUF <= RING_BYTES, "P6 chunk buffers inside the ring region");
__device__ __forceinline__ void p6_router(Frame& F) {
    unsigned char* ws = F.ws; const int lane = F.lane, i16 = lane & 15, kg = lane >> 4, row = i16 & 7;
    unsigned char* H2 = (unsigned char*)(ws + WS_A3); const bf16_t* X1 = (const bf16_t*)(ws + WS_X1B); const float* gain = F.in(I_NORM_FFN_G);
    const bf16_t* Wg = (const bf16_t*)(ws + WS_WRT);
    const float rb = F.in(I_ROUTER_BIAS)[lane];
    unsigned* coarse = (unsigned*)(ws + WS_CTL) + CW_COARSE;
    if (F.gw == 0) {
#pragma unroll
        for (int q = 0; q < 2; ++q) *(u32x4*)(H2 + (size_t)M * D + 32 * lane + 16 * q) = (u32x4){0u, 0u, 0u, 0u}; }
    for (int item = blockIdx.x; item < M / 64; item += F.G) {
        const int tok0 = item * 64 + F.wave * 8;
        float myr = 0.f;
#pragma unroll 2
        for (int i = 0; i < 8; ++i) { const bf16_t* xr = X1 + (size_t)(tok0 + i) * D; float ss = 0.f;
#pragma unroll
            for (int j = 0; j < 4; ++j) { const u32x4 v = *(const u32x4*)(xr + 8 * lane + 512 * j);
#pragma unroll
                for (int e = 0; e < 4; ++e) ss += bf_lo(v[e]) * bf_lo(v[e]) + bf_hi(v[e]) * bf_hi(v[e]); }
            const float r = __builtin_amdgcn_rsqf(wave_sum(ss) * (1.f / D) + RMS_EPS); if (row == i) myr = r; }
        f32x4 acc[4] = {{0.f, 0.f, 0.f, 0.f}, {0.f, 0.f, 0.f, 0.f}, {0.f, 0.f, 0.f, 0.f}, {0.f, 0.f, 0.f, 0.f}};
        const bf16_t* xr = X1 + (size_t)(tok0 + row) * D + 8 * kg; unsigned char* hr = H2 + (size_t)(tok0 + row) * D + 8 * kg;
        u32x4 wst[4];
#define P6_LOADW(ch) do { _Pragma("unroll") for (int i = 0; i < 4; ++i) { const int p = F.tid + 512 * i; wst[i] = *(const u32x4*)(Wg + (size_t)(p >> 4) * D + 128 * (ch) + 8 * (p & 15)); } } while (0)
#define P6_STOREW(bf) do { _Pragma("unroll") for (int i = 0; i < 4; ++i) { const int p = F.tid + 512 * i; *(LAS u32x4*)(F.lds + (bf) * P6_WBUF + ((p >> 4) * P6_WSTR + 8 * (p & 15)) * 2) = wst[i]; } } while (0)
        P6_LOADW(0);
        __syncthreads();
        P6_STOREW(0);
        __syncthreads();
        for (int ch = 0; ch < 16; ++ch) {
            if (ch < 15) P6_LOADW(ch + 1);
            const LAS unsigned char* wb = F.lds + (ch & 1) * P6_WBUF + (i16 * P6_WSTR + 8 * kg) * 2;
#pragma unroll 2
            for (int s = 0; s < 4; ++s) { const int k = 128 * ch + 32 * s;
                const u32x4 xb = *(const u32x4*)(xr + k); const f32x4 g0 = *(const f32x4*)(gain + k + 8 * kg), g1 = *(const f32x4*)(gain + k + 8 * kg + 4);
                const float xn[8] = {bf_lo(xb.x) * myr * g0.x, bf_hi(xb.x) * myr * g0.y, bf_lo(xb.y) * myr * g0.z, bf_hi(xb.y) * myr * g0.w, bf_lo(xb.z) * myr * g1.x, bf_hi(xb.z) * myr * g1.y, bf_lo(xb.w) * myr * g1.z, bf_hi(xb.w) * myr * g1.w};
                u32x4 h, l;
#pragma unroll
                for (int q = 0; q < 4; ++q) { h[q] = cvtpk(xn[2 * q], xn[2 * q + 1]); l[q] = cvtpk(xn[2 * q] - bf_lo(h[q]), xn[2 * q + 1] - bf_hi(h[q])); }
                if (i16 < 8) *(u32x2*)(hr + k) = (u32x2){pk_fp8x4(xn[0], xn[1], xn[2], xn[3]), pk_fp8x4(xn[4], xn[5], xn[6], xn[7])};
                const bf16x8 ah = __builtin_bit_cast(bf16x8, h), al = __builtin_bit_cast(bf16x8, l);
#pragma unroll
                for (int nt = 0; nt < 4; ++nt) { const LAS unsigned char* wp = wb + (16 * nt * P6_WSTR + 32 * s) * 2;
                    const bf16x8 bh = *(const LAS bf16x8*)wp, bl = *(const LAS bf16x8*)(wp + 64 * P6_WSTR * 2);
                    acc[nt] = __builtin_amdgcn_mfma_f32_16x16x32_bf16(ah, bh, acc[nt], 0, 0, 0);
                    acc[nt] = __builtin_amdgcn_mfma_f32_16x16x32_bf16(al, bh, acc[nt], 0, 0, 0);
                    acc[nt] = __builtin_amdgcn_mfma_f32_16x16x32_bf16(ah, bl, acc[nt], 0, 0, 0); }
            }
            if (ch < 15) P6_STOREW((ch + 1) & 1);
            __syncthreads();
        }
#undef P6_LOADW
#undef P6_STOREW
        LAS float* lg = (LAS float*)(F.lds + F.wave * 4096);
        if (kg < 2) {
#pragma unroll
            for (int nt = 0; nt < 4; ++nt)
#pragma unroll
                for (int r = 0; r < 4; ++r) lg[(4 * kg + r) * 64 + 16 * nt + i16] = acc[nt][r]; }
        LDS_WAIT(); asm volatile("" ::: "memory");
        int cnt = 0;
        u32x2* asg = (u32x2*)(ws + WS_ASG);
        for (int tt = 0; tt < 8; ++tt) {
            const float sc = 1.f / (1.f + __expf(-lg[tt * 64 + lane])); const float key = sc + rb;
            lg[512 + lane] = key; LDS_WAIT(); asm volatile("" ::: "memory");
            int rank = 0;
#pragma unroll
            for (int q = 0; q < 16; ++q) { const f32x4 kk = *(const LAS f32x4*)(lg + 512 + 4 * q);
#pragma unroll
                for (int e = 0; e < 4; ++e) { const int eo = 4 * q + e; rank += (kk[e] > key || (kk[e] == key && eo < lane)) ? 1 : 0; } }
            LDS_WAIT(); asm volatile("" ::: "memory");
            const bool selx = rank < TOPK;
            const float ssum = wave_sum(selx ? sc : 0.f);
            const unsigned long long bal = __ballot(selx);
            if (selx) { const int k = __popcll(bal & ((1ull << lane) - 1ull));
                asg[(size_t)(tok0 + tt) * TOPK + k] = (u32x2){(unsigned)lane | ((unsigned)cnt << 8), __float_as_uint(sc / ssum * 2.5f)}; ++cnt; }
        }
        const int wi = item * 8 + F.wave;
        ((int*)(ws + WS_HIST))[wi * 64 + lane] = cnt;
        __hip_atomic_fetch_add(coarse + (wi >> 5) * 64 + lane, (unsigned)cnt, RLX_AGENT);
    }
}
__device__ __forceinline__ void p7_slots(Frame& F) {
    unsigned char* ws = F.ws; const int lane = F.lane;
    const int* hist = (const int*)(ws + WS_HIST); const u32x2* asg = (const u32x2*)(ws + WS_ASG); const unsigned* coarse = (const unsigned*)(ws + WS_CTL) + CW_COARSE;
    int* rowasg = (int*)(ws + WS_ROWASG); int* rowtok = (int*)(ws + WS_ROWTOK); float* rowg = (float*)(ws + WS_ROWG);
    for (int wi = F.gw; wi < M / 8; wi += F.NGW) {
        const int grp = wi >> 5; int base = 0, total = 0;
#pragma unroll 8
        for (int g = 0; g < 64; ++g) { const int cv = (int)coarse[g * 64 + lane]; total += cv; base += g < grp ? cv : 0; }
        for (int i = grp * 32; i < wi; ++i) base += hist[i * 64 + lane];
        const int padded = (total + 255) & ~255;
        int incl = padded;
#pragma unroll
        for (int o = 1; o < 64; o <<= 1) { const int t = __shfl_up(incl, o); if (lane >= o) incl += t; }
        const int pstart = incl - padded, rtot = __shfl(incl, 63);
        const int my = pstart + base;
        { const int tok = wi * 8 + (lane >> 3), k = lane & 7; const u32x2 rec = asg[(size_t)tok * TOPK + k];
          const int e = rec.x & 255, rl = rec.x >> 8; const int dest = __shfl(my, e) + rl;
          rowasg[dest] = tok * ASG_PER_TOK + k; rowtok[dest] = tok; rowg[dest] = __uint_as_float(rec.y); }
        if (lane < 8) { const int tok = wi * 8 + lane, dest = rtot + tok; rowasg[dest] = tok * ASG_PER_TOK + 8; rowtok[dest] = tok; rowg[dest] = 1.f; }
        if (wi == 0) { for (int sl = pstart + total; sl < pstart + padded; ++sl) { rowasg[sl] = -1; rowtok[sl] = M; rowg[sl] = 0.f; }
                       ((int*)(ws + WS_CNT))[lane] = total; }
    }
}
__device__ __forceinline__ int build_blocks(Frame& F, LAS unsigned char* blk_e, LAS int* tmp) {
    const int* cnt = (const int*)(F.ws + WS_CNT);
    if (F.tid < NEX) tmp[F.tid] = F.tid < NE ? (cnt[F.tid] + 255) >> 8 : M / 256;
    __syncthreads();
    if (F.tid < NEX) { int st = 0; for (int e = 0; e < F.tid; ++e) st += tmp[e]; const int nb = tmp[F.tid]; for (int i = 0; i < nb; ++i) blk_e[st + i] = (unsigned char)F.tid; if (F.tid == NEX - 1) tmp[NEX] = st + nb; }
    __syncthreads();
    return tmp[NEX];
}
__device__ __forceinline__ void p10_combine(Frame& F) {
    const unsigned char* Y = (const unsigned char*)(F.ws + WS_Y); float* O = F.out; const bf16_t* X1 = (const bf16_t*)(F.ws + WS_X1B); const int lane = F.lane;
    for (int tok = F.gw; tok < M; tok += F.NGW) {
#pragma unroll
        for (int c = 0; c < 2; ++c) { const int col = 16 * lane + 1024 * c; float* op = O + (size_t)tok * D + col;
            const u32x4 xa = *(const u32x4*)(X1 + (size_t)tok * D + col), xb = *(const u32x4*)(X1 + (size_t)tok * D + col + 8);
            const f32x4 x0 = {bf_lo(xa.x), bf_hi(xa.x), bf_lo(xa.y), bf_hi(xa.y)}, x1 = {bf_lo(xa.z), bf_hi(xa.z), bf_lo(xa.w), bf_hi(xa.w)}, x2 = {bf_lo(xb.x), bf_hi(xb.x), bf_lo(xb.y), bf_hi(xb.y)}, x3 = {bf_lo(xb.z), bf_hi(xb.z), bf_lo(xb.w), bf_hi(xb.w)};
            u32x4 y[ASG_PER_TOK];
#pragma unroll
            for (int k = 0; k < ASG_PER_TOK; ++k) y[k] = *(const u32x4*)(Y + ((size_t)tok * ASG_PER_TOK + k) * D + col);
            float a[16];
#pragma unroll
            for (int e = 0; e < 16; ++e) a[e] = 0.f;
#pragma unroll
            for (int k = 0; k < ASG_PER_TOK; ++k)
#pragma unroll
                for (int q = 0; q < 4; ++q) { const auto lo = __builtin_amdgcn_cvt_pk_f32_fp8((int)y[k][q], false); const auto hi = __builtin_amdgcn_cvt_pk_f32_fp8((int)y[k][q], true);
                    a[4 * q] += lo[0]; a[4 * q + 1] += lo[1]; a[4 * q + 2] += hi[0]; a[4 * q + 3] += hi[1]; }
            const float r = 1.f / Y_SCALE;
            *(f32x4*)op = (f32x4){x0[0] + a[0] * r, x0[1] + a[1] * r, x0[2] + a[2] * r, x0[3] + a[3] * r};
            *(f32x4*)(op + 4) = (f32x4){x1[0] + a[4] * r, x1[1] + a[5] * r, x1[2] + a[6] * r, x1[3] + a[7] * r};
            *(f32x4*)(op + 8) = (f32x4){x2[0] + a[8] * r, x2[1] + a[9] * r, x2[2] + a[10] * r, x2[3] + a[11] * r};
            *(f32x4*)(op + 12) = (f32x4){x3[0] + a[12] * r, x3[1] + a[13] * r, x3[2] + a[14] * r, x3[3] + a[15] * r}; }
    }
}

constexpr int N_PHASES = 11;
struct Args { const float* in[31]; float* out; unsigned char* ws; int ph_lo, ph_hi, use_bar, pad; };
__global__ void __launch_bounds__(512, 2) mega(Args args) {
    extern __shared__ __attribute__((aligned(16))) unsigned char lds_raw[];
    LAS unsigned char* lds = (LAS unsigned char*)lds_raw;
    Frame F; F.lds = lds; F.tid = threadIdx.x; F.lane = F.tid & 63; F.wave = __builtin_amdgcn_readfirstlane(F.tid >> 6); F.G = gridDim.x;
    F.gw = blockIdx.x * 8 + F.wave; F.NGW = F.G * 8; F.out = args.out; F.ws = args.ws;
    unsigned char* ws = args.ws;
    unsigned* ctl = (unsigned*)(ws + WS_CTL);
    for (int u = F.tid; u < 256; u += 512) ((LAS unsigned*)(lds + LDSCTL_OFF))[u] = 0u;
    __syncthreads();
    XcdBarrier bar; bar.bar = ctl + CW_BAR; bar.x = 0; bar.st = nullptr;
    if (args.use_bar) bar = xcd_barrier_post(ctl + CW_BAR, (volatile LAS unsigned*)(lds + LDSCTL_OFF));
    const int lo = args.ph_lo, hi = args.ph_hi;
#ifndef PH_MASK
#define PH_MASK 0x7ff
#endif
#define IN(k) (((PH_MASK >> (k)) & 1) && lo <= (k) && (k) < hi)
#define SEAM(k) do { if (IN(k) && IN((k) + 1)) xcd_barrier(bar); } while (0)
    const int c = (int)blockIdx.x;
#ifndef REP_PHASE
#define REP_PHASE -1
#endif
#define RUN(k, ...) do { if (IN(k)) { const int rep = 0; (void)rep; __VA_ARGS__ } if (REP_PHASE == (k) && IN(k)) { xcd_barrier(bar); const int rep = 1; (void)rep; __VA_ARGS__ } } while (0)
    RUN(0, p0_prologue(F); ); SEAM(0);
    RUN(1,
        Epi1 E{(bf16_t*)(ws + WS_PA), (unsigned char*)(ws + WS_PG), (float*)(ws + WS_GL), (bf16_t*)(ws + WS_KVMEM)};
        { Sched1 S; S.o.init(64, NB16 ? NB16 : 1); S.A = (const char*)(ws + WS_A3); S.Bt = (const char*)(ws + WS_WINT); S.G = F.G; S.c = c; S.fp8 = 0;
          pg8::gemm_phase<Epi1, Sched1, false, false>(lds, 2 * D, 2 * D, S, E); }
        { Sched1 S; S.o.init(64, 24 + NF8); S.A = (const char*)(ws + WS_H8); S.Bt = (const char*)(ws + WS_WIN8); S.G = F.G; S.c = c; S.fp8 = 1;
          pg8::gemm_phase<Epi1, Sched1, false, true>(lds, D, D, S, E); }
    ); SEAM(1);
    RUN(2, p2_thin(F); ); SEAM(2);
    RUN(3,
        att::Tensors Tn{(const bf16_t*)(ws + WS_PA), (const float*)(ws + WS_GL), (const bf16_t*)(ws + WS_KVMEM), (const bf16_t*)(ws + WS_KC), (const bf16_t*)(ws + WS_VC), (const float*)(ws + WS_CUM),
                        (bf16_t*)(ws + WS_A3), F.in(I_NSA_Q_G), F.in(I_FOX_Q_G), F.in(I_MEM_Q_G), F.in(I_REL_BIAS)};
        att::attn_phase(F, (LAS char*)lds, Tn, ctl + CW_QUEUE + rep * 256);
    ); SEAM(3);
    RUN(4,
        Sched4 S; S.o.init(64, 8); S.A = (const char*)(ws + WS_A3); S.Bt = (const char*)(ws + WS_WOT); S.G = F.G; S.c = c;
        Epi4 E{(const unsigned char*)(ws + WS_PG), (bf16_t*)(ws + WS_PA)};
        pg8::gemm_phase<Epi4, Sched4, false>(lds, 2 * D, 2 * D, S, E);
    ); SEAM(4);
    RUN(5,
        Sched5 S; S.o.init(64, 8); S.A = (const char*)(ws + WS_PA); S.Bt = (const char*)(ws + WS_WOUTT); S.G = F.G; S.c = c;
        Epi5 E{F.in(I_X), (bf16_t*)(ws + WS_X1B)};
        pg8::gemm_phase<Epi5, Sched5, false>(lds, 2 * D, 2 * D, S, E);
    ); SEAM(5);
    RUN(6, p6_router(F); ); SEAM(6);
    RUN(7, p7_slots(F); ); SEAM(7);
    RUN(8,
        LAS unsigned char* blk_e = lds + EPI_OFF; LAS int* tmp = (LAS int*)(lds + EPI_OFF + 1024);
        const int nblk = build_blocks(F, blk_e, tmp);
        SchedMoe S{blk_e, nblk, F.G, c, 2, (const char*)(ws + WS_A3), (const char*)(ws + WS_WGU), (const int*)(ws + WS_ROWTOK), true};
        Epi8 E{(unsigned char*)(ws + WS_PG)};
        pg8::gemm_phase<Epi8, SchedMoe, true, true>(lds, D, D, S, E);
    ); SEAM(8);
    RUN(9,
        LAS unsigned char* blk_e = lds + EPI_OFF; LAS int* tmp = (LAS int*)(lds + EPI_OFF + 1024);
        const int nblk = build_blocks(F, blk_e, tmp);
        SchedMoe S{blk_e, nblk, F.G, c, 3, (const char*)(ws + WS_PG), (const char*)(ws + WS_WD), nullptr, false};
        Epi9 E{(const int*)(ws + WS_ROWASG), (const float*)(ws + WS_ROWG), (unsigned char*)(ws + WS_Y)};
        pg8::gemm_phase<Epi9, SchedMoe, false, true>(lds, DE, DE, S, E);
    ); SEAM(9);
    RUN(10, p10_combine(F); );
#undef RUN
#undef IN
#undef SEAM
}

#ifndef MK_PER_PHASE
#define MK_PER_PHASE 0
#endif
extern "C" void kernel_launch(void* const* d_in, const int* in_sizes, int n_in, void* d_out, int out_size, void* d_ws, size_t ws_size, hipStream_t stream) {
    static int grid = 0;
    if (grid == 0) {
        if (n_in != N_IN || in_sizes[0] != M * D || out_size != M * D || ws_size < WS_END) { fprintf(stderr, "kernel_launch: unexpected shapes (n_in %d, in0 %d, out %d, ws %zu; need ws >= %zu)\n", n_in, n_in > 0 ? in_sizes[0] : -1, out_size, ws_size, (size_t)WS_END); grid = -1; return; }
        int dev = 0, cus = 0, per_cu = 0;
        if (hipGetDevice(&dev) != hipSuccess || hipDeviceGetAttribute(&cus, hipDeviceAttributeMultiprocessorCount, dev) != hipSuccess) { grid = -1; return; }
        if (hipFuncSetAttribute((const void*)mega, hipFuncAttributeMaxDynamicSharedMemorySize, LDS_BYTES) != hipSuccess) { fprintf(stderr, "kernel_launch: hipFuncSetAttribute failed\n"); grid = -1; return; }
        if (hipOccupancyMaxActiveBlocksPerMultiprocessor(&per_cu, (const void*)mega, 512, LDS_BYTES) != hipSuccess || per_cu < 1) fprintf(stderr, "kernel_launch: occupancy query says %d\n", per_cu);
        (void)hipGetLastError();
        grid = cus;
    }
    if (grid < 0) return;
    (void)hipMemsetAsync((char*)d_ws + WS_CTL, 0, CTL_ZERO_BYTES, stream);
    Args a{};
    for (int i = 0; i < 31; ++i) a.in[i] = (const float*)d_in[i];
    a.out = (float*)d_out; a.ws = (unsigned char*)d_ws; a.pad = 0;
#if MK_PER_PHASE
    for (int p = 0; p < N_PHASES; ++p) { a.ph_lo = p; a.ph_hi = p + 1; a.use_bar = 0; hipLaunchKernelGGL(mega, dim3(grid), dim3(512), LDS_BYTES, stream, a); }
#else
    a.ph_lo = 0; a.ph_hi = N_PHASES; a.use_bar = 1; hipLaunchKernelGGL(mega, dim3(grid), dim3(512), LDS_BYTES, stream, a);
#endif
}
```

```cpp
#include <hip/hip_runtime.h>
#include <cstdio>
#include <cstdint>

#define LAS __attribute__((address_space(3)))
#define GAS __attribute__((address_space(1)))
typedef unsigned short bf16_t;
typedef short bf16x8 __attribute__((ext_vector_type(8)));
typedef short s16x4 __attribute__((ext_vector_type(4)));
typedef float f32x2 __attribute__((ext_vector_type(2)));
typedef float f32x4 __attribute__((ext_vector_type(4)));
typedef float f32x16 __attribute__((ext_vector_type(16)));
typedef unsigned u32x2 __attribute__((ext_vector_type(2)));
typedef unsigned u32x4 __attribute__((ext_vector_type(4)));
typedef GAS unsigned gu32;

constexpr int NB = 8, T = 2048, D = 2048, M = NB * T;
constexpr int HD = 128;
constexpr int MEMT = 256, MROWS = NB * MEMT;
constexpr int NE = 64, TOPK = 8, DE = 512, NEX = NE + 1;
constexpr int W_IN_COLS = 10780;
constexpr int NPA = 4608, NPG = 6144, NPAD = 11008;
constexpr int LDG = 32;
constexpr float RMS_EPS = 1e-6f;
constexpr float LOG2E = 1.4426950408889634f;
constexpr float ATTN_SCALE = 0.08838834764831845f;
constexpr int CQ_NSA = 0, CK_CMP = 1024, CV_CMP = 1280, CK_SLC = 1536, CV_SLC = 1792, CK_WIN = 2048, CV_WIN = 2304;
constexpr int CQ_FOX = 2560, CK_FOX = 3072, CV_FOX = 3584, CQ_MEM = 4096;
constexpr int ASG_PER_TOK = 9;
constexpr int MAXSLOT = M * TOPK + NE * 256 + M;

constexpr size_t MiB = 1u << 20;
constexpr size_t WS_CTL = 0, CTL_ZERO_BYTES = 1 * MiB;
constexpr size_t WS_GL = 1 * MiB;
constexpr size_t WS_KVMEM = 3 * MiB;
constexpr size_t WS_KC = 7 * MiB, WS_VC = WS_KC + 512 * 1024;
constexpr size_t WS_CUM = 8 * MiB;
constexpr size_t WS_CBIAS = WS_CUM + 256 * 1024;
constexpr size_t WS_HIST = WS_CUM + 512 * 1024;
constexpr size_t WS_ASG = 9 * MiB;
constexpr size_t WS_ROWASG = 10 * MiB;
constexpr size_t WS_ROWG = 11 * MiB;
constexpr size_t WS_CNT = 12 * MiB;
constexpr size_t WS_WRT = 12 * MiB + 256 * 1024;
constexpr size_t WS_WCK = 13 * MiB, WS_WCV = 14 * MiB;
constexpr size_t WS_WOT = 16 * MiB;
constexpr size_t WS_WOUTT = 24 * MiB;
constexpr size_t WS_WD = 32 * MiB;
constexpr size_t WS_PG = WS_WD + (size_t)NEX * 2 * MiB;
constexpr size_t WS_Y = WS_PG + 192 * MiB;
constexpr size_t WS_WGU = WS_Y;
constexpr size_t WS_WINT = WS_WGU + (size_t)NEX * 4 * MiB;
constexpr size_t WS_PA = WS_WINT + 47 * MiB;
constexpr size_t WS_A3 = WS_PA + 144 * MiB;
constexpr size_t WS_WIN8 = WS_Y + 578 * MiB;
constexpr size_t WS_H8 = WS_WIN8 + 24 * MiB;
constexpr size_t WS_END = WS_H8 + 32 * MiB;
constexpr size_t WS_X1B = WS_PA + 64 * MiB;
static_assert(WS_A3 + (size_t)(M + MROWS) * D * 2 <= WS_Y + 576 * MiB, "ws map");
static_assert((size_t)MAXSLOT * DE * 2 <= 192 * MiB, "hid fits projG");
static_assert((size_t)MAXSLOT * 4 <= 1 * MiB, "row tables");

constexpr int CW_BAR = 4096;
constexpr int CW_QUEUE = 8192;

constexpr int RING_BYTES = 131072;
constexpr int LDSCTL_OFF = RING_BYTES;
constexpr int EPI_OFF = RING_BYTES + 1024;
constexpr int LDS_BYTES = RING_BYTES + 1024 + 8192 + 4096;

#define RLX_AGENT __ATOMIC_RELAXED, __HIP_MEMORY_SCOPE_AGENT
__device__ __forceinline__ unsigned cvtpk(float lo, float hi) { unsigned r; asm volatile("v_cvt_pk_bf16_f32 %0, %1, %2" : "=v"(r) : "v"(lo), "v"(hi)); return r; }
__device__ __forceinline__ float bf_lo(unsigned u) { return __uint_as_float(u << 16); }
__device__ __forceinline__ float bf_hi(unsigned u) { return __uint_as_float(u & 0xffff0000u); }
__device__ __forceinline__ float wave_sum(float v) {
#pragma unroll
    for (int o = 1; o < 64; o <<= 1) v += __shfl_xor(v, o);
    return v;
}
constexpr float WGU_SCALE = 32.f, WD_SCALE = 16.f, WIN_SCALE = 32.f;
__device__ __forceinline__ unsigned pk_fp8x4(float a, float b, float c, float d) { int w = 0; w = __builtin_amdgcn_cvt_pk_fp8_f32(a, b, w, false); w = __builtin_amdgcn_cvt_pk_fp8_f32(c, d, w, true); return (unsigned)w; }
__device__ __forceinline__ float fast_sigmoid(float x) { return __builtin_amdgcn_rcpf(1.f + __builtin_amdgcn_exp2f(-x * LOG2E)); }

#define XB_TMO      128
#define XB_XCNT(j)  (256  + 64 * (j))
#define XB_XSUB(j)  (1280 + 64 * (j))
#define XB_XGEN(j)  (2304 + 64 * (j))
#define XB_TOP      3328
#define XB_TOPGEN   3392
#define XCD_BAR_WORDS 3456
#define XB_SPIN_CAP (1u << 18)
__device__ __forceinline__ unsigned xb_ld(unsigned* p)              { return __hip_atomic_load(p, __ATOMIC_RELAXED, __HIP_MEMORY_SCOPE_AGENT); }
__device__ __forceinline__ unsigned xb_add(unsigned* p, unsigned v) { return __hip_atomic_fetch_add(p, v, __ATOMIC_RELAXED, __HIP_MEMORY_SCOPE_AGENT); }
__device__ __forceinline__ unsigned xb_xcc_id() { return (unsigned)__builtin_amdgcn_s_getreg((3 << 11) | 20) & 0xFu; }
#define XB_SPIN(cond, bar) do { unsigned _sp = 0; while (cond) { __builtin_amdgcn_s_sleep(1); \
    if ((++_sp & 255u) == 0u) { if (xb_ld(&(bar)[XB_TMO])) break; if (_sp > XB_SPIN_CAP) { atomicAdd(&(bar)[XB_TMO], 1u); break; } } } } while (0)
struct XcdBarrier { unsigned* bar; unsigned x; volatile LAS unsigned* st; };
__device__ __forceinline__ XcdBarrier xcd_barrier_post(unsigned* bar, volatile LAS unsigned* st) {
    XcdBarrier b; b.bar = bar; b.x = xb_xcc_id(); b.st = st;
    if (threadIdx.x == 0) (void)xb_add(&bar[XB_XCNT(b.x)], 1u);
    return b;
}
__device__ __forceinline__ void xcd_barrier_complete(unsigned* bar, unsigned x, unsigned& nloc, unsigned& nx) {
    const unsigned G = gridDim.x * gridDim.y * gridDim.z;
    unsigned sum, cnt, mine, sp = 0u;
    for (;;) {
        sum = 0u; cnt = 0u; mine = 0u;
#pragma unroll
        for (unsigned j = 0; j < 16; ++j) { const unsigned c = xb_ld(&bar[XB_XCNT(j)]); sum += c; cnt += (c > 0u) ? 1u : 0u; mine = (j == x) ? c : mine; }
        if (sum == G) break;
        __builtin_amdgcn_s_sleep(1);
        if ((++sp & 255u) == 0u) { if (xb_ld(&bar[XB_TMO])) break; if (sp > XB_SPIN_CAP) { atomicAdd(&bar[XB_TMO], 1u); break; } }
    }
    nloc = mine > 0u ? mine : 1u; nx = cnt > 0u ? cnt : 1u;
}
__device__ __forceinline__ void xcd_barrier(const XcdBarrier& b) {
    asm volatile("s_waitcnt vmcnt(0)" ::: "memory");
    __syncthreads();
    if (threadIdx.x == 0) {
        unsigned* bar = b.bar;
        __builtin_amdgcn_s_waitcnt(0);
        unsigned nloc = b.st[0], nx = b.st[1];
        if (nloc == 0u) { xcd_barrier_complete(bar, b.x, nloc, nx); b.st[0] = nloc; b.st[1] = nx; }
        const unsigned old = xb_add(&bar[XB_XSUB(b.x)], 1u);
        const unsigned gen = old / nloc;
        if (old + 1u == (gen + 1u) * nloc) {
            __builtin_amdgcn_fence(__ATOMIC_RELEASE, "agent");
            asm volatile("s_waitcnt vmcnt(0)" ::: "memory");
            const unsigned og = xb_add(&bar[XB_TOP], 1u);
            const unsigned tg = og / nx;
            if (og + 1u == (tg + 1u) * nx) xb_add(&bar[XB_TOPGEN], 1u);
            else XB_SPIN(xb_ld(&bar[XB_TOPGEN]) == tg, bar);
            __builtin_amdgcn_fence(__ATOMIC_ACQUIRE, "agent");
            xb_add(&bar[XB_XGEN(b.x)], 1u);
            asm volatile("s_waitcnt vmcnt(0)" ::: "memory");
        } else {
            XB_SPIN(xb_ld(&bar[XB_XGEN(b.x)]) == gen, bar);
            __builtin_amdgcn_fence(__ATOMIC_ACQUIRE, "agent");
            asm volatile("s_waitcnt vmcnt(0)" ::: "memory");
        }
    }
    __syncthreads();
}

namespace pg8 {
constexpr int BM = 256, BK = 64, HALF = 128, HTB = HALF * BK * 2, STAGE_BYTES = 8 * HTB, NXCD = 8, WGM = 8;
__host__ __device__ __forceinline__ int lds_byte(int r, int c) { const int st = (r >> 4) * 2 + (c >> 5), rr = r & 15, cc = c & 31, ob = rr * 64 + cc * 2; return st * 1024 + (ob ^ (((ob >> 9) & 1) << 5)); }
__host__ __device__ __forceinline__ void stage_rc(int b, int& R, int& C) { const int st = b / 1024, sb = b % 1024, swz = sb ^ (((sb >> 9) & 1) << 5); R = (st >> 1) * 16 + swz / 64; C = (st & 1) * 32 + (swz % 64) / 2; }
__host__ __device__ __forceinline__ int perm32(int rho) { const int n = rho >> 4, i = rho & 15; return 8 * (i >> 2) + 4 * n + (i & 3); }

template <bool FP8> struct FragSel { struct A4 { bf16x8 f[4][2]; }; struct B2 { bf16x8 f[2][2]; }; };
template <> struct FragSel<true> { typedef int v8i_ __attribute__((ext_vector_type(8))); struct A4 { v8i_ f[4]; }; struct B2 { v8i_ f[2]; }; };
struct Unit { const char* A; const char* B; const int* ridx; int nt, pm, pn, aux; };

template <class Epi, class Sched, bool GATHER, bool FP8 = false>
__device__ __forceinline__ void gemm_phase(LAS unsigned char* lds, const int lda, const int ldb, const Sched& S, const Epi& E) {
    const int tid = threadIdx.x, wid = __builtin_amdgcn_readfirstlane(tid >> 6), lane = tid & 63, wr = wid >> 2, wc = wid & 3, fr = lane & 15, fq = lane >> 4;
    unsigned voffA[2], voffB[2]; int RA[2], CA[2];
#pragma unroll
    for (int i = 0; i < 2; ++i) { int R, C; stage_rc(tid * 16 + i * 8192, R, C); const int Rb = (R & ~31) + perm32(R & 31);
        RA[i] = R; CA[i] = C; voffA[i] = (unsigned)(R * lda + 2 * C); voffB[i] = (unsigned)(Rb * ldb + 2 * C); }
    const size_t kstep = (size_t)(BK * 2);
    const size_t hstepA = (size_t)HALF * lda, hstepB = (size_t)HALF * ldb;
    const unsigned ldsw = (unsigned)wid * 1024u;
    const int aoff = lds_byte(wr * 64 + fr, fq * 8), boff = lds_byte(wc * 32 + fr, fq * 8);
#define PG8_SA(b, h) (((b) * 2 + (h)) * HTB)
#define PG8_SB(b, h) ((4 + (b) * 2 + (h)) * HTB)
#define PG8_STG(bufoff, gptr, v0, v1) do { \
        __builtin_amdgcn_global_load_lds((const unsigned*)((const char*)(gptr) + (v0)), (LAS unsigned*)(lds + (bufoff) + ldsw), 16, 0, 0); \
        __builtin_amdgcn_global_load_lds((const unsigned*)((const char*)(gptr) + (v1)), (LAS unsigned*)(lds + (bufoff) + ldsw + 8192), 16, 0, 0); } while (0)
#define PG8_STB(b, h, kp) PG8_STG(PG8_SB(b, h), (kp) + (h) * hstepB, voffB[0], voffB[1])
#define PG8_STA_CUR(b, h, kp) do { if constexpr (GATHER) PG8_STG(PG8_SA(b, h), (kp), vg[h][0], vg[h][1]); else PG8_STG(PG8_SA(b, h), (kp) + (h) * hstepA, voffA[0], voffA[1]); } while (0)
#define PG8_STA_SEL(b, h, kp) do { if constexpr (GATHER) { const unsigned s0_ = last ? nvg[h][0] : vg[h][0], s1_ = last ? nvg[h][1] : vg[h][1]; PG8_STG(PG8_SA(b, h), (kp), s0_, s1_); } \
        else PG8_STG(PG8_SA(b, h), (kp) + (h) * hstepA, voffA[0], voffA[1]); } while (0)
#define PG8_LD16(off) (*(const LAS u32x4*)(lds + (off)))
#define PG8_LDA(dst, b, h) do { _Pragma("unroll") for (int m = 0; m < 4; ++m) { if constexpr (FP8) { const u32x4 lo_ = PG8_LD16(PG8_SA(b, h) + aoff + m * 2048), hi_ = PG8_LD16(PG8_SA(b, h) + aoff + m * 2048 + 1024); \
            dst.f[m] = __builtin_bit_cast(v8i_, __builtin_shufflevector(lo_, hi_, 0, 1, 2, 3, 4, 5, 6, 7)); } \
        else { _Pragma("unroll") for (int k = 0; k < 2; ++k) dst.f[m][k] = *(const LAS bf16x8*)(lds + PG8_SA(b, h) + aoff + m * 2048 + k * 1024); } } } while (0)
#define PG8_LDB(dst, b, h) do { _Pragma("unroll") for (int n = 0; n < 2; ++n) { if constexpr (FP8) { const u32x4 lo_ = PG8_LD16(PG8_SB(b, h) + boff + n * 2048), hi_ = PG8_LD16(PG8_SB(b, h) + boff + n * 2048 + 1024); \
            dst.f[n] = __builtin_bit_cast(v8i_, __builtin_shufflevector(lo_, hi_, 0, 1, 2, 3, 4, 5, 6, 7)); } \
        else { _Pragma("unroll") for (int k = 0; k < 2; ++k) dst.f[n][k] = *(const LAS bf16x8*)(lds + PG8_SB(b, h) + boff + n * 2048 + k * 1024); } } } while (0)
#define PG8_MMA(ai, bj, At, Bt) do { __builtin_amdgcn_s_setprio(1); _Pragma("unroll") for (int m = 0; m < 4; ++m) _Pragma("unroll") for (int n = 0; n < 2; ++n) { \
        if constexpr (FP8) asm volatile("v_mfma_scale_f32_16x16x128_f8f6f4 %0, %1, %2, %0, %3, %3 op_sel_hi:[0,0,0]" : "+v"(acc[ai][bj][m][n]) : "v"(Bt.f[n]), "v"(At.f[m]), "v"(fp8_one)); \
        else { _Pragma("unroll") for (int k = 0; k < 2; ++k) acc[ai][bj][m][n] = __builtin_amdgcn_mfma_f32_16x16x32_bf16(Bt.f[n][k], At.f[m][k], acc[ai][bj][m][n], 0, 0, 0); } } \
        __builtin_amdgcn_s_setprio(0); } while (0)
#define PG8_WAIT_V(n) asm volatile("s_waitcnt vmcnt(" #n ")" ::: "memory")
#define PG8_WAIT_L(n) asm volatile("s_waitcnt lgkmcnt(" #n ")" ::: "memory")
#define PG8_BAR __builtin_amdgcn_s_barrier()
#define PG8_SCHED __builtin_amdgcn_sched_barrier(0)
#define PG8_LOADIDX(dst, u) do { if constexpr (GATHER) { _Pragma("unroll") for (int h = 0; h < 2; ++h) _Pragma("unroll") for (int i = 0; i < 2; ++i) \
        dst[h][i] = (unsigned)(u).ridx[h * HALF + RA[i]] * (unsigned)lda + (unsigned)(CA[i] * 2); } } while (0)
    Unit cur, nxt; int ui = 0;
    if (!S.next(0, cur)) return;
#define PG8_PIN_ACC() do { _Pragma("unroll") for (int a_ = 0; a_ < 2; ++a_) _Pragma("unroll") for (int b_ = 0; b_ < 2; ++b_) \
        asm volatile("" : "+v"(acc[a_][b_][0][0]), "+v"(acc[a_][b_][0][1]), "+v"(acc[a_][b_][1][0]), "+v"(acc[a_][b_][1][1]), "+v"(acc[a_][b_][2][0]), "+v"(acc[a_][b_][2][1]), "+v"(acc[a_][b_][3][0]), "+v"(acc[a_][b_][3][1])); } while (0)

    f32x4 acc[2][2][4][2];
    E.init(acc, cur, wr, wc, fr, fq);
    typedef int v8i_ __attribute__((ext_vector_type(8)));
    typedef typename pg8::FragSel<FP8>::A4 FragA; typedef typename pg8::FragSel<FP8>::B2 FragB;
    FragA At; FragB B0, B1;
    int fp8_one = 0x7f7f7f7f; if constexpr (FP8) asm volatile("" : "+v"(fp8_one));
    unsigned vg[2][2] = {{0u, 0u}, {0u, 0u}}, nvg[2][2] = {{0u, 0u}, {0u, 0u}};
    const char* cA = cur.A; const char* cB = cur.B;
    PG8_LOADIDX(vg, cur);
    { const bool last = false; (void)last;
      PG8_STB(0, 0, cB); PG8_STB(0, 1, cB); PG8_STA_CUR(0, 0, cA); PG8_STA_CUR(0, 1, cA);
      if (wr == 1) PG8_BAR;
      PG8_WAIT_V(2); PG8_BAR;
      PG8_STB(1, 0, cB + kstep); PG8_STA_CUR(1, 0, cA + kstep); PG8_STB(1, 1, cB + kstep);
      PG8_WAIT_V(6); PG8_BAR; }
    if constexpr (Epi::INIT_LOADS) PG8_PIN_ACC();
    for (;;) {
        const bool has_next = S.next(ui + 1, nxt);
        const char* nA = has_next ? nxt.A : cA; const char* nB = has_next ? nxt.B : cB;
        if constexpr (GATHER) { if (has_next) { PG8_LOADIDX(nvg, nxt); } else { nvg[0][0] = vg[0][0]; nvg[0][1] = vg[0][1]; nvg[1][0] = vg[1][0]; nvg[1][1] = vg[1][1]; } }
        const int nt = cur.nt;
        for (int t = 0; t < nt; t += 2) {
            const bool last = (t == nt - 2);
            const char* a1 = cA + (size_t)(t + 1) * kstep;
            const char* a2 = last ? nA : cA + (size_t)(t + 2) * kstep; const char* b2 = last ? nB : cB + (size_t)(t + 2) * kstep;
            const char* a3 = a2 + kstep; const char* b3 = b2 + kstep;
            PG8_LDB(B0, 0, 0); PG8_LDB(B1, 0, 1); PG8_SCHED; PG8_LDA(At, 0, 0); PG8_STA_CUR(1, 1, a1);
            PG8_WAIT_V(8); PG8_WAIT_L(0); PG8_BAR; PG8_MMA(0, 0, At, B0); PG8_MMA(0, 1, At, B1); PG8_BAR; PG8_SCHED;
            PG8_LDA(At, 0, 1); PG8_STB(0, 0, b2); PG8_STB(0, 1, b2); PG8_STA_SEL(0, 0, a2);
            PG8_WAIT_V(8); PG8_WAIT_L(0); PG8_BAR; PG8_MMA(1, 0, At, B0); PG8_MMA(1, 1, At, B1); PG8_BAR; PG8_SCHED;
            PG8_LDB(B0, 1, 0); PG8_LDB(B1, 1, 1); PG8_SCHED; PG8_LDA(At, 1, 0); PG8_STA_SEL(0, 1, a2);
            PG8_WAIT_V(8); PG8_WAIT_L(0); PG8_BAR; PG8_MMA(0, 0, At, B0); PG8_MMA(0, 1, At, B1); PG8_BAR; PG8_SCHED;
            PG8_LDA(At, 1, 1); PG8_STB(1, 0, b3); PG8_STB(1, 1, b3); PG8_STA_SEL(1, 0, a3);
            PG8_WAIT_V(8); PG8_WAIT_L(0); PG8_BAR; PG8_MMA(1, 0, At, B0); PG8_MMA(1, 1, At, B1); PG8_BAR; PG8_SCHED;
        }
        if (wr == 0) PG8_BAR;
        if constexpr (FP8) { asm volatile("s_nop 15\n\ts_nop 15\n\ts_nop 15" ::: "memory"); PG8_PIN_ACC(); }
        E(acc, cur, wr, wc, fr, fq);
        if (!has_next) break;
        E.init(acc, nxt, wr, wc, fr, fq);
        if constexpr (Epi::INIT_LOADS) PG8_PIN_ACC();
        cur = nxt; cA = nA; cB = nB; ++ui;
        if constexpr (GATHER) { vg[0][0] = nvg[0][0]; vg[0][1] = nvg[0][1]; vg[1][0] = nvg[1][0]; vg[1][1] = nvg[1][1]; }
        if (wr == 1) PG8_BAR;
    }
    PG8_WAIT_V(0);
    PG8_BAR;
#undef PG8_SA
#undef PG8_SB
#undef PG8_STG
#undef PG8_STB
#undef PG8_STA_CUR
#undef PG8_STA_SEL
#undef PG8_LDA
#undef PG8_LD16
#undef PG8_LDB
#undef PG8_MMA
#undef PG8_WAIT_V
#undef PG8_WAIT_L
#undef PG8_BAR
#undef PG8_SCHED
#undef PG8_LOADIDX
#undef PG8_PIN_ACC
}
}

#define EPI_ZERO_INIT static constexpr bool INIT_LOADS = false; __device__ __forceinline__ void init(f32x4 (&acc)[2][2][4][2], const pg8::Unit&, int, int, int, int) const { \
        _Pragma("unroll") for (int a = 0; a < 2; ++a) _Pragma("unroll") for (int b = 0; b < 2; ++b) _Pragma("unroll") for (int m = 0; m < 4; ++m) _Pragma("unroll") for (int n = 0; n < 2; ++n) acc[a][b][m][n] = (f32x4){0.f, 0.f, 0.f, 0.f}; }
constexpr size_t WS_ROWTOK = 15 * MiB;
struct TileOrder {
    int nM, nN, nwg;
    __device__ __forceinline__ void init(int nM_, int nN_) { nM = nM_; nN = nN_; nwg = nM_ * nN_; }
    __device__ __forceinline__ void decode(int L, int& pm, int& pn) const {
        int wgid = L; { const int q = nwg / pg8::NXCD, r = nwg % pg8::NXCD, xcd = wgid % pg8::NXCD, off = wgid / pg8::NXCD; wgid = (xcd < r ? xcd * (q + 1) : r * (q + 1) + (xcd - r) * q) + off; }
        const int nig = pg8::WGM * nN, gid = wgid / nig, fm = gid * pg8::WGM, gsz = (nM - fm) < pg8::WGM ? (nM - fm) : pg8::WGM;
        pm = fm + ((wgid % nig) % gsz); pn = (wgid % nig) / gsz;
    }
};
#ifndef P1_FP8_MASK
#define P1_FP8_MASK 0x3FFFFu
#endif
constexpr unsigned FP8M = P1_FP8_MASK & 0x3ffffu;
constexpr int NF8 = __builtin_popcount(FP8M), NB16 = 18 - NF8;
__device__ __forceinline__ int nth_set(unsigned m, int n) { for (int i = 0; i < n; ++i) m &= m - 1; return __builtin_ctz(m); }
struct Sched1 {
    TileOrder o; const char* A; const char* Bt; int G, c, fp8;
    __device__ __forceinline__ bool next(int i, pg8::Unit& u) const {
        const int L = i * G + c; int pm, pn;
        if (fp8) { constexpr int NT8 = 64 * (24 + NF8), NBU = 64 * NB16 + 32;
            int L8 = L;
            if (NBU < G) { const int RB = NT8 / G, rem = NT8 - RB * G, nfree = G - NBU;
                if (c < NBU) { if (i >= RB - 1) return false; }
                else if (i >= RB) { const int e = (i - RB) * nfree + (c - NBU); if (e >= NBU + rem) return false; L8 = e < NBU ? (RB - 1) * G + e : RB * G + (e - NBU); } }
            if (L8 >= NT8) return false; o.decode(L8, pm, pn);
            u.A = A + (size_t)pm * 256 * D; u.B = Bt + (size_t)pn * 256 * D; u.nt = D / 128; pn = pn < 24 ? pn + 18 : nth_set(FP8M, pn - 24); u.aux = 1; }
        else { if (L < 64 * NB16) { o.decode(L, pm, pn); pn = nth_set(~FP8M & 0x3ffffu, pn); } else if (L < 64 * NB16 + 32) { const int r = L - 64 * NB16; pm = 64 + (r >> 2); pn = 43 + (r & 3); } else return false;
            u.A = A + (size_t)pm * 256 * D * 2; u.B = Bt + (size_t)pn * 256 * D * 2; u.nt = D / 64; u.aux = 0; }
        u.ridx = nullptr; u.pm = pm; u.pn = pn; return true;
    }
};
struct Epi1 {
    EPI_ZERO_INIT
    bf16_t* PA; unsigned char* PG8; float* GL; bf16_t* KVM;
    __device__ __forceinline__ void operator()(const f32x4 (&acc)[2][2][4][2], const pg8::Unit& u, int wr, int wc, int fr, int fq) const {
        const int pn = u.pn; int row0 = u.pm * 256 + wr * 64 + fr;
        if (pn == 42) {
            if (wc == 0) {
#pragma unroll
                for (int ai = 0; ai < 2; ++ai)
#pragma unroll
                    for (int m = 0; m < 4; ++m) { float* p = GL + (size_t)(row0 + ai * 128 + m * 16) * LDG + 8 * fq; *(f32x4*)p = acc[ai][0][m][0]; *(f32x4*)(p + 4) = acc[ai][0][m][1]; }
            }
            return;
        }
        if (pn >= 18 && pn < 42) {
            unsigned char* gb = PG8 + (pn - 18) * 256 + wc * 32 + 8 * fq;
#pragma unroll
            for (int ai = 0; ai < 2; ++ai)
#pragma unroll
                for (int m = 0; m < 4; ++m) { unsigned char* rowp = gb + (size_t)(row0 + ai * 128 + m * 16) * NPG;
#pragma unroll
                    for (int bj = 0; bj < 2; ++bj) { const f32x4 v0 = acc[ai][bj][m][0] * (1.f / WIN_SCALE), v1 = acc[ai][bj][m][1] * (1.f / WIN_SCALE); unsigned w0 = 0u, w1 = 0u;
                        w0 = __builtin_amdgcn_cvt_pk_u8_f32(fast_sigmoid(v0[0]) * 255.f, 0, w0); w0 = __builtin_amdgcn_cvt_pk_u8_f32(fast_sigmoid(v0[1]) * 255.f, 1, w0);
                        w0 = __builtin_amdgcn_cvt_pk_u8_f32(fast_sigmoid(v0[2]) * 255.f, 2, w0); w0 = __builtin_amdgcn_cvt_pk_u8_f32(fast_sigmoid(v0[3]) * 255.f, 3, w0);
                        w1 = __builtin_amdgcn_cvt_pk_u8_f32(fast_sigmoid(v1[0]) * 255.f, 0, w1); w1 = __builtin_amdgcn_cvt_pk_u8_f32(fast_sigmoid(v1[1]) * 255.f, 1, w1);
                        w1 = __builtin_amdgcn_cvt_pk_u8_f32(fast_sigmoid(v1[2]) * 255.f, 2, w1); w1 = __builtin_amdgcn_cvt_pk_u8_f32(fast_sigmoid(v1[3]) * 255.f, 3, w1);
                        *(u32x2*)(rowp + bj * 128) = (u32x2){w0, w1}; } }
            return;
        }
        bf16_t* base; int ld;
        if (pn < 18) { base = PA + pn * 256; ld = NPA; }
        else { base = KVM + (pn - 43) * 256; ld = 1024; row0 -= M; }
        base += wc * 32 + 8 * fq;
        const float sc = u.aux ? 1.f / WIN_SCALE : 1.f;
#pragma unroll
        for (int ai = 0; ai < 2; ++ai)
#pragma unroll
            for (int m = 0; m < 4; ++m) { bf16_t* rowp = base + (size_t)(row0 + ai * 128 + m * 16) * ld;
#pragma unroll
                for (int bj = 0; bj < 2; ++bj) { const f32x4 v0 = acc[ai][bj][m][0] * sc, v1 = acc[ai][bj][m][1] * sc;
                    u32x4 w; w.x = cvtpk(v0[0], v0[1]); w.y = cvtpk(v0[2], v0[3]); w.z = cvtpk(v1[0], v1[1]); w.w = cvtpk(v1[2], v1[3]);
                    *(u32x4*)(rowp + bj * 128) = w; } }
    }
};
struct Sched4 {
    TileOrder o; const char* A; const char* Bt; int G, c;
    __device__ __forceinline__ bool next(int i, pg8::Unit& u) const {
        const int it = i / 3, br = i - it * 3, L = it * G + c; if (L >= 64 * 8) return false;
        int pm, pn; o.decode(L, pm, pn);
        const int koff = br == 0 ? 0 : (br == 1 ? 1024 : 1536);
        u.A = A + ((size_t)pm * 256 * D + koff) * 2; u.B = Bt + ((size_t)pn * 256 * D + koff) * 2; u.ridx = nullptr; u.nt = br == 0 ? 16 : 8; u.pm = pm; u.pn = pn; u.aux = br; return true;
    }
};
struct Epi4 {
    EPI_ZERO_INIT
    const unsigned char* PG8; bf16_t* Z;
    __device__ __forceinline__ void operator()(const f32x4 (&acc)[2][2][4][2], const pg8::Unit& u, int wr, int wc, int fr, int fq) const {
        const int row0 = u.pm * 256 + wr * 64 + fr, col0 = u.pn * 256 + wc * 32 + 8 * fq, br = u.aux;
#pragma unroll
        for (int ai = 0; ai < 2; ++ai) {
            u32x2 gv[4][2]; u32x4 zv[4][2];
#pragma unroll
            for (int m = 0; m < 4; ++m) { const size_t row = (size_t)(row0 + ai * 128 + m * 16);
#pragma unroll
                for (int bj = 0; bj < 2; ++bj) { const int col = col0 + bj * 128; gv[m][bj] = *(const u32x2*)(PG8 + row * NPG + br * D + col);
                    if (br > 0) zv[m][bj] = *(const u32x4*)(Z + row * D + col); else zv[m][bj] = (u32x4){0u, 0u, 0u, 0u}; } }
#pragma unroll
            for (int m = 0; m < 4; ++m) { const size_t row = (size_t)(row0 + ai * 128 + m * 16);
#pragma unroll
                for (int bj = 0; bj < 2; ++bj) { const int col = col0 + bj * 128; const u32x2 g = gv[m][bj]; const u32x4 z = zv[m][bj]; const float gs = 1.f / 255.f;
                    f32x4 v0 = acc[ai][bj][m][0] * gs, v1 = acc[ai][bj][m][1] * gs;
                    v0[0] = v0[0] * (float)(g.x & 0xffu) + bf_lo(z.x); v0[1] = v0[1] * (float)((g.x >> 8) & 0xffu) + bf_hi(z.x); v0[2] = v0[2] * (float)((g.x >> 16) & 0xffu) + bf_lo(z.y); v0[3] = v0[3] * (float)(g.x >> 24) + bf_hi(z.y);
                    v1[0] = v1[0] * (float)(g.y & 0xffu) + bf_lo(z.z); v1[1] = v1[1] * (float)((g.y >> 8) & 0xffu) + bf_hi(z.z); v1[2] = v1[2] * (float)((g.y >> 16) & 0xffu) + bf_lo(z.w); v1[3] = v1[3] * (float)(g.y >> 24) + bf_hi(z.w);
                    u32x4 w; w.x = cvtpk(v0[0], v0[1]); w.y = cvtpk(v0[2], v0[3]); w.z = cvtpk(v1[0], v1[1]); w.w = cvtpk(v1[2], v1[3]);
                    *(u32x4*)(Z + row * D + col) = w; } }
        }
    }
};
struct Sched5 {
    TileOrder o; const char* A; const char* Bt; int G, c;
    __device__ __forceinline__ bool next(int i, pg8::Unit& u) const {
        const int L = i * G + c; if (L >= 64 * 8) return false;
        int pm, pn; o.decode(L, pm, pn);
        u.A = A + (size_t)pm * 256 * D * 2; u.B = Bt + (size_t)pn * 256 * D * 2; u.ridx = nullptr; u.nt = D / 64; u.pm = pm; u.pn = pn; u.aux = 0; return true;
    }
};
struct Epi5 {
    static constexpr bool INIT_LOADS = true;
    const float* X; bf16_t* O;
    __device__ __forceinline__ void init(f32x4 (&acc)[2][2][4][2], const pg8::Unit& u, int wr, int wc, int fr, int fq) const {
        const int row0 = u.pm * 256 + wr * 64 + fr, col0 = u.pn * 256 + wc * 32 + 8 * fq;
#pragma unroll
        for (int ai = 0; ai < 2; ++ai)
#pragma unroll
            for (int m = 0; m < 4; ++m) { const size_t off = (size_t)(row0 + ai * 128 + m * 16) * D + col0;
#pragma unroll
                for (int bj = 0; bj < 2; ++bj) { acc[ai][bj][m][0] = *(const f32x4*)(X + off + bj * 128); acc[ai][bj][m][1] = *(const f32x4*)(X + off + bj * 128 + 4); } }
    }
    __device__ __forceinline__ void operator()(const f32x4 (&acc)[2][2][4][2], const pg8::Unit& u, int wr, int wc, int fr, int fq) const {
        const int row0 = u.pm * 256 + wr * 64 + fr, col0 = u.pn * 256 + wc * 32 + 8 * fq;
#pragma unroll
        for (int ai = 0; ai < 2; ++ai)
#pragma unroll
            for (int m = 0; m < 4; ++m) { const size_t off = (size_t)(row0 + ai * 128 + m * 16) * D + col0;
#pragma unroll
                for (int bj = 0; bj < 2; ++bj) { const f32x4 v0 = acc[ai][bj][m][0], v1 = acc[ai][bj][m][1];
                    u32x4 w; w.x = cvtpk(v0[0], v0[1]); w.y = cvtpk(v0[2], v0[3]); w.z = cvtpk(v1[0], v1[1]); w.w = cvtpk(v1[2], v1[3]);
                    *(u32x4*)(O + off + bj * 128) = w; } }
    }
};
struct SchedMoe {
    const LAS unsigned char* blk_e; int nblk, G, c, npn_shift;
    const char* A; const char* W; const int* rowtok; bool up;
    __device__ __forceinline__ bool next(int i, pg8::Unit& u) const {
        int L; if (G == 256) L = ((i * 8 + (c & 7)) * 32 + (c >> 3)); else L = i * G + c;
        const int blk = L >> npn_shift, pn = L & ((1 << npn_shift) - 1);
        if (blk >= nblk) { if (G != 256) return false; return false; }
        const int e = blk_e[blk];
        if (up) { u.A = A; u.ridx = rowtok + blk * 256; u.B = W + ((size_t)e * 1024 + pn * 256) * D; u.nt = D / 128; }
        else    { u.A = A + (size_t)blk * 256 * DE; u.ridx = nullptr; u.B = W + ((size_t)e * D + pn * 256) * DE; u.nt = DE / 128; }
        u.pm = blk; u.pn = pn; u.aux = e; return true;
    }
};
struct Epi8 {  EPI_ZERO_INIT
    unsigned char* HID;
    __device__ __forceinline__ void operator()(const f32x4 (&acc)[2][2][4][2], const pg8::Unit& u, int wr, int wc, int fr, int fq) const {
        const int row0 = u.pm * 256 + wr * 64 + fr, col0 = u.pn * 128 + wc * 32 + 8 * fq; const float rs = 1.f / WGU_SCALE;
#pragma unroll
        for (int ai = 0; ai < 2; ++ai)
#pragma unroll
            for (int m = 0; m < 4; ++m) { float h[8];
#pragma unroll
                for (int e = 0; e < 4; ++e) { const float g0 = acc[ai][0][m][0][e] * rs, g1 = acc[ai][0][m][1][e] * rs;
                    h[e] = __builtin_amdgcn_fmed3f(g0 * fast_sigmoid(g0) * (acc[ai][1][m][0][e] * rs), -440.f, 440.f); h[4 + e] = __builtin_amdgcn_fmed3f(g1 * fast_sigmoid(g1) * (acc[ai][1][m][1][e] * rs), -440.f, 440.f); }
                *(u32x2*)(HID + (size_t)(row0 + ai * 128 + m * 16) * DE + col0) = (u32x2){pk_fp8x4(h[0], h[1], h[2], h[3]), pk_fp8x4(h[4], h[5], h[6], h[7])}; }
    }
};
constexpr float Y_SCALE = 16.f;
struct Epi9 {  EPI_ZERO_INIT
    const int* rowasg; const float* rowg; unsigned char* Y;
    __device__ __forceinline__ void operator()(const f32x4 (&acc)[2][2][4][2], const pg8::Unit& u, int wr, int wc, int fr, int fq) const {
        const int row0 = u.pm * 256 + wr * 64 + fr, col0 = u.pn * 256 + wc * 32 + 8 * fq;
        int asg[2][4]; float g[2][4];
#pragma unroll
        for (int ai = 0; ai < 2; ++ai)
#pragma unroll
            for (int m = 0; m < 4; ++m) { const int slot = row0 + ai * 128 + m * 16; asg[ai][m] = rowasg[slot]; g[ai][m] = rowg[slot] * (Y_SCALE / WD_SCALE); }
#pragma unroll
        for (int ai = 0; ai < 2; ++ai)
#pragma unroll
            for (int m = 0; m < 4; ++m) {
                if (asg[ai][m] >= 0) { unsigned char* yp = Y + (size_t)asg[ai][m] * D + col0; const float gg = g[ai][m];
#pragma unroll
                    for (int bj = 0; bj < 2; ++bj) { f32x4 v0 = acc[ai][bj][m][0] * gg, v1 = acc[ai][bj][m][1] * gg;
#pragma unroll
                        for (int e = 0; e < 4; ++e) { v0[e] = __builtin_amdgcn_fmed3f(v0[e], -440.f, 440.f); v1[e] = __builtin_amdgcn_fmed3f(v1[e], -440.f, 440.f); }
                        int w0 = 0, w1 = 0;
                        w0 = __builtin_amdgcn_cvt_pk_fp8_f32(v0[0], v0[1], w0, false); w0 = __builtin_amdgcn_cvt_pk_fp8_f32(v0[2], v0[3], w0, true);
                        w1 = __builtin_amdgcn_cvt_pk_fp8_f32(v1[0], v1[1], w1, false); w1 = __builtin_amdgcn_cvt_pk_fp8_f32(v1[2], v1[3], w1, true);
                        *(u32x2*)(yp + bj * 128) = (u32x2){(unsigned)w0, (unsigned)w1}; } } }
    }
};

struct Frame {
    LAS unsigned char* lds; int tid, lane, wave, G, gw, NGW;
    float* out; unsigned char* ws;
    __device__ __forceinline__ const float* in(int i) const { return ((const float* const __attribute__((address_space(4)))*)__builtin_amdgcn_kernarg_segment_ptr())[i]; }
};
#define LDS_WAIT() asm volatile("s_waitcnt lgkmcnt(0)" ::: "memory")
template <class SrcCol, class DstRow>
__device__ __forceinline__ void tr_item(const float* W, size_t ldw, int k0, int n0, const SrcCol& sc, bf16_t* WT, size_t ldt, int kd0, const DstRow& dr, LAS float* scr, int lane) {
    const int c = sc(n0 + (lane & 31));
#pragma unroll 8
    for (int i = 0; i < 32; ++i) { const int kk = 2 * i + (lane >> 5); scr[kk * 33 + (lane & 31)] = c >= 0 ? W[(size_t)(k0 + kk) * ldw + c] : 0.f; }
    LDS_WAIT(); asm volatile("" ::: "memory");
    const int c8 = lane & 7;
#pragma unroll
    for (int j = 0; j < 4; ++j) { const int n = (lane >> 3) + 8 * j; const LAS float* s = scr + (8 * c8) * 33 + n;
        u32x4 o; o.x = cvtpk(s[0 * 33], s[1 * 33]); o.y = cvtpk(s[2 * 33], s[3 * 33]); o.z = cvtpk(s[4 * 33], s[5 * 33]); o.w = cvtpk(s[6 * 33], s[7 * 33]);
        *(u32x4*)(WT + (size_t)dr(n0 + n) * ldt + kd0 + k0 + 8 * c8) = o; }
    LDS_WAIT(); asm volatile("" ::: "memory");
}
struct IdCol { __device__ __forceinline__ int operator()(int n) const { return n; } };
struct OffRow { int off; __device__ __forceinline__ int operator()(int n) const { return off + n; } };
struct WinCol {
    __device__ __forceinline__ int operator()(int n) const {
        if (n < 2560) return n; if (n < 4096) return 2584 + (n - 2560); if (n < 4608) return 4124 + (n - 4096); if (n < 10752) return 4636 + (n - 4608);
        if (n < 10776) return 2560 + (n - 10752); if (n < 10780) return 4120 + (n - 10776); return -1; }
};
struct GuRow { int up; __device__ __forceinline__ int operator()(int j) const { return (j >> 7) * 256 + up * 128 + (j & 127); } };
__device__ __forceinline__ void rms_row_bf16(const float* xrow, const float* gain, bf16_t* orow, int lane) {
    f32x4 v[8]; float s = 0.f;
#pragma unroll
    for (int j = 0; j < 8; ++j) { v[j] = *(const f32x4*)(xrow + 4 * lane + 256 * j); s += (v[j].x * v[j].x + v[j].y * v[j].y) + (v[j].z * v[j].z + v[j].w * v[j].w); }
    const float rstd = __builtin_amdgcn_rsqf(wave_sum(s) * (1.f / D) + RMS_EPS);
#pragma unroll
    for (int j = 0; j < 8; ++j) { const f32x4 g = *(const f32x4*)(gain + 4 * lane + 256 * j);
        u32x2 o; o.x = cvtpk(v[j].x * rstd * g.x, v[j].y * rstd * g.y); o.y = cvtpk(v[j].z * rstd * g.z, v[j].w * rstd * g.w);
        *(u32x2*)(orow + 4 * lane + 256 * j) = o; }
}
__device__ __forceinline__ void rms_row_both(const float* xrow, const float* gain, bf16_t* orow, unsigned char* orow8, int lane) {
    f32x4 v[8]; float s = 0.f;
#pragma unroll
    for (int j = 0; j < 8; ++j) { v[j] = *(const f32x4*)(xrow + 4 * lane + 256 * j); s += (v[j].x * v[j].x + v[j].y * v[j].y) + (v[j].z * v[j].z + v[j].w * v[j].w); }
    const float rstd = __builtin_amdgcn_rsqf(wave_sum(s) * (1.f / D) + RMS_EPS);
#pragma unroll
    for (int j = 0; j < 8; ++j) { const f32x4 g = *(const f32x4*)(gain + 4 * lane + 256 * j); const float a = v[j].x * rstd * g.x, b = v[j].y * rstd * g.y, c = v[j].z * rstd * g.z, d = v[j].w * rstd * g.w;
        u32x2 o; o.x = cvtpk(a, b); o.y = cvtpk(c, d); *(u32x2*)(orow + 4 * lane + 256 * j) = o;
        *(unsigned*)(orow8 + 4 * lane + 256 * j) = pk_fp8x4(a, b, c, d); }
}
__device__ __forceinline__ float dot2c_bf16(float acc, unsigned a, unsigned b) { asm("v_dot2c_f32_bf16 %0, %1, %2" : "+v"(acc) : "v"(a), "v"(b)); return acc; }
template <bool WRITE_BF16>
__device__ __forceinline__ void rms_row_logits(const float* xrow, const float* gain, bf16_t* orow, unsigned char* orow8, float* glrow, const LAS unsigned char* WL, int lane) {
    f32x4 v[8]; float s = 0.f;
#pragma unroll
    for (int j = 0; j < 8; ++j) { v[j] = *(const f32x4*)(xrow + 4 * lane + 256 * j); s += (v[j].x * v[j].x + v[j].y * v[j].y) + (v[j].z * v[j].z + v[j].w * v[j].w); }
    const float rstd = __builtin_amdgcn_rsqf(wave_sum(s) * (1.f / D) + RMS_EPS);
    u32x2 hb[8];
#pragma unroll
    for (int j = 0; j < 8; ++j) { const f32x4 g = *(const f32x4*)(gain + 4 * lane + 256 * j); const float a = v[j].x * rstd * g.x, b = v[j].y * rstd * g.y, c = v[j].z * rstd * g.z, d = v[j].w * rstd * g.w;
        hb[j].x = cvtpk(a, b); hb[j].y = cvtpk(c, d); if (WRITE_BF16) *(u32x2*)(orow + 4 * lane + 256 * j) = hb[j];
        *(unsigned*)(orow8 + 4 * lane + 256 * j) = pk_fp8x4(a, b, c, d); }
    float lg[32];
#pragma unroll
    for (int c = 0; c < 32; ++c) lg[c] = 0.f;
#pragma unroll
    for (int j = 0; j < 8; ++j) {
        u32x2 w[28];
#pragma unroll
        for (int c = 0; c < 28; ++c) w[c] = *(const LAS u32x2*)(WL + (size_t)(c * 2048 + 4 * lane + 256 * j) * 2);
        asm volatile("s_waitcnt lgkmcnt(0)" ::: "memory"); __builtin_amdgcn_sched_barrier(0);
#pragma unroll
        for (int c = 0; c < 28; ++c) { lg[c] = dot2c_bf16(lg[c], hb[j].x, w[c].x); lg[c] = dot2c_bf16(lg[c], hb[j].y, w[c].y); }
        __builtin_amdgcn_sched_barrier(0); }
    float r1[16];
#pragma unroll
    for (int i = 0; i < 16; ++i) { const auto sw = __builtin_amdgcn_permlane32_swap(__float_as_uint(lg[i]), __float_as_uint(lg[i + 16]), false, false); r1[i] = __uint_as_float(sw[0]) + __uint_as_float(sw[1]); }
    float r2[8];
#pragma unroll
    for (int i = 0; i < 8; ++i) { const auto sw = __builtin_amdgcn_permlane16_swap(__float_as_uint(r1[i]), __float_as_uint(r1[i + 8]), false, false); r2[i] = __uint_as_float(sw[0]) + __uint_as_float(sw[1]); }
#pragma unroll
    for (int i = 0; i < 8; ++i) {
        float t = r2[i];
        t += __builtin_bit_cast(float, __builtin_amdgcn_update_dpp(0, __builtin_bit_cast(int, t), 0x128, 0xF, 0xF, false));
        t += __builtin_bit_cast(float, __builtin_amdgcn_update_dpp(0, __builtin_bit_cast(int, t), 0x124, 0xF, 0xF, false));
        t += __builtin_bit_cast(float, __builtin_amdgcn_update_dpp(0, __builtin_bit_cast(int, t), 0x122, 0xF, 0xF, false));
        t += __builtin_bit_cast(float, __builtin_amdgcn_update_dpp(0, __builtin_bit_cast(int, t), 0x121, 0xF, 0xF, false));
        r2[i] = t; }
    if ((lane & 15) == 0) { float* p = glrow + 8 * (lane >> 4); *(f32x4*)p = (f32x4){r2[0], r2[1], r2[2], r2[3]}; *(f32x4*)(p + 4) = (f32x4){r2[4], r2[5], r2[6], r2[7]}; }
}
enum { I_X = 0, I_MEM, I_NORM_ATTN_G, I_W_IN, I_PE_K, I_W_CK, I_PE_V, I_W_CV, I_NSA_Q_G, I_NSA_K_G, I_REL_BIAS, I_FOX_B_F, I_FOX_Q_G, I_FOX_K_G, I_NORM_MEM_G, I_W_MEM_KV,
       I_MEM_Q_G, I_MEM_K_G, I_W_O_NSA, I_W_O_FOX, I_W_O_MEM, I_W_OUT, I_NORM_FFN_G, I_W_ROUTER, I_ROUTER_BIAS, I_WE_GATE, I_WE_UP, I_WE_DOWN, I_WS_GATE, I_WS_UP, I_WS_DOWN, N_IN };

struct TrDesc { const float* src; bf16_t* dst; unsigned ldw, ldt; };
__device__ __forceinline__ TrDesc tr_decode(const Frame& F, int t) {
    unsigned char* ws = F.ws; TrDesc d;
    bf16_t* WinT = (bf16_t*)(ws + WS_WINT); bf16_t* WkvT = WinT + (size_t)NPAD * D; bf16_t* WoT = (bf16_t*)(ws + WS_WOT);
    bf16_t* Wgu = (bf16_t*)(ws + WS_WGU); bf16_t* Wd = (bf16_t*)(ws + WS_WD);
    constexpr int T0 = 16 * 2 * NB16, T1 = T0 + 128, T2 = T1 + 128, T3 = T2 + 64, T4 = T3 + 64, T5 = T4 + 256, T6 = T5 + 32, T7 = T6 + 32, T8 = T7 + 65 * 64, T9 = T8 + 65 * 64;
    if (t < T0) { constexpr int NU = NB16 ? 2 * NB16 : 1; const int kt = t / NU, nt = t - kt * NU, n0 = 256 * nth_set(~FP8M & 0x3ffffu, nt >> 1) + 128 * (nt & 1); const int sc = WinCol{}(n0);
        d.src = F.in(I_W_IN) + (size_t)(128 * kt) * W_IN_COLS + sc; d.ldw = W_IN_COLS; d.dst = WinT + (size_t)n0 * D + 128 * kt; d.ldt = D; }
    else if (t < T1) { const int r = t - T0, kt = r >> 3, nt = r & 7; d.src = F.in(I_W_MEM_KV) + (size_t)(128 * kt) * 1024 + 128 * nt; d.ldw = 1024; d.dst = WkvT + (size_t)(128 * nt) * D + 128 * kt; d.ldt = D; }
    else if (t < T2) { const int r = t - T1, kt = r >> 4, nt = r & 15; d.src = F.in(I_W_O_NSA) + (size_t)(128 * kt) * D + 128 * nt; d.ldw = D; d.dst = WoT + (size_t)(128 * nt) * D + 128 * kt; d.ldt = D; }
    else if (t < T4) { const int mm = t >= T3, r = t - (mm ? T3 : T2), kt = r >> 4, nt = r & 15; d.src = F.in(mm ? I_W_O_MEM : I_W_O_FOX) + (size_t)(128 * kt) * D + 128 * nt; d.ldw = D; d.dst = WoT + (size_t)(128 * nt) * D + (mm ? 1536 : 1024) + 128 * kt; d.ldt = D; }
    else if (t < T5) { const int r = t - T4, kt = r >> 4, nt = r & 15; d.src = F.in(I_W_OUT) + (size_t)(128 * kt) * D + 128 * nt; d.ldw = D; d.dst = (bf16_t*)(ws + WS_WOUTT) + (size_t)(128 * nt) * D + 128 * kt; d.ldt = D; }
    else if (t < T7) { const int v = t >= T6, kt = t - (v ? T6 : T5); d.src = F.in(v ? I_W_CV : I_W_CK) + (size_t)(128 * kt) * 128; d.ldw = 128; d.dst = (bf16_t*)(ws + (v ? WS_WCV : WS_WCK)) + 128 * kt; d.ldt = 4096; }
    else if (t < T8) { const int r = t - T7, e = r >> 6, rr = r & 63, kt = rr >> 2, nt = rr & 3, up = 0;
        const float* W = e < NE ? F.in(I_WE_GATE) + (size_t)e * D * DE : F.in(I_WS_GATE);
        d.src = W + (size_t)(128 * kt) * DE + 128 * nt; d.ldw = DE; d.dst = Wgu + ((size_t)e * 1024 + 256 * nt + 128 * up) * D + 128 * kt; d.ldt = D; }
    else if (t < T9) { const int r = t - T8, e = r >> 6, rr = r & 63, kt = rr >> 2, nt = rr & 3, up = 1;
        const float* W = e < NE ? F.in(I_WE_UP) + (size_t)e * D * DE : F.in(I_WS_UP);
        d.src = W + (size_t)(128 * kt) * DE + 128 * nt; d.ldw = DE; d.dst = Wgu + ((size_t)e * 1024 + 256 * nt + 128 * up) * D + 128 * kt; d.ldt = D; }
    else { const int r = t - T9, e = r >> 6, rr = r & 63, kt = rr >> 4, nt = rr & 15;
        const float* W = e < NE ? F.in(I_WE_DOWN) + (size_t)e * DE * D : F.in(I_WS_DOWN);
        d.src = W + (size_t)(128 * kt) * D + 128 * nt; d.ldw = D; d.dst = Wd + ((size_t)e * D + 128 * nt) * DE + 128 * kt; d.ldt = DE; }
    return d;
}
constexpr int TR_NTILES = 16 * 84 + 128 + 128 + 64 + 64 + 256 + 32 + 32 + 3 * 65 * 64;
__device__ __forceinline__ void tr_load(const TrDesc& d, f32x4 (&v)[8], int wave, int lane) {
#pragma unroll
    for (int i = 0; i < 4; ++i) { const int q = wave + 8 * i, n4 = (q & 3) * 8 + (lane & 7), kp = (q >> 2) * 8 + (lane >> 3);
        const float* p = d.src + (size_t)(2 * kp) * d.ldw + 4 * n4; v[2 * i] = __builtin_nontemporal_load((const f32x4*)p); v[2 * i + 1] = __builtin_nontemporal_load((const f32x4*)(p + d.ldw)); }
}
__device__ __forceinline__ void tr_to_lds(const f32x4 (&v)[8], LAS unsigned* T32, int wave, int lane) {
#pragma unroll
    for (int i = 0; i < 4; ++i) { const int q = wave + 8 * i, n4 = (q & 3) * 8 + (lane & 7), kp = (q >> 2) * 8 + (lane >> 3);
#pragma unroll
        for (int e = 0; e < 4; ++e) T32[(4 * n4 + e) * 65 + kp] = cvtpk(v[2 * i][e], v[2 * i + 1][e]); }
}
__device__ __forceinline__ void tr_from_lds(const TrDesc& d, const LAS unsigned* T32, int wave, int lane) {
    const int c = lane & 15, nn = lane >> 4;
#pragma unroll
    for (int i = 0; i < 4; ++i) { const int n = wave * 16 + 4 * i + nn; const LAS unsigned* r = T32 + n * 65 + 4 * c;
        const u32x4 o = {r[0], r[1], r[2], r[3]};
        __builtin_nontemporal_store(o, (u32x4*)(d.dst + (size_t)n * d.ldt + 8 * c)); }
}
constexpr int TR_FIRST_EXPERT = 16 * 2 * NB16 + 128 + 128 + 64 + 64 + 256 + 32 + 32;
constexpr int TR8W_NTILES = 16 * (48 + 2 * NF8);
struct Tr8Desc { const float* src; unsigned char* dst; unsigned ldw, ldt; float scale; };
__device__ __forceinline__ Tr8Desc tr8_decode(const Frame& F, int t) {
    unsigned char* ws = F.ws; Tr8Desc d; unsigned char* Wgu = ws + WS_WGU; unsigned char* Wd = ws + WS_WD;
    constexpr int TG = 65 * 64;
    if (t < 2 * TG) { const int up = t >= TG, r = t - (up ? TG : 0), e = r >> 6, rr = r & 63, kt = rr >> 2, nt = rr & 3;
        const float* W = e < NE ? F.in(up ? I_WE_UP : I_WE_GATE) + (size_t)e * D * DE : F.in(up ? I_WS_UP : I_WS_GATE);
        d.src = W + (size_t)(128 * kt) * DE + 128 * nt; d.ldw = DE; d.dst = Wgu + ((size_t)e * 1024 + 256 * nt + 128 * up) * D + 128 * kt; d.ldt = D; d.scale = WGU_SCALE; }
    else { const int r = t - 2 * TG, e = r >> 6, rr = r & 63, kt = rr >> 4, nt = rr & 15;
        const float* W = e < NE ? F.in(I_WE_DOWN) + (size_t)e * DE * D : F.in(I_WS_DOWN);
        d.src = W + (size_t)(128 * kt) * D + 128 * nt; d.ldw = D; d.dst = Wd + ((size_t)e * D + 128 * nt) * DE + 128 * kt; d.ldt = DE; d.scale = WD_SCALE; }
    return d;
}
__device__ __forceinline__ Tr8Desc tr8w_decode(const Frame& F, int t) {
    Tr8Desc d; d.scale = WIN_SCALE; d.ldt = D; constexpr int NU = 48 + 2 * NF8; const int kt = t / NU, nt = t - kt * NU, n0 = nt < 48 ? 4608 + 128 * nt : 256 * nth_set(FP8M, (nt - 48) >> 1) + 128 * (nt & 1); const int sc = WinCol{}(n0);
    d.src = F.in(I_W_IN) + (size_t)(128 * kt) * W_IN_COLS + sc; d.ldw = W_IN_COLS; d.dst = F.ws + WS_WIN8 + (size_t)(128 * nt) * D + 128 * kt;
    return d;
}
__device__ __forceinline__ void tr8_load(const Tr8Desc& d, f32x4 (&v)[8], int wave, int lane) {
#pragma unroll
    for (int i = 0; i < 2; ++i) { const int q = wave + 8 * i, n4 = (q & 3) * 8 + (lane & 7), kq = (q >> 2) * 8 + (lane >> 3);
        const float* p = d.src + (size_t)(4 * kq) * d.ldw + 4 * n4;
#pragma unroll
        for (int r = 0; r < 4; ++r) v[4 * i + r] = __builtin_nontemporal_load((const f32x4*)(p + (size_t)r * d.ldw)); }
}
__device__ __forceinline__ void tr8_to_lds(const f32x4 (&v)[8], float sc, LAS unsigned* T32, int wave, int lane) {
#pragma unroll
    for (int i = 0; i < 2; ++i) { const int q = wave + 8 * i, n4 = (q & 3) * 8 + (lane & 7), kq = (q >> 2) * 8 + (lane >> 3);
#pragma unroll
        for (int e = 0; e < 4; ++e) T32[(4 * n4 + e) * 33 + kq] = pk_fp8x4(v[4 * i][e] * sc, v[4 * i + 1][e] * sc, v[4 * i + 2][e] * sc, v[4 * i + 3][e] * sc); }
}
__device__ __forceinline__ void tr8_from_lds(const Tr8Desc& d, const LAS unsigned* T32, int wave, int lane) {
    const int c = lane & 7, nn = lane >> 3;
#pragma unroll
    for (int i = 0; i < 2; ++i) { const int n = wave * 16 + 8 * i + nn; const LAS unsigned* r = T32 + n * 33 + 4 * c;
        const u32x4 o = {r[0], r[1], r[2], r[3]};
        __builtin_nontemporal_store(o, (u32x4*)(d.dst + (size_t)n * d.ldt + 16 * c)); }
}
__device__ __forceinline__ void conv_batch(const Frame& F, int first, int end) {
    constexpr int NT8 = 3 * 65 * 64;
    if (end > NT8) end = NT8;
    if (first >= end) return;
    LAS unsigned* I0 = (LAS unsigned*)F.lds; LAS unsigned* I1 = I0 + 128 * 33; const int lane = F.lane;
    f32x4 r0[8], r1[8], r2[8], r3[8];
    int t = first;
    tr8_load(tr8_decode(F, t), r0, F.wave, lane);
    if (t + 1 < end) tr8_load(tr8_decode(F, t + 1), r1, F.wave, lane);
    if (t + 2 < end) tr8_load(tr8_decode(F, t + 2), r2, F.wave, lane);
    if (t + 3 < end) tr8_load(tr8_decode(F, t + 3), r3, F.wave, lane);
    __syncthreads();
    tr8_to_lds(r0, tr8_decode(F, t).scale, I0, F.wave, lane);
    __syncthreads();
#define CB_STEP(RF, RN, IC, IN) { \
        if (t + 4 < end) tr8_load(tr8_decode(F, t + 4), RF, F.wave, lane); \
        if (t + 1 < end) tr8_to_lds(RN, tr8_decode(F, t + 1).scale, IN, F.wave, lane); \
        tr8_from_lds(tr8_decode(F, t), IC, F.wave, lane); \
        __syncthreads(); \
        if (++t >= end) break; }
    for (;;) {
        CB_STEP(r0, r1, I0, I1)
        CB_STEP(r1, r2, I1, I0)
        CB_STEP(r2, r3, I0, I1)
        CB_STEP(r3, r0, I1, I0)
    }
#undef CB_STEP
}

namespace att {
constexpr int SHM = 16384;
constexpr int L_V = 0, L_K = 3 * SHM;
constexpr int L_WS = 5 * SHM;
constexpr int L_TBL = L_WS + 2048;
constexpr int L_SEL = L_TBL + 8 * 132 * 4;
constexpr int L_NIB = L_SEL + 512;
constexpr int L_CUM = L_SEL + 1024;
constexpr int L_IMP = L_CUM;
constexpr int L_ORD = L_IMP + 32768;
constexpr int L_Q = L_ORD + 2048;
constexpr int L_END = L_Q + 64;
static_assert(L_END <= RING_BYTES, "attention LDS map");
__constant__ unsigned char T5B[128] = {0, 1, 2, 3, 4, 5, 6, 7, 8, 9, 10, 11, 12, 13, 14, 15, 16, 16, 16, 17, 17, 18, 18, 18, 19, 19, 19, 20, 20, 20, 20, 21, 21, 21, 21, 22, 22, 22, 22, 22, 23, 23, 23, 23, 23, 23, 24, 24, 24, 24, 24, 24, 25, 25, 25, 25, 25, 25, 25, 26, 26, 26, 26, 26, 26, 26, 26, 27, 27, 27, 27, 27, 27, 27, 27, 27, 27, 28, 28, 28, 28, 28, 28, 28, 28, 28, 28, 29, 29, 29, 29, 29, 29, 29, 29, 29, 29, 29, 29, 30, 30, 30, 30, 30, 30, 30, 30, 30, 30, 30, 30, 30, 30, 31, 31, 31, 31, 31, 31, 31, 31, 31, 31, 31, 31, 31, 31, 31};

#define KSWZ(row, colB) ((row) * 256 + ((colB) ^ (((row) & 7) << 4)))
#define SBAR() __builtin_amdgcn_sched_barrier(0)
__device__ __forceinline__ int v_st(int k, int c) { const int kk = (k & ~0xC) | ((k & 4) << 1) | ((k & 8) >> 1); return ((kk >> 3) * 4 + (c >> 5)) * 512 + ((kk & 7) * 32 + (c & 31)) * 2; }
__device__ __forceinline__ int v_rd_base(int lane) { return ((lane & 3) << 3) | (((lane >> 2) & 3) << 6) | (((lane >> 4) & 1) << 5) | (((lane >> 5) & 1) << 8); }
__device__ __forceinline__ int crow(int r, int hi) { return (r & 3) + 8 * (r >> 2) + 4 * hi; }
__device__ __forceinline__ float pswap_max(float v) { auto rr = __builtin_amdgcn_permlane32_swap(__float_as_uint(v), __float_as_uint(v), false, false); return fmaxf(__uint_as_float(rr[0]), __uint_as_float(rr[1])); }
__device__ __forceinline__ float pswap_sum(float v) { auto rr = __builtin_amdgcn_permlane32_swap(__float_as_uint(v), __float_as_uint(v), false, false); return __uint_as_float(rr[0]) + __uint_as_float(rr[1]); }

__device__ __forceinline__ void qkt(f32x16& p0, f32x16& p1, const LAS char* Kb, int r32, int hi, const bf16x8 (&qr)[8]) {
    const LAS char* kb[4];
#pragma unroll
    for (int dd = 0; dd < 4; ++dd) kb[dd] = Kb + KSWZ(r32, (dd * 16 + hi * 8) * 2);
#pragma unroll
    for (int d0 = 0; d0 < 8; ++d0) { const LAS char* a = kb[d0 & 3] + (d0 >> 2) * 128;
        const bf16x8 b0 = *(const LAS bf16x8*)a;
        const bf16x8 b1 = *(const LAS bf16x8*)(a + 32 * 256);
        p0 = __builtin_amdgcn_mfma_f32_32x32x16_bf16(b0, qr[d0], p0, 0, 0, 0);
        p1 = __builtin_amdgcn_mfma_f32_32x32x16_bf16(b1, qr[d0], p1, 0, 0, 0);
#ifdef QKT_SPLIT
        if ((d0 & (QKT_SPLIT - 1)) == QKT_SPLIT - 1 && d0 != 7) SBAR();
#endif
    }
}
__device__ __forceinline__ void pv_tile(f32x16 (&o)[4], int vb, bf16x8 pa0, bf16x8 pa1, bf16x8 pa2, bf16x8 pa3) {
#define TRRD(dst, off) asm volatile("ds_read_b64_tr_b16 %0, %1 offset:%2" : "=&v"(dst) : "v"(vb), "i"(off) : "memory")
#define PV_D0(d0) do { s16x4 l0, l1, l2, l3, h0, h1, h2, h3; constexpr int b_ = (d0) * 512; \
        TRRD(l0, b_); TRRD(h0, b_ + 2048); TRRD(l1, b_ + 4096); TRRD(h1, b_ + 6144); TRRD(l2, b_ + 8192); TRRD(h2, b_ + 10240); TRRD(l3, b_ + 12288); TRRD(h3, b_ + 14336); \
        asm volatile("s_waitcnt lgkmcnt(0)" ::: "memory"); SBAR(); \
        o[d0] = __builtin_amdgcn_mfma_f32_32x32x16_bf16(pa0, (bf16x8){l0[0], l0[1], l0[2], l0[3], h0[0], h0[1], h0[2], h0[3]}, o[d0], 0, 0, 0); \
        o[d0] = __builtin_amdgcn_mfma_f32_32x32x16_bf16(pa1, (bf16x8){l1[0], l1[1], l1[2], l1[3], h1[0], h1[1], h1[2], h1[3]}, o[d0], 0, 0, 0); \
        o[d0] = __builtin_amdgcn_mfma_f32_32x32x16_bf16(pa2, (bf16x8){l2[0], l2[1], l2[2], l2[3], h2[0], h2[1], h2[2], h2[3]}, o[d0], 0, 0, 0); \
        o[d0] = __builtin_amdgcn_mfma_f32_32x32x16_bf16(pa3, (bf16x8){l3[0], l3[1], l3[2], l3[3], h3[0], h3[1], h3[2], h3[3]}, o[d0], 0, 0, 0); } while (0)
    PV_D0(0); PV_D0(1); PV_D0(2); PV_D0(3);
#undef PV_D0
#undef TRRD
}
__device__ __forceinline__ void pack_p(const f32x16& p0, const f32x16& p1, bf16x8& pa0, bf16x8& pa1, bf16x8& pa2, bf16x8& pa3) {
#define PK4(P, B_, OUT) do { unsigned a0 = cvtpk(P[B_+0], P[B_+1]), a1 = cvtpk(P[B_+2], P[B_+3]); \
        unsigned b0 = cvtpk(P[B_+4], P[B_+5]), b1 = cvtpk(P[B_+6], P[B_+7]); \
        auto r0 = __builtin_amdgcn_permlane32_swap(a0, b0, false, false); auto r1 = __builtin_amdgcn_permlane32_swap(a1, b1, false, false); \
        u32x4 w = {r0[0], r1[0], r0[1], r1[1]}; OUT = __builtin_bit_cast(bf16x8, w); } while (0)
    PK4(p0, 0, pa0); PK4(p0, 8, pa1); PK4(p1, 0, pa2); PK4(p1, 8, pa3);
#undef PK4
}
__device__ __forceinline__ void bcast_rows(float (&f)[16], float v, LAS float* ws, int r32, int hi) {
    if (hi == 0) ws[r32] = v;
    asm volatile("s_waitcnt lgkmcnt(0)" ::: "memory");
#pragma unroll
    for (int q = 0; q < 4; ++q) { const f32x4 t = *(const LAS f32x4*)(ws + 8 * q + 4 * hi); f[4 * q] = t[0]; f[4 * q + 1] = t[1]; f[4 * q + 2] = t[2]; f[4 * q + 3] = t[3]; }
    asm volatile("s_waitcnt lgkmcnt(0)" ::: "memory");
}
struct Ctx {
    LAS char* lds; int tid, wid, lane, r32, hi;
    int trow;
    int qlo;
};
struct DmaOff { unsigned k, v0, v1; };
__device__ __forceinline__ DmaOff dma_off(int wid, int lane, size_t ld) {
    DmaOff d; const int kr = 4 * wid + (lane >> 4), kc = (lane & 15) ^ (kr & 7);
    d.k = (unsigned)(kr * ld + kc * 8) * 2u;
#pragma unroll
    for (int t = 0; t < 2; ++t) { const int sub = 2 * (wid + 8 * t) + (lane >> 5), kk = (sub >> 2) * 8 + ((lane & 31) >> 2), k = (kk & ~0xC) | ((kk & 4) << 1) | ((kk & 8) >> 1), c0 = (sub & 3) * 32 + (lane & 3) * 8;
        const unsigned o = (unsigned)(k * ld + c0) * 2u; if (t == 0) d.v0 = o; else d.v1 = o; }
    return d;
}
__device__ __forceinline__ void dma_tile(const DmaOff& d, const bf16_t* Kg, const bf16_t* Vg, size_t ld, LAS char* lds, int buf, int vbuf, int wid) {
    const char* kp = (const char*)Kg; const char* vp = (const char*)Vg;
    __builtin_amdgcn_global_load_lds((const unsigned*)(kp + d.k), (LAS unsigned*)(lds + L_K + buf * SHM + wid * 1024), 16, 0, 0);
    __builtin_amdgcn_global_load_lds((const unsigned*)(kp + d.k + 32 * ld * 2), (LAS unsigned*)(lds + L_K + buf * SHM + (wid + 8) * 1024), 16, 0, 0);
    __builtin_amdgcn_global_load_lds((const unsigned*)(vp + d.v0), (LAS unsigned*)(lds + L_V + vbuf * SHM + wid * 1024), 16, 0, 0);
    __builtin_amdgcn_global_load_lds((const unsigned*)(vp + d.v1), (LAS unsigned*)(lds + L_V + vbuf * SHM + (wid + 8) * 1024), 16, 0, 0);
}
__device__ __forceinline__ void dma_tile_v(const DmaOff& d, const bf16_t* Kg, const bf16_t* Vg, size_t ld, LAS char* lds, int kbuf, int voff, int wid) {
    const char* kp = (const char*)Kg; const char* vp = (const char*)Vg;
    __builtin_amdgcn_global_load_lds((const unsigned*)(kp + d.k), (LAS unsigned*)(lds + L_K + kbuf * SHM + wid * 1024), 16, 0, 0);
    __builtin_amdgcn_global_load_lds((const unsigned*)(kp + d.k + 32 * ld * 2), (LAS unsigned*)(lds + L_K + kbuf * SHM + (wid + 8) * 1024), 16, 0, 0);
    __builtin_amdgcn_global_load_lds((const unsigned*)(vp + d.v0), (LAS unsigned*)(lds + L_V + voff + wid * 1024), 16, 0, 0);
    __builtin_amdgcn_global_load_lds((const unsigned*)(vp + d.v1), (LAS unsigned*)(lds + L_V + voff + (wid + 8) * 1024), 16, 0, 0);
}
#define DMA_WAIT() asm volatile("s_waitcnt vmcnt(0)" ::: "memory")
constexpr float DEFER_THR = 8.f;
__device__ __forceinline__ void qkt_half(f32x16& p, const LAS char* Kb, int r32, int hi, const bf16x8 (&qr)[8], bool zero) {
    const LAS char* kb[4];
#pragma unroll
    for (int dd = 0; dd < 4; ++dd) kb[dd] = Kb + KSWZ(r32, (dd * 16 + hi * 8) * 2);
    { const bf16x8 b = *(const LAS bf16x8*)(kb[0]);
      if (zero) p = __builtin_amdgcn_mfma_f32_32x32x16_bf16(b, qr[0], (f32x16){0.f, 0.f, 0.f, 0.f, 0.f, 0.f, 0.f, 0.f, 0.f, 0.f, 0.f, 0.f, 0.f, 0.f, 0.f, 0.f}, 0, 0, 0);
      else p = __builtin_amdgcn_mfma_f32_32x32x16_bf16(b, qr[0], p, 0, 0, 0); }
#pragma unroll
    for (int d0 = 1; d0 < 8; ++d0) { const bf16x8 b = *(const LAS bf16x8*)(kb[d0 & 3] + (d0 >> 2) * 128);
        p = __builtin_amdgcn_mfma_f32_32x32x16_bf16(b, qr[d0], p, 0, 0, 0); }
}
__device__ __forceinline__ float max3f(float a, float b, float c) { float r; asm("v_max3_f32 %0, %1, %2, %3" : "=v"(r) : "v"(a), "v"(b), "v"(c)); return r; }
__device__ __forceinline__ bool sm_half(f32x16& p, float& m_reg, float& l_reg, float& alpha, bf16x8& pa0, bf16x8& pa1, float brow) {
    float pmax = max3f(p[0], p[1], p[2]);
#pragma unroll
    for (int r = 3; r < 15; r += 2) pmax = max3f(pmax, p[r], p[r + 1]);
    pmax = max3f(pmax, p[15], p[15]);
    { const auto rr = __builtin_amdgcn_permlane32_swap(__float_as_uint(pmax), __float_as_uint(pmax), false, false); pmax = max3f(__uint_as_float(rr[0]), __uint_as_float(rr[1]), __uint_as_float(rr[1])) + brow; }
    const bool upd = !__all(pmax - m_reg <= DEFER_THR);
    const float mx_ = max3f(m_reg, pmax, pmax);
    const float mn = upd ? mx_ : m_reg;
    alpha = __builtin_amdgcn_exp2f(m_reg - mn); m_reg = mn;
    f32x2 mn2 = {brow - mn, brow - mn}; asm("" : "+v"(mn2)); f32x2 ps2 = {0.f, 0.f};
#pragma unroll
    for (int r = 0; r < 16; r += 2) { f32x2 t = {p[r], p[r + 1]}; t += mn2; t.x = __builtin_amdgcn_exp2f(t.x); t.y = __builtin_amdgcn_exp2f(t.y); p[r] = t.x; p[r + 1] = t.y; ps2 += t; }
    float ps = pswap_sum(ps2.x + ps2.y);
    l_reg = l_reg * alpha + ps;
#define PK4(P, B_, OUT) do { unsigned a0 = cvtpk(P[B_+0], P[B_+1]), a1 = cvtpk(P[B_+2], P[B_+3]); \
        unsigned b0 = cvtpk(P[B_+4], P[B_+5]), b1 = cvtpk(P[B_+6], P[B_+7]); \
        auto r0 = __builtin_amdgcn_permlane32_swap(a0, b0, false, false); auto r1 = __builtin_amdgcn_permlane32_swap(a1, b1, false, false); \
        u32x4 w = {r0[0], r1[0], r0[1], r1[1]}; OUT = __builtin_bit_cast(bf16x8, w); } while (0)
    PK4(p, 0, pa0); PK4(p, 8, pa1);
#undef PK4
    return upd;
}
__device__ __forceinline__ void pv_half(f32x16 (&o)[4], int vb, bf16x8 pa0, bf16x8 pa1) {
#define TRRD(dst, off) asm volatile("ds_read_b64_tr_b16 %0, %1 offset:%2" : "=&v"(dst) : "v"(vb), "i"(off) : "memory")
#define PVH(dA, dB) do { s16x4 l0, h0, l1, h1, m0, n0, m1, n1; \
        TRRD(l0, (dA) * 512); TRRD(h0, (dA) * 512 + 2048); TRRD(m0, (dB) * 512); TRRD(n0, (dB) * 512 + 2048); \
        TRRD(l1, (dA) * 512 + 4096); TRRD(h1, (dA) * 512 + 6144); TRRD(m1, (dB) * 512 + 4096); TRRD(n1, (dB) * 512 + 6144); \
        asm volatile("s_waitcnt lgkmcnt(0)" ::: "memory"); SBAR(); \
        o[dA] = __builtin_amdgcn_mfma_f32_32x32x16_bf16(pa0, (bf16x8){l0[0], l0[1], l0[2], l0[3], h0[0], h0[1], h0[2], h0[3]}, o[dA], 0, 0, 0); \
        o[dB] = __builtin_amdgcn_mfma_f32_32x32x16_bf16(pa0, (bf16x8){m0[0], m0[1], m0[2], m0[3], n0[0], n0[1], n0[2], n0[3]}, o[dB], 0, 0, 0); \
        o[dA] = __builtin_amdgcn_mfma_f32_32x32x16_bf16(pa1, (bf16x8){l1[0], l1[1], l1[2], l1[3], h1[0], h1[1], h1[2], h1[3]}, o[dA], 0, 0, 0); \
        o[dB] = __builtin_amdgcn_mfma_f32_32x32x16_bf16(pa1, (bf16x8){m1[0], m1[1], m1[2], m1[3], n1[0], n1[1], n1[2], n1[3]}, o[dB], 0, 0, 0); } while (0)
    PVH(0, 1); PVH(2, 3);
#undef PVH
#undef TRRD
}
__device__ __forceinline__ bool sm_cheap(f32x16& p, float& l_reg, float& alpha, bf16x8& pa0, bf16x8& pa1) {
    alpha = 1.f; l_reg += p[0] + p[15];
    u32x4 w0 = {__builtin_bit_cast(unsigned, p[0]), __builtin_bit_cast(unsigned, p[1]), __builtin_bit_cast(unsigned, p[2]), __builtin_bit_cast(unsigned, p[3])};
    u32x4 w1 = {__builtin_bit_cast(unsigned, p[8]), __builtin_bit_cast(unsigned, p[9]), __builtin_bit_cast(unsigned, p[10]), __builtin_bit_cast(unsigned, p[11])};
    pa0 = __builtin_bit_cast(bf16x8, w0); pa1 = __builtin_bit_cast(bf16x8, w1); return false;
}
template <int VAR = 0, class F>
__device__ __forceinline__ void stream(const Ctx& C0, const bf16x8 (&qr)[8], const bf16_t* Kg, const bf16_t* Vg, size_t ld, unsigned mask, float& m_reg, float& l_reg, f32x16 (&o)[4], const F& f) {
    Ctx C = C0; { int tz = C0.tid; asm volatile("" : "+v"(tz)); C.tid = tz; C.lane = tz & 63; C.r32 = tz & 31; C.hi = (tz >> 5) & 1; }
    const int vb0 = (int)(uintptr_t)(C.lds + L_V) + v_rd_base(C.lane);
    LAS float* ws = (LAS float*)(C.lds + L_WS) + C.wid * 64;
    const DmaOff dof = dma_off(C.wid, C.lane, ld);
    unsigned rem = mask; int j = __builtin_ctz(rem); rem &= rem - 1;
    __syncthreads();
    dma_tile_v(dof, Kg + (size_t)j * 64 * ld, Vg + (size_t)j * 64 * ld, ld, C.lds, 0, 0, C.wid);
    DMA_WAIT();
    __syncthreads();
    int kb = 0, vprev = 2 * SHM, vcur = 0, vnext = SHM;
    bool more = rem != 0u; int jn = j;
    if (more) { jn = __builtin_ctz(rem); rem &= rem - 1; if (!(VAR & 1)) dma_tile_v(dof, Kg + (size_t)jn * 64 * ld, Vg + (size_t)jn * 64 * ld, ld, C.lds, 1, vnext, C.wid); }
#define ST_RESC(a) do { if (C.hi == 0) ws[C.r32] = (a); asm volatile("s_waitcnt lgkmcnt(0)" ::: "memory"); \
        _Pragma("unroll") for (int q = 0; q < 4; ++q) { const f32x4 t = *(const LAS f32x4*)(ws + 8 * q + 4 * C.hi); \
            _Pragma("unroll") for (int d = 0; d < 4; ++d) { o[d][4 * q] *= t[0]; o[d][4 * q + 1] *= t[1]; o[d][4 * q + 2] *= t[2]; o[d][4 * q + 3] *= t[3]; } } } while (0)
    f32x16 pA, pB; float alpha, browA, browB; bf16x8 pa0, pa1;
    bool zA = f.pre(pA, j, 0, browA);
    qkt_half(pA, C.lds + L_K, C.r32, C.hi, qr, zA);
    bool zB = f.pre(pB, j, 1, browB);
    bool first = true;
    for (;;) {
        if (!(VAR & 16)) qkt_half(pB, C.lds + L_K + kb * SHM + 32 * 256, C.r32, C.hi, qr, zB);
        const bool u0 = (VAR & 4) ? sm_cheap(pA, l_reg, alpha, pa0, pa1) : sm_half(pA, m_reg, l_reg, alpha, pa0, pa1, browA);
        if (u0 && !first) ST_RESC(alpha);
        first = false;
        if (!(VAR & 8)) pv_half(o, vb0 + vcur, pa0, pa1); else { o[0][0] += __builtin_bit_cast(float, (int)pa0[0] + (int)pa1[1]); }
        if (!(VAR & 32)) zA = f.pre(pA, jn, 0, browA);
        DMA_WAIT(); if (!(VAR & 2)) __syncthreads();
        if (!more) break;
        j = jn; kb ^= 1; { const int t_ = vprev; vprev = vcur; vcur = vnext; vnext = t_; }
        more = rem != 0u;
        if (more) { jn = __builtin_ctz(rem); rem &= rem - 1; if (!(VAR & 1)) dma_tile_v(dof, Kg + (size_t)jn * 64 * ld, Vg + (size_t)jn * 64 * ld, ld, C.lds, kb ^ 1, vnext, C.wid); }
        if (!(VAR & 16)) qkt_half(pA, C.lds + L_K + kb * SHM, C.r32, C.hi, qr, zA);
        const bool u1 = (VAR & 4) ? sm_cheap(pB, l_reg, alpha, pa0, pa1) : sm_half(pB, m_reg, l_reg, alpha, pa0, pa1, browB);
        if (u1) ST_RESC(alpha);
        if (!(VAR & 8)) pv_half(o, vb0 + vprev + 8192, pa0, pa1); else { o[1][0] += __builtin_bit_cast(float, (int)pa0[2] + (int)pa1[3]); }
        if (!(VAR & 32)) zB = f.pre(pB, j, 1, browB);
    }
    { const bool u1 = sm_half(pB, m_reg, l_reg, alpha, pa0, pa1, browB);
      if (u1) ST_RESC(alpha);
      pv_half(o, vb0 + vcur + 8192, pa0, pa1); }
    __syncthreads();
#undef ST_RESC
}
__device__ __forceinline__ void load_q(bf16x8 (&qr)[8], const bf16_t* qrow, const float* gain, int hi) {
    u32x4 raw[8]; float ss = 0.f;
#pragma unroll
    for (int d0 = 0; d0 < 8; ++d0) { raw[d0] = *(const u32x4*)(qrow + d0 * 16 + hi * 8);
#pragma unroll
        for (int e = 0; e < 4; ++e) { const float a = bf_lo(raw[d0][e]), b = bf_hi(raw[d0][e]); ss += a * a + b * b; } }
    ss = pswap_sum(ss);
    const float f = __builtin_amdgcn_rsqf(ss * (1.f / HD) + RMS_EPS) * (ATTN_SCALE * LOG2E);
#pragma unroll
    for (int d0 = 0; d0 < 8; ++d0) { const f32x4 g0 = *(const f32x4*)(gain + d0 * 16 + hi * 8), g1 = *(const f32x4*)(gain + d0 * 16 + hi * 8 + 4);
        u32x4 w; w.x = cvtpk(bf_lo(raw[d0].x) * f * g0[0], bf_hi(raw[d0].x) * f * g0[1]); w.y = cvtpk(bf_lo(raw[d0].y) * f * g0[2], bf_hi(raw[d0].y) * f * g0[3]);
        w.z = cvtpk(bf_lo(raw[d0].z) * f * g1[0], bf_hi(raw[d0].z) * f * g1[1]); w.w = cvtpk(bf_lo(raw[d0].w) * f * g1[2], bf_hi(raw[d0].w) * f * g1[3]);
        qr[d0] = __builtin_bit_cast(bf16x8, w); }
}
__device__ __forceinline__ void store_o(const f32x16 (&v)[4], const float (&w)[16], bf16_t* orow0, size_t ld, LAS char* lds, int wid, int lane_, bool accum) {
    int lane = lane_; asm volatile("" : "+v"(lane));
    const int r32 = lane & 31, hi = lane >> 5;
    LAS char* st = lds + wid * 8192;
    const bool odd = (r32 & 1) != 0;
#pragma unroll
    for (int r = 0; r < 16; r += 2) { LAS char* rowp = st + (crow(r, hi) + (odd ? 1 : 0)) * 256 + (r32 & ~1) * 2;
#pragma unroll
        for (int d = 0; d < 4; ++d) { const float a = v[d][r] * w[r], b = v[d][r + 1] * w[r + 1];
            const float recv = __builtin_bit_cast(float, __builtin_amdgcn_mov_dpp(__builtin_bit_cast(int, odd ? a : b), 0xB1, 0xF, 0xF, true));
            *(LAS unsigned*)(rowp + d * 64) = cvtpk(odd ? recv : a, odd ? b : recv); } }
    asm volatile("s_waitcnt lgkmcnt(0)" ::: "memory");
    u32x4 ov[8];
    if (accum) {
#pragma unroll
        for (int it = 0; it < 8; ++it) { const int id = it * 64 + lane, row = id >> 4, c16 = id & 15; ov[it] = *(const u32x4*)(orow0 + (size_t)row * ld + c16 * 8); } }
#pragma unroll
    for (int it = 0; it < 8; ++it) { const int id = it * 64 + lane, row = id >> 4, c16 = id & 15;
        u32x4 nv = *(const LAS u32x4*)(st + row * 256 + c16 * 16);
        if (accum) {
#pragma unroll
            for (int e = 0; e < 4; ++e) nv[e] = cvtpk(bf_lo(nv[e]) + bf_lo(ov[it][e]), bf_hi(nv[e]) + bf_hi(ov[it][e])); }
        *(u32x4*)(orow0 + (size_t)row * ld + c16 * 8) = nv; }
    asm volatile("s_waitcnt lgkmcnt(0)" ::: "memory");
}

struct Tensors {
    const bf16_t* PA; const float* GL; const bf16_t* KVM; const bf16_t* KC; const bf16_t* VC; const float* CUM; bf16_t* OC;
    const float* nsa_q_g; const float* fox_q_g; const float* mem_q_g; const float* rel_bias;
};

template <int TY> struct BiasUni {
    const Ctx* C; const LAS float* tb; int u; unsigned sel; int mode;
    __device__ __forceinline__ bool pre(f32x16& bv, int j, int half, float& brow) const {
        const float NEG = -__builtin_inff();
        const int dq = C->trow - 64 * j - 4 * C->hi - 32 * half;
        brow = 0.f;
        if constexpr (TY == 0) {
            const bool win = mode == 1; const bool on = win || ((sel >> j) & 1u);
            if (j + 3 <= u && !(win && j + 8 <= u)) {
                brow = on ? tb[128] : NEG; return true;
            } else {
#pragma unroll
                for (int q = 0; q < 4; ++q) {
#pragma unroll
                    for (int e = 0; e < 4; ++e) { const int r = 4 * q + e, c = e + 8 * q, rel = dq - c;
                        const bool ok = on && (unsigned)rel < 512u; const float b = tb[min(max(rel, 0), 128)];
                        bv[r] = ok ? b : NEG; }
                    SBAR(); }
            }
        } else if constexpr (TY == 1) {
            const LAS float* cb = (const LAS float*)(C->lds + L_CUM) + 64 * j + 4 * C->hi + 32 * half;
            const bool msk = 64 * j + 63 > C->qlo;
#pragma unroll
            for (int q = 0; q < 4; ++q) { const f32x4 a = *(const LAS f32x4*)(cb + 8 * q);
#pragma unroll
                for (int e = 0; e < 4; ++e) { const int r = 4 * q + e, c = e + 8 * q; bv[r] = (msk && dq - c < 0) ? NEG : a[e]; } }
        } else {
            return true;
        }
        return false;
    }
};

__device__ __forceinline__ void nsa_pre(Ctx& C, const Tensors& Tn, const bf16x8 (&qr)[8], int b, int g, int u, float g_c, bf16_t* orow0, unsigned& sel_out, unsigned& U_out) {
    { int tz = C.tid; asm volatile("" : "+v"(tz)); C.tid = tz; C.lane = tz & 63; C.r32 = tz & 31; C.hi = (tz >> 5) & 1; }
    const int hh = C.wid >> 1, pos = (C.wid & 1) * 32 + C.r32, head = g * 4 + hh;
    const LAS float* tb = (const LAS float*)(C.lds + L_TBL) + head * 132;
    LAS float* ws = (LAS float*)(C.lds + L_WS) + C.wid * 64;
    LAS unsigned* SEL = (LAS unsigned*)(C.lds + L_SEL);
    const float NEG = -__builtin_inff();
    const int vb0 = (int)(uintptr_t)(C.lds + L_V) + v_rd_base(C.lane);
    {
        const bf16_t* KCb = Tn.KC + (size_t)(b * 2 + g) * 128 * HD; const bf16_t* VCb = Tn.VC + (size_t)(b * 2 + g) * 128 * HD;
        const DmaOff dof = dma_off(C.wid, C.lane, HD);
        __syncthreads();
        if (C.tid < 65) SEL[C.tid] = 0u;
        dma_tile(dof, KCb, VCb, HD, C.lds, 0, 0, C.wid); dma_tile(dof, KCb + 64 * HD, VCb + 64 * HD, HD, C.lds, 1, 1, C.wid);
        DMA_WAIT();
        __syncthreads();
        f32x16 P[4];
        const int dq = C.trow - 31 - 64 * C.hi;
#pragma unroll
        for (int X = 0; X < 4; ++X)
#pragma unroll
            for (int r = 0; r < 16; ++r) { const int c = (r & 3) + 8 * (r >> 2), rel = dq - 16 * (32 * X + c);
                const float bb = tb[min(max(rel, 0), 128)]; P[X][r] = rel >= 0 ? bb : NEG; }
        qkt(P[0], P[1], C.lds + L_K, C.r32, C.hi, qr); qkt(P[2], P[3], C.lds + L_K + SHM, C.r32, C.hi, qr);
        float pmax = NEG;
#pragma unroll
        for (int X = 0; X < 4; ++X)
#pragma unroll
            for (int r = 0; r < 16; ++r) pmax = fmaxf(pmax, P[X][r]);
        pmax = pswap_max(pmax);
        const float mm = pmax == NEG ? 0.f : pmax;
        float ps = 0.f;
#pragma unroll
        for (int X = 0; X < 4; ++X)
#pragma unroll
            for (int r = 0; r < 16; ++r) { P[X][r] = __builtin_amdgcn_exp2f(P[X][r] - mm); ps += P[X][r]; }
        ps = pswap_sum(ps);
        const float inv = ps > 0.f ? 1.f / ps : 0.f;
        if (u >= 16) {
            LAS float* imp = (LAS float*)(C.lds + L_IMP) + (hh * 64 + pos) * 32;
            float bprev = 0.f;
#pragma unroll
            for (int X = 0; X < 4; ++X)
#pragma unroll
                for (int q = 0; q < 4; ++q) { const float b3 = 0.5f * P[X][4 * q + 3];
                    const float aG = P[X][4 * q] + P[X][4 * q + 1] + P[X][4 * q + 2] + b3;
                    const auto sw_ = __builtin_amdgcn_permlane32_swap(__float_as_uint(b3), __float_as_uint(b3), false, false);
                    const float bp = __uint_as_float(C.hi ? sw_[0] : sw_[1]);
                    const float val = aG + (C.hi ? bp : bprev);
                    imp[2 * (4 * X + q) + C.hi] = val * inv;
                    bprev = bp; }
        }
        f32x16 o[4] = {};
        bf16x8 pa0, pa1, pa2, pa3;
        pack_p(P[0], P[1], pa0, pa1, pa2, pa3); pv_tile(o, vb0, pa0, pa1, pa2, pa3);
        pack_p(P[2], P[3], pa0, pa1, pa2, pa3); pv_tile(o, vb0 + SHM, pa0, pa1, pa2, pa3);
        float w[16]; bcast_rows(w, g_c * inv, ws, C.r32, C.hi);
        __syncthreads();
        store_o(o, w, orow0, D, C.lds, C.wid, C.lane, false);
    }
    if (u >= 16) {
        const int p = C.tid & 63, jg = C.tid >> 6;
        const LAS float* i0 = (const LAS float*)(C.lds + L_IMP) + p * 32;
        float sc[32];
#pragma unroll
        for (int j4 = 0; j4 < 8; ++j4) { const f32x4 a = *(const LAS f32x4*)(i0 + 4 * j4), b2 = *(const LAS f32x4*)(i0 + 2048 + 4 * j4), c2 = *(const LAS f32x4*)(i0 + 4096 + 4 * j4), d2 = *(const LAS f32x4*)(i0 + 6144 + 4 * j4);
#pragma unroll
            for (int e = 0; e < 4; ++e) { const int j = 4 * j4 + e; const float s = ((a[e] + b2[e]) + c2[e]) + d2[e];
                const bool valid = j <= u, forced = j == 0 || j == u || j == u - 1;
                sc[j] = valid ? (forced ? 1e4f : s) : -1.f; } }
        unsigned bits = 0u;
#pragma unroll
        for (int e = 0; e < 4; ++e) { const int j = 4 * jg + e; float sj = 0.f;
#pragma unroll
            for (int k = 0; k < 32; ++k) sj = (k == j) ? sc[k] : sj;
            int rank = 0;
#pragma unroll
            for (int k = 0; k < 32; ++k) rank += (sc[k] > sj || (sc[k] == sj && k < j)) ? 1 : 0;
            if (j <= u && rank < 16) bits |= 1u << j; }
        ((LAS unsigned char*)(C.lds + L_NIB))[p * 8 + jg] = (unsigned char)(bits >> (4 * jg));
        __syncthreads();
        if (C.tid < 64) { const u32x2 nb = *(const LAS u32x2*)(C.lds + L_NIB + C.tid * 8); unsigned full = 0u;
#pragma unroll
            for (int k = 0; k < 4; ++k) { full |= ((nb.x >> (8 * k)) & 0xfu) << (4 * k); full |= ((nb.y >> (8 * k)) & 0xfu) << (16 + 4 * k); }
            SEL[C.tid] = full; unsigned un = full;
#pragma unroll
            for (int o = 1; o < 64; o <<= 1) un |= __shfl_xor(un, o);
            if (C.tid == 0) SEL[64] = un; }
    } else { if (C.tid < 65) SEL[C.tid] = (2u << u) - 1u; }
    __syncthreads();
    sel_out = SEL[pos]; U_out = SEL[64];
}
__device__ __forceinline__ int dequeue(LAS char* lds, unsigned* head, int tid) {
    if (tid == 0) *(LAS int*)(lds + L_Q) = (int)__hip_atomic_fetch_add(head, 1u, RLX_AGENT);
    __syncthreads();
    const int q = *(const LAS int*)(lds + L_Q);
    __syncthreads();
    return q;
}
#ifndef DBL_VAR
#define DBL_VAR 0
#endif
#ifndef DBL_STREAM
#define DBL_STREAM 0
#endif
#ifndef CONV_IN_P0
#define CONV_IN_P0 0
#endif
__device__ __forceinline__ void conv_some(const Frame& F, LAS char* lds, unsigned* chead, int n) {
    if (CONV_IN_P0) return;
    if (F.tid == 0) *(LAS int*)(lds + L_Q) = (int)__hip_atomic_fetch_add(chead, (unsigned)n, RLX_AGENT);
    __syncthreads();
    const int base = *(const LAS int*)(lds + L_Q);
    __syncthreads();
    conv_batch(F, base, base + n);
}
__device__ __forceinline__ void attn_phase(const Frame& F, LAS char* lds, const Tensors& Tn, unsigned* qhead) {
    Ctx C; C.lds = lds; C.tid = threadIdx.x; C.wid = __builtin_amdgcn_readfirstlane(C.tid >> 6); C.lane = C.tid & 63; C.r32 = C.lane & 31; C.hi = C.lane >> 5; C.trow = 0; C.qlo = 0;
    for (int i = C.tid; i < 8 * 129; i += 512) { const int head = i / 129, rel = i - head * 129; const int bk = rel < 128 ? T5B[rel] : 31;
        ((LAS float*)(lds + L_TBL))[head * 132 + rel] = Tn.rel_bias[bk * 8 + head] * LOG2E; }
    __syncthreads();
    LAS float* ws = (LAS float*)(lds + L_WS) + C.wid * 64;
#ifndef PASS_MASK
#define PASS_MASK 7
#endif
    int nconv = (int)((blockIdx.x >> 3) & 7) * 7;
    if (PASS_MASK & 1) for (;;) {
        conv_some(F, lds, qhead + 192, nconv); nconv = 9;
        const int q = dequeue(lds, qhead, C.tid); if (q >= 512) break;
        const int u = 31 - (q >> 4), b = (q >> 1) & 7, g = q & 1, head = g * 4 + (C.wid >> 1);
        C.qlo = 64 * u + (C.wid & 1) * 32; C.trow = C.qlo + C.r32;
        const size_t tok = (size_t)b * T + C.trow;
        bf16x8 qr[8]; load_q(qr, Tn.PA + tok * NPA + CQ_NSA + head * HD, Tn.nsa_q_g, C.hi);
        bf16_t* orow0 = Tn.OC + ((size_t)b * T + C.qlo) * D + head * HD;
        const LAS float* tb = (const LAS float*)(lds + L_TBL) + head * 132;
        const float* gl = Tn.GL + tok * LDG; const float g_c = fast_sigmoid(gl[head]), g_s = fast_sigmoid(gl[8 + head]), g_w = fast_sigmoid(gl[16 + head]);
        unsigned sel, U; nsa_pre(C, Tn, qr, b, g, u, g_c, orow0, sel, U);
        const bf16_t* PAb = Tn.PA + (size_t)b * T * NPA + g * HD;
        int br = 0;
        do {
            const unsigned mask = br ? (((2u << u) - 1u) & ~(u >= 9 ? ((1u << (u - 8)) - 1u) : 0u)) : U;
            f32x16 o[4] = {}; float m_reg = -1e30f, l_reg = 0.f;
            stream(C, qr, PAb + (br ? CK_WIN : CK_SLC), PAb + (br ? CV_WIN : CV_SLC), NPA, mask, m_reg, l_reg, o, BiasUni<0>{&C, tb, u, sel, br});
            float w[16]; bcast_rows(w, l_reg > 0.f ? (br ? g_w : g_s) / l_reg : 0.f, ws, C.r32, C.hi);
            store_o(o, w, orow0, D, lds, C.wid, C.lane, true);
#if DBL_STREAM
            { f32x16 o2[4] = {}; float m2 = -1e30f, l2 = 0.f; stream<DBL_VAR>(C, qr, PAb + (br ? CK_WIN : CK_SLC), PAb + (br ? CV_WIN : CV_SLC), NPA, mask, m2, l2, o2, BiasUni<0>{&C, tb, u, sel, br}); float sk = ((o2[0][0] + o2[1][0]) + (o2[2][0] + o2[3][0])) + l2 + m2; asm volatile("" :: "v"(sk)); }
#endif
            ++br; asm volatile("" : "+s"(br));
        } while (br < 2);
    }
    if (PASS_MASK & 2) for (;;) {
        const int q = dequeue(lds, qhead + 64, C.tid); if (q >= 256) break;
        const int qb = 7 - (q >> 5), b = (q >> 2) & 7, h = q & 3;
        C.qlo = 256 * qb + 32 * C.wid; C.trow = C.qlo + C.r32;
        const size_t tok = (size_t)b * T + C.trow;
        bf16x8 qr[8]; load_q(qr, Tn.PA + tok * NPA + CQ_FOX + h * HD, Tn.fox_q_g, C.hi);
        { LAS float* cl = (LAS float*)(lds + L_CUM); const float* cg = Tn.CUM + (size_t)(b * 4 + h) * T;
          for (int i = C.tid; i < 256 * (qb + 1); i += 512) cl[i] = -cg[i] * LOG2E; }
        const bf16_t* PAb = Tn.PA + (size_t)b * T * NPA + h * HD;
        const unsigned mask = qb == 7 ? 0xffffffffu : ((1u << (4 * qb + 4)) - 1u);
        f32x16 o[4] = {}; float m_reg = -1e30f, l_reg = 0.f;
        stream(C, qr, PAb + CK_FOX, PAb + CV_FOX, NPA, mask, m_reg, l_reg, o, BiasUni<1>{&C, nullptr, 0, 0u, 2});
        float w[16]; bcast_rows(w, l_reg > 0.f ? 1.f / l_reg : 0.f, ws, C.r32, C.hi);
        store_o(o, w, Tn.OC + ((size_t)b * T + C.qlo) * D + 1024 + h * HD, D, lds, C.wid, C.lane, false);
#if DBL_STREAM
        { f32x16 o2[4] = {}; float m2 = -1e30f, l2 = 0.f; stream<DBL_VAR>(C, qr, PAb + CK_FOX, PAb + CV_FOX, NPA, mask, m2, l2, o2, BiasUni<1>{&C, nullptr, 0, 0u, 2}); float sk = ((o2[0][0] + o2[1][0]) + (o2[2][0] + o2[3][0])) + l2 + m2; asm volatile("" :: "v"(sk)); }
#endif
        conv_some(F, lds, qhead + 192, 6);
    }
    if (PASS_MASK & 4) for (;;) {
        const int q = dequeue(lds, qhead + 128, C.tid); if (q >= 256) break;
        const int qb = q & 7, h = (q >> 3) & 3, b = q >> 5;
        C.qlo = 256 * qb + 32 * C.wid; C.trow = C.qlo + C.r32;
        const size_t tok = (size_t)b * T + C.trow;
        bf16x8 qr[8]; load_q(qr, Tn.PA + tok * NPA + CQ_MEM + h * HD, Tn.mem_q_g, C.hi);
        const bf16_t* Kb = Tn.KVM + (size_t)b * MEMT * 1024 + h * HD;
        f32x16 o[4] = {}; float m_reg = -1e30f, l_reg = 0.f;
        stream(C, qr, Kb, Kb + 512, 1024, 0xfu, m_reg, l_reg, o, BiasUni<2>{&C, nullptr, 0, 0u, 3});
        float w[16]; bcast_rows(w, l_reg > 0.f ? 1.f / l_reg : 0.f, ws, C.r32, C.hi);
        store_o(o, w, Tn.OC + ((size_t)b * T + C.qlo) * D + 1536 + h * HD, D, lds, C.wid, C.lane, false);
#if DBL_STREAM
        { f32x16 o2[4] = {}; float m2 = -1e30f, l2 = 0.f; stream<DBL_VAR>(C, qr, Kb, Kb + 512, 1024, 0xfu, m2, l2, o2, BiasUni<2>{&C, nullptr, 0, 0u, 3}); float sk = ((o2[0][0] + o2[1][0]) + (o2[2][0] + o2[3][0])) + l2 + m2; asm volatile("" :: "v"(sk)); }
#endif
        conv_some(F, lds, qhead + 192, 2);
    }
    if (!CONV_IN_P0) for (;;) {
        if (F.tid == 0) *(LAS int*)(lds + L_Q) = (int)__hip_atomic_fetch_add(qhead + 192, 8u, RLX_AGENT);
        __syncthreads();
        const int base = *(const LAS int*)(lds + L_Q);
        __syncthreads();
        if (base >= 3 * 65 * 64) break;
        conv_batch(F, base, base + 8);
    }
}
#undef KSWZ
#undef SBAR
}

__device__ __forceinline__ void p0_prologue(Frame& F) {
    LAS float* scr = (LAS float*)(F.lds + 40960 + F.wave * 8704);
    unsigned char* ws = F.ws; const int lane = F.lane;
    if (F.gw < 128) { const int kv = F.gw >> 6, j = F.gw & 63; const float* pe = F.in(kv ? I_PE_V : I_PE_K) + 64 * j; const float* w = F.in(kv ? I_W_CV : I_W_CK) + (size_t)64 * j * 128; float a0 = 0.f, a1 = 0.f;
#pragma unroll 16
        for (int k = 0; k < 64; ++k) { const float p = pe[k]; a0 += p * w[(size_t)k * 128 + lane]; a1 += p * w[(size_t)k * 128 + 64 + lane]; }
        float* cb = (float*)(ws + WS_CBIAS) + (size_t)(kv * 64 + j) * 128; cb[lane] = a0; cb[64 + lane] = a1; }
    constexpr int S0 = 32 * 8, S1 = S0 + 64;
    bf16_t* WinT = (bf16_t*)(ws + WS_WINT);
    for (int it = F.gw; it < S1; it += F.NGW) {
        if (it < S0) { }
        else {
            const int r = it - S0, kb = r >> 1, nb = r & 1, k0 = 64 * kb, n0 = 32 * nb; const float* W = F.in(I_W_ROUTER);
#pragma unroll 8
            for (int i = 0; i < 32; ++i) { const int kk = 2 * i + (lane >> 5); scr[kk * 33 + (lane & 31)] = W[(size_t)(k0 + kk) * NE + n0 + (lane & 31)]; }
            LDS_WAIT(); asm volatile("" ::: "memory");
            const int c8 = lane & 7; bf16_t* Whi = (bf16_t*)(ws + WS_WRT); bf16_t* Wlo = Whi + (size_t)NE * D;
#pragma unroll
            for (int j = 0; j < 4; ++j) { const int n = (lane >> 3) + 8 * j; const LAS float* s = scr + (8 * c8) * 33 + n; unsigned h[4], l[4];
#pragma unroll
                for (int q = 0; q < 4; ++q) { const float a = s[(2 * q) * 33], b = s[(2 * q + 1) * 33]; h[q] = cvtpk(a, b); l[q] = cvtpk(a - bf_lo(h[q]), b - bf_hi(h[q])); }
                *(u32x4*)(Whi + (size_t)(n0 + n) * D + k0 + 8 * c8) = (u32x4){h[0], h[1], h[2], h[3]};
                *(u32x4*)(Wlo + (size_t)(n0 + n) * D + k0 + 8 * c8) = (u32x4){l[0], l[1], l[2], l[3]}; }
            LDS_WAIT(); asm volatile("" ::: "memory");
        }
    }
    {
        LAS unsigned* T32 = (LAS unsigned*)F.lds;
        int t = blockIdx.x; f32x4 v[8]; Tr8Desc d = tr8w_decode(F, t < TR8W_NTILES ? t : 0);
        if (t < TR8W_NTILES) tr8_load(d, v, F.wave, lane);
        while (t < TR8W_NTILES) {
            tr8_to_lds(v, d.scale, T32, F.wave, lane);
            __syncthreads();
            const int tn = t + F.G; const Tr8Desc dn = tr8w_decode(F, tn < TR8W_NTILES ? tn : 0);
            if (tn < TR8W_NTILES) tr8_load(dn, v, F.wave, lane);
            tr8_from_lds(d, T32, F.wave, lane);
            __syncthreads();
            t = tn; d = dn;
        }
    }
    {
        LAS unsigned* T32 = (LAS unsigned*)F.lds;
        constexpr int NT0 = TR_FIRST_EXPERT;
        int t = blockIdx.x; f32x4 v[8]; TrDesc d = tr_decode(F, t < NT0 ? t : 0);
        if (t < NT0) tr_load(d, v, F.wave, lane);
        while (t < NT0) {
            tr_to_lds(v, T32, F.wave, lane);
            __syncthreads();
            const int tn = t + F.G; const TrDesc dn = tr_decode(F, tn < NT0 ? tn : 0);
            if (tn < NT0) tr_load(dn, v, F.wave, lane);
            tr_from_lds(d, T32, F.wave, lane);
            __syncthreads();
            t = tn; d = dn;
        }
    }
    if (CONV_IN_P0) { __syncthreads(); for (int base = blockIdx.x * 8; base < 3 * 65 * 64; base += F.G * 8) conv_batch(F, base, base + 8); }
    __syncthreads();
    bf16_t* A3 = (bf16_t*)(ws + WS_A3); unsigned char* H8 = ws + WS_H8;
    {
        constexpr int TSTR = 4096 + 16;
        LAS unsigned char* tile = F.lds; LAS float* red = (LAS float*)(F.lds + 16 * TSTR);
        const int w = F.wave, fr = lane & 15, fq = lane >> 4;
        bf16x8 Bf[8][2];
        { const float* W = F.in(I_W_IN);
#pragma unroll
          for (int c = 0; c < 8; ++c)
#pragma unroll
              for (int hf = 0; hf < 2; ++hf) { const int j = fr + 16 * hf, sc = j < 24 ? 2560 + j : (j < 28 ? 4120 + (j - 24) : -1); const float* p = W + (size_t)(256 * w + 32 * c + 8 * fq) * W_IN_COLS + (sc >= 0 ? sc : 0);
                  float x[8];
#pragma unroll
                  for (int e = 0; e < 8; ++e) x[e] = sc >= 0 ? p[(size_t)e * W_IN_COLS] : 0.f;
                  u32x4 pk = {cvtpk(x[0], x[1]), cvtpk(x[2], x[3]), cvtpk(x[4], x[5]), cvtpk(x[6], x[7])}; Bf[c][hf] = __builtin_bit_cast(bf16x8, pk); } }
        const float* X = F.in(I_X); const float* gain = F.in(I_NORM_ATTN_G); float* GLp = (float*)(ws + WS_GL);
        for (int m0 = blockIdx.x * 16; m0 < M; m0 += F.G * 16) {
#pragma unroll
            for (int r = 0; r < 2; ++r) { const int m = m0 + 2 * w + r; const float* xrow = X + (size_t)m * D;
                f32x4 v[8]; float ss = 0.f;
#pragma unroll
                for (int j = 0; j < 8; ++j) { v[j] = *(const f32x4*)(xrow + 4 * lane + 256 * j); ss += (v[j].x * v[j].x + v[j].y * v[j].y) + (v[j].z * v[j].z + v[j].w * v[j].w); }
                const float rstd = __builtin_amdgcn_rsqf(wave_sum(ss) * (1.f / D) + RMS_EPS);
#pragma unroll
                for (int j = 0; j < 8; ++j) { const f32x4 g = *(const f32x4*)(gain + 4 * lane + 256 * j); const float a = v[j].x * rstd * g.x, b = v[j].y * rstd * g.y, c = v[j].z * rstd * g.z, d = v[j].w * rstd * g.w;
                    u32x2 o; o.x = cvtpk(a, b); o.y = cvtpk(c, d);
                    *(LAS u32x2*)(tile + (2 * w + r) * TSTR + (4 * lane + 256 * j) * 2) = o;
                    if (NB16 > 0) *(u32x2*)(A3 + (size_t)m * D + 4 * lane + 256 * j) = o;
                    *(unsigned*)(H8 + (size_t)m * D + 4 * lane + 256 * j) = pk_fp8x4(a, b, c, d); } }
            __syncthreads();
            f32x4 a0 = {0.f, 0.f, 0.f, 0.f}, a1 = {0.f, 0.f, 0.f, 0.f};
#pragma unroll
            for (int c = 0; c < 8; ++c) { const bf16x8 af = *(const LAS bf16x8*)(tile + fr * TSTR + (256 * w + 32 * c + 8 * fq) * 2);
                a0 = __builtin_amdgcn_mfma_f32_16x16x32_bf16(af, Bf[c][0], a0, 0, 0, 0); a1 = __builtin_amdgcn_mfma_f32_16x16x32_bf16(af, Bf[c][1], a1, 0, 0, 0); }
#pragma unroll
            for (int r = 0; r < 4; ++r) { red[(w * 16 + 4 * fq + r) * 32 + fr] = a0[r]; red[(w * 16 + 4 * fq + r) * 32 + 16 + fr] = a1[r]; }
            __syncthreads();
            { const int row = F.tid >> 5, col = F.tid & 31; float sacc = 0.f;
#pragma unroll
              for (int ww = 0; ww < 8; ++ww) sacc += red[(ww * 16 + row) * 32 + col];
              GLp[(size_t)(m0 + row) * LDG + col] = sacc; }
            asm volatile("s_waitcnt vmcnt(0) lgkmcnt(0)" ::: "memory");
            __syncthreads();
        }
        for (int m = M + F.gw; m < M + MROWS; m += F.NGW) rms_row_bf16(F.in(I_MEM) + (size_t)(m - M) * D, F.in(I_NORM_MEM_G), A3 + (size_t)m * D, lane);
    }
}

__device__ __forceinline__ void p2_thin(Frame& F) {
    unsigned char* ws = F.ws; const int lane = F.lane;
    bf16_t* PA = (bf16_t*)(ws + WS_PA); bf16_t* KVM = (bf16_t*)(ws + WS_KVMEM); const float* GL = (const float*)(ws + WS_GL);
    {
        LAS float* part = (LAS float*)F.lds;
        LAS float* red = (LAS float*)(F.lds + 65536);
        const int i16 = lane & 15, kg = lane >> 4, w = F.wave;
        for (int item = blockIdx.x; item < 128; item += F.G) {
            const int kv = item & 1, rt2 = (item >> 1) & 3, bg = item >> 3, b = bg >> 1, g = bg & 1;
            const int n0 = 32 * rt2 + i16, n1 = n0 + 16, ne0 = n0 < 127 ? n0 : 126, ne1 = n1 < 127 ? n1 : 126;
            const bf16_t* Ab0 = PA + ((size_t)(b * T + 16 * ne0 + 4 * w) * NPA + (kv ? CV_CMP : CK_CMP) + g * HD) + 8 * kg;
            const bf16_t* Ab1 = PA + ((size_t)(b * T + 16 * ne1 + 4 * w) * NPA + (kv ? CV_CMP : CK_CMP) + g * HD) + 8 * kg;
            const bf16_t* Bb = (const bf16_t*)(ws + (kv ? WS_WCV : WS_WCK)) + (size_t)i16 * 4096 + 512 * w + 8 * kg;
            f32x4 acc2[2][8];
#pragma unroll
            for (int nt = 0; nt < 8; ++nt) { acc2[0][nt] = (f32x4){0.f, 0.f, 0.f, 0.f}; acc2[1][nt] = (f32x4){0.f, 0.f, 0.f, 0.f}; }
#pragma unroll 2
            for (int s = 0; s < 16; ++s) { const bf16x8 a0 = *(const bf16x8*)(Ab0 + (size_t)(s >> 2) * NPA + 32 * (s & 3)), a1 = *(const bf16x8*)(Ab1 + (size_t)(s >> 2) * NPA + 32 * (s & 3));
#pragma unroll
                for (int nt = 0; nt < 8; ++nt) { const bf16x8 bb = *(const bf16x8*)(Bb + (size_t)nt * 16 * 4096 + 32 * s);
                    acc2[0][nt] = __builtin_amdgcn_mfma_f32_16x16x32_bf16(a0, bb, acc2[0][nt], 0, 0, 0); acc2[1][nt] = __builtin_amdgcn_mfma_f32_16x16x32_bf16(a1, bb, acc2[1][nt], 0, 0, 0); } }
#pragma unroll
          for (int hh = 0; hh < 2; ++hh) { const int rt = 2 * rt2 + hh;
            __syncthreads();
#pragma unroll
            for (int nt = 0; nt < 8; ++nt) *(LAS f32x4*)(part + ((w * 8 + nt) * 64 + lane) * 4) = acc2[hh][nt];
            __syncthreads();
            f32x4 t = {0.f, 0.f, 0.f, 0.f};
#pragma unroll
            for (int ww = 0; ww < 8; ++ww) t += *(const LAS f32x4*)(part + ((ww * 8 + w) * 64 + lane) * 4);
            const int e = 16 * w + i16; float cb = 0.f;
#pragma unroll 16
            for (int j = 0; j < 64; ++j) cb += ((const float*)(ws + WS_CBIAS))[(size_t)(kv * 64 + j) * 128 + e];
#pragma unroll
            for (int r = 0; r < 4; ++r) t[r] += cb;
            float scl[4] = {1.f, 1.f, 1.f, 1.f};
            if (kv == 0) {
#pragma unroll
                for (int r = 0; r < 4; ++r) { float q = t[r] * t[r]; q += __shfl_xor(q, 1); q += __shfl_xor(q, 2); q += __shfl_xor(q, 4); q += __shfl_xor(q, 8); if (i16 == 0) red[w * 16 + 4 * kg + r] = q; }
            }
            __syncthreads();
            if (kv == 0) { const float kgain = F.in(I_NSA_K_G)[e];
#pragma unroll
                for (int r = 0; r < 4; ++r) { float q = 0.f;
#pragma unroll
                    for (int ww = 0; ww < 8; ++ww) q += red[ww * 16 + 4 * kg + r];
                    scl[r] = __builtin_amdgcn_rsqf(q * (1.f / HD) + RMS_EPS) * kgain; } }
            bf16_t* Ob = (bf16_t*)(ws + (kv ? WS_VC : WS_KC)) + (size_t)bg * 128 * HD;
#pragma unroll
            for (int r = 0; r < 4; ++r) { const int nn = 16 * rt + 4 * kg + r; const float v = nn < 127 ? t[r] * scl[r] : 0.f; Ob[(size_t)nn * HD + e] = (bf16_t)(cvtpk(v, 0.f) & 0xffffu); }
          }
        }
    }
    const int g0 = F.G >= 256 ? 128 * 8 : 0, gwa = F.gw - g0, ngwa = F.NGW - g0;
    if (gwa < 0) return;
#pragma unroll 2
    for (int row = gwa; row < M; row += ngwa) {
        const int hd = lane >> 3, col = (hd < 2 ? CK_SLC + hd * HD : (hd < 4 ? CK_WIN + (hd - 2) * HD : CK_FOX + (hd - 4) * HD)) + (lane & 7) * 16;
        bf16_t* p = PA + (size_t)row * NPA + col; const u32x4 r0 = *(const u32x4*)p, r1 = *(const u32x4*)(p + 8);
        float ss = 0.f;
#pragma unroll
        for (int e = 0; e < 4; ++e) { ss += bf_lo(r0[e]) * bf_lo(r0[e]) + bf_hi(r0[e]) * bf_hi(r0[e]) + bf_lo(r1[e]) * bf_lo(r1[e]) + bf_hi(r1[e]) * bf_hi(r1[e]); }
        ss += __shfl_xor(ss, 1); ss += __shfl_xor(ss, 2); ss += __shfl_xor(ss, 4);
        const float rstd = __builtin_amdgcn_rsqf(ss * (1.f / HD) + RMS_EPS); const float* gn = F.in(hd < 4 ? I_NSA_K_G : I_FOX_K_G) + (lane & 7) * 16;
        u32x4 o0, o1;
#pragma unroll
        for (int e = 0; e < 4; ++e) { o0[e] = cvtpk(bf_lo(r0[e]) * rstd * gn[2 * e], bf_hi(r0[e]) * rstd * gn[2 * e + 1]); o1[e] = cvtpk(bf_lo(r1[e]) * rstd * gn[8 + 2 * e], bf_hi(r1[e]) * rstd * gn[8 + 2 * e + 1]); }
        *(u32x4*)p = o0; *(u32x4*)(p + 8) = o1;
    }
    for (int mr = gwa; mr < MROWS; mr += ngwa) {
        bf16_t* p = KVM + (size_t)mr * 1024 + (lane >> 4) * HD + (lane & 15) * 8; const u32x4 r0 = *(const u32x4*)p; float ss = 0.f;
#pragma unroll
        for (int e = 0; e < 4; ++e) ss += bf_lo(r0[e]) * bf_lo(r0[e]) + bf_hi(r0[e]) * bf_hi(r0[e]);
        ss += __shfl_xor(ss, 1); ss += __shfl_xor(ss, 2); ss += __shfl_xor(ss, 4); ss += __shfl_xor(ss, 8);
        const float rstd = __builtin_amdgcn_rsqf(ss * (1.f / HD) + RMS_EPS); const float* gn = F.in(I_MEM_K_G) + (lane & 15) * 8; u32x4 o0;
#pragma unroll
        for (int e = 0; e < 4; ++e) o0[e] = cvtpk(bf_lo(r0[e]) * rstd * gn[2 * e], bf_hi(r0[e]) * rstd * gn[2 * e + 1]);
        *(u32x4*)p = o0;
    }
    for (int seq = gwa; seq < 32; seq += ngwa) {
        const int b = seq >> 2, h = seq & 3; const float bf = F.in(I_FOX_B_F)[h]; float v[32]; float run = 0.f;
#pragma unroll
        for (int i = 0; i < 32; ++i) { const float x = GL[(size_t)(b * T + 32 * lane + i) * LDG + 24 + h] + bf;
            const float ls = fminf(x, 0.f) - log1pf(__expf(-fabsf(x))); run += ls; v[i] = run; }
        float incl = run;
#pragma unroll
        for (int o = 1; o < 64; o <<= 1) { const float t = __shfl_up(incl, o); if (lane >= o) incl += t; }
        const float excl = incl - run; float* cp = (float*)(ws + WS_CUM) + (size_t)seq * T + 32 * lane;
#pragma unroll
        for (int i = 0; i < 32; ++i) cp[i] = v[i] + excl;
    }
}

constexpr int CW_COARSE = 16384;
constexpr int P6_WSTR = 136;
constexpr int P6_WBUF = 2 * 64 * P6_WSTR * 2;
static_assert(2 * P6_WBUF <= RING_BYTES, "P6 chunk buffers inside the ring region");
__device__ __forceinline__ void p6_router(Frame& F) {
    unsigned char* ws = F.ws; const int lane = F.lane, i16 = lane & 15, kg = lane >> 4, row = i16 & 7;
    unsigned char* H2 = (unsigned char*)(ws + WS_A3); const bf16_t* X1 = (const bf16_t*)(ws + WS_X1B); const float* gain = F.in(I_NORM_FFN_G);
    const bf16_t* Wg = (const bf16_t*)(ws + WS_WRT);
    const float rb = F.in(I_ROUTER_BIAS)[lane];
    unsigned* coarse = (unsigned*)(ws + WS_CTL) + CW_COARSE;
    if (F.gw == 0) {
#pragma unroll
        for (int q = 0; q < 2; ++q) *(u32x4*)(H2 + (size_t)M * D + 32 * lane + 16 * q) = (u32x4){0u, 0u, 0u, 0u}; }
    for (int item = blockIdx.x; item < M / 64; item += F.G) {
        const int tok0 = item * 64 + F.wave * 8;
        float myr = 0.f;
#pragma unroll 2
        for (int i = 0; i < 8; ++i) { const bf16_t* xr = X1 + (size_t)(tok0 + i) * D; float ss = 0.f;
#pragma unroll
            for (int j = 0; j < 4; ++j) { const u32x4 v = *(const u32x4*)(xr + 8 * lane + 512 * j);
#pragma unroll
                for (int e = 0; e < 4; ++e) ss += bf_lo(v[e]) * bf_lo(v[e]) + bf_hi(v[e]) * bf_hi(v[e]); }
            const float r = __builtin_amdgcn_rsqf(wave_sum(ss) * (1.f / D) + RMS_EPS); if (row == i) myr = r; }
        f32x4 acc[4] = {{0.f, 0.f, 0.f, 0.f}, {0.f, 0.f, 0.f, 0.f}, {0.f, 0.f, 0.f, 0.f}, {0.f, 0.f, 0.f, 0.f}};
        const bf16_t* xr = X1 + (size_t)(tok0 + row) * D + 8 * kg; unsigned char* hr = H2 + (size_t)(tok0 + row) * D + 8 * kg;
        u32x4 wst[4];
#define P6_LOADW(ch) do { _Pragma("unroll") for (int i = 0; i < 4; ++i) { const int p = F.tid + 512 * i; wst[i] = *(const u32x4*)(Wg + (size_t)(p >> 4) * D + 128 * (ch) + 8 * (p & 15)); } } while (0)
#define P6_STOREW(bf) do { _Pragma("unroll") for (int i = 0; i < 4; ++i) { const int p = F.tid + 512 * i; *(LAS u32x4*)(F.lds + (bf) * P6_WBUF + ((p >> 4) * P6_WSTR + 8 * (p & 15)) * 2) = wst[i]; } } while (0)
        P6_LOADW(0);
        __syncthreads();
        P6_STOREW(0);
        __syncthreads();
        for (int ch = 0; ch < 16; ++ch) {
            if (ch < 15) P6_LOADW(ch + 1);
            const LAS unsigned char* wb = F.lds + (ch & 1) * P6_WBUF + (i16 * P6_WSTR + 8 * kg) * 2;
#pragma unroll 2
            for (int s = 0; s < 4; ++s) { const int k = 128 * ch + 32 * s;
                const u32x4 xb = *(const u32x4*)(xr + k); const f32x4 g0 = *(const f32x4*)(gain + k + 8 * kg), g1 = *(const f32x4*)(gain + k + 8 * kg + 4);
                const float xn[8] = {bf_lo(xb.x) * myr * g0.x, bf_hi(xb.x) * myr * g0.y, bf_lo(xb.y) * myr * g0.z, bf_hi(xb.y) * myr * g0.w, bf_lo(xb.z) * myr * g1.x, bf_hi(xb.z) * myr * g1.y, bf_lo(xb.w) * myr * g1.z, bf_hi(xb.w) * myr * g1.w};
                u32x4 h, l;
#pragma unroll
                for (int q = 0; q < 4; ++q) { h[q] = cvtpk(xn[2 * q], xn[2 * q + 1]); l[q] = cvtpk(xn[2 * q] - bf_lo(h[q]), xn[2 * q + 1] - bf_hi(h[q])); }
                if (i16 < 8) *(u32x2*)(hr + k) = (u32x2){pk_fp8x4(xn[0], xn[1], xn[2], xn[3]), pk_fp8x4(xn[4], xn[5], xn[6], xn[7])};
                const bf16x8 ah = __builtin_bit_cast(bf16x8, h), al = __builtin_bit_cast(bf16x8, l);
#pragma unroll
                for (int nt = 0; nt < 4; ++nt) { const LAS unsigned char* wp = wb + (16 * nt * P6_WSTR + 32 * s) * 2;
                    const bf16x8 bh = *(const LAS bf16x8*)wp, bl = *(const LAS bf16x8*)(wp + 64 * P6_WSTR * 2);
                    acc[nt] = __builtin_amdgcn_mfma_f32_16x16x32_bf16(ah, bh, acc[nt], 0, 0, 0);
                    acc[nt] = __builtin_amdgcn_mfma_f32_16x16x32_bf16(al, bh, acc[nt], 0, 0, 0);
                    acc[nt] = __builtin_amdgcn_mfma_f32_16x16x32_bf16(ah, bl, acc[nt], 0, 0, 0); }
            }
            if (ch < 15) P6_STOREW((ch + 1) & 1);
            __syncthreads();
        }
#undef P6_LOADW
#undef P6_STOREW
        LAS float* lg = (LAS float*)(F.lds + F.wave * 4096);
        if (kg < 2) {
#pragma unroll
            for (int nt = 0; nt < 4; ++nt)
#pragma unroll
                for (int r = 0; r < 4; ++r) lg[(4 * kg + r) * 64 + 16 * nt + i16] = acc[nt][r]; }
        LDS_WAIT(); asm volatile("" ::: "memory");
        int cnt = 0;
        u32x2* asg = (u32x2*)(ws + WS_ASG);
        for (int tt = 0; tt < 8; ++tt) {
            const float sc = 1.f / (1.f + __expf(-lg[tt * 64 + lane])); const float key = sc + rb;
            lg[512 + lane] = key; LDS_WAIT(); asm volatile("" ::: "memory");
            int rank = 0;
#pragma unroll
            for (int q = 0; q < 16; ++q) { const f32x4 kk = *(const LAS f32x4*)(lg + 512 + 4 * q);
#pragma unroll
                for (int e = 0; e < 4; ++e) { const int eo = 4 * q + e; rank += (kk[e] > key || (kk[e] == key && eo < lane)) ? 1 : 0; } }
            LDS_WAIT(); asm volatile("" ::: "memory");
            const bool selx = rank < TOPK;
            const float ssum = wave_sum(selx ? sc : 0.f);
            const unsigned long long bal = __ballot(selx);
            if (selx) { const int k = __popcll(bal & ((1ull << lane) - 1ull));
                asg[(size_t)(tok0 + tt) * TOPK + k] = (u32x2){(unsigned)lane | ((unsigned)cnt << 8), __float_as_uint(sc / ssum * 2.5f)}; ++cnt; }
        }
        const int wi = item * 8 + F.wave;
        ((int*)(ws + WS_HIST))[wi * 64 + lane] = cnt;
        __hip_atomic_fetch_add(coarse + (wi >> 5) * 64 + lane, (unsigned)cnt, RLX_AGENT);
    }
}
__device__ __forceinline__ void p7_slots(Frame& F) {
    unsigned char* ws = F.ws; const int lane = F.lane;
    const int* hist = (const int*)(ws + WS_HIST); const u32x2* asg = (const u32x2*)(ws + WS_ASG); const unsigned* coarse = (const unsigned*)(ws + WS_CTL) + CW_COARSE;
    int* rowasg = (int*)(ws + WS_ROWASG); int* rowtok = (int*)(ws + WS_ROWTOK); float* rowg = (float*)(ws + WS_ROWG);
    for (int wi = F.gw; wi < M / 8; wi += F.NGW) {
        const int grp = wi >> 5; int base = 0, total = 0;
#pragma unroll 8
        for (int g = 0; g < 64; ++g) { const int cv = (int)coarse[g * 64 + lane]; total += cv; base += g < grp ? cv : 0; }
        for (int i = grp * 32; i < wi; ++i) base += hist[i * 64 + lane];
        const int padded = (total + 255) & ~255;
        int incl = padded;
#pragma unroll
        for (int o = 1; o < 64; o <<= 1) { const int t = __shfl_up(incl, o); if (lane >= o) incl += t; }
        const int pstart = incl - padded, rtot = __shfl(incl, 63);
        const int my = pstart + base;
        { const int tok = wi * 8 + (lane >> 3), k = lane & 7; const u32x2 rec = asg[(size_t)tok * TOPK + k];
          const int e = rec.x & 255, rl = rec.x >> 8; const int dest = __shfl(my, e) + rl;
          rowasg[dest] = tok * ASG_PER_TOK + k; rowtok[dest] = tok; rowg[dest] = __uint_as_float(rec.y); }
        if (lane < 8) { const int tok = wi * 8 + lane, dest = rtot + tok; rowasg[dest] = tok * ASG_PER_TOK + 8; rowtok[dest] = tok; rowg[dest] = 1.f; }
        if (wi == 0) { for (int sl = pstart + total; sl < pstart + padded; ++sl) { rowasg[sl] = -1; rowtok[sl] = M; rowg[sl] = 0.f; }
                       ((int*)(ws + WS_CNT))[lane] = total; }
    }
}
__device__ __forceinline__ int build_blocks(Frame& F, LAS unsigned char* blk_e, LAS int* tmp) {
    const int* cnt = (const int*)(F.ws + WS_CNT);
    if (F.tid < NEX) tmp[F.tid] = F.tid < NE ? (cnt[F.tid] + 255) >> 8 : M / 256;
    __syncthreads();
    if (F.tid < NEX) { int st = 0; for (int e = 0; e < F.tid; ++e) st += tmp[e]; const int nb = tmp[F.tid]; for (int i = 0; i < nb; ++i) blk_e[st + i] = (unsigned char)F.tid; if (F.tid == NEX - 1) tmp[NEX] = st + nb; }
    __syncthreads();
    return tmp[NEX];
}
__device__ __forceinline__ void p10_combine(Frame& F) {
    const unsigned char* Y = (const unsigned char*)(F.ws + WS_Y); float* O = F.out; const bf16_t* X1 = (const bf16_t*)(F.ws + WS_X1B); const int lane = F.lane;
    for (int tok = F.gw; tok < M; tok += F.NGW) {
#pragma unroll
        for (int c = 0; c < 2; ++c) { const int col = 16 * lane + 1024 * c; float* op = O + (size_t)tok * D + col;
            const u32x4 xa = *(const u32x4*)(X1 + (size_t)tok * D + col), xb = *(const u32x4*)(X1 + (size_t)tok * D + col + 8);
            const f32x4 x0 = {bf_lo(xa.x), bf_hi(xa.x), bf_lo(xa.y), bf_hi(xa.y)}, x1 = {bf_lo(xa.z), bf_hi(xa.z), bf_lo(xa.w), bf_hi(xa.w)}, x2 = {bf_lo(xb.x), bf_hi(xb.x), bf_lo(xb.y), bf_hi(xb.y)}, x3 = {bf_lo(xb.z), bf_hi(xb.z), bf_lo(xb.w), bf_hi(xb.w)};
            u32x4 y[ASG_PER_TOK];
#pragma unroll
            for (int k = 0; k < ASG_PER_TOK; ++k) y[k] = *(const u32x4*)(Y + ((size_t)tok * ASG_PER_TOK + k) * D + col);
            float a[16];
#pragma unroll
            for (int e = 0; e < 16; ++e) a[e] = 0.f;
#pragma unroll
            for (int k = 0; k < ASG_PER_TOK; ++k)
#pragma unroll
                for (int q = 0; q < 4; ++q) { const auto lo = __builtin_amdgcn_cvt_pk_f32_fp8((int)y[k][q], false); const auto hi = __builtin_amdgcn_cvt_pk_f32_fp8((int)y[k][q], true);
                    a[4 * q] += lo[0]; a[4 * q + 1] += lo[1]; a[4 * q + 2] += hi[0]; a[4 * q + 3] += hi[1]; }
            const float r = 1.f / Y_SCALE;
            *(f32x4*)op = (f32x4){x0[0] + a[0] * r, x0[1] + a[1] * r, x0[2] + a[2] * r, x0[3] + a[3] * r};
            *(f32x4*)(op + 4) = (f32x4){x1[0] + a[4] * r, x1[1] + a[5] * r, x1[2] + a[6] * r, x1[3] + a[7] * r};
            *(f32x4*)(op + 8) = (f32x4){x2[0] + a[8] * r, x2[1] + a[9] * r, x2[2] + a[10] * r, x2[3] + a[11] * r};
            *(f32x4*)(op + 12) = (f32x4){x3[0] + a[12] * r, x3[1] + a[13] * r, x3[2] + a[14] * r, x3[3] + a[15] * r}; }
    }
}

constexpr int N_PHASES = 11;
struct Args { const float* in[31]; float* out; unsigned char* ws; int ph_lo, ph_hi, use_bar, pad; };
__global__ void __launch_bounds__(512, 2) mega(Args args) {
    extern __shared__ __attribute__((aligned(16))) unsigned char lds_raw[];
    LAS unsigned char* lds = (LAS unsigned char*)lds_raw;
    Frame F; F.lds = lds; F.tid = threadIdx.x; F.lane = F.tid & 63; F.wave = __builtin_amdgcn_readfirstlane(F.tid >> 6); F.G = gridDim.x;
    F.gw = blockIdx.x * 8 + F.wave; F.NGW = F.G * 8; F.out = args.out; F.ws = args.ws;
    unsigned char* ws = args.ws;
    unsigned* ctl = (unsigned*)(ws + WS_CTL);
    for (int u = F.tid; u < 256; u += 512) ((LAS unsigned*)(lds + LDSCTL_OFF))[u] = 0u;
    __syncthreads();
    XcdBarrier bar; bar.bar = ctl + CW_BAR; bar.x = 0; bar.st = nullptr;
    if (args.use_bar) bar = xcd_barrier_post(ctl + CW_BAR, (volatile LAS unsigned*)(lds + LDSCTL_OFF));
    const int lo = args.ph_lo, hi = args.ph_hi;
#ifndef PH_MASK
#define PH_MASK 0x7ff
#endif
#define IN(k) (((PH_MASK >> (k)) & 1) && lo <= (k) && (k) < hi)
#define SEAM(k) do { if (IN(k) && IN((k) + 1)) xcd_barrier(bar); } while (0)
    const int c = (int)blockIdx.x;
#ifndef REP_PHASE
#define REP_PHASE -1
#endif
#define RUN(k, ...) do { if (IN(k)) { const int rep = 0; (void)rep; __VA_ARGS__ } if (REP_PHASE == (k) && IN(k)) { xcd_barrier(bar); const int rep = 1; (void)rep; __VA_ARGS__ } } while (0)
    RUN(0, p0_prologue(F); ); SEAM(0);
    RUN(1,
        Epi1 E{(bf16_t*)(ws + WS_PA), (unsigned char*)(ws + WS_PG), (float*)(ws + WS_GL), (bf16_t*)(ws + WS_KVMEM)};
        { Sched1 S; S.o.init(64, NB16 ? NB16 : 1); S.A = (const char*)(ws + WS_A3); S.Bt = (const char*)(ws + WS_WINT); S.G = F.G; S.c = c; S.fp8 = 0;
          pg8::gemm_phase<Epi1, Sched1, false, false>(lds, 2 * D, 2 * D, S, E); }
        { Sched1 S; S.o.init(64, 24 + NF8); S.A = (const char*)(ws + WS_H8); S.Bt = (const char*)(ws + WS_WIN8); S.G = F.G; S.c = c; S.fp8 = 1;
          pg8::gemm_phase<Epi1, Sched1, false, true>(lds, D, D, S, E); }
    ); SEAM(1);
    RUN(2, p2_thin(F); ); SEAM(2);
    RUN(3,
        att::Tensors Tn{(const bf16_t*)(ws + WS_PA), (const float*)(ws + WS_GL), (const bf16_t*)(ws + WS_KVMEM), (const bf16_t*)(ws + WS_KC), (const bf16_t*)(ws + WS_VC), (const float*)(ws + WS_CUM),
                        (bf16_t*)(ws + WS_A3), F.in(I_NSA_Q_G), F.in(I_FOX_Q_G), F.in(I_MEM_Q_G), F.in(I_REL_BIAS)};
        att::attn_phase(F, (LAS char*)lds, Tn, ctl + CW_QUEUE + rep * 256);
    ); SEAM(3);
    RUN(4,
        Sched4 S; S.o.init(64, 8); S.A = (const char*)(ws + WS_A3); S.Bt = (const char*)(ws + WS_WOT); S.G = F.G; S.c = c;
        Epi4 E{(const unsigned char*)(ws + WS_PG), (bf16_t*)(ws + WS_PA)};
        pg8::gemm_phase<Epi4, Sched4, false>(lds, 2 * D, 2 * D, S, E);
    ); SEAM(4);
    RUN(5,
        Sched5 S; S.o.init(64, 8); S.A = (const char*)(ws + WS_PA); S.Bt = (const char*)(ws + WS_WOUTT); S.G = F.G; S.c = c;
        Epi5 E{F.in(I_X), (bf16_t*)(ws + WS_X1B)};
        pg8::gemm_phase<Epi5, Sched5, false>(lds, 2 * D, 2 * D, S, E);
    ); SEAM(5);
    RUN(6, p6_router(F); ); SEAM(6);
    RUN(7, p7_slots(F); ); SEAM(7);
    RUN(8,
        LAS unsigned char* blk_e = lds + EPI_OFF; LAS int* tmp = (LAS int*)(lds + EPI_OFF + 1024);
        const int nblk = build_blocks(F, blk_e, tmp);
        SchedMoe S{blk_e, nblk, F.G, c, 2, (const char*)(ws + WS_A3), (const char*)(ws + WS_WGU), (const int*)(ws + WS_ROWTOK), true};
        Epi8 E{(unsigned char*)(ws + WS_PG)};
        pg8::gemm_phase<Epi8, SchedMoe, true, true>(lds, D, D, S, E);
    ); SEAM(8);
    RUN(9,
        LAS unsigned char* blk_e = lds + EPI_OFF; LAS int* tmp = (LAS int*)(lds + EPI_OFF + 1024);
        const int nblk = build_blocks(F, blk_e, tmp);
        SchedMoe S{blk_e, nblk, F.G, c, 3, (const char*)(ws + WS_PG), (const char*)(ws + WS_WD), nullptr, false};
        Epi9 E{(const int*)(ws + WS_ROWASG), (const float*)(ws + WS_ROWG), (unsigned char*)(ws + WS_Y)};
        pg8::gemm_phase<Epi9, SchedMoe, false, true>(lds, DE, DE, S, E);
    ); SEAM(9);
    RUN(10, p10_combine(F); );
#undef RUN
#undef IN
#undef SEAM
}

#ifndef MK_PER_PHASE
#define MK_PER_PHASE 0
#endif
extern "C" void kernel_launch(void* const* d_in, const int* in_sizes, int n_in, void* d_out, int out_size, void* d_ws, size_t ws_size, hipStream_t stream) {
    static int grid = 0;
    if (grid == 0) {
        if (n_in != N_IN || in_sizes[0] != M * D || out_size != M * D || ws_size < WS_END) { fprintf(stderr, "kernel_launch: unexpected shapes (n_in %d, in0 %d, out %d, ws %zu; need ws >= %zu)\n", n_in, n_in > 0 ? in_sizes[0] : -1, out_size, ws_size, (size_t)WS_END); grid = -1; return; }
        int dev = 0, cus = 0, per_cu = 0;
        if (hipGetDevice(&dev) != hipSuccess || hipDeviceGetAttribute(&cus, hipDeviceAttributeMultiprocessorCount, dev) != hipSuccess) { grid = -1; return; }
        if (hipFuncSetAttribute((const void*)mega, hipFuncAttributeMaxDynamicSharedMemorySize, LDS_BYTES) != hipSuccess) { fprintf(stderr, "kernel_launch: hipFuncSetAttribute failed\n"); grid = -1; return; }
        if (hipOccupancyMaxActiveBlocksPerMultiprocessor(&per_cu, (const void*)mega, 512, LDS_BYTES) != hipSuccess || per_cu < 1) fprintf(stderr, "kernel_launch: occupancy query says %d\n", per_cu);
        (void)hipGetLastError();
        grid = cus;
    }
    if (grid < 0) return;
    (void)hipMemsetAsync((char*)d_ws + WS_CTL, 0, CTL_ZERO_BYTES, stream);
    Args a{};
    for (int i = 0; i < 31; ++i) a.in[i] = (const float*)d_in[i];
    a.out = (float*)d_out; a.ws = (unsigned char*)d_ws; a.pad = 0;
#if MK_PER_PHASE
    for (int p = 0; p < N_PHASES; ++p) { a.ph_lo = p; a.ph_hi = p + 1; a.use_bar = 0; hipLaunchKernelGGL(mega, dim3(grid), dim3(512), LDS_BYTES, stream, a); }
#else
    a.ph_lo = 0; a.ph_hi = N_PHASES; a.use_bar = 1; hipLaunchKernelGGL(mega, dim3(grid), dim3(512), LDS_BYTES, stream, a);
#endif
}
```

```cpp
#include <hip/hip_runtime.h>
#include <cstdio>
#include <cstdint>

#define LAS __attribute__((address_space(3)))
#define GAS __attribute__((address_space(1)))
typedef unsigned short bf16_t;
typedef short bf16x8 __attribute__((ext_vector_type(8)));
typedef short s16x4 __attribute__((ext_vector_type(4)));
typedef float f32x2 __attribute__((ext_vector_type(2)));
typedef float f32x4 __attribute__((ext_vector_type(4)));
typedef float f32x16 __attribute__((ext_vector_type(16)));
typedef unsigned u32x2 __attribute__((ext_vector_type(2)));
typedef unsigned u32x4 __attribute__((ext_vector_type(4)));
typedef GAS unsigned gu32;

constexpr int NB = 8, T = 2048, D = 2048, M = NB * T;
constexpr int HD = 128;
constexpr int MEMT = 256, MROWS = NB * MEMT;
constexpr int NE = 64, TOPK = 8, DE = 512, NEX = NE + 1;
constexpr int W_IN_COLS = 10780;
constexpr int NPA = 4608, NPG = 6144, NPAD = 11008;
constexpr int LDG = 32;
constexpr float RMS_EPS = 1e-6f;
constexpr float LOG2E = 1.4426950408889634f;
constexpr float ATTN_SCALE = 0.08838834764831845f;
constexpr int CQ_NSA = 0, CK_CMP = 1024, CV_CMP = 1280, CK_SLC = 1536, CV_SLC = 1792, CK_WIN = 2048, CV_WIN = 2304;
constexpr int CQ_FOX = 2560, CK_FOX = 3072, CV_FOX = 3584, CQ_MEM = 4096;
constexpr int ASG_PER_TOK = 9;
constexpr int MAXSLOT = M * TOPK + NE * 256 + M;

constexpr size_t MiB = 1u << 20;
constexpr size_t WS_CTL = 0, CTL_ZERO_BYTES = 1 * MiB;
constexpr size_t WS_GL = 1 * MiB;
constexpr size_t WS_KVMEM = 3 * MiB;
constexpr size_t WS_KC = 7 * MiB, WS_VC = WS_KC + 512 * 1024;
constexpr size_t WS_CUM = 8 * MiB;
constexpr size_t WS_CBIAS = WS_CUM + 256 * 1024;
constexpr size_t WS_HIST = WS_CUM + 512 * 1024;
constexpr size_t WS_ASG = 9 * MiB;
constexpr size_t WS_ROWASG = 10 * MiB;
constexpr size_t WS_ROWG = 11 * MiB;
constexpr size_t WS_CNT = 12 * MiB;
constexpr size_t WS_WRT = 12 * MiB + 256 * 1024;
constexpr size_t WS_WCK = 13 * MiB, WS_WCV = 14 * MiB;
constexpr size_t WS_WOT = 16 * MiB;
constexpr size_t WS_WOUTT = 24 * MiB;
constexpr size_t WS_WD = 32 * MiB;
constexpr size_t WS_PG = WS_WD + (size_t)NEX * 2 * MiB;
constexpr size_t WS_Y = WS_PG + 192 * MiB;
constexpr size_t WS_WGU = WS_Y;
constexpr size_t WS_WINT = WS_WGU + (size_t)NEX * 4 * MiB;
constexpr size_t WS_PA = WS_WINT + 47 * MiB;
constexpr size_t WS_A3 = WS_PA + 144 * MiB;
constexpr size_t WS_WIN8 = WS_Y + 578 * MiB;
constexpr size_t WS_H8 = WS_WIN8 + 24 * MiB;
constexpr size_t WS_END = WS_H8 + 32 * MiB;
constexpr size_t WS_X1B = WS_PA + 64 * MiB;
static_assert(WS_A3 + (size_t)(M + MROWS) * D * 2 <= WS_Y + 576 * MiB, "ws map");
static_assert((size_t)MAXSLOT * DE * 2 <= 192 * MiB, "hid fits projG");
static_assert((size_t)MAXSLOT * 4 <= 1 * MiB, "row tables");

constexpr int CW_BAR = 4096;
constexpr int CW_QUEUE = 8192;

constexpr int RING_BYTES = 131072;
constexpr int LDSCTL_OFF = RING_BYTES;
constexpr int EPI_OFF = RING_BYTES + 1024;
constexpr int LDS_BYTES = RING_BYTES + 1024 + 8192 + 4096;

#define RLX_AGENT __ATOMIC_RELAXED, __HIP_MEMORY_SCOPE_AGENT
__device__ __forceinline__ unsigned cvtpk(float lo, float hi) { unsigned r; asm volatile("v_cvt_pk_bf16_f32 %0, %1, %2" : "=v"(r) : "v"(lo), "v"(hi)); return r; }
__device__ __forceinline__ float bf_lo(unsigned u) { return __uint_as_float(u << 16); }
__device__ __forceinline__ float bf_hi(unsigned u) { return __uint_as_float(u & 0xffff0000u); }
__device__ __forceinline__ float wave_sum(float v) {
#pragma unroll
    for (int o = 1; o < 64; o <<= 1) v += __shfl_xor(v, o);
    return v;
}
constexpr float WGU_SCALE = 32.f, WD_SCALE = 16.f, WIN_SCALE = 32.f;
__device__ __forceinline__ unsigned pk_fp8x4(float a, float b, float c, float d) { int w = 0; w = __builtin_amdgcn_cvt_pk_fp8_f32(a, b, w, false); w = __builtin_amdgcn_cvt_pk_fp8_f32(c, d, w, true); return (unsigned)w; }
__device__ __forceinline__ float fast_sigmoid(float x) { return __builtin_amdgcn_rcpf(1.f + __builtin_amdgcn_exp2f(-x * LOG2E)); }

#define XB_TMO      128
#define XB_XCNT(j)  (256  + 64 * (j))
#define XB_XSUB(j)  (1280 + 64 * (j))
#define XB_XGEN(j)  (2304 + 64 * (j))
#define XB_TOP      3328
#define XB_TOPGEN   3392
#define XCD_BAR_WORDS 3456
#define XB_SPIN_CAP (1u << 18)
__device__ __forceinline__ unsigned xb_ld(unsigned* p)              { return __hip_atomic_load(p, __ATOMIC_RELAXED, __HIP_MEMORY_SCOPE_AGENT); }
__device__ __forceinline__ unsigned xb_add(unsigned* p, unsigned v) { return __hip_atomic_fetch_add(p, v, __ATOMIC_RELAXED, __HIP_MEMORY_SCOPE_AGENT); }
__device__ __forceinline__ unsigned xb_xcc_id() { return (unsigned)__builtin_amdgcn_s_getreg((3 << 11) | 20) & 0xFu; }
#define XB_SPIN(cond, bar) do { unsigned _sp = 0; while (cond) { __builtin_amdgcn_s_sleep(1); \
    if ((++_sp & 255u) == 0u) { if (xb_ld(&(bar)[XB_TMO])) break; if (_sp > XB_SPIN_CAP) { atomicAdd(&(bar)[XB_TMO], 1u); break; } } } } while (0)
struct XcdBarrier { unsigned* bar; unsigned x; volatile LAS unsigned* st; };
__device__ __forceinline__ XcdBarrier xcd_barrier_post(unsigned* bar, volatile LAS unsigned* st) {
    XcdBarrier b; b.bar = bar; b.x = xb_xcc_id(); b.st = st;
    if (threadIdx.x == 0) (void)xb_add(&bar[XB_XCNT(b.x)], 1u);
    return b;
}
__device__ __forceinline__ void xcd_barrier_complete(unsigned* bar, unsigned x, unsigned& nloc, unsigned& nx) {
    const unsigned G = gridDim.x * gridDim.y * gridDim.z;
    unsigned sum, cnt, mine, sp = 0u;
    for (;;) {
        sum = 0u; cnt = 0u; mine = 0u;
#pragma unroll
        for (unsigned j = 0; j < 16; ++j) { const unsigned c = xb_ld(&bar[XB_XCNT(j)]); sum += c; cnt += (c > 0u) ? 1u : 0u; mine = (j == x) ? c : mine; }
        if (sum == G) break;
        __builtin_amdgcn_s_sleep(1);
        if ((++sp & 255u) == 0u) { if (xb_ld(&bar[XB_TMO])) break; if (sp > XB_SPIN_CAP) { atomicAdd(&bar[XB_TMO], 1u); break; } }
    }
    nloc = mine > 0u ? mine : 1u; nx = cnt > 0u ? cnt : 1u;
}
__device__ __forceinline__ void xcd_barrier(const XcdBarrier& b) {
    asm volatile("s_waitcnt vmcnt(0)" ::: "memory");
    __syncthreads();
    if (threadIdx.x == 0) {
        unsigned* bar = b.bar;
        __builtin_amdgcn_s_waitcnt(0);
        unsigned nloc = b.st[0], nx = b.st[1];
        if (nloc == 0u) { xcd_barrier_complete(bar, b.x, nloc, nx); b.st[0] = nloc; b.st[1] = nx; }
        const unsigned old = xb_add(&bar[XB_XSUB(b.x)], 1u);
        const unsigned gen = old / nloc;
        if (old + 1u == (gen + 1u) * nloc) {
            __builtin_amdgcn_fence(__ATOMIC_RELEASE, "agent");
            asm volatile("s_waitcnt vmcnt(0)" ::: "memory");
            const unsigned og = xb_add(&bar[XB_TOP], 1u);
            const unsigned tg = og / nx;
            if (og + 1u == (tg + 1u) * nx) xb_add(&bar[XB_TOPGEN], 1u);
            else XB_SPIN(xb_ld(&bar[XB_TOPGEN]) == tg, bar);
            __builtin_amdgcn_fence(__ATOMIC_ACQUIRE, "agent");
            xb_add(&bar[XB_XGEN(b.x)], 1u);
            asm volatile("s_waitcnt vmcnt(0)" ::: "memory");
        } else {
            XB_SPIN(xb_ld(&bar[XB_XGEN(b.x)]) == gen, bar);
            __builtin_amdgcn_fence(__ATOMIC_ACQUIRE, "agent");
            asm volatile("s_waitcnt vmcnt(0)" ::: "memory");
        }
    }
    __syncthreads();
}

namespace pg8 {
constexpr int BM = 256, BK = 64, HALF = 128, HTB = HALF * BK * 2, STAGE_BYTES = 8 * HTB, NXCD = 8, WGM = 8;
__host__ __device__ __forceinline__ int lds_byte(int r, int c) { const int st = (r >> 4) * 2 + (c >> 5), rr = r & 15, cc = c & 31, ob = rr * 64 + cc * 2; return st * 1024 + (ob ^ (((ob >> 9) & 1) << 5)); }
__host__ __device__ __forceinline__ void stage_rc(int b, int& R, int& C) { const int st = b / 1024, sb = b % 1024, swz = sb ^ (((sb >> 9) & 1) << 5); R = (st >> 1) * 16 + swz / 64; C = (st & 1) * 32 + (swz % 64) / 2; }
__host__ __device__ __forceinline__ int perm32(int rho) { const int n = rho >> 4, i = rho & 15; return 8 * (i >> 2) + 4 * n + (i & 3); }

template <bool FP8> struct FragSel { struct A4 { bf16x8 f[4][2]; }; struct B2 { bf16x8 f[2][2]; }; };
template <> struct FragSel<true> { typedef int v8i_ __attribute__((ext_vector_type(8))); struct A4 { v8i_ f[4]; }; struct B2 { v8i_ f[2]; }; };
struct Unit { const char* A; const char* B; const int* ridx; int nt, pm, pn, aux; };

template <class Epi, class Sched, bool GATHER, bool FP8 = false>
__device__ __forceinline__ void gemm_phase(LAS unsigned char* lds, const int lda, const int ldb, const Sched& S, const Epi& E) {
    const int tid = threadIdx.x, wid = __builtin_amdgcn_readfirstlane(tid >> 6), lane = tid & 63, wr = wid >> 2, wc = wid & 3, fr = lane & 15, fq = lane >> 4;
    unsigned voffA[2], voffB[2]; int RA[2], CA[2];
#pragma unroll
    for (int i = 0; i < 2; ++i) { int R, C; stage_rc(tid * 16 + i * 8192, R, C); const int Rb = (R & ~31) + perm32(R & 31);
        RA[i] = R; CA[i] = C; voffA[i] = (unsigned)(R * lda + 2 * C); voffB[i] = (unsigned)(Rb * ldb + 2 * C); }
    const size_t kstep = (size_t)(BK * 2);
    const size_t hstepA = (size_t)HALF * lda, hstepB = (size_t)HALF * ldb;
    const unsigned ldsw = (unsigned)wid * 1024u;
    const int aoff = lds_byte(wr * 64 + fr, fq * 8), boff = lds_byte(wc * 32 + fr, fq * 8);
#define PG8_SA(b, h) (((b) * 2 + (h)) * HTB)
#define PG8_SB(b, h) ((4 + (b) * 2 + (h)) * HTB)
#define PG8_STG(bufoff, gptr, v0, v1) do { \
        __builtin_amdgcn_global_load_lds((const unsigned*)((const char*)(gptr) + (v0)), (LAS unsigned*)(lds + (bufoff) + ldsw), 16, 0, 0); \
        __builtin_amdgcn_global_load_lds((const unsigned*)((const char*)(gptr) + (v1)), (LAS unsigned*)(lds + (bufoff) + ldsw + 8192), 16, 0, 0); } while (0)
#define PG8_STB(b, h, kp) PG8_STG(PG8_SB(b, h), (kp) + (h) * hstepB, voffB[0], voffB[1])
#define PG8_STA_CUR(b, h, kp) do { if constexpr (GATHER) PG8_STG(PG8_SA(b, h), (kp), vg[h][0], vg[h][1]); else PG8_STG(PG8_SA(b, h), (kp) + (h) * hstepA, voffA[0], voffA[1]); } while (0)
#define PG8_STA_SEL(b, h, kp) do { if constexpr (GATHER) { const unsigned s0_ = last ? nvg[h][0] : vg[h][0], s1_ = last ? nvg[h][1] : vg[h][1]; PG8_STG(PG8_SA(b, h), (kp), s0_, s1_); } \
        else PG8_STG(PG8_SA(b, h), (kp) + (h) * hstepA, voffA[0], voffA[1]); } while (0)
#define PG8_LD16(off) (*(const LAS u32x4*)(lds + (off)))
#define PG8_LDA(dst, b, h) do { _Pragma("unroll") for (int m = 0; m < 4; ++m) { if constexpr (FP8) { const u32x4 lo_ = PG8_LD16(PG8_SA(b, h) + aoff + m * 2048), hi_ = PG8_LD16(PG8_SA(b, h) + aoff + m * 2048 + 1024); \
            dst.f[m] = __builtin_bit_cast(v8i_, __builtin_shufflevector(lo_, hi_, 0, 1, 2, 3, 4, 5, 6, 7)); } \
        else { _Pragma("unroll") for (int k = 0; k < 2; ++k) dst.f[m][k] = *(const LAS bf16x8*)(lds + PG8_SA(b, h) + aoff + m * 2048 + k * 1024); } } } while (0)
#define PG8_LDB(dst, b, h) do { _Pragma("unroll") for (int n = 0; n < 2; ++n) { if constexpr (FP8) { const u32x4 lo_ = PG8_LD16(PG8_SB(b, h) + boff + n * 2048), hi_ = PG8_LD16(PG8_SB(b, h) + boff + n * 2048 + 1024); \
            dst.f[n] = __builtin_bit_cast(v8i_, __builtin_shufflevector(lo_, hi_, 0, 1, 2, 3, 4, 5, 6, 7)); } \
        else { _Pragma("unroll") for (int k = 0; k < 2; ++k) dst.f[n][k] = *(const LAS bf16x8*)(lds + PG8_SB(b, h) + boff + n * 2048 + k * 1024); } } } while (0)
#define PG8_MMA(ai, bj, At, Bt) do { __builtin_amdgcn_s_setprio(1); _Pragma("unroll") for (int m = 0; m < 4; ++m) _Pragma("unroll") for (int n = 0; n < 2; ++n) { \
        if constexpr (FP8) asm volatile("v_mfma_scale_f32_16x16x128_f8f6f4 %0, %1, %2, %0, %3, %3 op_sel_hi:[0,0,0]" : "+v"(acc[ai][bj][m][n]) : "v"(Bt.f[n]), "v"(At.f[m]), "v"(fp8_one)); \
        else { _Pragma("unroll") for (int k = 0; k < 2; ++k) acc[ai][bj][m][n] = __builtin_amdgcn_mfma_f32_16x16x32_bf16(Bt.f[n][k], At.f[m][k], acc[ai][bj][m][n], 0, 0, 0); } } \
        __builtin_amdgcn_s_setprio(0); } while (0)
#define PG8_WAIT_V(n) asm volatile("s_waitcnt vmcnt(" #n ")" ::: "memory")
#define PG8_WAIT_L(n) asm volatile("s_waitcnt lgkmcnt(" #n ")" ::: "memory")
#define PG8_BAR __builtin_amdgcn_s_barrier()
#define PG8_SCHED __builtin_amdgcn_sched_barrier(0)
#define PG8_LOADIDX(dst, u) do { if constexpr (GATHER) { _Pragma("unroll") for (int h = 0; h < 2; ++h) _Pragma("unroll") for (int i = 0; i < 2; ++i) \
        dst[h][i] = (unsigned)(u).ridx[h * HALF + RA[i]] * (unsigned)lda + (unsigned)(CA[i] * 2); } } while (0)
    Unit cur, nxt; int ui = 0;
    if (!S.next(0, cur)) return;
#define PG8_PIN_ACC() do { _Pragma("unroll") for (int a_ = 0; a_ < 2; ++a_) _Pragma("unroll") for (int b_ = 0; b_ < 2; ++b_) \
        asm volatile("" : "+v"(acc[a_][b_][0][0]), "+v"(acc[a_][b_][0][1]), "+v"(acc[a_][b_][1][0]), "+v"(acc[a_][b_][1][1]), "+v"(acc[a_][b_][2][0]), "+v"(acc[a_][b_][2][1]), "+v"(acc[a_][b_][3][0]), "+v"(acc[a_][b_][3][1])); } while (0)

    f32x4 acc[2][2][4][2];
    E.init(acc, cur, wr, wc, fr, fq);
    typedef int v8i_ __attribute__((ext_vector_type(8)));
    typedef typename pg8::FragSel<FP8>::A4 FragA; typedef typename pg8::FragSel<FP8>::B2 FragB;
    FragA At; FragB B0, B1;
    int fp8_one = 0x7f7f7f7f; if constexpr (FP8) asm volatile("" : "+v"(fp8_one));
    unsigned vg[2][2] = {{0u, 0u}, {0u, 0u}}, nvg[2][2] = {{0u, 0u}, {0u, 0u}};
    const char* cA = cur.A; const char* cB = cur.B;
    PG8_LOADIDX(vg, cur);
    { const bool last = false; (void)last;
      PG8_STB(0, 0, cB); PG8_STB(0, 1, cB); PG8_STA_CUR(0, 0, cA); PG8_STA_CUR(0, 1, cA);
      if (wr == 1) PG8_BAR;
      PG8_WAIT_V(2); PG8_BAR;
      PG8_STB(1, 0, cB + kstep); PG8_STA_CUR(1, 0, cA + kstep); PG8_STB(1, 1, cB + kstep);
      PG8_WAIT_V(6); PG8_BAR; }
    if constexpr (Epi::INIT_LOADS) PG8_PIN_ACC();
    for (;;) {
        const bool has_next = S.next(ui + 1, nxt);
        const char* nA = has_next ? nxt.A : cA; const char* nB = has_next ? nxt.B : cB;
        if constexpr (GATHER) { if (has_next) { PG8_LOADIDX(nvg, nxt); } else { nvg[0][0] = vg[0][0]; nvg[0][1] = vg[0][1]; nvg[1][0] = vg[1][0]; nvg[1][1] = vg[1][1]; } }
        const int nt = cur.nt;
        for (int t = 0; t < nt; t += 2) {
            const bool last = (t == nt - 2);
            const char* a1 = cA + (size_t)(t + 1) * kstep;
            const char* a2 = last ? nA : cA + (size_t)(t + 2) * kstep; const char* b2 = last ? nB : cB + (size_t)(t + 2) * kstep;
            const char* a3 = a2 + kstep; const char* b3 = b2 + kstep;
            PG8_LDB(B0, 0, 0); PG8_LDB(B1, 0, 1); PG8_SCHED; PG8_LDA(At, 0, 0); PG8_STA_CUR(1, 1, a1);
            PG8_WAIT_V(8); PG8_WAIT_L(0); PG8_BAR; PG8_MMA(0, 0, At, B0); PG8_MMA(0, 1, At, B1); PG8_BAR; PG8_SCHED;
            PG8_LDA(At, 0, 1); PG8_STB(0, 0, b2); PG8_STB(0, 1, b2); PG8_STA_SEL(0, 0, a2);
            PG8_WAIT_V(8); PG8_WAIT_L(0); PG8_BAR; PG8_MMA(1, 0, At, B0); PG8_MMA(1, 1, At, B1); PG8_BAR; PG8_SCHED;
            PG8_LDB(B0, 1, 0); PG8_LDB(B1, 1, 1); PG8_SCHED; PG8_LDA(At, 1, 0); PG8_STA_SEL(0, 1, a2);
            PG8_WAIT_V(8); PG8_WAIT_L(0); PG8_BAR; PG8_MMA(0, 0, At, B0); PG8_MMA(0, 1, At, B1); PG8_BAR; PG8_SCHED;
            PG8_LDA(At, 1, 1); PG8_STB(1, 0, b3); PG8_STB(1, 1, b3); PG8_STA_SEL(1, 0, a3);
            PG8_WAIT_V(8); PG8_WAIT_L(0); PG8_BAR; PG8_MMA(1, 0, At, B0); PG8_MMA(1, 1, At, B1); PG8_BAR; PG8_SCHED;
        }
        if (wr == 0) PG8_BAR;
        if constexpr (FP8) { asm volatile("s_nop 15\n\ts_nop 15\n\ts_nop 15" ::: "memory"); PG8_PIN_ACC(); }
        E(acc, cur, wr, wc, fr, fq);
        if (!has_next) break;
        E.init(acc, nxt, wr, wc, fr, fq);
        if constexpr (Epi::INIT_LOADS) PG8_PIN_ACC();
        cur = nxt; cA = nA; cB = nB; ++ui;
        if constexpr (GATHER) { vg[0][0] = nvg[0][0]; vg[0][1] = nvg[0][1]; vg[1][0] = nvg[1][0]; vg[1][1] = nvg[1][1]; }
        if (wr == 1) PG8_BAR;
    }
    PG8_WAIT_V(0);
    PG8_BAR;
#undef PG8_SA
#undef PG8_SB
#undef PG8_STG
#undef PG8_STB
#undef PG8_STA_CUR
#undef PG8_STA_SEL
#undef PG8_LDA
#undef PG8_LD16
#undef PG8_LDB
#undef PG8_MMA
#undef PG8_WAIT_V
#undef PG8_WAIT_L
#undef PG8_BAR
#undef PG8_SCHED
#undef PG8_LOADIDX
#undef PG8_PIN_ACC
}
}

#define EPI_ZERO_INIT static constexpr bool INIT_LOADS = false; __device__ __forceinline__ void init(f32x4 (&acc)[2][2][4][2], const pg8::Unit&, int, int, int, int) const { \
        _Pragma("unroll") for (int a = 0; a < 2; ++a) _Pragma("unroll") for (int b = 0; b < 2; ++b) _Pragma("unroll") for (int m = 0; m < 4; ++m) _Pragma("unroll") for (int n = 0; n < 2; ++n) acc[a][b][m][n] = (f32x4){0.f, 0.f, 0.f, 0.f}; }
constexpr size_t WS_ROWTOK = 15 * MiB;
struct TileOrder {
    int nM, nN, nwg;
    __device__ __forceinline__ void init(int nM_, int nN_) { nM = nM_; nN = nN_; nwg = nM_ * nN_; }
    __device__ __forceinline__ void decode(int L, int& pm, int& pn) const {
        int wgid = L; { const int q = nwg / pg8::NXCD, r = nwg % pg8::NXCD, xcd = wgid % pg8::NXCD, off = wgid / pg8::NXCD; wgid = (xcd < r ? xcd * (q + 1) : r * (q + 1) + (xcd - r) * q) + off; }
        const int nig = pg8::WGM * nN, gid = wgid / nig, fm = gid * pg8::WGM, gsz = (nM - fm) < pg8::WGM ? (nM - fm) : pg8::WGM;
        pm = fm + ((wgid % nig) % gsz); pn = (wgid % nig) / gsz;
    }
};
#ifndef P1_FP8_MASK
#define P1_FP8_MASK 0x3FFFFu
#endif
constexpr unsigned FP8M = P1_FP8_MASK & 0x3ffffu;
constexpr int NF8 = __builtin_popcount(FP8M), NB16 = 18 - NF8;
__device__ __forceinline__ int nth_set(unsigned m, int n) { for (int i = 0; i < n; ++i) m &= m - 1; return __builtin_ctz(m); }
struct Sched1 {
    TileOrder o; const char* A; const char* Bt; int G, c, fp8;
    __device__ __forceinline__ bool next(int i, pg8::Unit& u) const {
        const int L = i * G + c; int pm, pn;
        if (fp8) { constexpr int NT8 = 64 * (24 + NF8), NBU = 64 * NB16 + 32;
            int L8 = L;
            if (NBU < G) { const int RB = NT8 / G, rem = NT8 - RB * G, nfree = G - NBU;
                if (c < NBU) { if (i >= RB - 1) return false; }
                else if (i >= RB) { const int e = (i - RB) * nfree + (c - NBU); if (e >= NBU + rem) return false; L8 = e < NBU ? (RB - 1) * G + e : RB * G + (e - NBU); } }
            if (L8 >= NT8) return false; o.decode(L8, pm, pn);
            u.A = A + (size_t)pm * 256 * D; u.B = Bt + (size_t)pn * 256 * D; u.nt = D / 128; pn = pn < 24 ? pn + 18 : nth_set(FP8M, pn - 24); u.aux = 1; }
        else { if (L < 64 * NB16) { o.decode(L, pm, pn); pn = nth_set(~FP8M & 0x3ffffu, pn); } else if (L < 64 * NB16 + 32) { const int r = L - 64 * NB16; pm = 64 + (r >> 2); pn = 43 + (r & 3); } else return false;
            u.A = A + (size_t)pm * 256 * D * 2; u.B = Bt + (size_t)pn * 256 * D * 2; u.nt = D / 64; u.aux = 0; }
        u.ridx = nullptr; u.pm = pm; u.pn = pn; return true;
    }
};
struct Epi1 {
    EPI_ZERO_INIT
    bf16_t* PA; unsigned char* PG8; float* GL; bf16_t* KVM;
    __device__ __forceinline__ void operator()(const f32x4 (&acc)[2][2][4][2], const pg8::Unit& u, int wr, int wc, int fr, int fq) const {
        const int pn = u.pn; int row0 = u.pm * 256 + wr * 64 + fr;
        if (pn == 42) {
            if (wc == 0) {
#pragma unroll
                for (int ai = 0; ai < 2; ++ai)
#pragma unroll
                    for (int m = 0; m < 4; ++m) { float* p = GL + (size_t)(row0 + ai * 128 + m * 16) * LDG + 8 * fq; *(f32x4*)p = acc[ai][0][m][0]; *(f32x4*)(p + 4) = acc[ai][0][m][1]; }
            }
            return;
        }
        if (pn >= 18 && pn < 42) {
            unsigned char* gb = PG8 + (pn - 18) * 256 + wc * 32 + 8 * fq;
#pragma unroll
            for (int ai = 0; ai < 2; ++ai)
#pragma unroll
                for (int m = 0; m < 4; ++m) { unsigned char* rowp = gb + (size_t)(row0 + ai * 128 + m * 16) * NPG;
                    unsigned wq[2][2];
#pragma unroll
                    for (int bj = 0; bj < 2; ++bj) { const f32x4 v0 = acc[ai][bj][m][0] * (1.f / WIN_SCALE), v1 = acc[ai][bj][m][1] * (1.f / WIN_SCALE); unsigned w0 = 0u, w1 = 0u;
                        w0 = __builtin_amdgcn_cvt_pk_u8_f32(fast_sigmoid(v0[0]) * 255.f, 0, w0); w0 = __builtin_amdgcn_cvt_pk_u8_f32(fast_sigmoid(v0[1]) * 255.f, 1, w0);
                        w0 = __builtin_amdgcn_cvt_pk_u8_f32(fast_sigmoid(v0[2]) * 255.f, 2, w0); w0 = __builtin_amdgcn_cvt_pk_u8_f32(fast_sigmoid(v0[3]) * 255.f, 3, w0);
                        w1 = __builtin_amdgcn_cvt_pk_u8_f32(fast_sigmoid(v1[0]) * 255.f, 0, w1); w1 = __builtin_amdgcn_cvt_pk_u8_f32(fast_sigmoid(v1[1]) * 255.f, 1, w1);
                        w1 = __builtin_amdgcn_cvt_pk_u8_f32(fast_sigmoid(v1[2]) * 255.f, 2, w1); w1 = __builtin_amdgcn_cvt_pk_u8_f32(fast_sigmoid(v1[3]) * 255.f, 3, w1);
                        wq[bj][0] = w0; wq[bj][1] = w1; }
                    const auto s0 = __builtin_amdgcn_permlane16_swap(wq[0][0], wq[1][0], false, false), s1 = __builtin_amdgcn_permlane16_swap(wq[0][1], wq[1][1], false, false);
                    if ((fq & 1) == 0) *(u32x4*)rowp = (u32x4){s0[0], s1[0], s0[1], s1[1]};
                    else *(u32x4*)(rowp + 128 - 8) = (u32x4){s0[0], s1[0], s0[1], s1[1]}; }
            return;
        }
        bf16_t* base; int ld;
        if (pn < 18) { base = PA + pn * 256; ld = NPA; }
        else { base = KVM + (pn - 43) * 256; ld = 1024; row0 -= M; }
        base += wc * 32 + 8 * fq;
        const float sc = u.aux ? 1.f / WIN_SCALE : 1.f;
#pragma unroll
        for (int ai = 0; ai < 2; ++ai)
#pragma unroll
            for (int m = 0; m < 4; ++m) { bf16_t* rowp = base + (size_t)(row0 + ai * 128 + m * 16) * ld;
#pragma unroll
                for (int bj = 0; bj < 2; ++bj) { const f32x4 v0 = acc[ai][bj][m][0] * sc, v1 = acc[ai][bj][m][1] * sc;
                    u32x4 w; w.x = cvtpk(v0[0], v0[1]); w.y = cvtpk(v0[2], v0[3]); w.z = cvtpk(v1[0], v1[1]); w.w = cvtpk(v1[2], v1[3]);
                    *(u32x4*)(rowp + bj * 128) = w; } }
    }
};
struct Sched4 {
    TileOrder o; const char* A; const char* Bt; int G, c;
    __device__ __forceinline__ bool next(int i, pg8::Unit& u) const {
        const int it = i / 3, br = i - it * 3, L = it * G + c; if (L >= 64 * 8) return false;
        int pm, pn; o.decode(L, pm, pn);
        const int koff = br == 0 ? 0 : (br == 1 ? 1024 : 1536);
        u.A = A + ((size_t)pm * 256 * D + koff) * 2; u.B = Bt + ((size_t)pn * 256 * D + koff) * 2; u.ridx = nullptr; u.nt = br == 0 ? 16 : 8; u.pm = pm; u.pn = pn; u.aux = br; return true;
    }
};
struct Epi4 {
    EPI_ZERO_INIT
    const unsigned char* PG8; bf16_t* Z;
    mutable u32x4 zr[4][2];
    __device__ __forceinline__ void operator()(const f32x4 (&acc)[2][2][4][2], const pg8::Unit& u, int wr, int wc, int fr, int fq) const {
        const int row0 = u.pm * 256 + wr * 64 + fr, col0 = u.pn * 256 + wc * 32 + 8 * fq, br = u.aux;
#pragma unroll
        for (int ai = 0; ai < 2; ++ai) {
            u32x2 gv[4][2]; u32x4 zv[4][2];
#pragma unroll
            for (int m = 0; m < 4; ++m) { const size_t row = (size_t)(row0 + ai * 128 + m * 16);
#pragma unroll
                for (int bj = 0; bj < 2; ++bj) { const int col = col0 + bj * 128; gv[m][bj] = *(const u32x2*)(PG8 + row * NPG + br * D + col);
                    if (ai == 0) { const u32x4 zo = zr[m][bj]; zv[m][bj] = br > 0 ? zo : (u32x4){0u, 0u, 0u, 0u}; }
                    else { if (br > 0) zv[m][bj] = *(const u32x4*)(Z + row * D + col); else zv[m][bj] = (u32x4){0u, 0u, 0u, 0u}; } } }
            asm volatile("s_waitcnt vmcnt(0)" ::: "memory");
#pragma unroll
            for (int m = 0; m < 4; ++m) { const size_t row = (size_t)(row0 + ai * 128 + m * 16);
#pragma unroll
                for (int bj = 0; bj < 2; ++bj) { const int col = col0 + bj * 128; const u32x2 g = gv[m][bj]; const u32x4 z = zv[m][bj]; const float gs = 1.f / 255.f;
                    f32x4 v0 = acc[ai][bj][m][0] * gs, v1 = acc[ai][bj][m][1] * gs;
                    v0[0] = v0[0] * (float)(g.x & 0xffu) + bf_lo(z.x); v0[1] = v0[1] * (float)((g.x >> 8) & 0xffu) + bf_hi(z.x); v0[2] = v0[2] * (float)((g.x >> 16) & 0xffu) + bf_lo(z.y); v0[3] = v0[3] * (float)(g.x >> 24) + bf_hi(z.y);
                    v1[0] = v1[0] * (float)(g.y & 0xffu) + bf_lo(z.z); v1[1] = v1[1] * (float)((g.y >> 8) & 0xffu) + bf_hi(z.z); v1[2] = v1[2] * (float)((g.y >> 16) & 0xffu) + bf_lo(z.w); v1[3] = v1[3] * (float)(g.y >> 24) + bf_hi(z.w);
                    u32x4 w; w.x = cvtpk(v0[0], v0[1]); w.y = cvtpk(v0[2], v0[3]); w.z = cvtpk(v1[0], v1[1]); w.w = cvtpk(v1[2], v1[3]);
                    if (ai == 0) { zr[m][bj] = w; if (br == 2) *(u32x4*)(Z + row * D + col) = w; }
                    else *(u32x4*)(Z + row * D + col) = w; } }
        }
    }
};
struct Sched5 {
    TileOrder o; const char* A; const char* Bt; int G, c;
    __device__ __forceinline__ bool next(int i, pg8::Unit& u) const {
        const int L = i * G + c; if (L >= 64 * 8) return false;
        int pm, pn; o.decode(L, pm, pn);
        u.A = A + (size_t)pm * 256 * D * 2; u.B = Bt + (size_t)pn * 256 * D * 2; u.ridx = nullptr; u.nt = D / 64; u.pm = pm; u.pn = pn; u.aux = 0; return true;
    }
};
struct Epi5 {
    static constexpr bool INIT_LOADS = true;
    const float* X; bf16_t* O;
    __device__ __forceinline__ void init(f32x4 (&acc)[2][2][4][2], const pg8::Unit& u, int wr, int wc, int fr, int fq) const {
        const int row0 = u.pm * 256 + wr * 64 + fr, col0 = u.pn * 256 + wc * 32 + 8 * fq;
#pragma unroll
        for (int ai = 0; ai < 2; ++ai)
#pragma unroll
            for (int m = 0; m < 4; ++m) { const size_t off = (size_t)(row0 + ai * 128 + m * 16) * D + col0;
#pragma unroll
                for (int bj = 0; bj < 2; ++bj) { acc[ai][bj][m][0] = *(const f32x4*)(X + off + bj * 128); acc[ai][bj][m][1] = *(const f32x4*)(X + off + bj * 128 + 4); } }
    }
    __device__ __forceinline__ void operator()(const f32x4 (&acc)[2][2][4][2], const pg8::Unit& u, int wr, int wc, int fr, int fq) const {
        const int row0 = u.pm * 256 + wr * 64 + fr, col0 = u.pn * 256 + wc * 32 + 8 * fq;
#pragma unroll
        for (int ai = 0; ai < 2; ++ai)
#pragma unroll
            for (int m = 0; m < 4; ++m) { const size_t off = (size_t)(row0 + ai * 128 + m * 16) * D + col0;
#pragma unroll
                for (int bj = 0; bj < 2; ++bj) { const f32x4 v0 = acc[ai][bj][m][0], v1 = acc[ai][bj][m][1];
                    u32x4 w; w.x = cvtpk(v0[0], v0[1]); w.y = cvtpk(v0[2], v0[3]); w.z = cvtpk(v1[0], v1[1]); w.w = cvtpk(v1[2], v1[3]);
                    *(u32x4*)(O + off + bj * 128) = w; } }
    }
};
struct SchedMoe {
    const LAS unsigned char* blk_e; int nblk, G, c, npn_shift;
    const char* A; const char* W; const int* rowtok; bool up;
    __device__ __forceinline__ bool next(int i, pg8::Unit& u) const {
        int L; if (G == 256) L = ((i * 8 + (c & 7)) * 32 + (c >> 3)); else L = i * G + c;
        const int blk = L >> npn_shift, pn = L & ((1 << npn_shift) - 1);
        if (blk >= nblk) { if (G != 256) return false; return false; }
        const int e = blk_e[blk];
        if (up) { u.A = A; u.ridx = rowtok + blk * 256; u.B = W + ((size_t)e * 1024 + pn * 256) * D; u.nt = D / 128; }
        else    { u.A = A + (size_t)blk * 256 * DE; u.ridx = nullptr; u.B = W + ((size_t)e * D + pn * 256) * DE; u.nt = DE / 128; }
        u.pm = blk; u.pn = pn; u.aux = e; return true;
    }
};
struct Epi8 {  EPI_ZERO_INIT
    unsigned char* HID;
    __device__ __forceinline__ void operator()(const f32x4 (&acc)[2][2][4][2], const pg8::Unit& u, int wr, int wc, int fr, int fq) const {
        const int row0 = u.pm * 256 + wr * 64 + fr, col0 = u.pn * 128 + wc * 32 + 8 * fq; const float rs = 1.f / WGU_SCALE;
#pragma unroll
        for (int ai = 0; ai < 2; ++ai)
#pragma unroll
            for (int mp = 0; mp < 4; mp += 2) { unsigned wq[2][2];
#pragma unroll
                for (int mm = 0; mm < 2; ++mm) { const int m = mp + mm; float h[8];
#pragma unroll
                    for (int e = 0; e < 4; ++e) { const float g0 = acc[ai][0][m][0][e] * rs, g1 = acc[ai][0][m][1][e] * rs;
                        h[e] = __builtin_amdgcn_fmed3f(g0 * fast_sigmoid(g0) * (acc[ai][1][m][0][e] * rs), -440.f, 440.f); h[4 + e] = __builtin_amdgcn_fmed3f(g1 * fast_sigmoid(g1) * (acc[ai][1][m][1][e] * rs), -440.f, 440.f); }
                    wq[mm][0] = pk_fp8x4(h[0], h[1], h[2], h[3]); wq[mm][1] = pk_fp8x4(h[4], h[5], h[6], h[7]); }
                const auto s0 = __builtin_amdgcn_permlane16_swap(wq[0][0], wq[1][0], false, false), s1 = __builtin_amdgcn_permlane16_swap(wq[0][1], wq[1][1], false, false);
                unsigned char* hp = HID + (size_t)(row0 + ai * 128 + (mp + (fq & 1)) * 16) * DE + col0 - 8 * (fq & 1);
                *(u32x4*)hp = (u32x4){s0[0], s1[0], s0[1], s1[1]}; }
    }
};
constexpr float Y_SCALE = 16.f;
struct Epi9 {
    const int* rowasg; const float* rowg; unsigned char* Y;
    mutable unsigned ppk[2][4];
    static constexpr bool INIT_LOADS = false;
    __device__ __forceinline__ void init(f32x4 (&acc)[2][2][4][2], const pg8::Unit& u, int wr, int, int fr, int) const {
#pragma unroll
        for (int a = 0; a < 2; ++a)
#pragma unroll
            for (int b = 0; b < 2; ++b)
#pragma unroll
                for (int m = 0; m < 4; ++m)
#pragma unroll
                    for (int n = 0; n < 2; ++n) acc[a][b][m][n] = (f32x4){0.f, 0.f, 0.f, 0.f};
        const int row0 = u.pm * 256 + wr * 64 + fr;
#pragma unroll
        for (int ai = 0; ai < 2; ++ai)
#pragma unroll
            for (int m = 0; m < 4; ++m) { const int slot = row0 + ai * 128 + m * 16; ppk[ai][m] = __float_as_uint(rowg[slot]); }
    }
    __device__ __forceinline__ void operator()(const f32x4 (&acc)[2][2][4][2], const pg8::Unit& u, int wr, int wc, int fr, int fq) const {
        const int col0 = u.pn * 256 + wc * 32 + 8 * fq;
        int asg[2][4]; float g[2][4];
#pragma unroll
        for (int ai = 0; ai < 2; ++ai)
#pragma unroll
            for (int m = 0; m < 4; ++m) { asg[ai][m] = (int)(ppk[ai][m] & 0x3ffffu) - 1; g[ai][m] = (float)(ppk[ai][m] >> 18) * ((1.f / 4096.f) * (Y_SCALE / WD_SCALE)); }
        asm volatile("s_waitcnt vmcnt(0)" ::: "memory");
#pragma unroll
        for (int ai = 0; ai < 2; ++ai)
#pragma unroll
            for (int m = 0; m < 4; ++m) {
                { const float gg = g[ai][m]; unsigned wq[2][2];
#pragma unroll
                    for (int bj = 0; bj < 2; ++bj) { f32x4 v0 = acc[ai][bj][m][0] * gg, v1 = acc[ai][bj][m][1] * gg;
#pragma unroll
                        for (int e = 0; e < 4; ++e) { v0[e] = __builtin_amdgcn_fmed3f(v0[e], -440.f, 440.f); v1[e] = __builtin_amdgcn_fmed3f(v1[e], -440.f, 440.f); }
                        int w0 = 0, w1 = 0;
                        w0 = __builtin_amdgcn_cvt_pk_fp8_f32(v0[0], v0[1], w0, false); w0 = __builtin_amdgcn_cvt_pk_fp8_f32(v0[2], v0[3], w0, true);
                        w1 = __builtin_amdgcn_cvt_pk_fp8_f32(v1[0], v1[1], w1, false); w1 = __builtin_amdgcn_cvt_pk_fp8_f32(v1[2], v1[3], w1, true);
                        wq[bj][0] = (unsigned)w0; wq[bj][1] = (unsigned)w1; }
                    const auto s0 = __builtin_amdgcn_permlane16_swap(wq[0][0], wq[1][0], false, false), s1 = __builtin_amdgcn_permlane16_swap(wq[0][1], wq[1][1], false, false);
                    if (asg[ai][m] >= 0) { unsigned char* yp = Y + (size_t)asg[ai][m] * D + col0;
                        if ((fq & 1) == 0) *(u32x4*)yp = (u32x4){s0[0], s1[0], s0[1], s1[1]};
                        else *(u32x4*)(yp + 128 - 8) = (u32x4){s0[0], s1[0], s0[1], s1[1]}; } } }
    }
};

struct Frame {
    LAS unsigned char* lds; int tid, lane, wave, G, gw, NGW;
    float* out; unsigned char* ws;
    __device__ __forceinline__ const float* in(int i) const { return ((const float* const __attribute__((address_space(4)))*)__builtin_amdgcn_kernarg_segment_ptr())[i]; }
};
#define LDS_WAIT() asm volatile("s_waitcnt lgkmcnt(0)" ::: "memory")
template <class SrcCol, class DstRow>
__device__ __forceinline__ void tr_item(const float* W, size_t ldw, int k0, int n0, const SrcCol& sc, bf16_t* WT, size_t ldt, int kd0, const DstRow& dr, LAS float* scr, int lane) {
    const int c = sc(n0 + (lane & 31));
#pragma unroll 8
    for (int i = 0; i < 32; ++i) { const int kk = 2 * i + (lane >> 5); scr[kk * 33 + (lane & 31)] = c >= 0 ? W[(size_t)(k0 + kk) * ldw + c] : 0.f; }
    LDS_WAIT(); asm volatile("" ::: "memory");
    const int c8 = lane & 7;
#pragma unroll
    for (int j = 0; j < 4; ++j) { const int n = (lane >> 3) + 8 * j; const LAS float* s = scr + (8 * c8) * 33 + n;
        u32x4 o; o.x = cvtpk(s[0 * 33], s[1 * 33]); o.y = cvtpk(s[2 * 33], s[3 * 33]); o.z = cvtpk(s[4 * 33], s[5 * 33]); o.w = cvtpk(s[6 * 33], s[7 * 33]);
        *(u32x4*)(WT + (size_t)dr(n0 + n) * ldt + kd0 + k0 + 8 * c8) = o; }
    LDS_WAIT(); asm volatile("" ::: "memory");
}
struct IdCol { __device__ __forceinline__ int operator()(int n) const { return n; } };
struct OffRow { int off; __device__ __forceinline__ int operator()(int n) const { return off + n; } };
struct WinCol {
    __device__ __forceinline__ int operator()(int n) const {
        if (n < 2560) return n; if (n < 4096) return 2584 + (n - 2560); if (n < 4608) return 4124 + (n - 4096); if (n < 10752) return 4636 + (n - 4608);
        if (n < 10776) return 2560 + (n - 10752); if (n < 10780) return 4120 + (n - 10776); return -1; }
};
struct GuRow { int up; __device__ __forceinline__ int operator()(int j) const { return (j >> 7) * 256 + up * 128 + (j & 127); } };
__device__ __forceinline__ void rms_row_bf16(const float* xrow, const float* gain, bf16_t* orow, int lane) {
    f32x4 v[8]; float s = 0.f;
#pragma unroll
    for (int j = 0; j < 8; ++j) { v[j] = *(const f32x4*)(xrow + 4 * lane + 256 * j); s += (v[j].x * v[j].x + v[j].y * v[j].y) + (v[j].z * v[j].z + v[j].w * v[j].w); }
    const float rstd = __builtin_amdgcn_rsqf(wave_sum(s) * (1.f / D) + RMS_EPS);
#pragma unroll
    for (int j = 0; j < 8; ++j) { const f32x4 g = *(const f32x4*)(gain + 4 * lane + 256 * j);
        u32x2 o; o.x = cvtpk(v[j].x * rstd * g.x, v[j].y * rstd * g.y); o.y = cvtpk(v[j].z * rstd * g.z, v[j].w * rstd * g.w);
        *(u32x2*)(orow + 4 * lane + 256 * j) = o; }
}
__device__ __forceinline__ void rms_row_both(const float* xrow, const float* gain, bf16_t* orow, unsigned char* orow8, int lane) {
    f32x4 v[8]; float s = 0.f;
#pragma unroll
    for (int j = 0; j < 8; ++j) { v[j] = *(const f32x4*)(xrow + 4 * lane + 256 * j); s += (v[j].x * v[j].x + v[j].y * v[j].y) + (v[j].z * v[j].z + v[j].w * v[j].w); }
    const float rstd = __builtin_amdgcn_rsqf(wave_sum(s) * (1.f / D) + RMS_EPS);
#pragma unroll
    for (int j = 0; j < 8; ++j) { const f32x4 g = *(const f32x4*)(gain + 4 * lane + 256 * j); const float a = v[j].x * rstd * g.x, b = v[j].y * rstd * g.y, c = v[j].z * rstd * g.z, d = v[j].w * rstd * g.w;
        u32x2 o; o.x = cvtpk(a, b); o.y = cvtpk(c, d); *(u32x2*)(orow + 4 * lane + 256 * j) = o;
        *(unsigned*)(orow8 + 4 * lane + 256 * j) = pk_fp8x4(a, b, c, d); }
}
__device__ __forceinline__ float dot2c_bf16(float acc, unsigned a, unsigned b) { asm("v_dot2c_f32_bf16 %0, %1, %2" : "+v"(acc) : "v"(a), "v"(b)); return acc; }
template <bool WRITE_BF16>
__device__ __forceinline__ void rms_row_logits(const float* xrow, const float* gain, bf16_t* orow, unsigned char* orow8, float* glrow, const LAS unsigned char* WL, int lane) {
    f32x4 v[8]; float s = 0.f;
#pragma unroll
    for (int j = 0; j < 8; ++j) { v[j] = *(const f32x4*)(xrow + 4 * lane + 256 * j); s += (v[j].x * v[j].x + v[j].y * v[j].y) + (v[j].z * v[j].z + v[j].w * v[j].w); }
    const float rstd = __builtin_amdgcn_rsqf(wave_sum(s) * (1.f / D) + RMS_EPS);
    u32x2 hb[8];
#pragma unroll
    for (int j = 0; j < 8; ++j) { const f32x4 g = *(const f32x4*)(gain + 4 * lane + 256 * j); const float a = v[j].x * rstd * g.x, b = v[j].y * rstd * g.y, c = v[j].z * rstd * g.z, d = v[j].w * rstd * g.w;
        hb[j].x = cvtpk(a, b); hb[j].y = cvtpk(c, d); if (WRITE_BF16) *(u32x2*)(orow + 4 * lane + 256 * j) = hb[j];
        *(unsigned*)(orow8 + 4 * lane + 256 * j) = pk_fp8x4(a, b, c, d); }
    float lg[32];
#pragma unroll
    for (int c = 0; c < 32; ++c) lg[c] = 0.f;
#pragma unroll
    for (int j = 0; j < 8; ++j) {
        u32x2 w[28];
#pragma unroll
        for (int c = 0; c < 28; ++c) w[c] = *(const LAS u32x2*)(WL + (size_t)(c * 2048 + 4 * lane + 256 * j) * 2);
        asm volatile("s_waitcnt lgkmcnt(0)" ::: "memory"); __builtin_amdgcn_sched_barrier(0);
#pragma unroll
        for (int c = 0; c < 28; ++c) { lg[c] = dot2c_bf16(lg[c], hb[j].x, w[c].x); lg[c] = dot2c_bf16(lg[c], hb[j].y, w[c].y); }
        __builtin_amdgcn_sched_barrier(0); }
    float r1[16];
#pragma unroll
    for (int i = 0; i < 16; ++i) { const auto sw = __builtin_amdgcn_permlane32_swap(__float_as_uint(lg[i]), __float_as_uint(lg[i + 16]), false, false); r1[i] = __uint_as_float(sw[0]) + __uint_as_float(sw[1]); }
    float r2[8];
#pragma unroll
    for (int i = 0; i < 8; ++i) { const auto sw = __builtin_amdgcn_permlane16_swap(__float_as_uint(r1[i]), __float_as_uint(r1[i + 8]), false, false); r2[i] = __uint_as_float(sw[0]) + __uint_as_float(sw[1]); }
#pragma unroll
    for (int i = 0; i < 8; ++i) {
        float t = r2[i];
        t += __builtin_bit_cast(float, __builtin_amdgcn_update_dpp(0, __builtin_bit_cast(int, t), 0x128, 0xF, 0xF, false));
        t += __builtin_bit_cast(float, __builtin_amdgcn_update_dpp(0, __builtin_bit_cast(int, t), 0x124, 0xF, 0xF, false));
        t += __builtin_bit_cast(float, __builtin_amdgcn_update_dpp(0, __builtin_bit_cast(int, t), 0x122, 0xF, 0xF, false));
        t += __builtin_bit_cast(float, __builtin_amdgcn_update_dpp(0, __builtin_bit_cast(int, t), 0x121, 0xF, 0xF, false));
        r2[i] = t; }
    if ((lane & 15) == 0) { float* p = glrow + 8 * (lane >> 4); *(f32x4*)p = (f32x4){r2[0], r2[1], r2[2], r2[3]}; *(f32x4*)(p + 4) = (f32x4){r2[4], r2[5], r2[6], r2[7]}; }
}
enum { I_X = 0, I_MEM, I_NORM_ATTN_G, I_W_IN, I_PE_K, I_W_CK, I_PE_V, I_W_CV, I_NSA_Q_G, I_NSA_K_G, I_REL_BIAS, I_FOX_B_F, I_FOX_Q_G, I_FOX_K_G, I_NORM_MEM_G, I_W_MEM_KV,
       I_MEM_Q_G, I_MEM_K_G, I_W_O_NSA, I_W_O_FOX, I_W_O_MEM, I_W_OUT, I_NORM_FFN_G, I_W_ROUTER, I_ROUTER_BIAS, I_WE_GATE, I_WE_UP, I_WE_DOWN, I_WS_GATE, I_WS_UP, I_WS_DOWN, N_IN };

struct TrDesc { const float* src; bf16_t* dst; unsigned ldw, ldt; };
__device__ __forceinline__ TrDesc tr_decode(const Frame& F, int t) {
    unsigned char* ws = F.ws; TrDesc d;
    bf16_t* WinT = (bf16_t*)(ws + WS_WINT); bf16_t* WkvT = WinT + (size_t)NPAD * D; bf16_t* WoT = (bf16_t*)(ws + WS_WOT);
    bf16_t* Wgu = (bf16_t*)(ws + WS_WGU); bf16_t* Wd = (bf16_t*)(ws + WS_WD);
    constexpr int T0 = 16 * 2 * NB16, T1 = T0 + 128, T2 = T1 + 128, T3 = T2 + 64, T4 = T3 + 64, T5 = T4 + 256, T6 = T5 + 32, T7 = T6 + 32, T8 = T7 + 65 * 64, T9 = T8 + 65 * 64;
    if (t < T0) { constexpr int NU = NB16 ? 2 * NB16 : 1; const int kt = t / NU, nt = t - kt * NU, n0 = 256 * nth_set(~FP8M & 0x3ffffu, nt >> 1) + 128 * (nt & 1); const int sc = WinCol{}(n0);
        d.src = F.in(I_W_IN) + (size_t)(128 * kt) * W_IN_COLS + sc; d.ldw = W_IN_COLS; d.dst = WinT + (size_t)n0 * D + 128 * kt; d.ldt = D; }
    else if (t < T1) { const int r = t - T0, kt = r >> 3, nt = r & 7; d.src = F.in(I_W_MEM_KV) + (size_t)(128 * kt) * 1024 + 128 * nt; d.ldw = 1024; d.dst = WkvT + (size_t)(128 * nt) * D + 128 * kt; d.ldt = D; }
    else if (t < T2) { const int r = t - T1, kt = r >> 4, nt = r & 15; d.src = F.in(I_W_O_NSA) + (size_t)(128 * kt) * D + 128 * nt; d.ldw = D; d.dst = WoT + (size_t)(128 * nt) * D + 128 * kt; d.ldt = D; }
    else if (t < T4) { const int mm = t >= T3, r = t - (mm ? T3 : T2), kt = r >> 4, nt = r & 15; d.src = F.in(mm ? I_W_O_MEM : I_W_O_FOX) + (size_t)(128 * kt) * D + 128 * nt; d.ldw = D; d.dst = WoT + (size_t)(128 * nt) * D + (mm ? 1536 : 1024) + 128 * kt; d.ldt = D; }
    else if (t < T5) { const int r = t - T4, kt = r >> 4, nt = r & 15; d.src = F.in(I_W_OUT) + (size_t)(128 * kt) * D + 128 * nt; d.ldw = D; d.dst = (bf16_t*)(ws + WS_WOUTT) + (size_t)(128 * nt) * D + 128 * kt; d.ldt = D; }
    else if (t < T7) { const int v = t >= T6, kt = t - (v ? T6 : T5); d.src = F.in(v ? I_W_CV : I_W_CK) + (size_t)(128 * kt) * 128; d.ldw = 128; d.dst = (bf16_t*)(ws + (v ? WS_WCV : WS_WCK)) + 128 * kt; d.ldt = 4096; }
    else if (t < T8) { const int r = t - T7, e = r >> 6, rr = r & 63, kt = rr >> 2, nt = rr & 3, up = 0;
        const float* W = e < NE ? F.in(I_WE_GATE) + (size_t)e * D * DE : F.in(I_WS_GATE);
        d.src = W + (size_t)(128 * kt) * DE + 128 * nt; d.ldw = DE; d.dst = Wgu + ((size_t)e * 1024 + 256 * nt + 128 * up) * D + 128 * kt; d.ldt = D; }
    else if (t < T9) { const int r = t - T8, e = r >> 6, rr = r & 63, kt = rr >> 2, nt = rr & 3, up = 1;
        const float* W = e < NE ? F.in(I_WE_UP) + (size_t)e * D * DE : F.in(I_WS_UP);
        d.src = W + (size_t)(128 * kt) * DE + 128 * nt; d.ldw = DE; d.dst = Wgu + ((size_t)e * 1024 + 256 * nt + 128 * up) * D + 128 * kt; d.ldt = D; }
    else { const int r = t - T9, e = r >> 6, rr = r & 63, kt = rr >> 4, nt = rr & 15;
        const float* W = e < NE ? F.in(I_WE_DOWN) + (size_t)e * DE * D : F.in(I_WS_DOWN);
        d.src = W + (size_t)(128 * kt) * D + 128 * nt; d.ldw = D; d.dst = Wd + ((size_t)e * D + 128 * nt) * DE + 128 * kt; d.ldt = DE; }
    return d;
}
constexpr int TR_NTILES = 16 * 84 + 128 + 128 + 64 + 64 + 256 + 32 + 32 + 3 * 65 * 64;
__device__ __forceinline__ void tr_load(const TrDesc& d, f32x4 (&v)[8], int wave, int lane) {
#pragma unroll
    for (int i = 0; i < 4; ++i) { const int q = wave + 8 * i, n4 = (q & 3) * 8 + (lane & 7), kp = (q >> 2) * 8 + (lane >> 3);
        const float* p = d.src + (size_t)(2 * kp) * d.ldw + 4 * n4; v[2 * i] = __builtin_nontemporal_load((const f32x4*)p); v[2 * i + 1] = __builtin_nontemporal_load((const f32x4*)(p + d.ldw)); }
}
__device__ __forceinline__ void tr_to_lds(const f32x4 (&v)[8], LAS unsigned* T32, int wave, int lane) {
#pragma unroll
    for (int i = 0; i < 4; ++i) { const int q = wave + 8 * i, n4 = (q & 3) * 8 + (lane & 7), kp = (q >> 2) * 8 + (lane >> 3);
#pragma unroll
        for (int e = 0; e < 4; ++e) T32[(4 * n4 + e) * 65 + kp] = cvtpk(v[2 * i][e], v[2 * i + 1][e]); }
}
__device__ __forceinline__ void tr_from_lds(const TrDesc& d, const LAS unsigned* T32, int wave, int lane) {
    const int c = lane & 15, nn = lane >> 4;
#pragma unroll
    for (int i = 0; i < 4; ++i) { const int n = wave * 16 + 4 * i + nn; const LAS unsigned* r = T32 + n * 65 + 4 * c;
        const u32x4 o = {r[0], r[1], r[2], r[3]};
        __builtin_nontemporal_store(o, (u32x4*)(d.dst + (size_t)n * d.ldt + 8 * c)); }
}
constexpr int TR_FIRST_EXPERT = 16 * 2 * NB16 + 128 + 128 + 64 + 64 + 256 + 32 + 32;
constexpr int TR8W_NTILES = 16 * (48 + 2 * NF8);
struct Tr8Desc { const float* src; unsigned char* dst; unsigned ldw, ldt; float scale; };
__device__ __forceinline__ Tr8Desc tr8_decode(const Frame& F, int t) {
    unsigned char* ws = F.ws; Tr8Desc d; unsigned char* Wgu = ws + WS_WGU; unsigned char* Wd = ws + WS_WD;
    constexpr int TG = 65 * 64;
    if (t < 2 * TG) { const int up = t >= TG, r = t - (up ? TG : 0), e = r >> 6, rr = r & 63, kt = rr >> 2, nt = rr & 3;
        const float* W = e < NE ? F.in(up ? I_WE_UP : I_WE_GATE) + (size_t)e * D * DE : F.in(up ? I_WS_UP : I_WS_GATE);
        d.src = W + (size_t)(128 * kt) * DE + 128 * nt; d.ldw = DE; d.dst = Wgu + ((size_t)e * 1024 + 256 * nt + 128 * up) * D + 128 * kt; d.ldt = D; d.scale = WGU_SCALE; }
    else { const int r = t - 2 * TG, e = r >> 6, rr = r & 63, kt = rr >> 4, nt = rr & 15;
        const float* W = e < NE ? F.in(I_WE_DOWN) + (size_t)e * DE * D : F.in(I_WS_DOWN);
        d.src = W + (size_t)(128 * kt) * D + 128 * nt; d.ldw = D; d.dst = Wd + ((size_t)e * D + 128 * nt) * DE + 128 * kt; d.ldt = DE; d.scale = WD_SCALE; }
    return d;
}
__device__ __forceinline__ Tr8Desc tr8w_decode(const Frame& F, int t) {
    Tr8Desc d; d.scale = WIN_SCALE; d.ldt = D; constexpr int NU = 48 + 2 * NF8; const int kt = t / NU, nt = t - kt * NU, n0 = nt < 48 ? 4608 + 128 * nt : 256 * nth_set(FP8M, (nt - 48) >> 1) + 128 * (nt & 1); const int sc = WinCol{}(n0);
    d.src = F.in(I_W_IN) + (size_t)(128 * kt) * W_IN_COLS + sc; d.ldw = W_IN_COLS; d.dst = F.ws + WS_WIN8 + (size_t)(128 * nt) * D + 128 * kt;
    return d;
}
__device__ __forceinline__ void tr8_load(const Tr8Desc& d, f32x4 (&v)[8], int wave, int lane) {
#pragma unroll
    for (int i = 0; i < 2; ++i) { const int q = wave + 8 * i, n4 = (q & 3) * 8 + (lane & 7), kq = (q >> 2) * 8 + (lane >> 3);
        const float* p = d.src + (size_t)(4 * kq) * d.ldw + 4 * n4;
#pragma unroll
        for (int r = 0; r < 4; ++r) v[4 * i + r] = __builtin_nontemporal_load((const f32x4*)(p + (size_t)r * d.ldw)); }
}
__device__ __forceinline__ void tr8_to_lds(const f32x4 (&v)[8], float sc, LAS unsigned* T32, int wave, int lane) {
#pragma unroll
    for (int i = 0; i < 2; ++i) { const int q = wave + 8 * i, n4 = (q & 3) * 8 + (lane & 7), kq = (q >> 2) * 8 + (lane >> 3);
#pragma unroll
        for (int e = 0; e < 4; ++e) T32[(4 * n4 + e) * 33 + kq] = pk_fp8x4(v[4 * i][e] * sc, v[4 * i + 1][e] * sc, v[4 * i + 2][e] * sc, v[4 * i + 3][e] * sc); }
}
__device__ __forceinline__ void tr8_from_lds(const Tr8Desc& d, const LAS unsigned* T32, int wave, int lane) {
    const int c = lane & 7, nn = lane >> 3;
#pragma unroll
    for (int i = 0; i < 2; ++i) { const int n = wave * 16 + 8 * i + nn; const LAS unsigned* r = T32 + n * 33 + 4 * c;
        const u32x4 o = {r[0], r[1], r[2], r[3]};
        __builtin_nontemporal_store(o, (u32x4*)(d.dst + (size_t)n * d.ldt + 16 * c)); }
}
__device__ __forceinline__ void conv_batch(const Frame& F, int first, int end) {
    constexpr int NT8 = 3 * 65 * 64;
    if (end > NT8) end = NT8;
    if (first >= end) return;
    LAS unsigned* I0 = (LAS unsigned*)F.lds; LAS unsigned* I1 = I0 + 128 * 33; const int lane = F.lane;
    f32x4 r0[8], r1[8], r2[8], r3[8];
    int t = first;
    tr8_load(tr8_decode(F, t), r0, F.wave, lane);
    if (t + 1 < end) tr8_load(tr8_decode(F, t + 1), r1, F.wave, lane);
    if (t + 2 < end) tr8_load(tr8_decode(F, t + 2), r2, F.wave, lane);
    if (t + 3 < end) tr8_load(tr8_decode(F, t + 3), r3, F.wave, lane);
    __syncthreads();
    tr8_to_lds(r0, tr8_decode(F, t).scale, I0, F.wave, lane);
    __syncthreads();
#define CB_STEP(RF, RN, IC, IN) { \
        if (t + 4 < end) tr8_load(tr8_decode(F, t + 4), RF, F.wave, lane); \
        if (t + 1 < end) tr8_to_lds(RN, tr8_decode(F, t + 1).scale, IN, F.wave, lane); \
        tr8_from_lds(tr8_decode(F, t), IC, F.wave, lane); \
        __syncthreads(); \
        if (++t >= end) break; }
    for (;;) {
        CB_STEP(r0, r1, I0, I1)
        CB_STEP(r1, r2, I1, I0)
        CB_STEP(r2, r3, I0, I1)
        CB_STEP(r3, r0, I1, I0)
    }
#undef CB_STEP
}

namespace att {
constexpr int SHM = 16384;
constexpr int L_V = 0, L_K = 3 * SHM;
constexpr int L_WS = 5 * SHM;
constexpr int L_TBL = L_WS + 2048;
constexpr int L_SEL = L_TBL + 8 * 132 * 4;
constexpr int L_NIB = L_SEL + 512;
constexpr int L_CUM = L_SEL + 1024;
constexpr int L_IMP = L_CUM;
constexpr int L_ORD = L_IMP + 32768;
constexpr int L_Q = L_ORD + 2048;
constexpr int L_END = L_Q + 64;
static_assert(L_END <= RING_BYTES, "attention LDS map");
__constant__ unsigned char T5B[128] = {0, 1, 2, 3, 4, 5, 6, 7, 8, 9, 10, 11, 12, 13, 14, 15, 16, 16, 16, 17, 17, 18, 18, 18, 19, 19, 19, 20, 20, 20, 20, 21, 21, 21, 21, 22, 22, 22, 22, 22, 23, 23, 23, 23, 23, 23, 24, 24, 24, 24, 24, 24, 25, 25, 25, 25, 25, 25, 25, 26, 26, 26, 26, 26, 26, 26, 26, 27, 27, 27, 27, 27, 27, 27, 27, 27, 27, 28, 28, 28, 28, 28, 28, 28, 28, 28, 28, 29, 29, 29, 29, 29, 29, 29, 29, 29, 29, 29, 29, 30, 30, 30, 30, 30, 30, 30, 30, 30, 30, 30, 30, 30, 30, 31, 31, 31, 31, 31, 31, 31, 31, 31, 31, 31, 31, 31, 31, 31};

#define KSWZ(row, colB) ((row) * 256 + ((colB) ^ (((row) & 7) << 4)))
#define SBAR() __builtin_amdgcn_sched_barrier(0)
__device__ __forceinline__ int v_st(int k, int c) { const int kk = (k & ~0xC) | ((k & 4) << 1) | ((k & 8) >> 1); return ((kk >> 3) * 4 + (c >> 5)) * 512 + ((kk & 7) * 32 + (c & 31)) * 2; }
__device__ __forceinline__ int v_rd_base(int lane) { return ((lane & 3) << 3) | (((lane >> 2) & 3) << 6) | (((lane >> 4) & 1) << 5) | (((lane >> 5) & 1) << 8); }
__device__ __forceinline__ int crow(int r, int hi) { return (r & 3) + 8 * (r >> 2) + 4 * hi; }
__device__ __forceinline__ float pswap_max(float v) { auto rr = __builtin_amdgcn_permlane32_swap(__float_as_uint(v), __float_as_uint(v), false, false); return fmaxf(__uint_as_float(rr[0]), __uint_as_float(rr[1])); }
__device__ __forceinline__ float pswap_sum(float v) { auto rr = __builtin_amdgcn_permlane32_swap(__float_as_uint(v), __float_as_uint(v), false, false); return __uint_as_float(rr[0]) + __uint_as_float(rr[1]); }

__device__ __forceinline__ void qkt(f32x16& p0, f32x16& p1, const LAS char* Kb, int r32, int hi, const bf16x8 (&qr)[8]) {
    const LAS char* kb[4];
#pragma unroll
    for (int dd = 0; dd < 4; ++dd) kb[dd] = Kb + KSWZ(r32, (dd * 16 + hi * 8) * 2);
#pragma unroll
    for (int d0 = 0; d0 < 8; ++d0) { const LAS char* a = kb[d0 & 3] + (d0 >> 2) * 128;
        const bf16x8 b0 = *(const LAS bf16x8*)a;
        const bf16x8 b1 = *(const LAS bf16x8*)(a + 32 * 256);
        p0 = __builtin_amdgcn_mfma_f32_32x32x16_bf16(b0, qr[d0], p0, 0, 0, 0);
        p1 = __builtin_amdgcn_mfma_f32_32x32x16_bf16(b1, qr[d0], p1, 0, 0, 0);
#ifdef QKT_SPLIT
        if ((d0 & (QKT_SPLIT - 1)) == QKT_SPLIT - 1 && d0 != 7) SBAR();
#endif
    }
}
__device__ __forceinline__ void pv_tile(f32x16 (&o)[4], int vb, bf16x8 pa0, bf16x8 pa1, bf16x8 pa2, bf16x8 pa3) {
#define TRRD(dst, off) asm volatile("ds_read_b64_tr_b16 %0, %1 offset:%2" : "=&v"(dst) : "v"(vb), "i"(off) : "memory")
#define PV_D0(d0) do { s16x4 l0, l1, l2, l3, h0, h1, h2, h3; constexpr int b_ = (d0) * 512; \
        TRRD(l0, b_); TRRD(h0, b_ + 2048); TRRD(l1, b_ + 4096); TRRD(h1, b_ + 6144); TRRD(l2, b_ + 8192); TRRD(h2, b_ + 10240); TRRD(l3, b_ + 12288); TRRD(h3, b_ + 14336); \
        asm volatile("s_waitcnt lgkmcnt(0)" ::: "memory"); SBAR(); \
        o[d0] = __builtin_amdgcn_mfma_f32_32x32x16_bf16(pa0, (bf16x8){l0[0], l0[1], l0[2], l0[3], h0[0], h0[1], h0[2], h0[3]}, o[d0], 0, 0, 0); \
        o[d0] = __builtin_amdgcn_mfma_f32_32x32x16_bf16(pa1, (bf16x8){l1[0], l1[1], l1[2], l1[3], h1[0], h1[1], h1[2], h1[3]}, o[d0], 0, 0, 0); \
        o[d0] = __builtin_amdgcn_mfma_f32_32x32x16_bf16(pa2, (bf16x8){l2[0], l2[1], l2[2], l2[3], h2[0], h2[1], h2[2], h2[3]}, o[d0], 0, 0, 0); \
        o[d0] = __builtin_amdgcn_mfma_f32_32x32x16_bf16(pa3, (bf16x8){l3[0], l3[1], l3[2], l3[3], h3[0], h3[1], h3[2], h3[3]}, o[d0], 0, 0, 0); } while (0)
    PV_D0(0); PV_D0(1); PV_D0(2); PV_D0(3);
#undef PV_D0
#undef TRRD
}
__device__ __forceinline__ void pack_p(const f32x16& p0, const f32x16& p1, bf16x8& pa0, bf16x8& pa1, bf16x8& pa2, bf16x8& pa3) {
#define PK4(P, B_, OUT) do { unsigned a0 = cvtpk(P[B_+0], P[B_+1]), a1 = cvtpk(P[B_+2], P[B_+3]); \
        unsigned b0 = cvtpk(P[B_+4], P[B_+5]), b1 = cvtpk(P[B_+6], P[B_+7]); \
        auto r0 = __builtin_amdgcn_permlane32_swap(a0, b0, false, false); auto r1 = __builtin_amdgcn_permlane32_swap(a1, b1, false, false); \
        u32x4 w = {r0[0], r1[0], r0[1], r1[1]}; OUT = __builtin_bit_cast(bf16x8, w); } while (0)
    PK4(p0, 0, pa0); PK4(p0, 8, pa1); PK4(p1, 0, pa2); PK4(p1, 8, pa3);
#undef PK4
}
__device__ __forceinline__ void bcast_rows(float (&f)[16], float v, LAS float* ws, int r32, int hi) {
    if (hi == 0) ws[r32] = v;
    asm volatile("s_waitcnt lgkmcnt(0)" ::: "memory");
#pragma unroll
    for (int q = 0; q < 4; ++q) { const f32x4 t = *(const LAS f32x4*)(ws + 8 * q + 4 * hi); f[4 * q] = t[0]; f[4 * q + 1] = t[1]; f[4 * q + 2] = t[2]; f[4 * q + 3] = t[3]; }
    asm volatile("s_waitcnt lgkmcnt(0)" ::: "memory");
}
struct Ctx {
    LAS char* lds; int tid, wid, lane, r32, hi;
    int trow;
    int qlo;
};
struct DmaOff { unsigned k, v0, v1; };
__device__ __forceinline__ DmaOff dma_off(int wid, int lane, size_t ld) {
    DmaOff d; const int kr = 4 * wid + (lane >> 4), kc = (lane & 15) ^ (kr & 7);
    d.k = (unsigned)(kr * ld + kc * 8) * 2u;
#pragma unroll
    for (int t = 0; t < 2; ++t) { const int sub = 2 * (wid + 8 * t) + (lane >> 5), kk = (sub >> 2) * 8 + ((lane & 31) >> 2), k = (kk & ~0xC) | ((kk & 4) << 1) | ((kk & 8) >> 1), c0 = (sub & 3) * 32 + (lane & 3) * 8;
        const unsigned o = (unsigned)(k * ld + c0) * 2u; if (t == 0) d.v0 = o; else d.v1 = o; }
    return d;
}
__device__ __forceinline__ void dma_tile(const DmaOff& d, const bf16_t* Kg, const bf16_t* Vg, size_t ld, LAS char* lds, int buf, int vbuf, int wid) {
    const char* kp = (const char*)Kg; const char* vp = (const char*)Vg;
    __builtin_amdgcn_global_load_lds((const unsigned*)(kp + d.k), (LAS unsigned*)(lds + L_K + buf * SHM + wid * 1024), 16, 0, 0);
    __builtin_amdgcn_global_load_lds((const unsigned*)(kp + d.k + 32 * ld * 2), (LAS unsigned*)(lds + L_K + buf * SHM + (wid + 8) * 1024), 16, 0, 0);
    __builtin_amdgcn_global_load_lds((const unsigned*)(vp + d.v0), (LAS unsigned*)(lds + L_V + vbuf * SHM + wid * 1024), 16, 0, 0);
    __builtin_amdgcn_global_load_lds((const unsigned*)(vp + d.v1), (LAS unsigned*)(lds + L_V + vbuf * SHM + (wid + 8) * 1024), 16, 0, 0);
}
__device__ __forceinline__ void dma_tile_v(const DmaOff& d, const bf16_t* Kg, const bf16_t* Vg, size_t ld, LAS char* lds, int kbuf, int voff, int wid) {
    const char* kp = (const char*)Kg; const char* vp = (const char*)Vg;
    __builtin_amdgcn_global_load_lds((const unsigned*)(kp + d.k), (LAS unsigned*)(lds + L_K + kbuf * SHM + wid * 1024), 16, 0, 0);
    __builtin_amdgcn_global_load_lds((const unsigned*)(kp + d.k + 32 * ld * 2), (LAS unsigned*)(lds + L_K + kbuf * SHM + (wid + 8) * 1024), 16, 0, 0);
    __builtin_amdgcn_global_load_lds((const unsigned*)(vp + d.v0), (LAS unsigned*)(lds + L_V + voff + wid * 1024), 16, 0, 0);
    __builtin_amdgcn_global_load_lds((const unsigned*)(vp + d.v1), (LAS unsigned*)(lds + L_V + voff + (wid + 8) * 1024), 16, 0, 0);
}
#define DMA_WAIT() asm volatile("s_waitcnt vmcnt(0)" ::: "memory")
constexpr float DEFER_THR = 8.f;
__device__ __forceinline__ void qkt_half(f32x16& p, const LAS char* Kb, int r32, int hi, const bf16x8 (&qr)[8], bool zero) {
    const LAS char* kb[4];
#pragma unroll
    for (int dd = 0; dd < 4; ++dd) kb[dd] = Kb + KSWZ(r32, (dd * 16 + hi * 8) * 2);
    { const bf16x8 b = *(const LAS bf16x8*)(kb[0]);
      if (zero) p = __builtin_amdgcn_mfma_f32_32x32x16_bf16(b, qr[0], (f32x16){0.f, 0.f, 0.f, 0.f, 0.f, 0.f, 0.f, 0.f, 0.f, 0.f, 0.f, 0.f, 0.f, 0.f, 0.f, 0.f}, 0, 0, 0);
      else p = __builtin_amdgcn_mfma_f32_32x32x16_bf16(b, qr[0], p, 0, 0, 0); }
#pragma unroll
    for (int d0 = 1; d0 < 8; ++d0) { const bf16x8 b = *(const LAS bf16x8*)(kb[d0 & 3] + (d0 >> 2) * 128);
        p = __builtin_amdgcn_mfma_f32_32x32x16_bf16(b, qr[d0], p, 0, 0, 0); }
}
__device__ __forceinline__ float max3f(float a, float b, float c) { float r; asm("v_max3_f32 %0, %1, %2, %3" : "=v"(r) : "v"(a), "v"(b), "v"(c)); return r; }
__device__ __forceinline__ bool sm_half(f32x16& p, float& m_reg, float& l_reg, float& alpha, bf16x8& pa0, bf16x8& pa1, float brow) {
    float pmax = max3f(p[0], p[1], p[2]);
#pragma unroll
    for (int r = 3; r < 15; r += 2) pmax = max3f(pmax, p[r], p[r + 1]);
    pmax = max3f(pmax, p[15], p[15]);
    { const auto rr = __builtin_amdgcn_permlane32_swap(__float_as_uint(pmax), __float_as_uint(pmax), false, false); pmax = max3f(__uint_as_float(rr[0]), __uint_as_float(rr[1]), __uint_as_float(rr[1])) + brow; }
    const bool upd = !__all(pmax - m_reg <= DEFER_THR);
    const float mx_ = max3f(m_reg, pmax, pmax);
    const float mn = upd ? mx_ : m_reg;
    alpha = __builtin_amdgcn_exp2f(m_reg - mn); m_reg = mn;
    f32x2 mn2 = {brow - mn, brow - mn}; asm("" : "+v"(mn2)); f32x2 ps2 = {0.f, 0.f};
#pragma unroll
    for (int r = 0; r < 16; r += 2) { f32x2 t = {p[r], p[r + 1]}; t += mn2; t.x = __builtin_amdgcn_exp2f(t.x); t.y = __builtin_amdgcn_exp2f(t.y); p[r] = t.x; p[r + 1] = t.y; ps2 += t; }
    float ps = pswap_sum(ps2.x + ps2.y);
    l_reg = l_reg * alpha + ps;
#define PK4(P, B_, OUT) do { unsigned a0 = cvtpk(P[B_+0], P[B_+1]), a1 = cvtpk(P[B_+2], P[B_+3]); \
        unsigned b0 = cvtpk(P[B_+4], P[B_+5]), b1 = cvtpk(P[B_+6], P[B_+7]); \
        auto r0 = __builtin_amdgcn_permlane32_swap(a0, b0, false, false); auto r1 = __builtin_amdgcn_permlane32_swap(a1, b1, false, false); \
        u32x4 w = {r0[0], r1[0], r0[1], r1[1]}; OUT = __builtin_bit_cast(bf16x8, w); } while (0)
    PK4(p, 0, pa0); PK4(p, 8, pa1);
#undef PK4
    return upd;
}
__device__ __forceinline__ void pv_half(f32x16 (&o)[4], int vb, bf16x8 pa0, bf16x8 pa1) {
#define TRRD(dst, off) asm volatile("ds_read_b64_tr_b16 %0, %1 offset:%2" : "=&v"(dst) : "v"(vb), "i"(off) : "memory")
#define PVH(dA, dB) do { s16x4 l0, h0, l1, h1, m0, n0, m1, n1; \
        TRRD(l0, (dA) * 512); TRRD(h0, (dA) * 512 + 2048); TRRD(m0, (dB) * 512); TRRD(n0, (dB) * 512 + 2048); \
        TRRD(l1, (dA) * 512 + 4096); TRRD(h1, (dA) * 512 + 6144); TRRD(m1, (dB) * 512 + 4096); TRRD(n1, (dB) * 512 + 6144); \
        asm volatile("s_waitcnt lgkmcnt(0)" ::: "memory"); SBAR(); \
        o[dA] = __builtin_amdgcn_mfma_f32_32x32x16_bf16(pa0, (bf16x8){l0[0], l0[1], l0[2], l0[3], h0[0], h0[1], h0[2], h0[3]}, o[dA], 0, 0, 0); \
        o[dB] = __builtin_amdgcn_mfma_f32_32x32x16_bf16(pa0, (bf16x8){m0[0], m0[1], m0[2], m0[3], n0[0], n0[1], n0[2], n0[3]}, o[dB], 0, 0, 0); \
        o[dA] = __builtin_amdgcn_mfma_f32_32x32x16_bf16(pa1, (bf16x8){l1[0], l1[1], l1[2], l1[3], h1[0], h1[1], h1[2], h1[3]}, o[dA], 0, 0, 0); \
        o[dB] = __builtin_amdgcn_mfma_f32_32x32x16_bf16(pa1, (bf16x8){m1[0], m1[1], m1[2], m1[3], n1[0], n1[1], n1[2], n1[3]}, o[dB], 0, 0, 0); } while (0)
    PVH(0, 1); PVH(2, 3);
#undef PVH
#undef TRRD
}
__device__ __forceinline__ bool sm_cheap(f32x16& p, float& l_reg, float& alpha, bf16x8& pa0, bf16x8& pa1) {
    alpha = 1.f; l_reg += p[0] + p[15];
    u32x4 w0 = {__builtin_bit_cast(unsigned, p[0]), __builtin_bit_cast(unsigned, p[1]), __builtin_bit_cast(unsigned, p[2]), __builtin_bit_cast(unsigned, p[3])};
    u32x4 w1 = {__builtin_bit_cast(unsigned, p[8]), __builtin_bit_cast(unsigned, p[9]), __builtin_bit_cast(unsigned, p[10]), __builtin_bit_cast(unsigned, p[11])};
    pa0 = __builtin_bit_cast(bf16x8, w0); pa1 = __builtin_bit_cast(bf16x8, w1); return false;
}
template <int VAR = 0, class F>
__device__ __forceinline__ void stream(const Ctx& C0, const bf16x8 (&qr)[8], const bf16_t* Kg, const bf16_t* Vg, size_t ld, unsigned mask, float& m_reg, float& l_reg, f32x16 (&o)[4], const F& f) {
    Ctx C = C0; { int tz = C0.tid; asm volatile("" : "+v"(tz)); C.tid = tz; C.lane = tz & 63; C.r32 = tz & 31; C.hi = (tz >> 5) & 1; }
    const int vb0 = (int)(uintptr_t)(C.lds + L_V) + v_rd_base(C.lane);
    LAS float* ws = (LAS float*)(C.lds + L_WS) + C.wid * 64;
    const DmaOff dof = dma_off(C.wid, C.lane, ld);
    unsigned rem = mask; int j = __builtin_ctz(rem); rem &= rem - 1;
    __syncthreads();
    dma_tile_v(dof, Kg + (size_t)j * 64 * ld, Vg + (size_t)j * 64 * ld, ld, C.lds, 0, 0, C.wid);
    DMA_WAIT();
    __syncthreads();
    int kb = 0, vprev = 2 * SHM, vcur = 0, vnext = SHM;
    bool more = rem != 0u; int jn = j;
    if (more) { jn = __builtin_ctz(rem); rem &= rem - 1; if (!(VAR & 1)) dma_tile_v(dof, Kg + (size_t)jn * 64 * ld, Vg + (size_t)jn * 64 * ld, ld, C.lds, 1, vnext, C.wid); }
#define ST_RESC(a) do { if (C.hi == 0) ws[C.r32] = (a); asm volatile("s_waitcnt lgkmcnt(0)" ::: "memory"); \
        _Pragma("unroll") for (int q = 0; q < 4; ++q) { const f32x4 t = *(const LAS f32x4*)(ws + 8 * q + 4 * C.hi); \
            _Pragma("unroll") for (int d = 0; d < 4; ++d) { o[d][4 * q] *= t[0]; o[d][4 * q + 1] *= t[1]; o[d][4 * q + 2] *= t[2]; o[d][4 * q + 3] *= t[3]; } } } while (0)
    f32x16 pA, pB; float alpha, browA, browB; bf16x8 pa0, pa1;
    bool zA = f.pre(pA, j, 0, browA);
    qkt_half(pA, C.lds + L_K, C.r32, C.hi, qr, zA);
    bool zB = f.pre(pB, j, 1, browB);
    bool first = true;
    for (;;) {
        if (!(VAR & 16)) qkt_half(pB, C.lds + L_K + kb * SHM + 32 * 256, C.r32, C.hi, qr, zB);
        const bool u0 = (VAR & 4) ? sm_cheap(pA, l_reg, alpha, pa0, pa1) : sm_half(pA, m_reg, l_reg, alpha, pa0, pa1, browA);
        if (u0 && !first) ST_RESC(alpha);
        first = false;
        if (!(VAR & 8)) pv_half(o, vb0 + vcur, pa0, pa1); else { o[0][0] += __builtin_bit_cast(float, (int)pa0[0] + (int)pa1[1]); }
        if (!(VAR & 32)) zA = f.pre(pA, jn, 0, browA);
        DMA_WAIT(); if (!(VAR & 2)) __syncthreads();
        if (!more) break;
        j = jn; kb ^= 1; { const int t_ = vprev; vprev = vcur; vcur = vnext; vnext = t_; }
        more = rem != 0u;
        if (more) { jn = __builtin_ctz(rem); rem &= rem - 1; if (!(VAR & 1)) dma_tile_v(dof, Kg + (size_t)jn * 64 * ld, Vg + (size_t)jn * 64 * ld, ld, C.lds, kb ^ 1, vnext, C.wid); }
        if (!(VAR & 16)) qkt_half(pA, C.lds + L_K + kb * SHM, C.r32, C.hi, qr, zA);
        const bool u1 = (VAR & 4) ? sm_cheap(pB, l_reg, alpha, pa0, pa1) : sm_half(pB, m_reg, l_reg, alpha, pa0, pa1, browB);
        if (u1) ST_RESC(alpha);
        if (!(VAR & 8)) pv_half(o, vb0 + vprev + 8192, pa0, pa1); else { o[1][0] += __builtin_bit_cast(float, (int)pa0[2] + (int)pa1[3]); }
        if (!(VAR & 32)) zB = f.pre(pB, j, 1, browB);
    }
    { const bool u1 = sm_half(pB, m_reg, l_reg, alpha, pa0, pa1, browB);
      if (u1) ST_RESC(alpha);
      pv_half(o, vb0 + vcur + 8192, pa0, pa1); }
    __syncthreads();
#undef ST_RESC
}
__device__ __forceinline__ void load_q(bf16x8 (&qr)[8], const bf16_t* qrow, const float* gain, int hi) {
    u32x4 raw[8]; float ss = 0.f;
#pragma unroll
    for (int d0 = 0; d0 < 8; ++d0) { raw[d0] = *(const u32x4*)(qrow + d0 * 16 + hi * 8);
#pragma unroll
        for (int e = 0; e < 4; ++e) { const float a = bf_lo(raw[d0][e]), b = bf_hi(raw[d0][e]); ss += a * a + b * b; } }
    ss = pswap_sum(ss);
    const float f = __builtin_amdgcn_rsqf(ss * (1.f / HD) + RMS_EPS) * (ATTN_SCALE * LOG2E);
#pragma unroll
    for (int d0 = 0; d0 < 8; ++d0) { const f32x4 g0 = *(const f32x4*)(gain + d0 * 16 + hi * 8), g1 = *(const f32x4*)(gain + d0 * 16 + hi * 8 + 4);
        u32x4 w; w.x = cvtpk(bf_lo(raw[d0].x) * f * g0[0], bf_hi(raw[d0].x) * f * g0[1]); w.y = cvtpk(bf_lo(raw[d0].y) * f * g0[2], bf_hi(raw[d0].y) * f * g0[3]);
        w.z = cvtpk(bf_lo(raw[d0].z) * f * g1[0], bf_hi(raw[d0].z) * f * g1[1]); w.w = cvtpk(bf_lo(raw[d0].w) * f * g1[2], bf_hi(raw[d0].w) * f * g1[3]);
        qr[d0] = __builtin_bit_cast(bf16x8, w); }
}
__device__ __forceinline__ void store_o(const f32x16 (&v)[4], const float (&w)[16], bf16_t* orow0, size_t ld, LAS char* lds, int wid, int lane_, bool accum) {
    int lane = lane_; asm volatile("" : "+v"(lane));
    const int r32 = lane & 31, hi = lane >> 5;
    LAS char* st = lds + wid * 8192;
    const bool odd = (r32 & 1) != 0;
#pragma unroll
    for (int r = 0; r < 16; r += 2) { LAS char* rowp = st + (crow(r, hi) + (odd ? 1 : 0)) * 256 + (r32 & ~1) * 2;
#pragma unroll
        for (int d = 0; d < 4; ++d) { const float a = v[d][r] * w[r], b = v[d][r + 1] * w[r + 1];
            const float recv = __builtin_bit_cast(float, __builtin_amdgcn_mov_dpp(__builtin_bit_cast(int, odd ? a : b), 0xB1, 0xF, 0xF, true));
            *(LAS unsigned*)(rowp + d * 64) = cvtpk(odd ? recv : a, odd ? b : recv); } }
    asm volatile("s_waitcnt lgkmcnt(0)" ::: "memory");
    u32x4 ov[8];
    if (accum) {
#pragma unroll
        for (int it = 0; it < 8; ++it) { const int id = it * 64 + lane, row = id >> 4, c16 = id & 15; ov[it] = *(const u32x4*)(orow0 + (size_t)row * ld + c16 * 8); }
        asm volatile("s_waitcnt vmcnt(0)" ::: "memory"); }
#pragma unroll
    for (int it = 0; it < 8; ++it) { const int id = it * 64 + lane, row = id >> 4, c16 = id & 15;
        u32x4 nv = *(const LAS u32x4*)(st + row * 256 + c16 * 16);
        if (accum) {
#pragma unroll
            for (int e = 0; e < 4; ++e) nv[e] = cvtpk(bf_lo(nv[e]) + bf_lo(ov[it][e]), bf_hi(nv[e]) + bf_hi(ov[it][e])); }
        *(u32x4*)(orow0 + (size_t)row * ld + c16 * 8) = nv; }
    asm volatile("s_waitcnt lgkmcnt(0)" ::: "memory");
}

struct Tensors {
    const bf16_t* PA; const float* GL; const bf16_t* KVM; const bf16_t* KC; const bf16_t* VC; const float* CUM; bf16_t* OC;
    const float* nsa_q_g; const float* fox_q_g; const float* mem_q_g; const float* rel_bias;
};

template <int TY> struct BiasUni {
    const Ctx* C; const LAS float* tb; int u; unsigned sel; int mode;
    __device__ __forceinline__ bool pre(f32x16& bv, int j, int half, float& brow) const {
        const float NEG = -__builtin_inff();
        const int dq = C->trow - 64 * j - 4 * C->hi - 32 * half;
        brow = 0.f;
        if constexpr (TY == 0) {
            const bool win = mode == 1; const bool on = win || ((sel >> j) & 1u);
            if (j + 3 <= u && !(win && j + 8 <= u)) {
                brow = on ? tb[128] : NEG; return true;
            } else {
#pragma unroll
                for (int q = 0; q < 4; ++q) {
#pragma unroll
                    for (int e = 0; e < 4; ++e) { const int r = 4 * q + e, c = e + 8 * q, rel = dq - c;
                        const bool ok = on && (unsigned)rel < 512u; const float b = tb[min(max(rel, 0), 128)];
                        bv[r] = ok ? b : NEG; }
                    SBAR(); }
            }
        } else if constexpr (TY == 1) {
            const LAS float* cb = (const LAS float*)(C->lds + L_CUM) + 64 * j + 4 * C->hi + 32 * half;
            const bool msk = 64 * j + 63 > C->qlo;
#pragma unroll
            for (int q = 0; q < 4; ++q) { const f32x4 a = *(const LAS f32x4*)(cb + 8 * q);
#pragma unroll
                for (int e = 0; e < 4; ++e) { const int r = 4 * q + e, c = e + 8 * q; bv[r] = (msk && dq - c < 0) ? NEG : a[e]; } }
        } else {
            return true;
        }
        return false;
    }
};

__device__ __forceinline__ void nsa_pre(Ctx& C, const Tensors& Tn, const bf16x8 (&qr)[8], int b, int g, int u, float g_c, bf16_t* orow0, unsigned& sel_out, unsigned& U_out) {
    { int tz = C.tid; asm volatile("" : "+v"(tz)); C.tid = tz; C.lane = tz & 63; C.r32 = tz & 31; C.hi = (tz >> 5) & 1; }
    const int hh = C.wid >> 1, pos = (C.wid & 1) * 32 + C.r32, head = g * 4 + hh;
    const LAS float* tb = (const LAS float*)(C.lds + L_TBL) + head * 132;
    LAS float* ws = (LAS float*)(C.lds + L_WS) + C.wid * 64;
    LAS unsigned* SEL = (LAS unsigned*)(C.lds + L_SEL);
    const float NEG = -__builtin_inff();
    const int vb0 = (int)(uintptr_t)(C.lds + L_V) + v_rd_base(C.lane);
    {
        const bf16_t* KCb = Tn.KC + (size_t)(b * 2 + g) * 128 * HD; const bf16_t* VCb = Tn.VC + (size_t)(b * 2 + g) * 128 * HD;
        const DmaOff dof = dma_off(C.wid, C.lane, HD);
        __syncthreads();
        if (C.tid < 65) SEL[C.tid] = 0u;
        dma_tile(dof, KCb, VCb, HD, C.lds, 0, 0, C.wid); dma_tile(dof, KCb + 64 * HD, VCb + 64 * HD, HD, C.lds, 1, 1, C.wid);
        DMA_WAIT();
        __syncthreads();
        f32x16 P[4];
        const int dq = C.trow - 31 - 64 * C.hi;
#pragma unroll
        for (int X = 0; X < 4; ++X)
#pragma unroll
            for (int r = 0; r < 16; ++r) { const int c = (r & 3) + 8 * (r >> 2), rel = dq - 16 * (32 * X + c);
                const float bb = tb[min(max(rel, 0), 128)]; P[X][r] = rel >= 0 ? bb : NEG; }
        qkt(P[0], P[1], C.lds + L_K, C.r32, C.hi, qr); qkt(P[2], P[3], C.lds + L_K + SHM, C.r32, C.hi, qr);
        float pmax = NEG;
#pragma unroll
        for (int X = 0; X < 4; ++X)
#pragma unroll
            for (int r = 0; r < 16; ++r) pmax = fmaxf(pmax, P[X][r]);
        pmax = pswap_max(pmax);
        const float mm = pmax == NEG ? 0.f : pmax;
        float ps = 0.f;
#pragma unroll
        for (int X = 0; X < 4; ++X)
#pragma unroll
            for (int r = 0; r < 16; ++r) { P[X][r] = __builtin_amdgcn_exp2f(P[X][r] - mm); ps += P[X][r]; }
        ps = pswap_sum(ps);
        const float inv = ps > 0.f ? 1.f / ps : 0.f;
        if (u >= 16) {
            LAS float* imp = (LAS float*)(C.lds + L_IMP) + (hh * 64 + pos) * 32;
            float bprev = 0.f;
#pragma unroll
            for (int X = 0; X < 4; ++X)
#pragma unroll
                for (int q = 0; q < 4; ++q) { const float b3 = 0.5f * P[X][4 * q + 3];
                    const float aG = P[X][4 * q] + P[X][4 * q + 1] + P[X][4 * q + 2] + b3;
                    const auto sw_ = __builtin_amdgcn_permlane32_swap(__float_as_uint(b3), __float_as_uint(b3), false, false);
                    const float bp = __uint_as_float(C.hi ? sw_[0] : sw_[1]);
                    const float val = aG + (C.hi ? bp : bprev);
                    imp[2 * (4 * X + q) + C.hi] = val * inv;
                    bprev = bp; }
        }
        f32x16 o[4] = {};
        bf16x8 pa0, pa1, pa2, pa3;
        pack_p(P[0], P[1], pa0, pa1, pa2, pa3); pv_tile(o, vb0, pa0, pa1, pa2, pa3);
        pack_p(P[2], P[3], pa0, pa1, pa2, pa3); pv_tile(o, vb0 + SHM, pa0, pa1, pa2, pa3);
        float w[16]; bcast_rows(w, g_c * inv, ws, C.r32, C.hi);
        __syncthreads();
        store_o(o, w, orow0, D, C.lds, C.wid, C.lane, false);
    }
    if (u >= 16) {
        const int p = C.tid & 63, jg = C.tid >> 6;
        const LAS float* i0 = (const LAS float*)(C.lds + L_IMP) + p * 32;
        float sc[32];
#pragma unroll
        for (int j4 = 0; j4 < 8; ++j4) { const f32x4 a = *(const LAS f32x4*)(i0 + 4 * j4), b2 = *(const LAS f32x4*)(i0 + 2048 + 4 * j4), c2 = *(const LAS f32x4*)(i0 + 4096 + 4 * j4), d2 = *(const LAS f32x4*)(i0 + 6144 + 4 * j4);
#pragma unroll
            for (int e = 0; e < 4; ++e) { const int j = 4 * j4 + e; const float s = ((a[e] + b2[e]) + c2[e]) + d2[e];
                const bool valid = j <= u, forced = j == 0 || j == u || j == u - 1;
                sc[j] = valid ? (forced ? 1e4f : s) : -1.f; } }
        unsigned bits = 0u;
#pragma unroll
        for (int e = 0; e < 4; ++e) { const int j = 4 * jg + e; float sj = 0.f;
#pragma unroll
            for (int k = 0; k < 32; ++k) sj = (k == j) ? sc[k] : sj;
            int rank = 0;
#pragma unroll
            for (int k = 0; k < 32; ++k) rank += (sc[k] > sj || (sc[k] == sj && k < j)) ? 1 : 0;
            if (j <= u && rank < 16) bits |= 1u << j; }
        ((LAS unsigned char*)(C.lds + L_NIB))[p * 8 + jg] = (unsigned char)(bits >> (4 * jg));
        __syncthreads();
        if (C.tid < 64) { const u32x2 nb = *(const LAS u32x2*)(C.lds + L_NIB + C.tid * 8); unsigned full = 0u;
#pragma unroll
            for (int k = 0; k < 4; ++k) { full |= ((nb.x >> (8 * k)) & 0xfu) << (4 * k); full |= ((nb.y >> (8 * k)) & 0xfu) << (16 + 4 * k); }
            SEL[C.tid] = full; unsigned un = full;
#pragma unroll
            for (int o = 1; o < 64; o <<= 1) un |= __shfl_xor(un, o);
            if (C.tid == 0) SEL[64] = un; }
    } else { if (C.tid < 65) SEL[C.tid] = (2u << u) - 1u; }
    __syncthreads();
    sel_out = SEL[pos]; U_out = SEL[64];
}
__device__ __forceinline__ int dequeue(LAS char* lds, unsigned* head, int tid) {
    if (tid == 0) *(LAS int*)(lds + L_Q) = (int)__hip_atomic_fetch_add(head, 1u, RLX_AGENT);
    __syncthreads();
    const int q = *(const LAS int*)(lds + L_Q);
    __syncthreads();
    return q;
}
#ifndef DBL_VAR
#define DBL_VAR 0
#endif
#ifndef DBL_STREAM
#define DBL_STREAM 0
#endif
#ifndef CONV_IN_P0
#define CONV_IN_P0 0
#endif
__device__ __forceinline__ void conv_some(const Frame& F, LAS char* lds, unsigned* chead, int n) {
    if (CONV_IN_P0) return;
    if (F.tid == 0) *(LAS int*)(lds + L_Q) = (int)__hip_atomic_fetch_add(chead, (unsigned)n, RLX_AGENT);
    __syncthreads();
    const int base = *(const LAS int*)(lds + L_Q);
    __syncthreads();
    conv_batch(F, base, base + n);
}
__device__ __forceinline__ void attn_phase(const Frame& F, LAS char* lds, const Tensors& Tn, unsigned* qhead) {
    Ctx C; C.lds = lds; C.tid = threadIdx.x; C.wid = __builtin_amdgcn_readfirstlane(C.tid >> 6); C.lane = C.tid & 63; C.r32 = C.lane & 31; C.hi = C.lane >> 5; C.trow = 0; C.qlo = 0;
    for (int i = C.tid; i < 8 * 129; i += 512) { const int head = i / 129, rel = i - head * 129; const int bk = rel < 128 ? T5B[rel] : 31;
        ((LAS float*)(lds + L_TBL))[head * 132 + rel] = Tn.rel_bias[bk * 8 + head] * LOG2E; }
    __syncthreads();
    LAS float* ws = (LAS float*)(lds + L_WS) + C.wid * 64;
#ifndef PASS_MASK
#define PASS_MASK 7
#endif
    int nconv = (int)((blockIdx.x >> 3) & 7) * 7;
    if (PASS_MASK & 1) for (;;) {
        conv_some(F, lds, qhead + 192, nconv); nconv = 9;
        const int q = dequeue(lds, qhead, C.tid); if (q >= 512) break;
        const int u = 31 - (q >> 4), b = (q >> 1) & 7, g = q & 1, head = g * 4 + (C.wid >> 1);
        C.qlo = 64 * u + (C.wid & 1) * 32; C.trow = C.qlo + C.r32;
        const size_t tok = (size_t)b * T + C.trow;
        bf16x8 qr[8]; load_q(qr, Tn.PA + tok * NPA + CQ_NSA + head * HD, Tn.nsa_q_g, C.hi);
        bf16_t* orow0 = Tn.OC + ((size_t)b * T + C.qlo) * D + head * HD;
        const LAS float* tb = (const LAS float*)(lds + L_TBL) + head * 132;
        const float* gl = Tn.GL + tok * LDG; const float g_c = fast_sigmoid(gl[head]), g_s = fast_sigmoid(gl[8 + head]), g_w = fast_sigmoid(gl[16 + head]);
        unsigned sel, U; nsa_pre(C, Tn, qr, b, g, u, g_c, orow0, sel, U);
        const bf16_t* PAb = Tn.PA + (size_t)b * T * NPA + g * HD;
        int br = 0;
        do {
            const unsigned mask = br ? (((2u << u) - 1u) & ~(u >= 9 ? ((1u << (u - 8)) - 1u) : 0u)) : U;
            f32x16 o[4] = {}; float m_reg = -1e30f, l_reg = 0.f;
            stream(C, qr, PAb + (br ? CK_WIN : CK_SLC), PAb + (br ? CV_WIN : CV_SLC), NPA, mask, m_reg, l_reg, o, BiasUni<0>{&C, tb, u, sel, br});
            float w[16]; bcast_rows(w, l_reg > 0.f ? (br ? g_w : g_s) / l_reg : 0.f, ws, C.r32, C.hi);
            store_o(o, w, orow0, D, lds, C.wid, C.lane, true);
#if DBL_STREAM
            { f32x16 o2[4] = {}; float m2 = -1e30f, l2 = 0.f; stream<DBL_VAR>(C, qr, PAb + (br ? CK_WIN : CK_SLC), PAb + (br ? CV_WIN : CV_SLC), NPA, mask, m2, l2, o2, BiasUni<0>{&C, tb, u, sel, br}); float sk = ((o2[0][0] + o2[1][0]) + (o2[2][0] + o2[3][0])) + l2 + m2; asm volatile("" :: "v"(sk)); }
#endif
            ++br; asm volatile("" : "+s"(br));
        } while (br < 2);
    }
    if (PASS_MASK & 2) for (;;) {
        const int q = dequeue(lds, qhead + 64, C.tid); if (q >= 256) break;
        const int qb = 7 - (q >> 5), b = (q >> 2) & 7, h = q & 3;
        C.qlo = 256 * qb + 32 * C.wid; C.trow = C.qlo + C.r32;
        const size_t tok = (size_t)b * T + C.trow;
        bf16x8 qr[8]; load_q(qr, Tn.PA + tok * NPA + CQ_FOX + h * HD, Tn.fox_q_g, C.hi);
        { LAS float* cl = (LAS float*)(lds + L_CUM); const float* cg = Tn.CUM + (size_t)(b * 4 + h) * T;
          for (int i = C.tid; i < 256 * (qb + 1); i += 512) cl[i] = -cg[i] * LOG2E; }
        const bf16_t* PAb = Tn.PA + (size_t)b * T * NPA + h * HD;
        const unsigned mask = qb == 7 ? 0xffffffffu : ((1u << (4 * qb + 4)) - 1u);
        f32x16 o[4] = {}; float m_reg = -1e30f, l_reg = 0.f;
        stream(C, qr, PAb + CK_FOX, PAb + CV_FOX, NPA, mask, m_reg, l_reg, o, BiasUni<1>{&C, nullptr, 0, 0u, 2});
        float w[16]; bcast_rows(w, l_reg > 0.f ? 1.f / l_reg : 0.f, ws, C.r32, C.hi);
        store_o(o, w, Tn.OC + ((size_t)b * T + C.qlo) * D + 1024 + h * HD, D, lds, C.wid, C.lane, false);
#if DBL_STREAM
        { f32x16 o2[4] = {}; float m2 = -1e30f, l2 = 0.f; stream<DBL_VAR>(C, qr, PAb + CK_FOX, PAb + CV_FOX, NPA, mask, m2, l2, o2, BiasUni<1>{&C, nullptr, 0, 0u, 2}); float sk = ((o2[0][0] + o2[1][0]) + (o2[2][0] + o2[3][0])) + l2 + m2; asm volatile("" :: "v"(sk)); }
#endif
        conv_some(F, lds, qhead + 192, 6);
    }
    if (PASS_MASK & 4) for (;;) {
        const int q = dequeue(lds, qhead + 128, C.tid); if (q >= 256) break;
        const int qb = q & 7, h = (q >> 3) & 3, b = q >> 5;
        C.qlo = 256 * qb + 32 * C.wid; C.trow = C.qlo + C.r32;
        const size_t tok = (size_t)b * T + C.trow;
        bf16x8 qr[8]; load_q(qr, Tn.PA + tok * NPA + CQ_MEM + h * HD, Tn.mem_q_g, C.hi);
        const bf16_t* Kb = Tn.KVM + (size_t)b * MEMT * 1024 + h * HD;
        f32x16 o[4] = {}; float m_reg = -1e30f, l_reg = 0.f;
        stream(C, qr, Kb, Kb + 512, 1024, 0xfu, m_reg, l_reg, o, BiasUni<2>{&C, nullptr, 0, 0u, 3});
        float w[16]; bcast_rows(w, l_reg > 0.f ? 1.f / l_reg : 0.f, ws, C.r32, C.hi);
        store_o(o, w, Tn.OC + ((size_t)b * T + C.qlo) * D + 1536 + h * HD, D, lds, C.wid, C.lane, false);
#if DBL_STREAM
        { f32x16 o2[4] = {}; float m2 = -1e30f, l2 = 0.f; stream<DBL_VAR>(C, qr, Kb, Kb + 512, 1024, 0xfu, m2, l2, o2, BiasUni<2>{&C, nullptr, 0, 0u, 3}); float sk = ((o2[0][0] + o2[1][0]) + (o2[2][0] + o2[3][0])) + l2 + m2; asm volatile("" :: "v"(sk)); }
#endif
        conv_some(F, lds, qhead + 192, 2);
    }
    if (!CONV_IN_P0) for (;;) {
        if (F.tid == 0) *(LAS int*)(lds + L_Q) = (int)__hip_atomic_fetch_add(qhead + 192, 8u, RLX_AGENT);
        __syncthreads();
        const int base = *(const LAS int*)(lds + L_Q);
        __syncthreads();
        if (base >= 3 * 65 * 64) break;
        conv_batch(F, base, base + 8);
    }
}
#undef KSWZ
#undef SBAR
}

__device__ __forceinline__ void p0_prologue(Frame& F) {
    LAS float* scr = (LAS float*)(F.lds + 40960 + F.wave * 8704);
    unsigned char* ws = F.ws; const int lane = F.lane;
    if (F.gw < 128) { const int kv = F.gw >> 6, j = F.gw & 63; const float* pe = F.in(kv ? I_PE_V : I_PE_K) + 64 * j; const float* w = F.in(kv ? I_W_CV : I_W_CK) + (size_t)64 * j * 128; float a0 = 0.f, a1 = 0.f;
#pragma unroll 16
        for (int k = 0; k < 64; ++k) { const float p = pe[k]; a0 += p * w[(size_t)k * 128 + lane]; a1 += p * w[(size_t)k * 128 + 64 + lane]; }
        float* cb = (float*)(ws + WS_CBIAS) + (size_t)(kv * 64 + j) * 128; cb[lane] = a0; cb[64 + lane] = a1; }
    constexpr int S0 = 32 * 8, S1 = S0 + 64;
    bf16_t* WinT = (bf16_t*)(ws + WS_WINT);
    for (int it = F.gw; it < S1; it += F.NGW) {
        if (it < S0) { }
        else {
            const int r = it - S0, kb = r >> 1, nb = r & 1, k0 = 64 * kb, n0 = 32 * nb; const float* W = F.in(I_W_ROUTER);
#pragma unroll 8
            for (int i = 0; i < 32; ++i) { const int kk = 2 * i + (lane >> 5); scr[kk * 33 + (lane & 31)] = W[(size_t)(k0 + kk) * NE + n0 + (lane & 31)]; }
            LDS_WAIT(); asm volatile("" ::: "memory");
            const int c8 = lane & 7; bf16_t* Whi = (bf16_t*)(ws + WS_WRT); bf16_t* Wlo = Whi + (size_t)NE * D;
#pragma unroll
            for (int j = 0; j < 4; ++j) { const int n = (lane >> 3) + 8 * j; const LAS float* s = scr + (8 * c8) * 33 + n; unsigned h[4], l[4];
#pragma unroll
                for (int q = 0; q < 4; ++q) { const float a = s[(2 * q) * 33], b = s[(2 * q + 1) * 33]; h[q] = cvtpk(a, b); l[q] = cvtpk(a - bf_lo(h[q]), b - bf_hi(h[q])); }
                *(u32x4*)(Whi + (size_t)(n0 + n) * D + k0 + 8 * c8) = (u32x4){h[0], h[1], h[2], h[3]};
                *(u32x4*)(Wlo + (size_t)(n0 + n) * D + k0 + 8 * c8) = (u32x4){l[0], l[1], l[2], l[3]}; }
            LDS_WAIT(); asm volatile("" ::: "memory");
        }
    }
    {
        LAS unsigned* T32 = (LAS unsigned*)F.lds;
        int t = blockIdx.x; f32x4 v[8]; Tr8Desc d = tr8w_decode(F, t < TR8W_NTILES ? t : 0);
        if (t < TR8W_NTILES) tr8_load(d, v, F.wave, lane);
        while (t < TR8W_NTILES) {
            tr8_to_lds(v, d.scale, T32, F.wave, lane);
            __syncthreads();
            const int tn = t + F.G; const Tr8Desc dn = tr8w_decode(F, tn < TR8W_NTILES ? tn : 0);
            if (tn < TR8W_NTILES) tr8_load(dn, v, F.wave, lane);
            tr8_from_lds(d, T32, F.wave, lane);
            __syncthreads();
            t = tn; d = dn;
        }
    }
    {
        LAS unsigned* T32 = (LAS unsigned*)F.lds;
        constexpr int NT0 = TR_FIRST_EXPERT;
        int t = blockIdx.x; f32x4 v[8]; TrDesc d = tr_decode(F, t < NT0 ? t : 0);
        if (t < NT0) tr_load(d, v, F.wave, lane);
        while (t < NT0) {
            tr_to_lds(v, T32, F.wave, lane);
            __syncthreads();
            const int tn = t + F.G; const TrDesc dn = tr_decode(F, tn < NT0 ? tn : 0);
            if (tn < NT0) tr_load(dn, v, F.wave, lane);
            tr_from_lds(d, T32, F.wave, lane);
            __syncthreads();
            t = tn; d = dn;
        }
    }
    if (CONV_IN_P0) { __syncthreads(); for (int base = blockIdx.x * 8; base < 3 * 65 * 64; base += F.G * 8) conv_batch(F, base, base + 8); }
    __syncthreads();
    bf16_t* A3 = (bf16_t*)(ws + WS_A3); unsigned char* H8 = ws + WS_H8;
    {
        constexpr int TSTR = 4096 + 16;
        LAS unsigned char* tile = F.lds; LAS float* red = (LAS float*)(F.lds + 16 * TSTR);
        const int w = F.wave, fr = lane & 15, fq = lane >> 4;
        bf16x8 Bf[8][2];
        { const float* W = F.in(I_W_IN);
#pragma unroll
          for (int c = 0; c < 8; ++c)
#pragma unroll
              for (int hf = 0; hf < 2; ++hf) { const int j = fr + 16 * hf, sc = j < 24 ? 2560 + j : (j < 28 ? 4120 + (j - 24) : -1); const float* p = W + (size_t)(256 * w + 32 * c + 8 * fq) * W_IN_COLS + (sc >= 0 ? sc : 0);
                  float x[8];
#pragma unroll
                  for (int e = 0; e < 8; ++e) x[e] = sc >= 0 ? p[(size_t)e * W_IN_COLS] : 0.f;
                  u32x4 pk = {cvtpk(x[0], x[1]), cvtpk(x[2], x[3]), cvtpk(x[4], x[5]), cvtpk(x[6], x[7])}; Bf[c][hf] = __builtin_bit_cast(bf16x8, pk); } }
        const float* X = F.in(I_X); const float* gain = F.in(I_NORM_ATTN_G); float* GLp = (float*)(ws + WS_GL);
        for (int m0 = blockIdx.x * 16; m0 < M; m0 += F.G * 16) {
#pragma unroll
            for (int r = 0; r < 2; ++r) { const int m = m0 + 2 * w + r; const float* xrow = X + (size_t)m * D;
                f32x4 v[8]; float ss = 0.f;
#pragma unroll
                for (int j = 0; j < 8; ++j) { v[j] = *(const f32x4*)(xrow + 4 * lane + 256 * j); ss += (v[j].x * v[j].x + v[j].y * v[j].y) + (v[j].z * v[j].z + v[j].w * v[j].w); }
                const float rstd = __builtin_amdgcn_rsqf(wave_sum(ss) * (1.f / D) + RMS_EPS);
#pragma unroll
                for (int j = 0; j < 8; ++j) { const f32x4 g = *(const f32x4*)(gain + 4 * lane + 256 * j); const float a = v[j].x * rstd * g.x, b = v[j].y * rstd * g.y, c = v[j].z * rstd * g.z, d = v[j].w * rstd * g.w;
                    u32x2 o; o.x = cvtpk(a, b); o.y = cvtpk(c, d);
                    *(LAS u32x2*)(tile + (2 * w + r) * TSTR + (4 * lane + 256 * j) * 2) = o;
                    if (NB16 > 0) *(u32x2*)(A3 + (size_t)m * D + 4 * lane + 256 * j) = o;
                    *(unsigned*)(H8 + (size_t)m * D + 4 * lane + 256 * j) = pk_fp8x4(a, b, c, d); } }
            __syncthreads();
            f32x4 a0 = {0.f, 0.f, 0.f, 0.f}, a1 = {0.f, 0.f, 0.f, 0.f};
#pragma unroll
            for (int c = 0; c < 8; ++c) { const bf16x8 af = *(const LAS bf16x8*)(tile + fr * TSTR + (256 * w + 32 * c + 8 * fq) * 2);
                a0 = __builtin_amdgcn_mfma_f32_16x16x32_bf16(af, Bf[c][0], a0, 0, 0, 0); a1 = __builtin_amdgcn_mfma_f32_16x16x32_bf16(af, Bf[c][1], a1, 0, 0, 0); }
#pragma unroll
            for (int r = 0; r < 4; ++r) { red[(w * 16 + 4 * fq + r) * 32 + fr] = a0[r]; red[(w * 16 + 4 * fq + r) * 32 + 16 + fr] = a1[r]; }
            __syncthreads();
            { const int row = F.tid >> 5, col = F.tid & 31; float sacc = 0.f;
#pragma unroll
              for (int ww = 0; ww < 8; ++ww) sacc += red[(ww * 16 + row) * 32 + col];
              GLp[(size_t)(m0 + row) * LDG + col] = sacc; }
            asm volatile("s_waitcnt vmcnt(0) lgkmcnt(0)" ::: "memory");
            __syncthreads();
        }
        for (int m = M + F.gw; m < M + MROWS; m += F.NGW) rms_row_bf16(F.in(I_MEM) + (size_t)(m - M) * D, F.in(I_NORM_MEM_G), A3 + (size_t)m * D, lane);
    }
}

__device__ __forceinline__ void p2_thin(Frame& F) {
    unsigned char* ws = F.ws; const int lane = F.lane;
    bf16_t* PA = (bf16_t*)(ws + WS_PA); bf16_t* KVM = (bf16_t*)(ws + WS_KVMEM); const float* GL = (const float*)(ws + WS_GL);
    {
        LAS float* part = (LAS float*)F.lds;
        LAS float* red = (LAS float*)(F.lds + 65536);
        const int i16 = lane & 15, kg = lane >> 4, w = F.wave;
        for (int item = blockIdx.x; item < 128; item += F.G) {
            const int kv = item & 1, rt2 = (item >> 1) & 3, bg = item >> 3, b = bg >> 1, g = bg & 1;
            const int n0 = 32 * rt2 + i16, n1 = n0 + 16, ne0 = n0 < 127 ? n0 : 126, ne1 = n1 < 127 ? n1 : 126;
            const bf16_t* Ab0 = PA + ((size_t)(b * T + 16 * ne0 + 4 * w) * NPA + (kv ? CV_CMP : CK_CMP) + g * HD) + 8 * kg;
            const bf16_t* Ab1 = PA + ((size_t)(b * T + 16 * ne1 + 4 * w) * NPA + (kv ? CV_CMP : CK_CMP) + g * HD) + 8 * kg;
            const bf16_t* Bb = (const bf16_t*)(ws + (kv ? WS_WCV : WS_WCK)) + (size_t)i16 * 4096 + 512 * w + 8 * kg;
            f32x4 acc2[2][8];
#pragma unroll
            for (int nt = 0; nt < 8; ++nt) { acc2[0][nt] = (f32x4){0.f, 0.f, 0.f, 0.f}; acc2[1][nt] = (f32x4){0.f, 0.f, 0.f, 0.f}; }
#pragma unroll 2
            for (int s = 0; s < 16; ++s) { const bf16x8 a0 = *(const bf16x8*)(Ab0 + (size_t)(s >> 2) * NPA + 32 * (s & 3)), a1 = *(const bf16x8*)(Ab1 + (size_t)(s >> 2) * NPA + 32 * (s & 3));
#pragma unroll
                for (int nt = 0; nt < 8; ++nt) { const bf16x8 bb = *(const bf16x8*)(Bb + (size_t)nt * 16 * 4096 + 32 * s);
                    acc2[0][nt] = __builtin_amdgcn_mfma_f32_16x16x32_bf16(a0, bb, acc2[0][nt], 0, 0, 0); acc2[1][nt] = __builtin_amdgcn_mfma_f32_16x16x32_bf16(a1, bb, acc2[1][nt], 0, 0, 0); } }
#pragma unroll
          for (int hh = 0; hh < 2; ++hh) { const int rt = 2 * rt2 + hh;
            __syncthreads();
#pragma unroll
            for (int nt = 0; nt < 8; ++nt) *(LAS f32x4*)(part + ((w * 8 + nt) * 64 + lane) * 4) = acc2[hh][nt];
            __syncthreads();
            f32x4 t = {0.f, 0.f, 0.f, 0.f};
#pragma unroll
            for (int ww = 0; ww < 8; ++ww) t += *(const LAS f32x4*)(part + ((ww * 8 + w) * 64 + lane) * 4);
            const int e = 16 * w + i16; float cb = 0.f;
#pragma unroll 16
            for (int j = 0; j < 64; ++j) cb += ((const float*)(ws + WS_CBIAS))[(size_t)(kv * 64 + j) * 128 + e];
#pragma unroll
            for (int r = 0; r < 4; ++r) t[r] += cb;
            float scl[4] = {1.f, 1.f, 1.f, 1.f};
            if (kv == 0) {
#pragma unroll
                for (int r = 0; r < 4; ++r) { float q = t[r] * t[r]; q += __shfl_xor(q, 1); q += __shfl_xor(q, 2); q += __shfl_xor(q, 4); q += __shfl_xor(q, 8); if (i16 == 0) red[w * 16 + 4 * kg + r] = q; }
            }
            __syncthreads();
            if (kv == 0) { const float kgain = F.in(I_NSA_K_G)[e];
#pragma unroll
                for (int r = 0; r < 4; ++r) { float q = 0.f;
#pragma unroll
                    for (int ww = 0; ww < 8; ++ww) q += red[ww * 16 + 4 * kg + r];
                    scl[r] = __builtin_amdgcn_rsqf(q * (1.f / HD) + RMS_EPS) * kgain; } }
            bf16_t* Ob = (bf16_t*)(ws + (kv ? WS_VC : WS_KC)) + (size_t)bg * 128 * HD;
#pragma unroll
            for (int r = 0; r < 4; ++r) { const int nn = 16 * rt + 4 * kg + r; const float v = nn < 127 ? t[r] * scl[r] : 0.f; Ob[(size_t)nn * HD + e] = (bf16_t)(cvtpk(v, 0.f) & 0xffffu); }
          }
        }
    }
    const int g0 = F.G >= 256 ? 128 * 8 : 0, gwa = F.gw - g0, ngwa = F.NGW - g0;
    if (gwa < 0) return;
#pragma unroll 2
    for (int row = gwa; row < M; row += ngwa) {
        const int hd = lane >> 3, col = (hd < 2 ? CK_SLC + hd * HD : (hd < 4 ? CK_WIN + (hd - 2) * HD : CK_FOX + (hd - 4) * HD)) + (lane & 7) * 16;
        bf16_t* p = PA + (size_t)row * NPA + col; const u32x4 r0 = *(const u32x4*)p, r1 = *(const u32x4*)(p + 8);
        float ss = 0.f;
#pragma unroll
        for (int e = 0; e < 4; ++e) { ss += bf_lo(r0[e]) * bf_lo(r0[e]) + bf_hi(r0[e]) * bf_hi(r0[e]) + bf_lo(r1[e]) * bf_lo(r1[e]) + bf_hi(r1[e]) * bf_hi(r1[e]); }
        ss += __shfl_xor(ss, 1); ss += __shfl_xor(ss, 2); ss += __shfl_xor(ss, 4);
        const float rstd = __builtin_amdgcn_rsqf(ss * (1.f / HD) + RMS_EPS); const float* gn = F.in(hd < 4 ? I_NSA_K_G : I_FOX_K_G) + (lane & 7) * 16;
        u32x4 o0, o1;
#pragma unroll
        for (int e = 0; e < 4; ++e) { o0[e] = cvtpk(bf_lo(r0[e]) * rstd * gn[2 * e], bf_hi(r0[e]) * rstd * gn[2 * e + 1]); o1[e] = cvtpk(bf_lo(r1[e]) * rstd * gn[8 + 2 * e], bf_hi(r1[e]) * rstd * gn[8 + 2 * e + 1]); }
        *(u32x4*)p = o0; *(u32x4*)(p + 8) = o1;
    }
    for (int mr = gwa; mr < MROWS; mr += ngwa) {
        bf16_t* p = KVM + (size_t)mr * 1024 + (lane >> 4) * HD + (lane & 15) * 8; const u32x4 r0 = *(const u32x4*)p; float ss = 0.f;
#pragma unroll
        for (int e = 0; e < 4; ++e) ss += bf_lo(r0[e]) * bf_lo(r0[e]) + bf_hi(r0[e]) * bf_hi(r0[e]);
        ss += __shfl_xor(ss, 1); ss += __shfl_xor(ss, 2); ss += __shfl_xor(ss, 4); ss += __shfl_xor(ss, 8);
        const float rstd = __builtin_amdgcn_rsqf(ss * (1.f / HD) + RMS_EPS); const float* gn = F.in(I_MEM_K_G) + (lane & 15) * 8; u32x4 o0;
#pragma unroll
        for (int e = 0; e < 4; ++e) o0[e] = cvtpk(bf_lo(r0[e]) * rstd * gn[2 * e], bf_hi(r0[e]) * rstd * gn[2 * e + 1]);
        *(u32x4*)p = o0;
    }
    for (int seq = gwa; seq < 32; seq += ngwa) {
        const int b = seq >> 2, h = seq & 3; const float bf = F.in(I_FOX_B_F)[h]; float v[32]; float run = 0.f;
#pragma unroll
        for (int i = 0; i < 32; ++i) { const float x = GL[(size_t)(b * T + 32 * lane + i) * LDG + 24 + h] + bf;
            const float ls = fminf(x, 0.f) - log1pf(__expf(-fabsf(x))); run += ls; v[i] = run; }
        float incl = run;
#pragma unroll
        for (int o = 1; o < 64; o <<= 1) { const float t = __shfl_up(incl, o); if (lane >= o) incl += t; }
        const float excl = incl - run; float* cp = (float*)(ws + WS_CUM) + (size_t)seq * T + 32 * lane;
#pragma unroll
        for (int i = 0; i < 32; ++i) cp[i] = v[i] + excl;
    }
}

constexpr int CW_COARSE = 16384;
constexpr int P6_WSTR = 136;
constexpr int P6_WBUF = 2 * 64 * P6_WSTR * 2;
static_assert(2 * P6_WBUF <= RING_BYTES, "P6 chunk buffers inside the ring region");
__device__ __forceinline__ void p6_router(Frame& F) {
    unsigned char* ws = F.ws; const int lane = F.lane, i16 = lane & 15, kg = lane >> 4, row = i16 & 7;
    unsigned char* H2 = (unsigned char*)(ws + WS_A3); const bf16_t* X1 = (const bf16_t*)(ws + WS_X1B); const float* gain = F.in(I_NORM_FFN_G);
    const bf16_t* Wg = (const bf16_t*)(ws + WS_WRT);
    const float rb = F.in(I_ROUTER_BIAS)[lane];
    unsigned* coarse = (unsigned*)(ws + WS_CTL) + CW_COARSE;
    if (F.gw == 0) {
#pragma unroll
        for (int q = 0; q < 2; ++q) *(u32x4*)(H2 + (size_t)M * D + 32 * lane + 16 * q) = (u32x4){0u, 0u, 0u, 0u}; }
    for (int item = blockIdx.x; item < M / 64; item += F.G) {
        const int tok0 = item * 64 + F.wave * 8;
        float myr = 0.f;
#pragma unroll 2
        for (int i = 0; i < 8; ++i) { const bf16_t* xr = X1 + (size_t)(tok0 + i) * D; float ss = 0.f;
#pragma unroll
            for (int j = 0; j < 4; ++j) { const u32x4 v = *(const u32x4*)(xr + 8 * lane + 512 * j);
#pragma unroll
                for (int e = 0; e < 4; ++e) ss += bf_lo(v[e]) * bf_lo(v[e]) + bf_hi(v[e]) * bf_hi(v[e]); }
            const float r = __builtin_amdgcn_rsqf(wave_sum(ss) * (1.f / D) + RMS_EPS); if (row == i) myr = r; }
        f32x4 acc[4] = {{0.f, 0.f, 0.f, 0.f}, {0.f, 0.f, 0.f, 0.f}, {0.f, 0.f, 0.f, 0.f}, {0.f, 0.f, 0.f, 0.f}};
        const bf16_t* xr = X1 + (size_t)(tok0 + row) * D + 8 * kg; unsigned char* hr = H2 + (size_t)(tok0 + row) * D + 8 * kg;
        u32x4 wst[4];
#define P6_LOADW(ch) do { _Pragma("unroll") for (int i = 0; i < 4; ++i) { const int p = F.tid + 512 * i; wst[i] = *(const u32x4*)(Wg + (size_t)(p >> 4) * D + 128 * (ch) + 8 * (p & 15)); } } while (0)
#define P6_STOREW(bf) do { _Pragma("unroll") for (int i = 0; i < 4; ++i) { const int p = F.tid + 512 * i; *(LAS u32x4*)(F.lds + (bf) * P6_WBUF + ((p >> 4) * P6_WSTR + 8 * (p & 15)) * 2) = wst[i]; } } while (0)
        P6_LOADW(0);
        __syncthreads();
        P6_STOREW(0);
        __syncthreads();
        for (int ch = 0; ch < 16; ++ch) {
            if (ch < 15) P6_LOADW(ch + 1);
            const LAS unsigned char* wb = F.lds + (ch & 1) * P6_WBUF + (i16 * P6_WSTR + 8 * kg) * 2;
#pragma unroll 2
            for (int s = 0; s < 4; ++s) { const int k = 128 * ch + 32 * s;
                const u32x4 xb = *(const u32x4*)(xr + k); const f32x4 g0 = *(const f32x4*)(gain + k + 8 * kg), g1 = *(const f32x4*)(gain + k + 8 * kg + 4);
                const float xn[8] = {bf_lo(xb.x) * myr * g0.x, bf_hi(xb.x) * myr * g0.y, bf_lo(xb.y) * myr * g0.z, bf_hi(xb.y) * myr * g0.w, bf_lo(xb.z) * myr * g1.x, bf_hi(xb.z) * myr * g1.y, bf_lo(xb.w) * myr * g1.z, bf_hi(xb.w) * myr * g1.w};
                u32x4 h, l;
#pragma unroll
                for (int q = 0; q < 4; ++q) { h[q] = cvtpk(xn[2 * q], xn[2 * q + 1]); l[q] = cvtpk(xn[2 * q] - bf_lo(h[q]), xn[2 * q + 1] - bf_hi(h[q])); }
                if (i16 < 8) *(u32x2*)(hr + k) = (u32x2){pk_fp8x4(xn[0], xn[1], xn[2], xn[3]), pk_fp8x4(xn[4], xn[5], xn[6], xn[7])};
                const bf16x8 ah = __builtin_bit_cast(bf16x8, h), al = __builtin_bit_cast(bf16x8, l);
#pragma unroll
                for (int nt = 0; nt < 4; ++nt) { const LAS unsigned char* wp = wb + (16 * nt * P6_WSTR + 32 * s) * 2;
                    const bf16x8 bh = *(const LAS bf16x8*)wp, bl = *(const LAS bf16x8*)(wp + 64 * P6_WSTR * 2);
                    acc[nt] = __builtin_amdgcn_mfma_f32_16x16x32_bf16(ah, bh, acc[nt], 0, 0, 0);
                    acc[nt] = __builtin_amdgcn_mfma_f32_16x16x32_bf16(al, bh, acc[nt], 0, 0, 0);
                    acc[nt] = __builtin_amdgcn_mfma_f32_16x16x32_bf16(ah, bl, acc[nt], 0, 0, 0); }
            }
            if (ch < 15) P6_STOREW((ch + 1) & 1);
            __syncthreads();
        }
#undef P6_LOADW
#undef P6_STOREW
        LAS float* lg = (LAS float*)(F.lds + F.wave * 4096);
        if (kg < 2) {
#pragma unroll
            for (int nt = 0; nt < 4; ++nt)
#pragma unroll
                for (int r = 0; r < 4; ++r) lg[(4 * kg + r) * 64 + 16 * nt + i16] = acc[nt][r]; }
        LDS_WAIT(); asm volatile("" ::: "memory");
        int cnt = 0;
        u32x2* asg = (u32x2*)(ws + WS_ASG);
        for (int tt = 0; tt < 8; ++tt) {
            const float sc = 1.f / (1.f + __expf(-lg[tt * 64 + lane])); const float key = sc + rb;
            lg[512 + lane] = key; LDS_WAIT(); asm volatile("" ::: "memory");
            int rank = 0;
#pragma unroll
            for (int q = 0; q < 16; ++q) { const f32x4 kk = *(const LAS f32x4*)(lg + 512 + 4 * q);
#pragma unroll
                for (int e = 0; e < 4; ++e) { const int eo = 4 * q + e; rank += (kk[e] > key || (kk[e] == key && eo < lane)) ? 1 : 0; } }
            LDS_WAIT(); asm volatile("" ::: "memory");
            const bool selx = rank < TOPK;
            const float ssum = wave_sum(selx ? sc : 0.f);
            const unsigned long long bal = __ballot(selx);
            if (selx) { const int k = __popcll(bal & ((1ull << lane) - 1ull));
                asg[(size_t)(tok0 + tt) * TOPK + k] = (u32x2){(unsigned)lane | ((unsigned)cnt << 8), __float_as_uint(sc / ssum * 2.5f)}; ++cnt; }
        }
        const int wi = item * 8 + F.wave;
        ((int*)(ws + WS_HIST))[wi * 64 + lane] = cnt;
        __hip_atomic_fetch_add(coarse + (wi >> 5) * 64 + lane, (unsigned)cnt, RLX_AGENT);
    }
}
__device__ __forceinline__ unsigned pack_rowg(int asg, float g) { const int q = (int)(g * 4096.f + 0.5f); return (unsigned)(asg + 1) | ((unsigned)(q > 16383 ? 16383 : q) << 18); }
__device__ __forceinline__ void p7_slots(Frame& F) {
    unsigned char* ws = F.ws; const int lane = F.lane;
    const int* hist = (const int*)(ws + WS_HIST); const u32x2* asg = (const u32x2*)(ws + WS_ASG); const unsigned* coarse = (const unsigned*)(ws + WS_CTL) + CW_COARSE;
    int* rowasg = (int*)(ws + WS_ROWASG); int* rowtok = (int*)(ws + WS_ROWTOK); float* rowg = (float*)(ws + WS_ROWG);
    for (int wi = F.gw; wi < M / 8; wi += F.NGW) {
        const int grp = wi >> 5; int base = 0, total = 0;
#pragma unroll 8
        for (int g = 0; g < 64; ++g) { const int cv = (int)coarse[g * 64 + lane]; total += cv; base += g < grp ? cv : 0; }
        for (int i = grp * 32; i < wi; ++i) base += hist[i * 64 + lane];
        const int padded = (total + 255) & ~255;
        int incl = padded;
#pragma unroll
        for (int o = 1; o < 64; o <<= 1) { const int t = __shfl_up(incl, o); if (lane >= o) incl += t; }
        const int pstart = incl - padded, rtot = __shfl(incl, 63);
        const int my = pstart + base;
        { const int tok = wi * 8 + (lane >> 3), k = lane & 7; const u32x2 rec = asg[(size_t)tok * TOPK + k];
          const int e = rec.x & 255, rl = rec.x >> 8; const int dest = __shfl(my, e) + rl;
          rowasg[dest] = tok * ASG_PER_TOK + k; rowtok[dest] = tok; rowg[dest] = __uint_as_float(pack_rowg(tok * ASG_PER_TOK + k, __uint_as_float(rec.y))); }
        if (lane < 8) { const int tok = wi * 8 + lane, dest = rtot + tok; rowasg[dest] = tok * ASG_PER_TOK + 8; rowtok[dest] = tok; rowg[dest] = __uint_as_float(pack_rowg(tok * ASG_PER_TOK + 8, 1.f)); }
        if (wi == 0) { for (int sl = pstart + total; sl < pstart + padded; ++sl) { rowasg[sl] = -1; rowtok[sl] = M; rowg[sl] = __uint_as_float(0u); }
                       ((int*)(ws + WS_CNT))[lane] = total; }
    }
}
__device__ __forceinline__ int build_blocks(Frame& F, LAS unsigned char* blk_e, LAS int* tmp) {
    const int* cnt = (const int*)(F.ws + WS_CNT);
    if (F.tid < NEX) tmp[F.tid] = F.tid < NE ? (cnt[F.tid] + 255) >> 8 : M / 256;
    __syncthreads();
    if (F.tid < NEX) { int st = 0; for (int e = 0; e < F.tid; ++e) st += tmp[e]; const int nb = tmp[F.tid]; for (int i = 0; i < nb; ++i) blk_e[st + i] = (unsigned char)F.tid; if (F.tid == NEX - 1) tmp[NEX] = st + nb; }
    __syncthreads();
    return tmp[NEX];
}
__device__ __forceinline__ void p10_combine(Frame& F) {
    const unsigned char* Y = (const unsigned char*)(F.ws + WS_Y); float* O = F.out; const bf16_t* X1 = (const bf16_t*)(F.ws + WS_X1B); const int lane = F.lane;
    for (int tok = F.gw; tok < M; tok += F.NGW) {
#pragma unroll
        for (int c = 0; c < 2; ++c) { const int col = 16 * lane + 1024 * c; float* op = O + (size_t)tok * D + col;
            const u32x4 xa = *(const u32x4*)(X1 + (size_t)tok * D + col), xb = *(const u32x4*)(X1 + (size_t)tok * D + col + 8);
            const f32x4 x0 = {bf_lo(xa.x), bf_hi(xa.x), bf_lo(xa.y), bf_hi(xa.y)}, x1 = {bf_lo(xa.z), bf_hi(xa.z), bf_lo(xa.w), bf_hi(xa.w)}, x2 = {bf_lo(xb.x), bf_hi(xb.x), bf_lo(xb.y), bf_hi(xb.y)}, x3 = {bf_lo(xb.z), bf_hi(xb.z), bf_lo(xb.w), bf_hi(xb.w)};
            u32x4 y[ASG_PER_TOK];
#pragma unroll
            for (int k = 0; k < ASG_PER_TOK; ++k) y[k] = *(const u32x4*)(Y + ((size_t)tok * ASG_PER_TOK + k) * D + col);
            float a[16];
#pragma unroll
            for (int e = 0; e < 16; ++e) a[e] = 0.f;
#pragma unroll
            for (int k = 0; k < ASG_PER_TOK; ++k)
#pragma unroll
                for (int q = 0; q < 4; ++q) { const auto lo = __builtin_amdgcn_cvt_pk_f32_fp8((int)y[k][q], false); const auto hi = __builtin_amdgcn_cvt_pk_f32_fp8((int)y[k][q], true);
                    a[4 * q] += lo[0]; a[4 * q + 1] += lo[1]; a[4 * q + 2] += hi[0]; a[4 * q + 3] += hi[1]; }
            const float r = 1.f / Y_SCALE;
            *(f32x4*)op = (f32x4){x0[0] + a[0] * r, x0[1] + a[1] * r, x0[2] + a[2] * r, x0[3] + a[3] * r};
            *(f32x4*)(op + 4) = (f32x4){x1[0] + a[4] * r, x1[1] + a[5] * r, x1[2] + a[6] * r, x1[3] + a[7] * r};
            *(f32x4*)(op + 8) = (f32x4){x2[0] + a[8] * r, x2[1] + a[9] * r, x2[2] + a[10] * r, x2[3] + a[11] * r};
            *(f32x4*)(op + 12) = (f32x4){x3[0] + a[12] * r, x3[1] + a[13] * r, x3[2] + a[14] * r, x3[3] + a[15] * r}; }
    }
}

constexpr int N_PHASES = 11;
struct Args { const float* in[31]; float* out; unsigned char* ws; int ph_lo, ph_hi, use_bar, pad; };
__global__ void __launch_bounds__(512, 2) mega(Args args) {
    extern __shared__ __attribute__((aligned(16))) unsigned char lds_raw[];
    LAS unsigned char* lds = (LAS unsigned char*)lds_raw;
    Frame F; F.lds = lds; F.tid = threadIdx.x; F.lane = F.tid & 63; F.wave = __builtin_amdgcn_readfirstlane(F.tid >> 6); F.G = gridDim.x;
    F.gw = blockIdx.x * 8 + F.wave; F.NGW = F.G * 8; F.out = args.out; F.ws = args.ws;
    unsigned char* ws = args.ws;
    unsigned* ctl = (unsigned*)(ws + WS_CTL);
    for (int u = F.tid; u < 256; u += 512) ((LAS unsigned*)(lds + LDSCTL_OFF))[u] = 0u;
    __syncthreads();
    XcdBarrier bar; bar.bar = ctl + CW_BAR; bar.x = 0; bar.st = nullptr;
    if (args.use_bar) bar = xcd_barrier_post(ctl + CW_BAR, (volatile LAS unsigned*)(lds + LDSCTL_OFF));
    const int lo = args.ph_lo, hi = args.ph_hi;
#ifndef PH_MASK
#define PH_MASK 0x7ff
#endif
#define IN(k) (((PH_MASK >> (k)) & 1) && lo <= (k) && (k) < hi)
#define SEAM(k) do { if (IN(k) && IN((k) + 1)) xcd_barrier(bar); } while (0)
    const int c = (int)blockIdx.x;
#ifndef REP_PHASE
#define REP_PHASE -1
#endif
#define RUN(k, ...) do { if (IN(k)) { const int rep = 0; (void)rep; __VA_ARGS__ } if (REP_PHASE == (k) && IN(k)) { xcd_barrier(bar); const int rep = 1; (void)rep; __VA_ARGS__ } } while (0)
    RUN(0, p0_prologue(F); ); SEAM(0);
    RUN(1,
        Epi1 E{(bf16_t*)(ws + WS_PA), (unsigned char*)(ws + WS_PG), (float*)(ws + WS_GL), (bf16_t*)(ws + WS_KVMEM)};
        { Sched1 S; S.o.init(64, NB16 ? NB16 : 1); S.A = (const char*)(ws + WS_A3); S.Bt = (const char*)(ws + WS_WINT); S.G = F.G; S.c = c; S.fp8 = 0;
          pg8::gemm_phase<Epi1, Sched1, false, false>(lds, 2 * D, 2 * D, S, E); }
        { Sched1 S; S.o.init(64, 24 + NF8); S.A = (const char*)(ws + WS_H8); S.Bt = (const char*)(ws + WS_WIN8); S.G = F.G; S.c = c; S.fp8 = 1;
          pg8::gemm_phase<Epi1, Sched1, false, true>(lds, D, D, S, E); }
    ); SEAM(1);
    RUN(2, p2_thin(F); ); SEAM(2);
    RUN(3,
        att::Tensors Tn{(const bf16_t*)(ws + WS_PA), (const float*)(ws + WS_GL), (const bf16_t*)(ws + WS_KVMEM), (const bf16_t*)(ws + WS_KC), (const bf16_t*)(ws + WS_VC), (const float*)(ws + WS_CUM),
                        (bf16_t*)(ws + WS_A3), F.in(I_NSA_Q_G), F.in(I_FOX_Q_G), F.in(I_MEM_Q_G), F.in(I_REL_BIAS)};
        att::attn_phase(F, (LAS char*)lds, Tn, ctl + CW_QUEUE + rep * 256);
    ); SEAM(3);
    RUN(4,
        Sched4 S; S.o.init(64, 8); S.A = (const char*)(ws + WS_A3); S.Bt = (const char*)(ws + WS_WOT); S.G = F.G; S.c = c;
        Epi4 E{(const unsigned char*)(ws + WS_PG), (bf16_t*)(ws + WS_PA)};
        pg8::gemm_phase<Epi4, Sched4, false>(lds, 2 * D, 2 * D, S, E);
    ); SEAM(4);
    RUN(5,
        Sched5 S; S.o.init(64, 8); S.A = (const char*)(ws + WS_PA); S.Bt = (const char*)(ws + WS_WOUTT); S.G = F.G; S.c = c;
        Epi5 E{F.in(I_X), (bf16_t*)(ws + WS_X1B)};
        pg8::gemm_phase<Epi5, Sched5, false>(lds, 2 * D, 2 * D, S, E);
    ); SEAM(5);
    RUN(6, p6_router(F); ); SEAM(6);
    RUN(7, p7_slots(F); ); SEAM(7);
    RUN(8,
        LAS unsigned char* blk_e = lds + EPI_OFF; LAS int* tmp = (LAS int*)(lds + EPI_OFF + 1024);
        const int nblk = build_blocks(F, blk_e, tmp);
        SchedMoe S{blk_e, nblk, F.G, c, 2, (const char*)(ws + WS_A3), (const char*)(ws + WS_WGU), (const int*)(ws + WS_ROWTOK), true};
        Epi8 E{(unsigned char*)(ws + WS_PG)};
        pg8::gemm_phase<Epi8, SchedMoe, true, true>(lds, D, D, S, E);
    ); SEAM(8);
    RUN(9,
        LAS unsigned char* blk_e = lds + EPI_OFF; LAS int* tmp = (LAS int*)(lds + EPI_OFF + 1024);
        const int nblk = build_blocks(F, blk_e, tmp);
        SchedMoe S{blk_e, nblk, F.G, c, 3, (const char*)(ws + WS_PG), (const char*)(ws + WS_WD), nullptr, false};
        Epi9 E{(const int*)(ws + WS_ROWASG), (const float*)(ws + WS_ROWG), (unsigned char*)(ws + WS_Y)};
        pg8::gemm_phase<Epi9, SchedMoe, false, true>(lds, DE, DE, S, E);
    ); SEAM(9);
    RUN(10, p10_combine(F); );
#undef RUN
#undef IN
#undef SEAM
}

#ifndef MK_PER_PHASE
#define MK_PER_PHASE 0
#endif
extern "C" void kernel_launch(void* const* d_in, const int* in_sizes, int n_in, void* d_out, int out_size, void* d_ws, size_t ws_size, hipStream_t stream) {
    static int grid = 0;
    if (grid == 0) {
        if (n_in != N_IN || in_sizes[0] != M * D || out_size != M * D || ws_size < WS_END) { fprintf(stderr, "kernel_launch: unexpected shapes (n_in %d, in0 %d, out %d, ws %zu; need ws >= %zu)\n", n_in, n_in > 0 ? in_sizes[0] : -1, out_size, ws_size, (size_t)WS_END); grid = -1; return; }
        int dev = 0, cus = 0, per_cu = 0;
        if (hipGetDevice(&dev) != hipSuccess || hipDeviceGetAttribute(&cus, hipDeviceAttributeMultiprocessorCount, dev) != hipSuccess) { grid = -1; return; }
        if (hipFuncSetAttribute((const void*)mega, hipFuncAttributeMaxDynamicSharedMemorySize, LDS_BYTES) != hipSuccess) { fprintf(stderr, "kernel_launch: hipFuncSetAttribute failed\n"); grid = -1; return; }
        if (hipOccupancyMaxActiveBlocksPerMultiprocessor(&per_cu, (const void*)mega, 512, LDS_BYTES) != hipSuccess || per_cu < 1) fprintf(stderr, "kernel_launch: occupancy query says %d\n", per_cu);
        (void)hipGetLastError();
        grid = cus;
    }
    if (grid < 0) return;
    (void)hipMemsetAsync((char*)d_ws + WS_CTL, 0, CTL_ZERO_BYTES, stream);
    Args a{};
    for (int i = 0; i < 31; ++i) a.in[i] = (const float*)d_in[i];
    a.out = (float*)d_out; a.ws = (unsigned char*)d_ws; a.pad = 0;
#if MK_PER_PHASE
    for (int p = 0; p < N_PHASES; ++p) { a.ph_lo = p; a.ph_hi = p + 1; a.use_bar = 0; hipLaunchKernelGGL(mega, dim3(grid), dim3(512), LDS_BYTES, stream, a); }
#else
    a.ph_lo = 0; a.ph_hi = N_PHASES; a.use_bar = 1; hipLaunchKernelGGL(mega, dim3(grid), dim3(512), LDS_BYTES, stream, a);
#endif
}
```
